# Optimizing an MI355X kernel written in HIP

```python
import math
import jax
import jax.numpy as jnp
from jax import lax
import numpy as np

D_MODEL = 1024
BATCH = 4
SEQ = 8192
DEPTH = 1
DEC_BATCH = 32
DEC_SEQ = 8
PAST_LEN = 16384
PAGE_SIZE = 128

N_Q_HEADS = D_MODEL // 128
N_KV_HEADS = max(1, N_Q_HEADS // 4)
GROUP = N_Q_HEADS // N_KV_HEADS
HEAD_DIM = 64
D_ATTN = N_Q_HEADS * HEAD_DIM
CMP_BLOCK = 32
CMP_STRIDE = 16
CMP_RATIO = CMP_BLOCK // CMP_STRIDE
SEL_BLOCK = 64
N_SEL = 16
WINDOW = 512
Q_BLOCK = 128
N_KV_SLOTS = 6
D_SSM = D_MODEL // 2
SSM_GROUP = 16
N_SSM_GROUPS = D_SSM // SSM_GROUP
SSM_STATE = 64
SSM_CHUNK = 256
DT_MIN = 0.001
DT_MAX = 0.1
RMS_EPS = 1e-6
PROJ_SPLITS = (D_ATTN, N_KV_SLOTS * N_KV_HEADS * HEAD_DIM, 3 * N_Q_HEADS, D_ATTN, D_SSM, D_SSM, 2 * D_MODEL)
D_IN = sum(PROJ_SPLITS)

kernel_name = 'nsa_s5_gated_hybrid_step'


def rmsnorm(x, g):
    xf = x.astype(jnp.float32)
    xf = xf * lax.rsqrt(jnp.mean(xf * xf, axis=-1, keepdims=True) + RMS_EPS)
    return xf.astype(x.dtype) * g


def masked_softmax(s, mask, axis):
    s = jnp.where(mask, s.astype(jnp.float32), -jnp.inf)
    m = jnp.max(s, axis=axis, keepdims=True)
    m = jnp.where(jnp.isfinite(m), m, 0.0)
    e = jnp.exp(s - m)
    return e / jnp.maximum(jnp.sum(e, axis=axis, keepdims=True), 1e-30)


def split_proj(p):
    B, L = p.shape[:2]
    idx = np.cumsum(PROJ_SPLITS)[:-1].tolist()
    q, kv, g_nsa, z_attn, u, z_ssm, g_merge = jnp.split(p, idx, axis=-1)
    q = q.reshape(B, L, N_KV_HEADS, GROUP, HEAD_DIM)
    kv = kv.reshape(B, L, N_KV_SLOTS, N_KV_HEADS, HEAD_DIM)
    g_nsa = jax.nn.sigmoid(g_nsa).reshape(B, L, N_KV_HEADS, GROUP, 3)
    g_merge = jax.nn.sigmoid(g_merge).reshape(B, L, 2, D_MODEL)
    return q, kv, g_nsa, z_attn, u, z_ssm, g_merge


def compress(x, pe, w1, b1, w2):
    B, T = x.shape[:2]
    n_ch = -(-T // CMP_STRIDE)
    x = jnp.pad(x, ((0, 0), (0, n_ch * CMP_STRIDE - T), (0, 0), (0, 0)))
    ch = x.reshape(B, n_ch, CMP_STRIDE, N_KV_HEADS, HEAD_DIM)
    pe = pe.reshape(CMP_RATIO, CMP_STRIDE, 1, HEAD_DIM)
    w1 = w1.reshape(CMP_RATIO, CMP_STRIDE, HEAD_DIM, HEAD_DIM)
    n_cmp = n_ch - CMP_RATIO + 1
    hid = b1
    for r in range(CMP_RATIO):
        hid = hid + jnp.einsum('bnjhd,jde->bnhe', ch[:, r:r + n_cmp] + pe[r], w1[r])
    return jnp.einsum('bnhe,ed->bnhd', jax.nn.gelu(hid), w2)


def cmp_to_sel(n_cmp, n_sel):
    c0 = jnp.arange(n_cmp)[:, None] * CMP_STRIDE
    s0 = jnp.arange(n_sel)[None, :] * SEL_BLOCK
    shared = jnp.minimum(c0 + CMP_BLOCK, s0 + SEL_BLOCK) - jnp.maximum(c0, s0)
    return jnp.clip(shared, 0, None).astype(jnp.float32) / CMP_BLOCK


def nsa_attention(q, gates, full, win, q_pos0, cmp_pe, cmp_w1, cmp_b1, cmp_w2):
    B, L = q.shape[:2]
    T = full.shape[1]
    kc = compress(full[:, :, 0], cmp_pe[0], cmp_w1[0], cmp_b1[0], cmp_w2[0])
    vc = compress(full[:, :, 1], cmp_pe[1], cmp_w1[1], cmp_b1[1], cmp_w2[1])
    n_cmp = kc.shape[1]
    cmp_end = jnp.arange(n_cmp) * CMP_STRIDE + (CMP_BLOCK - 1)
    n_sel = -(-T // SEL_BLOCK)
    sel = jnp.pad(full[:, :, 2:4], ((0, 0), (0, n_sel * SEL_BLOCK - T), (0, 0), (0, 0), (0, 0)))
    sel = sel.reshape(B, n_sel, SEL_BLOCK, 2, N_KV_HEADS, HEAD_DIM)
    ks_blk = jnp.transpose(sel[:, :, :, 0], (0, 3, 1, 2, 4))
    vs_blk = jnp.transpose(sel[:, :, :, 1], (0, 3, 1, 2, 4))
    cmp_sel = cmp_to_sel(n_cmp, n_sel)
    k_top = min(N_SEL, n_sel)
    blk = jnp.arange(n_sel)
    bi = jnp.arange(B)[:, None, None, None]
    hi = jnp.arange(N_KV_HEADS)[None, None, :, None]
    qb = math.gcd(L, Q_BLOCK)
    scale = HEAD_DIM ** -0.5

    def one_block(i):
        q0 = i * qb
        qi = lax.dynamic_slice_in_dim(q, q0, qb, axis=1) * scale
        gi = lax.dynamic_slice_in_dim(gates, q0, qb, axis=1)
        qpos = q_pos0 + q0 + jnp.arange(qb)
        s = jnp.einsum('bqhgd,bnhd->bqhgn', qi, kc)
        p_c = masked_softmax(s, (cmp_end[None, :] <= qpos[:, None])[None, :, None, None, :], -1)
        o_c = jnp.einsum('bqhgn,bnhd->bqhgd', p_c.astype(vc.dtype), vc)
        imp = jnp.einsum('bqhgn,nj->bqhj', p_c, cmp_sel)
        forced = (blk[None, :] == 0) | (blk[None, :] == (qpos // SEL_BLOCK)[:, None])
        causal = blk[None, :] * SEL_BLOCK <= qpos[:, None]
        imp = jnp.where(forced[None, :, None, :], jnp.inf,
                        jnp.where(causal[None, :, None, :], imp, -jnp.inf))
        top_v, top_i = lax.top_k(imp, k_top)
        kg = ks_blk[bi, hi, top_i]
        vg = vs_blk[bi, hi, top_i]
        kpos = top_i[..., None] * SEL_BLOCK + jnp.arange(SEL_BLOCK)
        mask_s = (top_v > -jnp.inf)[..., None] & (kpos <= qpos[None, :, None, None, None])
        s = jnp.einsum('bqhgd,bqhksd->bqhgks', qi, kg)
        p_s = masked_softmax(s, mask_s[:, :, :, None], (-2, -1))
        o_s = jnp.einsum('bqhgks,bqhksd->bqhgd', p_s.astype(vg.dtype), vg)
        wi = lax.dynamic_slice_in_dim(win, q0, WINDOW + qb, axis=1)
        kpos_w = q_pos0 - WINDOW + q0 + jnp.arange(WINDOW + qb)
        dist = qpos[:, None] - kpos_w[None, :]
        mask_w = (kpos_w[None, :] >= 0) & (dist >= 0) & (dist < WINDOW)
        s = jnp.einsum('bqhgd,bkhd->bqhgk', qi, wi[:, :, 0])
        p_w = masked_softmax(s, mask_w[None, :, None, None, :], -1)
        o_w = jnp.einsum('bqhgk,bkhd->bqhgd', p_w.astype(wi.dtype), wi[:, :, 1])
        return gi[..., 0:1] * o_c + gi[..., 1:2] * o_s + gi[..., 2:3] * o_w

    out = lax.map(one_block, jnp.arange(L // qb))
    return jnp.moveaxis(out, 0, 1).reshape(B, L, D_ATTN)


def s5_scan(u, h_re, h_im, lam_re, lam_im, log_dt, b_re, b_im, c_re, c_im):
    f32 = jnp.float32
    u, h_re, h_im = u.astype(f32), h_re.astype(f32), h_im.astype(f32)
    lam_re, lam_im = lam_re.astype(f32), lam_im.astype(f32)
    b_re, b_im, c_re, c_im = b_re.astype(f32), b_im.astype(f32), c_re.astype(f32), c_im.astype(f32)
    dt = jnp.exp(log_dt.astype(f32))[:, None]
    mag = jnp.exp(lam_re * dt)
    a_re = mag * jnp.cos(lam_im * dt)
    a_im = mag * jnp.sin(lam_im * dt)
    den = lam_re * lam_re + lam_im * lam_im
    f_re = ((a_re - 1.0) * lam_re + a_im * lam_im) / den
    f_im = (a_im * lam_re - (a_re - 1.0) * lam_im) / den
    bb_re = f_re[..., None] * b_re - f_im[..., None] * b_im
    bb_im = f_re[..., None] * b_im + f_im[..., None] * b_re
    B, L = u.shape[:2]
    tc = math.gcd(L, SSM_CHUNK)
    uc = jnp.swapaxes(u.reshape(B, L // tc, tc, N_SSM_GROUPS, SSM_GROUP), 0, 1)

    def combine(e1, e2):
        a1r, a1i, b1r, b1i = e1
        a2r, a2i, b2r, b2i = e2
        return (a2r * a1r - a2i * a1i, a2r * a1i + a2i * a1r,
                a2r * b1r - a2i * b1i + b2r, a2r * b1i + a2i * b1r + b2i)

    def step(carry, u_t):
        hr, hi = carry
        bu_re = jnp.einsum('btgc,gpc->btgp', u_t, bb_re)
        bu_im = jnp.einsum('btgc,gpc->btgp', u_t, bb_im)
        ar = jnp.broadcast_to(a_re, bu_re.shape)
        ai = jnp.broadcast_to(a_im, bu_re.shape)
        cr, ci, sr, si = lax.associative_scan(combine, (ar, ai, bu_re, bu_im), axis=1)
        hr_t = sr + cr * hr[:, None] - ci * hi[:, None]
        hi_t = si + cr * hi[:, None] + ci * hr[:, None]
        y = jnp.einsum('btgp,gcp->btgc', hr_t, c_re) - jnp.einsum('btgp,gcp->btgc', hi_t, c_im)
        return (hr_t[:, -1], hi_t[:, -1]), y

    (h_re, h_im), ys = lax.scan(step, (h_re, h_im), uc)
    return jnp.swapaxes(ys, 0, 1).reshape(B, L, N_SSM_GROUPS, SSM_GROUP), h_re, h_im


def mixer(q, full, win, g_nsa, z_attn, u, z_ssm, g_merge, q_pos0, h_re, h_im, lw):
    (cmp_pe, cmp_w1, cmp_b1, cmp_w2, lam_re, lam_im, log_dt, b_re, b_im, c_re, c_im,
     d_skip, w_glu, b_glu, w_lift_attn, w_lift_ssm, w_out) = lw
    B, L = u.shape[:2]
    o_attn = nsa_attention(q, g_nsa, full, win, q_pos0, cmp_pe, cmp_w1, cmp_b1, cmp_w2)
    branch_a = (o_attn * jax.nn.silu(z_attn)) @ w_lift_attn
    y, h_re, h_im = s5_scan(u.reshape(B, L, N_SSM_GROUPS, SSM_GROUP), h_re, h_im,
                            lam_re, lam_im, log_dt, b_re, b_im, c_re, c_im)
    y = y.reshape(B, L, D_SSM).astype(u.dtype) + d_skip * u
    y = jax.nn.gelu(y)
    y = y * jax.nn.sigmoid(y @ w_glu + b_glu)
    branch_b = (y * jax.nn.silu(z_ssm)) @ w_lift_ssm
    merged = g_merge[:, :, 0] * branch_a + g_merge[:, :, 1] * branch_b
    return merged @ w_out, h_re, h_im


def setup_inputs(seed: int = 0) -> dict:
    key = jax.random.key(seed)
    ks = jax.random.split(key, 32)
    f32 = jnp.float32
    n_pages = PAST_LEN // PAGE_SIZE
    n_used = DEC_BATCH * n_pages
    n_phys = n_used + max(1, n_used // 4)
    w_buf = min(WINDOW, PAST_LEN)

    def nrm(k, shape, s):
        return s * jax.random.normal(k, shape, f32)

    page_table = jax.random.permutation(ks[6], n_phys)[:n_used].reshape(DEC_BATCH, n_pages).astype(jnp.int32)
    lam_im = math.pi * jnp.arange(SSM_STATE, dtype=f32) + nrm(ks[13], (DEPTH, N_SSM_GROUPS, SSM_STATE), 0.01)
    return {
        'x_prompt': nrm(ks[0], (BATCH, SEQ, D_MODEL), 1.0),
        'x_sample': nrm(ks[1], (DEC_BATCH, DEC_SEQ, D_MODEL), 1.0),
        'cache_kv': nrm(ks[2], (DEPTH, n_phys, PAGE_SIZE, 4, N_KV_HEADS, HEAD_DIM), 1.0),
        'cache_win_kv': nrm(ks[3], (DEPTH, DEC_BATCH, w_buf, 2, N_KV_HEADS, HEAD_DIM), 1.0),
        'state_ssm_re': nrm(ks[4], (DEPTH, DEC_BATCH, N_SSM_GROUPS, SSM_STATE), 0.1),
        'state_ssm_im': nrm(ks[5], (DEPTH, DEC_BATCH, N_SSM_GROUPS, SSM_STATE), 0.1),
        'page_table': page_table,
        'norm_g': 1.0 + nrm(ks[7], (DEPTH, D_MODEL), 0.01),
        'w_in': nrm(ks[8], (DEPTH, D_MODEL, D_IN), D_MODEL ** -0.5),
        'cmp_pe': nrm(ks[9], (DEPTH, 2, CMP_BLOCK, HEAD_DIM), 0.02),
        'cmp_w1': nrm(ks[10], (DEPTH, 2, CMP_BLOCK, HEAD_DIM, HEAD_DIM), (CMP_BLOCK * HEAD_DIM) ** -0.5),
        'cmp_b1': nrm(ks[11], (DEPTH, 2, HEAD_DIM), 0.01),
        'cmp_w2': nrm(ks[12], (DEPTH, 2, HEAD_DIM, HEAD_DIM), HEAD_DIM ** -0.5),
        'ssm_lam_re': -0.5 + nrm(ks[14], (DEPTH, N_SSM_GROUPS, SSM_STATE), 0.01),
        'ssm_lam_im': lam_im,
        'ssm_log_dt': jax.random.uniform(ks[15], (DEPTH, N_SSM_GROUPS), f32, math.log(DT_MIN), math.log(DT_MAX)),
        'ssm_b_re': nrm(ks[16], (DEPTH, N_SSM_GROUPS, SSM_STATE, SSM_GROUP), (2 * SSM_GROUP) ** -0.5),
        'ssm_b_im': nrm(ks[17], (DEPTH, N_SSM_GROUPS, SSM_STATE, SSM_GROUP), (2 * SSM_GROUP) ** -0.5),
        'ssm_c_re': nrm(ks[18], (DEPTH, N_SSM_GROUPS, SSM_GROUP, SSM_STATE), SSM_STATE ** -0.5),
        'ssm_c_im': nrm(ks[19], (DEPTH, N_SSM_GROUPS, SSM_GROUP, SSM_STATE), SSM_STATE ** -0.5),
        'ssm_d': nrm(ks[20], (DEPTH, D_SSM), 1.0),
        'w_glu': nrm(ks[21], (DEPTH, D_SSM, D_SSM), D_SSM ** -0.5),
        'b_glu': nrm(ks[22], (DEPTH, D_SSM), 0.01),
        'w_lift_attn': nrm(ks[23], (DEPTH, D_ATTN, D_MODEL), D_ATTN ** -0.5),
        'w_lift_ssm': nrm(ks[24], (DEPTH, D_SSM, D_MODEL), D_SSM ** -0.5),
        'w_out': nrm(ks[25], (DEPTH, D_MODEL, D_MODEL), D_MODEL ** -0.5),
        'final_g': 1.0 + nrm(ks[26], (D_MODEL,), 0.01),
    }


def reference(x_prompt, x_sample, cache_kv, cache_win_kv, state_ssm_re, state_ssm_im, page_table,
              norm_g, w_in, cmp_pe, cmp_w1, cmp_b1, cmp_w2, ssm_lam_re, ssm_lam_im, ssm_log_dt,
              ssm_b_re, ssm_b_im, ssm_c_re, ssm_c_im, ssm_d, w_glu, b_glu, w_lift_attn, w_lift_ssm,
              w_out, final_g):
    past_len = page_table.shape[1] * cache_kv.shape[2]
    w_buf = cache_win_kv.shape[2]
    xp, xs = x_prompt, x_sample
    Bp, Lp = xp.shape[:2]
    Bs, Ls = xs.shape[:2]
    kvp, winp, srp, sip = [], [], [], []
    kvs, wins, srs, sis = [], [], [], []
    for l in range(DEPTH):
        lw = (cmp_pe[l], cmp_w1[l], cmp_b1[l], cmp_w2[l], ssm_lam_re[l], ssm_lam_im[l], ssm_log_dt[l],
              ssm_b_re[l], ssm_b_im[l], ssm_c_re[l], ssm_c_im[l], ssm_d[l], w_glu[l], b_glu[l],
              w_lift_attn[l], w_lift_ssm[l], w_out[l])
        q, kv, g_nsa, z_a, u, z_s, g_m = split_proj(rmsnorm(xp, norm_g[l]) @ w_in[l])
        win = jnp.pad(kv[:, :, 4:], ((0, 0), (WINDOW, 0), (0, 0), (0, 0), (0, 0)))
        h0 = jnp.zeros((Bp, N_SSM_GROUPS, SSM_STATE), jnp.float32)
        y, hr, hi = mixer(q, kv[:, :, :4], win, g_nsa, z_a, u, z_s, g_m, 0, h0, h0, lw)
        xp = xp + y
        kvp.append(kv[:, :, :4])
        winp.append(kv[:, Lp - min(WINDOW, Lp):, 4:])
        srp.append(hr)
        sip.append(hi)
        q, kv, g_nsa, z_a, u, z_s, g_m = split_proj(rmsnorm(xs, norm_g[l]) @ w_in[l])
        past = cache_kv[l][page_table].reshape(Bs, past_len, 4, N_KV_HEADS, HEAD_DIM)
        full = jnp.concatenate([past, kv[:, :, :4]], axis=1)
        buf = jnp.concatenate([cache_win_kv[l], kv[:, :, 4:]], axis=1)
        win = jnp.pad(buf, ((0, 0), (WINDOW - w_buf, 0), (0, 0), (0, 0), (0, 0)))
        y, hr, hi = mixer(q, full, win, g_nsa, z_a, u, z_s, g_m, past_len,
                          state_ssm_re[l], state_ssm_im[l], lw)
        xs = xs + y
        kvs.append(kv[:, :, :4])
        n_keep = min(WINDOW, w_buf + Ls)
        wins.append(buf[:, buf.shape[1] - n_keep:])
        srs.append(hr)
        sis.append(hi)
    y_prompt = rmsnorm(xp, final_g)
    y_sample = rmsnorm(xs, final_g)
    kv_prompt = jnp.stack(kvp)
    win_prompt = jnp.stack(winp)
    ssm_re_prompt = jnp.stack(srp)
    ssm_im_prompt = jnp.stack(sip)
    kv_sample = jnp.stack(kvs)
    win_sample = jnp.stack(wins)
    ssm_re_sample = jnp.stack(srs)
    ssm_im_sample = jnp.stack(sis)
    return (y_prompt, y_sample, kv_prompt, win_prompt, ssm_re_prompt, ssm_im_prompt,
            kv_sample, win_sample, ssm_re_sample, ssm_im_sample)
```

```cpp
#include <hip/hip_runtime.h>
#include <cstdio>
#include <cstdint>
namespace pg8 {
#define PG8_LAS __attribute__((address_space(3)))
typedef unsigned short bf16_t;
typedef short bf16x8 __attribute__((ext_vector_type(8)));
typedef float f32x4 __attribute__((ext_vector_type(4)));
typedef unsigned u32x4 __attribute__((ext_vector_type(4)));
constexpr int BM = 256, BK = 64, HALF = 128, HTB = HALF * BK * 2  , STAGE_BYTES = 8 * HTB, NXCD = 8, WGM = 8;

__host__ __device__ __forceinline__ int lds_byte(int r, int c) { const int st = (r >> 4) * 2 + (c >> 5), rr = r & 15, cc = c & 31, ob = rr * 64 + cc * 2; return st * 1024 + (ob ^ (((ob >> 9) & 1) << 5)); }
__host__ __device__ __forceinline__ void stage_rc(int b, int& R, int& C) { const int st = b / 1024, sb = b % 1024, swz = sb ^ (((sb >> 9) & 1) << 5); R = (st >> 1) * 16 + swz / 64; C = (st & 1) * 32 + (swz % 64) / 2; }
__host__ __device__ __forceinline__ int perm32(int rho) { const int n = rho >> 4, i = rho & 15; return 8 * (i >> 2) + 4 * n + (i & 3); }

struct Unit { int pm, pn, part; };
struct Gemm { const bf16_t* A; const bf16_t* Bt; int M, N, K; const bf16_t* A2; const bf16_t* Bt2; };

struct StaticOrder {
    int nM, nN, nwg, G, c;
    __host__ __device__ void init(int M, int N, int G_, int c_) { nM = M / BM; nN = N / BM; nwg = nM * nN; G = G_; c = c_; }
    __host__ __device__ bool next(int i, Unit& u) const {
        const long L = (long)i * G + c; if (L >= nwg) return false;
        int wgid = (int)L; { const int q = nwg / NXCD, r = nwg % NXCD, xcd = wgid % NXCD, off = wgid / NXCD; wgid = (xcd < r ? xcd * (q + 1) : r * (q + 1) + (xcd - r) * q) + off; }
        const int nig = WGM * nN, gid = wgid / nig, fm = gid * WGM, gsz = (nM - fm) < WGM ? (nM - fm) : WGM;
        u.pm = fm + ((wgid % nig) % gsz); u.pn = (wgid % nig) / gsz; u.part = 0; return true;
    }
    __device__ __forceinline__ void a_ready(const Unit&) const {}
    __device__ __forceinline__ void done(const Unit&) const {}
};
struct PairOrder : StaticOrder {
    __host__ __device__ bool next(int i, Unit& u) const { if (!StaticOrder::next(i >> 1, u)) return false; u.part = i & 1; return true; }
};

__device__ __forceinline__ unsigned cvt_pk_bf16(float lo, float hi) { unsigned r; asm volatile("v_cvt_pk_bf16_f32 %0, %1, %2" : "=v"(r) : "v"(lo), "v"(hi)); return r; }
typedef float f32x2 __attribute__((ext_vector_type(2)));
__device__ __forceinline__ f32x2 gelu_pk(f32x2 v) {
    const f32x2 av = __builtin_elementwise_abs(v), d = av * 0.2316418882f + 1.0f;
    f32x2 t; t.x = __builtin_amdgcn_rcpf(d.x); t.y = __builtin_amdgcn_rcpf(d.y);
    f32x2 q = t * 0.5307027145f + (-0.7265760135f); q = q * t + 0.7107068705f; q = q * t + (-0.142248368f); q = q * t + 0.127414796f; q = q * t;
    const f32x2 s = (v * v) * (-0.72134752044f);
    f32x2 e; e.x = __builtin_amdgcn_exp2f(s.x); e.y = __builtin_amdgcn_exp2f(s.y);
    const f32x2 m = v * (q * e), r = v - m;
    f32x2 o; o.x = v.x < 0.f ? m.x : r.x; o.y = v.y < 0.f ? m.y : r.y; return o;
}

__device__ __forceinline__ float sigm(float x) { return 1.0f / (1.0f + __expf(-x)); }
__device__ __forceinline__ f32x4 sigm4(f32x4 v) { return (f32x4){sigm(v[0]), sigm(v[1]), sigm(v[2]), sigm(v[3])}; }

struct EpiF32 {
    static constexpr bool PERM = false, AFTER_DRAIN = false, TWO_PART = false;
    float* C; int ldc;
    __device__ __forceinline__ void operator()(const f32x4 (&acc)[2][2][4][2], const Unit& u, int wr, int wc, int fr, int fq) const {
        const int row0 = u.pm * BM + wr * 64 + fr, col0 = u.pn * BM + wc * 32 + 4 * fq;
#pragma unroll
        for (int ai = 0; ai < 2; ++ai)
#pragma unroll
            for (int m = 0; m < 4; ++m) { float* rowp = C + (size_t)(row0 + ai * HALF + m * 16) * ldc + col0;
#pragma unroll
                for (int bj = 0; bj < 2; ++bj)
#pragma unroll
                    for (int n = 0; n < 2; ++n) *(f32x4*)(rowp + bj * HALF + n * 16) = acc[ai][bj][m][n]; }
    }
};
__device__ __forceinline__ f32x4 bfx4(unsigned lo, unsigned hi) { return (f32x4){__uint_as_float(lo << 16), __uint_as_float(lo & 0xffff0000u), __uint_as_float(hi << 16), __uint_as_float(hi & 0xffff0000u)}; }
__device__ __forceinline__ u32x4 pack8f(f32x4 v0, f32x4 v1) { u32x4 w; w.x = cvt_pk_bf16(v0[0], v0[1]); w.y = cvt_pk_bf16(v0[2], v0[3]); w.z = cvt_pk_bf16(v1[0], v1[1]); w.w = cvt_pk_bf16(v1[2], v1[3]); return w; }
struct EpiIn {
    static constexpr bool PERM = true, AFTER_DRAIN = false, TWO_PART = false;
    bf16_t *QB, *KVB, *SZA, *SZS, *GM, *XC; float *U32, *GN, *out; float qscale; int mp;
    size_t o_kvp, o_kvs, o_winp, o_wins, xc_prow0;
    __device__ __forceinline__ void operator()(const f32x4 (&acc)[2][2][4][2], const Unit& u, int wr, int wc, int fr, int fq) const {
        const int row0 = u.pm * BM + wr * 64 + fr, pn = u.pn; const bool prm = u.pm * BM < mp;
#pragma unroll
        for (int ai = 0; ai < 2; ++ai)
#pragma unroll
            for (int m = 0; m < 4; ++m) { const size_t row = (size_t)(row0 + ai * HALF + m * 16);
#pragma unroll
                for (int bj = 0; bj < 2; ++bj) { const int c = pn * BM + bj * HALF + wc * 32 + 8 * fq; const f32x4 v0 = acc[ai][bj][m][0], v1 = acc[ai][bj][m][1];
                    if (pn < 2) { *(u32x4*)(QB + row * 512 + c) = pack8f(v0 * qscale, v1 * qscale); }
                    else if (pn < 5) { const int kc = c - 512, slot = kc >> 7;
                        *(u32x4*)(KVB + row * 768 + kc) = pack8f(v0, v1);
                        if (slot < 4) { float* d = out + (prm ? o_kvp + row * 512 : o_kvs + (row - mp) * 512) + kc; *(f32x4*)d = v0; *(f32x4*)(d + 4) = v1;
 }
                        else { const int wk = kc - 512;
                            if (prm) { const int t = (int)(row & 8191); if (t >= 7680) { float* d = out + o_winp + ((row >> 13) * 512 + (t - 7680)) * 256 + wk; *(f32x4*)d = v0; *(f32x4*)(d + 4) = v1; } }
                            else { const size_t q = row - mp; float* d = out + o_wins + ((q >> 3) * 512 + 504 + (q & 7)) * 256 + wk; *(f32x4*)d = v0; *(f32x4*)(d + 4) = v1; } } }
                    else if (pn < 7) { *(u32x4*)(SZA + row * 512 + (c - 1280)) = pack8f(v0 * sigm4(v0), v1 * sigm4(v1)); }
                    else if (pn < 9) { float* d = U32 + row * 512 + (c - 1792); *(f32x4*)d = v0; *(f32x4*)(d + 4) = v1; }
                    else if (pn < 11) { *(u32x4*)(SZS + row * 512 + (c - 2304)) = pack8f(v0 * sigm4(v0), v1 * sigm4(v1)); }
                    else if (pn < 19) { *(u32x4*)(GM + row * 2048 + (c - 2816)) = pack8f(sigm4(v0), sigm4(v1)); }
                    else if (c < 4888) { float* d = GN + row * 32 + (c - 4864); *(f32x4*)d = sigm4(v0); *(f32x4*)(d + 4) = sigm4(v1); } } }
    }
};
struct EpiGlu {
    static constexpr bool PERM = true, AFTER_DRAIN = false, TWO_PART = false;
    bf16_t* O; const bf16_t* Y1B; const bf16_t* SZS; const float* bias;
    __device__ __forceinline__ void operator()(const f32x4 (&acc)[2][2][4][2], const Unit& u, int wr, int wc, int fr, int fq) const {
        const int row0 = u.pm * BM + wr * 64 + fr, col0 = u.pn * BM + wc * 32 + 8 * fq;
#pragma unroll
        for (int ai = 0; ai < 2; ++ai)
#pragma unroll
            for (int m = 0; m < 4; ++m) { const size_t row = (size_t)(row0 + ai * HALF + m * 16);
#pragma unroll
                for (int bj = 0; bj < 2; ++bj) { const int c = col0 + bj * HALF;
                    const f32x4 b0 = *(const f32x4*)(bias + c), b1 = *(const f32x4*)(bias + c + 4);
                    const u32x4 yy = *(const u32x4*)(Y1B + row * 512 + c); const f32x4 y0 = bfx4(yy.x, yy.y), y1 = bfx4(yy.z, yy.w);
                    const u32x4 zz = *(const u32x4*)(SZS + row * 512 + c);
                    *(u32x4*)(O + row * 512 + c) = pack8f(y0 * sigm4(acc[ai][bj][m][0] + b0) * bfx4(zz.x, zz.y), y1 * sigm4(acc[ai][bj][m][1] + b1) * bfx4(zz.z, zz.w)); } }
    }
};
struct EpiLift2 {
    static constexpr bool PERM = true, AFTER_DRAIN = false, TWO_PART = true;
    bf16_t* O; const bf16_t* GM;
    __device__ __forceinline__ void mid(f32x4 (&acc)[2][2][4][2], const Unit& u, int wr, int wc, int fr, int fq) const {
        const int row0 = u.pm * BM + wr * 64 + fr, col0 = u.pn * BM + wc * 32 + 8 * fq;
#pragma unroll
        for (int ai = 0; ai < 2; ++ai)
#pragma unroll
            for (int m = 0; m < 4; ++m) { const size_t row = (size_t)(row0 + ai * HALF + m * 16);
#pragma unroll
                for (int bj = 0; bj < 2; ++bj) { const int c = col0 + bj * HALF; const u32x4 ga = *(const u32x4*)(GM + row * 2048 + c), gb = *(const u32x4*)(GM + row * 2048 + 1024 + c);
                    const f32x4 a0 = bfx4(ga.x, ga.y), a1 = bfx4(ga.z, ga.w), b0 = bfx4(gb.x, gb.y), b1 = bfx4(gb.z, gb.w);
#pragma unroll
                    for (int j = 0; j < 4; ++j) { acc[ai][bj][m][0][j] *= b0[j] * __builtin_amdgcn_rcpf(fmaxf(a0[j], 1e-30f)); acc[ai][bj][m][1][j] *= b1[j] * __builtin_amdgcn_rcpf(fmaxf(a1[j], 1e-30f)); } } }
    }
    __device__ __forceinline__ void operator()(const f32x4 (&acc)[2][2][4][2], const Unit& u, int wr, int wc, int fr, int fq) const {
        const int row0 = u.pm * BM + wr * 64 + fr, col0 = u.pn * BM + wc * 32 + 8 * fq;
#pragma unroll
        for (int ai = 0; ai < 2; ++ai)
#pragma unroll
            for (int m = 0; m < 4; ++m) { const size_t row = (size_t)(row0 + ai * HALF + m * 16);
#pragma unroll
                for (int bj = 0; bj < 2; ++bj) { const int c = col0 + bj * HALF; const u32x4 ga = *(const u32x4*)(GM + row * 2048 + c);
                    *(u32x4*)(O + row * 1024 + c) = pack8f(bfx4(ga.x, ga.y) * acc[ai][bj][m][0], bfx4(ga.z, ga.w) * acc[ai][bj][m][1]); } }
    }
};
struct EpiOut {
    static constexpr bool PERM = true, AFTER_DRAIN = false, TWO_PART = false;
    bf16_t* O; const float* xp; const float* xs; int mp;
    __device__ __forceinline__ void operator()(const f32x4 (&acc)[2][2][4][2], const Unit& u, int wr, int wc, int fr, int fq) const {
        const int row0 = u.pm * BM + wr * 64 + fr, col0 = u.pn * BM + wc * 32 + 8 * fq;
        const float* xb = (u.pm * BM < mp) ? xp : (xs - (size_t)mp * 1024);
#pragma unroll
        for (int ai = 0; ai < 2; ++ai)
#pragma unroll
            for (int m = 0; m < 4; ++m) { const size_t row = (size_t)(row0 + ai * HALF + m * 16);
#pragma unroll
                for (int bj = 0; bj < 2; ++bj) { const int c = col0 + bj * HALF;
                    const f32x4 x0 = *(const f32x4*)(xb + row * 1024 + c), x1 = *(const f32x4*)(xb + row * 1024 + c + 4);
                    *(u32x4*)(O + row * 1024 + c) = pack8f(x0 + acc[ai][bj][m][0], x1 + acc[ai][bj][m][1]); } }
    }
};

template <class Epi, class Sched, bool ALIGN_EPI = false, bool SP2 = false>
__device__ __forceinline__ void gemm_phase(PG8_LAS unsigned char* lds, const Gemm g, const Sched& S, const Epi& E, const int tid_in) {
    const int tid = tid_in, wid = __builtin_amdgcn_readfirstlane(tid >> 6), lane = tid & 63, wr = wid >> 2, wc = wid & 3, fr = lane & 15, fq = lane >> 4;
    const int K = g.K, nt = K / BK;
    unsigned voffA[2], voffB[2];
#pragma unroll
    for (int i = 0; i < 2; ++i) { int R, C; stage_rc(tid * 16 + i * 8192, R, C); const int Rb = Epi::PERM ? ((R & ~31) + perm32(R & 31)) : R;
        voffA[i] = (unsigned)(R * K + C) * 2u; voffB[i] = (unsigned)(Rb * K + C) * 2u; }
    const size_t kstep = (size_t)(BK * 2);
    const size_t hstep = (size_t)HALF * K * 2;
    const size_t tstep = 2 * hstep;
    const unsigned ldsw = (unsigned)wid * 1024u;
    const int aoff = lds_byte(wr * 64 + fr, fq * 8), boff = lds_byte(wc * 32 + fr, fq * 8);
#define PG8_SA(b, h) (((b) * 2 + (h)) * HTB)
#define PG8_SB(b, h) ((4 + (b) * 2 + (h)) * HTB)
#define PG8_STAGE(bufoff, gbase, voff) do { _Pragma("unroll") for (int _i = 0; _i < 2; ++_i) \
        __builtin_amdgcn_global_load_lds((const unsigned*)((const char*)(gbase) + (voff)[_i]), (PG8_LAS unsigned*)(lds + (bufoff) + ldsw + _i * 8192), 16, 0, 0); } while (0)
#define PG8_LDA(dst, b, h) do { _Pragma("unroll") for (int m = 0; m < 4; ++m) _Pragma("unroll") for (int k = 0; k < 2; ++k) dst[m][k] = *(const PG8_LAS bf16x8*)(lds + PG8_SA(b, h) + aoff + m * 2048 + k * 1024); } while (0)
#define PG8_LDB(dst, b, h) do { _Pragma("unroll") for (int n = 0; n < 2; ++n) _Pragma("unroll") for (int k = 0; k < 2; ++k) dst[n][k] = *(const PG8_LAS bf16x8*)(lds + PG8_SB(b, h) + boff + n * 2048 + k * 1024); } while (0)
#define PG8_MMA(ai, bj, At, Bt) do { __builtin_amdgcn_s_setprio(1); _Pragma("unroll") for (int m = 0; m < 4; ++m) _Pragma("unroll") for (int n = 0; n < 2; ++n) _Pragma("unroll") for (int k = 0; k < 2; ++k) \
        acc[ai][bj][m][n] = __builtin_amdgcn_mfma_f32_16x16x32_bf16(Bt[n][k], At[m][k], acc[ai][bj][m][n], 0, 0, 0); __builtin_amdgcn_s_setprio(0); } while (0)
#define PG8_WAIT_V(n) asm volatile("s_waitcnt vmcnt(" #n ")" ::: "memory")
#define PG8_WAIT_L(n) asm volatile("s_waitcnt lgkmcnt(" #n ")" ::: "memory")
#define PG8_BAR __builtin_amdgcn_s_barrier()
#define PG8_SCHED __builtin_amdgcn_sched_barrier(0)
    Unit cur, nxt; int ui = 0;
    if (!S.next(0, cur)) return;
    f32x4 acc[2][2][4][2];
#pragma unroll
    for (int a = 0; a < 2; ++a)
#pragma unroll
        for (int b = 0; b < 2; ++b)
#pragma unroll
            for (int m = 0; m < 4; ++m)
#pragma unroll
                for (int n = 0; n < 2; ++n) acc[a][b][m][n] = (f32x4){0.f, 0.f, 0.f, 0.f};
    bf16x8 At[4][2], B0[2][2], B1[2][2];
    const char* cA = (const char*)((Epi::TWO_PART && cur.part) ? g.A2 : g.A) + (size_t)cur.pm * tstep; const char* cB = (const char*)((Epi::TWO_PART && cur.part) ? g.Bt2 : g.Bt) + (size_t)cur.pn * tstep;
    S.a_ready(cur);
    if constexpr (SP2) {
        PG8_STAGE(PG8_SB(0, 0), cB, voffB); PG8_STAGE(PG8_SB(0, 1), cB + hstep, voffB); PG8_STAGE(PG8_SA(0, 0), cA, voffA); PG8_STAGE(PG8_SA(0, 1), cA + hstep, voffA);
        if (wr == 1) PG8_BAR;
        PG8_WAIT_V(2); PG8_BAR;
        PG8_STAGE(PG8_SB(1, 0), cB + kstep, voffB); PG8_STAGE(PG8_SA(1, 0), cA + kstep, voffA); PG8_STAGE(PG8_SB(1, 1), cB + hstep + kstep, voffB);
        PG8_WAIT_V(6); PG8_BAR;
    } else {
        PG8_STAGE(PG8_SB(0, 0), cB, voffB); PG8_STAGE(PG8_SA(0, 0), cA, voffA); PG8_STAGE(PG8_SB(0, 1), cB + hstep, voffB); PG8_STAGE(PG8_SA(0, 1), cA + hstep, voffA);
        if (wr == 1) PG8_BAR;
        PG8_WAIT_V(4); PG8_BAR;
        PG8_STAGE(PG8_SB(1, 0), cB + kstep, voffB); PG8_STAGE(PG8_SA(1, 0), cA + kstep, voffA); PG8_STAGE(PG8_SB(1, 1), cB + hstep + kstep, voffB);
        PG8_WAIT_V(6); PG8_BAR;
    }
    for (;;) {
        const bool has_next = S.next(ui + 1, nxt);
        const char* nA = has_next ? (const char*)((Epi::TWO_PART && nxt.part) ? g.A2 : g.A) + (size_t)nxt.pm * tstep : cA; const char* nB = has_next ? (const char*)((Epi::TWO_PART && nxt.part) ? g.Bt2 : g.Bt) + (size_t)nxt.pn * tstep : cB;
        for (int t = 0; t < nt; t += 2) {
            const bool last = (t == nt - 2);
            const char* a1 = cA + (size_t)(t + 1) * kstep;
            const char* a2 = last ? nA : cA + (size_t)(t + 2) * kstep; const char* b2 = last ? nB : cB + (size_t)(t + 2) * kstep;
            const char* a3 = a2 + kstep; const char* b3 = b2 + kstep;
            if (last && has_next) S.a_ready(nxt);
            if constexpr (SP2) {
            PG8_LDB(B0, 0, 0); PG8_LDB(B1, 0, 1); PG8_SCHED; PG8_LDA(At, 0, 0); PG8_STAGE(PG8_SA(1, 1), a1 + hstep, voffA);
            PG8_WAIT_V(8); PG8_WAIT_L(0); PG8_BAR; PG8_MMA(0, 0, At, B0); PG8_MMA(0, 1, At, B1); PG8_BAR; PG8_SCHED;
            PG8_LDA(At, 0, 1); PG8_STAGE(PG8_SB(0, 0), b2, voffB); PG8_STAGE(PG8_SB(0, 1), b2 + hstep, voffB); PG8_STAGE(PG8_SA(0, 0), a2, voffA);
            PG8_WAIT_V(8); PG8_WAIT_L(0); PG8_BAR; PG8_MMA(1, 0, At, B0); PG8_MMA(1, 1, At, B1); PG8_BAR; PG8_SCHED;
            PG8_LDB(B0, 1, 0); PG8_LDB(B1, 1, 1); PG8_SCHED; PG8_LDA(At, 1, 0); PG8_STAGE(PG8_SA(0, 1), a2 + hstep, voffA);
            PG8_WAIT_V(8); PG8_WAIT_L(0); PG8_BAR; PG8_MMA(0, 0, At, B0); PG8_MMA(0, 1, At, B1); PG8_BAR; PG8_SCHED;
            PG8_LDA(At, 1, 1); PG8_STAGE(PG8_SB(1, 0), b3, voffB); PG8_STAGE(PG8_SB(1, 1), b3 + hstep, voffB); PG8_STAGE(PG8_SA(1, 0), a3, voffA);
            PG8_WAIT_V(8); PG8_WAIT_L(0); PG8_BAR; PG8_MMA(1, 0, At, B0); PG8_MMA(1, 1, At, B1); PG8_BAR; PG8_SCHED;
            } else {
            PG8_LDB(B0, 0, 0); PG8_SCHED; PG8_LDA(At, 0, 0); PG8_STAGE(PG8_SA(1, 1), a1 + hstep, voffA);
            PG8_WAIT_L(8); PG8_BAR; PG8_WAIT_L(0); PG8_MMA(0, 0, At, B0); PG8_BAR; PG8_SCHED;
            PG8_LDB(B1, 0, 1); PG8_STAGE(PG8_SB(0, 0), b2, voffB);
            PG8_BAR; PG8_WAIT_L(0); PG8_MMA(0, 1, At, B1); PG8_BAR;
            PG8_LDA(At, 0, 1); PG8_STAGE(PG8_SA(0, 0), a2, voffA);
            PG8_BAR; PG8_WAIT_L(0); PG8_MMA(1, 0, At, B0); PG8_BAR; PG8_SCHED;
            PG8_STAGE(PG8_SB(0, 1), b2 + hstep, voffB);
            PG8_WAIT_V(6); PG8_BAR; PG8_MMA(1, 1, At, B1); PG8_BAR;
            PG8_LDB(B0, 1, 0); PG8_SCHED; PG8_LDA(At, 1, 0); PG8_STAGE(PG8_SA(0, 1), a2 + hstep, voffA);
            PG8_WAIT_L(8); PG8_BAR; PG8_WAIT_L(0); PG8_MMA(0, 0, At, B0); PG8_BAR; PG8_SCHED;
            PG8_LDB(B1, 1, 1); PG8_STAGE(PG8_SB(1, 0), b3, voffB);
            PG8_BAR; PG8_WAIT_L(0); PG8_MMA(0, 1, At, B1); PG8_BAR;
            PG8_LDA(At, 1, 1); PG8_STAGE(PG8_SA(1, 0), a3, voffA);
            PG8_BAR; PG8_WAIT_L(0); PG8_MMA(1, 0, At, B0); PG8_BAR; PG8_SCHED;
            PG8_STAGE(PG8_SB(1, 1), b3 + hstep, voffB);
            PG8_WAIT_V(6); PG8_BAR; PG8_MMA(1, 1, At, B1); PG8_BAR;
            }
        }
        if constexpr (ALIGN_EPI) { if (wr == 0) PG8_BAR; }
        bool keep_acc = false;
        if constexpr (Epi::TWO_PART) { if (cur.part == 0) { E.mid(acc, cur, wr, wc, fr, fq); keep_acc = true; } else { E(acc, cur, wr, wc, fr, fq); } }
        else if constexpr (!Epi::AFTER_DRAIN) { E(acc, cur, wr, wc, fr, fq); S.done(cur); }
        if (!has_next) break;
        if (!keep_acc)
#pragma unroll
        for (int a = 0; a < 2; ++a)
#pragma unroll
            for (int b = 0; b < 2; ++b)
#pragma unroll
                for (int m = 0; m < 4; ++m)
#pragma unroll
                    for (int n = 0; n < 2; ++n) acc[a][b][m][n] = (f32x4){0.f, 0.f, 0.f, 0.f};
        cur = nxt; cA = nA; cB = nB; ++ui;
        if constexpr (ALIGN_EPI) { if (wr == 1) PG8_BAR; }
    }
    PG8_WAIT_V(0);
    if constexpr (!ALIGN_EPI) { if (wr == 0) PG8_BAR; }
    PG8_BAR;
    if constexpr (Epi::AFTER_DRAIN) { E.fused(acc, cur, wr, wc, fr, fq, lds, wid, lane); S.done(cur); }
#undef PG8_SA
#undef PG8_SB
#undef PG8_STAGE
#undef PG8_LDA
#undef PG8_LDB
#undef PG8_MMA
#undef PG8_WAIT_V
#undef PG8_WAIT_L
#undef PG8_BAR
#undef PG8_SCHED
}
}
#define LAS __attribute__((address_space(3)))
#define XB_TMO      128
#define XB_XCNT(j)  (256  + 64 * (j))
#define XB_XSUB(j)  (1280 + 64 * (j))
#define XB_XGEN(j)  (2304 + 64 * (j))
#define XB_TOP      3328
#define XB_TOPGEN   3392
#define XCD_BAR_WORDS 3456
#define XB_SPIN_CAP (1u << 18)

__device__ __forceinline__ unsigned xb_ld(unsigned* p)              { return __hip_atomic_load(p, __ATOMIC_RELAXED, __HIP_MEMORY_SCOPE_AGENT); }
__device__ __forceinline__ unsigned xb_add(unsigned* p, unsigned v) { return __hip_atomic_fetch_add(p, v, __ATOMIC_RELAXED, __HIP_MEMORY_SCOPE_AGENT); }
__device__ __forceinline__ unsigned xb_xcc_id() { return (unsigned)__builtin_amdgcn_s_getreg((3 << 11) | 20) & 0xFu; }
#define XB_SPIN(cond, bar) do { unsigned _sp = 0; while (cond) { __builtin_amdgcn_s_sleep(1); \
    if ((++_sp & 255u) == 0u) { if (xb_ld(&(bar)[XB_TMO])) break; if (_sp > XB_SPIN_CAP) { atomicAdd(&(bar)[XB_TMO], 1u); break; } } } } while (0)

struct XcdBarrier {
    unsigned* bar; unsigned x;
    volatile LAS unsigned* st;
};

__device__ __forceinline__ XcdBarrier xcd_barrier_post(unsigned* bar, volatile LAS unsigned* st, const int tid) {
    XcdBarrier b; b.bar = bar; b.x = xb_xcc_id(); b.st = st;
    if (tid == 0) (void)xb_add(&bar[XB_XCNT(b.x)], 1u);
    return b;
}
__device__ __forceinline__ void xcd_barrier_complete(unsigned* bar, unsigned x, unsigned& nloc, unsigned& nx) {
    const unsigned G = gridDim.x * gridDim.y * gridDim.z;
    unsigned sum, cnt, mine, sp = 0u;
    for (;;) {
        sum = 0u; cnt = 0u; mine = 0u;
#pragma unroll
        for (unsigned j = 0; j < 16; ++j) { const unsigned c = xb_ld(&bar[XB_XCNT(j)]); sum += c; cnt += (c > 0u) ? 1u : 0u; mine = (j == x) ? c : mine; }
        if (sum == G) break;
        __builtin_amdgcn_s_sleep(1);
        if ((++sp & 255u) == 0u) { if (xb_ld(&bar[XB_TMO])) break; if (sp > XB_SPIN_CAP) { atomicAdd(&bar[XB_TMO], 1u); break; } }
    }
    nloc = mine > 0u ? mine : 1u; nx = cnt > 0u ? cnt : 1u;
}

__device__ __forceinline__ void xcd_barrier(const XcdBarrier& b, const int tid) {
    asm volatile("s_waitcnt vmcnt(0)" ::: "memory");
    __syncthreads();
    if (tid == 0) {
        unsigned* bar = b.bar;
        __builtin_amdgcn_s_waitcnt(0);
        unsigned nloc = b.st[0], nx = b.st[1];
        if (nloc == 0u) { xcd_barrier_complete(bar, b.x, nloc, nx); b.st[0] = nloc; b.st[1] = nx; }
        const unsigned old = xb_add(&bar[XB_XSUB(b.x)], 1u);
        const unsigned gen = old / nloc;
        if (old + 1u == (gen + 1u) * nloc) {
            __builtin_amdgcn_fence(__ATOMIC_RELEASE, "agent");
            asm volatile("s_waitcnt vmcnt(0)" ::: "memory");
            const unsigned og = xb_add(&bar[XB_TOP], 1u);
            const unsigned tg = og / nx;
            if (og + 1u == (tg + 1u) * nx) xb_add(&bar[XB_TOPGEN], 1u);
            else XB_SPIN(xb_ld(&bar[XB_TOPGEN]) == tg, bar);
            __builtin_amdgcn_fence(__ATOMIC_ACQUIRE, "agent");
            xb_add(&bar[XB_XGEN(b.x)], 1u);
            asm volatile("s_waitcnt vmcnt(0)" ::: "memory");
        } else {
            XB_SPIN(xb_ld(&bar[XB_XGEN(b.x)]) == gen, bar);
            __builtin_amdgcn_fence(__ATOMIC_ACQUIRE, "agent");
            asm volatile("s_waitcnt vmcnt(0)" ::: "memory");
        }
    }
    __syncthreads();
}


constexpr int D = 1024, BP = 4, LP = 8192, BS = 32, LS = 8, PAST = 16384, PAGE = 128, NPAGE = 128;
constexpr int MP = BP * LP, MS = BS * LS, MT = MP + MS;
constexpr int HD = 64, DATT = 512, DSSM = 512, NG = 32, NST = 64;
constexpr int NIN = 4888, NINP = 5120;
constexpr int C_Q = 0, C_KV = 512, C_ZA = 1280, C_U = 1792, C_ZS = 2304, C_GM = 2816, C_GN = 4864;
constexpr int NCS = 1024, NCP = 512;
constexpr int XC_S_ROWS = BS * 2 * 2 * NCS, XC_P_ROWS = BP * 2 * 2 * NCP, XC_ROWS = XC_S_ROWS + XC_P_ROWS;
constexpr int CH = 128, NCHK = LP / CH;
constexpr float RMS_EPS = 1e-6f;
constexpr size_t O_YP = 0, O_YS = 33554432, O_KVP = 33816576, O_WINP = 50593792, O_SRP = 51118080, O_SIP = 51126272, O_KVS = 51134464, O_WINS = 51265536, O_SRS = 55459840, O_SIS = 55525376, O_END = 55590912;
constexpr size_t MiB = 1u << 20;
constexpr size_t WS_CTL = 0, CTL_ZERO_BYTES = 1 * MiB;
constexpr size_t WS_WTIN = 1 * MiB, WS_WTGLU = 11 * MiB, WS_WTLA = 12 * MiB, WS_WTLS = 13 * MiB, WS_WTOUT = 14 * MiB, WS_WTC1 = 16 * MiB, WS_CONST = 17 * MiB, WS_SEND = 20 * MiB  ;
constexpr size_t WS_KC = 20 * MiB, WS_VC = 38 * MiB, WS_XN = 64 * MiB, WS_OA = 130 * MiB, WS_Y1B = 164 * MiB, WS_YB = 198 * MiB, WS_MG = 232 * MiB, WS_Y1 = 298 * MiB, WS_MB = 364 * MiB;
constexpr size_t WS_PP = 494 * MiB, WS_XC = 632 * MiB, WS_KVB = 904 * MiB, WS_SZA = 956 * MiB, WS_U32 = 992 * MiB, WS_SZS = 1060 * MiB, WS_GM = 1096 * MiB, WS_GN = 1228 * MiB;
constexpr size_t WS_QB = 1552 * MiB, WS_KSB = 1586 * MiB, WS_KWB = 1596 * MiB, WS_VST = 1606 * MiB, WS_VWT = 1614 * MiB, WS_KCB = 1622 * MiB, WS_VCT = 1623 * MiB, WS_KCBS = 1624 * MiB, WS_VCBS = 1632 * MiB, WS_END = 1640 * MiB;
constexpr int K_CB = 0  , K_CBP = 80000  , K_ARE = 256, K_AIM = K_ARE + 2048, K_ALRE = K_AIM + 2048, K_ALIM = K_ALRE + 2048, K_BBRE = K_ALIM + 2048, K_BBIM = K_BBRE + 32768;
constexpr size_t WS_SSMCF = WS_CONST + 512 * 1024;
constexpr size_t WS_SSMW = 632 * MiB;
constexpr size_t WS_TEND = WS_CONST + 1 * MiB;
constexpr size_t WS_YPB = 364 * MiB;
constexpr int CW_BAR = 4096;
constexpr int LDS_BYTES = 163840, MISC_OFF = LDS_BYTES - 256;
constexpr int NWAVES = 8;


typedef unsigned short bf16;
typedef unsigned v4u __attribute__((ext_vector_type(4)));
typedef unsigned v2u __attribute__((ext_vector_type(2)));
typedef float f32x4 __attribute__((ext_vector_type(4)));
#define LDS_FENCE() asm volatile("s_waitcnt lgkmcnt(0)" ::: "memory")
__device__ __forceinline__ unsigned f2bf(float f) { unsigned u = __builtin_bit_cast(unsigned, f); return (u + 0x7fffu + ((u >> 16) & 1u)) >> 16; }
__device__ __forceinline__ unsigned pk2(float lo, float hi) { return f2bf(lo) | (f2bf(hi) << 16); }
__device__ __forceinline__ float wave_sum(float v) {
#pragma unroll
    for (int o = 1; o < 64; o <<= 1) v += __shfl_xor(v, o);
    return v; }
__device__ __forceinline__ float wave_max(float v) {
#pragma unroll
    for (int o = 1; o < 64; o <<= 1) v = fmaxf(v, __shfl_xor(v, o));
    return v; }
__device__ __forceinline__ float sigmf(float x) { return 1.0f / (1.0f + __expf(-x)); }
__device__ __forceinline__ float gelu_t(float x) { const float u = 1.5957691216f * (x + 0.044715f * x * x * x); return x / (1.0f + __expf(-u)); }

struct Ctx {
    LAS unsigned char* lds; int tid, lane, wave, G, gw, NGW;
    const float *xp, *xs, *cache_kv, *cache_win, *st_re, *st_im; const int* page_table;
    const float *norm_g, *w_in, *cmp_pe, *cmp_w1, *cmp_b1, *cmp_w2, *lam_re, *lam_im, *log_dt, *b_re, *b_im, *c_re, *c_im, *ssm_d, *w_glu, *b_glu, *w_la, *w_ls, *w_out, *final_g;
    float* out; unsigned char* ws;
    bf16 *WTIN, *WTGLU, *WTLA, *WTLS, *WTOUT, *WTC1, *XN, *OA, *Y1B, *YB, *MG, *XC, *QB, *KSB, *KWB, *VST, *VWT, *KCB, *VCT, *KCBS, *VCBS, *KVB, *SZA, *SZS, *GM;
    float *KST, *SEND, *KC, *VC, *Y1, *MB, *PP, *U32, *GN;
};

__device__ __forceinline__ void transpose_item(const float* W, int ldw, int nvalid, int nblk, int K, bf16* WT, int row_off, LAS float* scr, int item, int lane) {
    const int kb = item / nblk, nb = item % nblk, k0 = 64 * kb, n0 = 32 * nb;
    const int n = n0 + (lane & 31);
#pragma unroll 8
    for (int i = 0; i < 32; ++i) { const int kk = 2 * i + (lane >> 5); scr[kk * 33 + (lane & 31)] = (n < nvalid) ? W[(size_t)(k0 + kk) * ldw + n] : 0.f; }
    LDS_FENCE();
    const int c = lane & 7;
#pragma unroll
    for (int j = 0; j < 4; ++j) { const int nn = (lane >> 3) + 8 * j; const LAS float* s = scr + (8 * c) * 33 + nn;
        v4u o; o.x = pk2(s[0 * 33], s[1 * 33]); o.y = pk2(s[2 * 33], s[3 * 33]); o.z = pk2(s[4 * 33], s[5 * 33]); o.w = pk2(s[6 * 33], s[7 * 33]);
        *(v4u*)(WT + (size_t)(row_off + n0 + nn) * K + k0 + 8 * c) = o; }
    LDS_FENCE();
}
__device__ __forceinline__ void rms_row_to_bf16(const float* xrow, const float* g, bf16* orow, int lane) {
    const f32x4* xr = (const f32x4*)xrow + lane; const f32x4* gr = (const f32x4*)g + lane;
    f32x4 v[4]; float s = 0.f;
#pragma unroll
    for (int j = 0; j < 4; ++j) { v[j] = xr[64 * j]; s += (v[j].x * v[j].x + v[j].y * v[j].y) + (v[j].z * v[j].z + v[j].w * v[j].w); }
    const float r = rsqrtf(wave_sum(s) * (1.f / D) + RMS_EPS);
    v2u* o8 = (v2u*)orow + lane;
#pragma unroll
    for (int j = 0; j < 4; ++j) { const f32x4 gg = gr[64 * j]; v2u o; o.x = pk2(v[j].x * r * gg.x, v[j].y * r * gg.y); o.y = pk2(v[j].z * r * gg.z, v[j].w * r * gg.w); o8[64 * j] = o; }
}
__device__ __forceinline__ void xc_chunk(const float* src0, size_t rstride, bf16* XC, size_t rowbase  , size_t hstride, size_t sstride, int lane) {
    const int col = 4 * lane, slot = col >> 7, h = (col >> 6) & 1, d = col & 63;
    bf16* dst = XC + (rowbase + (size_t)h * hstride + (size_t)slot * sstride) * 1024 + d;
#pragma unroll 4
    for (int j = 0; j < 16; ++j) { const f32x4 v = *(const f32x4*)(src0 + (size_t)j * rstride + col); v2u o; o.x = pk2(v.x, v.y); o.y = pk2(v.z, v.w); *(v2u*)(dst + j * 64) = o; }
}
__device__ __forceinline__ void p0_prep(const Ctx& C) {
    LAS float* scr = (LAS float*)(C.lds + C.wave * 16384);
    constexpr int I_IN = 16 * 160, I_GLU = 8 * 16, I_LA = 8 * 32, I_LS = 8 * 32, I_OUT = 16 * 32, I_C1 = 16 * 2;
    constexpr int NIT = I_IN + I_GLU + I_LA + I_LS + I_OUT + 4 * I_C1;
    for (int it = C.gw; it < NIT; it += C.NGW) {
        int r = it;
        if (r < I_IN) { const int nb = r % 160, n0 = 32 * nb;
            const int src0 = n0 < 1280 ? n0 : (n0 < 4864 ? n0 + 24 : 1280), nv = n0 < 4864 ? 32 : (n0 == 4864 ? 24 : 0);
            transpose_item(C.w_in + src0 - n0, NIN, n0 + nv, 160, 1024, C.WTIN, 0, scr, r, C.lane); continue; } r -= I_IN;
        if (r < I_GLU) { transpose_item(C.w_glu, 512, 512, 16, 512, C.WTGLU, 0, scr, r, C.lane); continue; } r -= I_GLU;
        if (r < I_LA) { transpose_item(C.w_la, 1024, 1024, 32, 512, C.WTLA, 0, scr, r, C.lane); continue; } r -= I_LA;
        if (r < I_LS) { transpose_item(C.w_ls, 1024, 1024, 32, 512, C.WTLS, 0, scr, r, C.lane); continue; } r -= I_LS;
        if (r < I_OUT) { transpose_item(C.w_out, 1024, 1024, 32, 1024, C.WTOUT, 0, scr, r, C.lane); continue; } r -= I_OUT;
        { const int q = r / I_C1, s = q >> 1, rr = q & 1;
          transpose_item(C.cmp_w1 + (size_t)(s * 32 + rr * 16) * 4096, 64, 64, 2, 1024, C.WTC1, s * 128 + rr * 64, scr, r % I_C1, C.lane); }
    }
    for (int m0 = C.gw; m0 < MT; m0 += 2 * C.NGW) {
        const int m1 = m0 + C.NGW < MT ? m0 + C.NGW : m0;
        const float* x0 = m0 < MP ? C.xp + (size_t)m0 * D : C.xs + (size_t)(m0 - MP) * D; const float* x1 = m1 < MP ? C.xp + (size_t)m1 * D : C.xs + (size_t)(m1 - MP) * D;
        f32x4 va[4], vb[4]; float sa = 0.f, sb = 0.f;
#pragma unroll
        for (int j = 0; j < 4; ++j) { va[j] = ((const f32x4*)x0)[C.lane + 64 * j]; vb[j] = ((const f32x4*)x1)[C.lane + 64 * j]; }
#pragma unroll
        for (int j = 0; j < 4; ++j) { sa += (va[j].x * va[j].x + va[j].y * va[j].y) + (va[j].z * va[j].z + va[j].w * va[j].w); sb += (vb[j].x * vb[j].x + vb[j].y * vb[j].y) + (vb[j].z * vb[j].z + vb[j].w * vb[j].w); }
        const float ra = rsqrtf(wave_sum(sa) * (1.f / D) + RMS_EPS), rb = rsqrtf(wave_sum(sb) * (1.f / D) + RMS_EPS);
#pragma unroll
        for (int j = 0; j < 4; ++j) { const f32x4 gg = ((const f32x4*)C.norm_g)[C.lane + 64 * j];
            v2u o; o.x = pk2(va[j].x * ra * gg.x, va[j].y * ra * gg.y); o.y = pk2(va[j].z * ra * gg.z, va[j].w * ra * gg.w); ((v2u*)(C.XN + (size_t)m0 * D))[C.lane + 64 * j] = o;
            if (m1 != m0) { v2u o1; o1.x = pk2(vb[j].x * rb * gg.x, vb[j].y * rb * gg.y); o1.y = pk2(vb[j].z * rb * gg.z, vb[j].w * rb * gg.w); ((v2u*)(C.XN + (size_t)m1 * D))[C.lane + 64 * j] = o1; } }
    }
    for (int j = C.gw * 64 + C.lane; j < NG * NST * 16; j += C.NGW * 64) {
        const int i = j >> 4, c = j & 15, g = i >> 6;
        const double dt = exp((double)C.log_dt[g]), lr = (double)C.lam_re[i], li = (double)C.lam_im[i];
        const double mag = exp(lr * dt), ar = mag * cos(li * dt), ai = mag * sin(li * dt);
        const double den = lr * lr + li * li, fr = ((ar - 1.0) * lr + ai * li) / den, fi = (ai * lr - (ar - 1.0) * li) / den;
        if (c == 0) { const double magL = exp(lr * dt * CH), aLr = magL * cos(li * dt * CH), aLi = magL * sin(li * dt * CH);
            C.KST[K_ARE + i] = (float)ar; C.KST[K_AIM + i] = (float)ai; C.KST[K_ALRE + i] = (float)aLr; C.KST[K_ALIM + i] = (float)aLi; }
        const double br = (double)C.b_re[i * 16 + c], bi = (double)C.b_im[i * 16 + c];
        C.KST[K_BBRE + i * 16 + c] = (float)(fr * br - fi * bi); C.KST[K_BBIM + i * 16 + c] = (float)(fr * bi + fi * br);
        { bf16* CF = (bf16*)(C.ws + WS_SSMCF); const int pp = i & 63; const size_t o = ((size_t)g * 16 + c) * 128 + 2 * pp;
          CF[o] = (bf16)f2bf(C.c_re[((size_t)g * 16 + c) * 64 + pp]); CF[o + 1] = (bf16)f2bf(-C.c_im[((size_t)g * 16 + c) * 64 + pp]); }
    }
    for (int j = ((C.gw + C.NGW - 512) % C.NGW) * 64 + C.lane; j < NG * NST * (CH / 8); j += C.NGW * 64) {
        const int tb = j & (CH / 8 - 1), i = j >> 4, g = i >> 6, pp = i & 63;
        const double dt = exp((double)C.log_dt[g]), lr = (double)C.lam_re[i], li = (double)C.lam_im[i];
        const double mag = exp(lr * dt), ar = mag * cos(li * dt), ai = mag * sin(li * dt);
        const double den = lr * lr + li * li, fr = ((ar - 1.0) * lr + ai * li) / den, fi = (ai * lr - (ar - 1.0) * li) / den;
        const double dd = (double)(CH - 8 - 8 * tb), magd = exp(lr * dt * dd), pr = magd * cos(li * dt * dd), pi = magd * sin(li * dt * dd);
        double gr = pr * fr - pi * fi, gi = pr * fi + pi * fr;
        bf16* W0 = (bf16*)(C.ws + WS_SSMW); const size_t olo = (size_t)NG * 128 * 2048;
#pragma unroll 1
        for (int tt = 7; tt >= 0; --tt) {
            unsigned hr[8], hi_[8], lr_[8], li_[8];
#pragma unroll
            for (int c2 = 0; c2 < 8; ++c2) { unsigned vh[2][2], vl[2][2];
#pragma unroll
                for (int e = 0; e < 2; ++e) { const int c = 2 * c2 + e; const double br = (double)C.b_re[i * 16 + c], bi = (double)C.b_im[i * 16 + c];
                    const float wr = (float)(gr * br - gi * bi), wi = (float)(gr * bi + gi * br);
                    const unsigned h0 = f2bf(wr), h1 = f2bf(wi);
                    vh[0][e] = h0; vh[1][e] = h1; vl[0][e] = f2bf(wr - __uint_as_float(h0 << 16)); vl[1][e] = f2bf(wi - __uint_as_float(h1 << 16)); }
                hr[c2] = vh[0][0] | (vh[0][1] << 16); hi_[c2] = vh[1][0] | (vh[1][1] << 16); lr_[c2] = vl[0][0] | (vl[0][1] << 16); li_[c2] = vl[1][0] | (vl[1][1] << 16); }
            const size_t ore = ((size_t)g * 128 + pp) * 2048 + (8 * tb + tt) * 16, oim = ore + (size_t)64 * 2048;
            *(v4u*)(W0 + ore) = (v4u){hr[0], hr[1], hr[2], hr[3]}; *(v4u*)(W0 + ore + 8) = (v4u){hr[4], hr[5], hr[6], hr[7]};
            *(v4u*)(W0 + oim) = (v4u){hi_[0], hi_[1], hi_[2], hi_[3]}; *(v4u*)(W0 + oim + 8) = (v4u){hi_[4], hi_[5], hi_[6], hi_[7]};
            *(v4u*)(W0 + olo + ore) = (v4u){lr_[0], lr_[1], lr_[2], lr_[3]}; *(v4u*)(W0 + olo + ore + 8) = (v4u){lr_[4], lr_[5], lr_[6], lr_[7]};
            *(v4u*)(W0 + olo + oim) = (v4u){li_[0], li_[1], li_[2], li_[3]}; *(v4u*)(W0 + olo + oim + 8) = (v4u){li_[4], li_[5], li_[6], li_[7]};
            const double ngr = gr * ar - gi * ai, ngi = gr * ai + gi * ar; gr = ngr; gi = ngi;
        }
    }
    for (int it = C.gw - 64; it >= 0 && it < 64; it += C.NGW) { const int s = it >> 5, part = it & 31;
        float acc = (part == 0) ? C.cmp_b1[s * 64 + C.lane] : 0.f;
#pragma unroll 16
        for (int k = part * 64; k < part * 64 + 64; ++k) acc += C.cmp_pe[s * 2048 + k] * C.cmp_w1[(size_t)s * 131072 + (size_t)k * 64 + C.lane];
        C.KST[K_CBP + (s * 32 + part) * 64 + C.lane] = acc;
    }
}
constexpr int C1_PITCH = 2080, C1_BUF = 16 * C1_PITCH;
constexpr int C1_ITEMS_S = BS * NPAGE, C1_ITEMS_P = BP * (LP / 128), C1_ITEMS = C1_ITEMS_S + C1_ITEMS_P;
typedef short c1_bf16x8 __attribute__((ext_vector_type(8)));
__device__ __forceinline__ void c1_issue(const Ctx& C, f32x4 (&st)[8], int item, int slot, int r0, int i5) {
    if (item < C1_ITEMS_S) { const int b = item >> 7, pg = item & 127, page = C.page_table[b * NPAGE + pg];
        const float* src = C.cache_kv + ((size_t)page * PAGE + r0) * 512 + slot * 128 + 4 * i5;
#pragma unroll
        for (int it = 0; it < 8; ++it) st[it] = *(const f32x4*)(src + (size_t)it * 16 * 512); }
    else { const int q = item - C1_ITEMS_S, b = q >> 6, pg = q & 63; const bf16* src = C.KVB + ((size_t)b * LP + (size_t)pg * 128 + r0) * 768 + slot * 128 + 4 * i5;
#pragma unroll
        for (int it = 0; it < 8; ++it) { const v2u v = *(const v2u*)(src + (size_t)it * 16 * 768); st[it] = (f32x4){__uint_as_float(v.x << 16), __uint_as_float(v.x & 0xffff0000u), __uint_as_float(v.y << 16), __uint_as_float(v.y & 0xffff0000u)}; } }
}
__device__ __forceinline__ void p2_cmp1(const Ctx& C) {
    const int tid = C.tid, lane = C.lane, w = C.wave;
    const int half = C.G / 2, slot = ((int)blockIdx.x >= half) ? 1 : 0, wg = (int)blockIdx.x - slot * half, nwg = slot ? C.G - half : half;
    c1_bf16x8 Bf[32];
    { const bf16* bp = C.WTC1 + (size_t)(slot * 128 + 16 * w + (lane & 15)) * 1024 + 8 * (lane >> 4);
#pragma unroll
      for (int ks = 0; ks < 32; ++ks) Bf[ks] = *(const c1_bf16x8*)(bp + 32 * ks); }
    const int r0 = tid >> 5, i5 = tid & 31, hh = i5 >> 4, d4 = (i5 & 15) * 4;
    f32x4 st[8];
    int item = wg, buf = 0;
    if (item < C1_ITEMS) c1_issue(C, st, item, slot, r0, i5);
    for (; item < C1_ITEMS; item += nwg, buf ^= 1) {
        LAS unsigned char* X = C.lds + buf * C1_BUF;
#pragma unroll
        for (int it = 0; it < 8; ++it) { const int r = r0 + 16 * it; v2u o; o.x = pk2(st[it].x, st[it].y); o.y = pk2(st[it].z, st[it].w);
            *(LAS v2u*)(X + ((r >> 4) * 2 + hh) * C1_PITCH + ((r & 15) * 64 + d4) * 2) = o; }
        LDS_FENCE(); __syncthreads();
        if (item + nwg < C1_ITEMS) c1_issue(C, st, item + nwg, slot, r0, i5);
        f32x4 acc = (f32x4){0.f, 0.f, 0.f, 0.f};
        const LAS unsigned char* ap = X + (lane & 15) * C1_PITCH + (lane >> 4) * 16;
#pragma unroll
        for (int ks = 0; ks < 32; ++ks) acc = __builtin_amdgcn_mfma_f32_16x16x32_bf16(*(const LAS c1_bf16x8*)(ap + 64 * ks), Bf[ks], acc, 0, 0, 0);
        const bool smp = item < C1_ITEMS_S; const int q = smp ? item : item - C1_ITEMS_S;
        const size_t seq0 = (size_t)(smp ? (q >> 7) : (q >> 6)) * 4 + slot; const int ch0 = (smp ? (q & 127) : (q & 63)) * 8, NC = smp ? NCS : NCP;
        float* pp = C.PP + (smp ? (size_t)0 : (size_t)XC_S_ROWS * 128);
#pragma unroll
        for (int r = 0; r < 4; ++r) { const int m = 4 * (lane >> 4) + r, chunk = ch0 + (m >> 1), h = m & 1;
            pp[((seq0 + 2 * h) * NC + chunk) * 128 + 16 * w + (lane & 15)] = acc[r]; }
    }
    __syncthreads();
}
__device__ __forceinline__ void ssm_load_u(const Ctx& C, LAS float* U, size_t row0, int g, int nt, int lane) {
    const int t = lane >> 1, hf = lane & 1;
    if (t < nt) { const float* p = C.U32 + (row0 + t) * 512 + g * 16 + hf * 8; const f32x4 a = *(const f32x4*)p, b = *(const f32x4*)(p + 4);
        *(LAS f32x4*)(U + t * 16 + hf * 8) = a; *(LAS f32x4*)(U + t * 16 + hf * 8 + 4) = b; }
    LDS_FENCE();
}
__device__ __forceinline__ void ssm_issue_u(const Ctx& C, size_t row0, int g, int nt, int lane, f32x4& ua, f32x4& ub) {
    const int t = lane >> 1, hf = lane & 1;
    if (t < nt) { const float* p = C.U32 + (row0 + t) * 512 + g * 16 + hf * 8; ua = *(const f32x4*)p; ub = *(const f32x4*)(p + 4); }
}
typedef float f32x2 __attribute__((ext_vector_type(2)));
#define SFMAC(acc, a, b) asm("v_fmac_f32 %0, %1, %2" : "+v"(acc) : "v"(a), "v"(b))
#define SMUL(d, a, b) asm("v_mul_f32 %0, %1, %2" : "=v"(d) : "v"(a), "v"(b))
__device__ __forceinline__ unsigned ssm_cvt_pk(float lo, float hi) { unsigned r; asm("v_cvt_pk_bf16_f32 %0, %1, %2" : "=v"(r) : "v"(lo), "v"(hi)); return r; }
struct SsmCoef { float are, aim, naim; float bre[16], bim[16]; };
__device__ __forceinline__ void ssm_coef(const Ctx& C, SsmCoef& K, int g, int lane) {
    const int i = g * 64 + lane; K.are = C.KST[K_ARE + i]; K.aim = C.KST[K_AIM + i]; K.naim = -K.aim;
#pragma unroll
    for (int c = 0; c < 16; ++c) { K.bre[c] = C.KST[K_BBRE + i * 16 + c]; K.bim[c] = C.KST[K_BBIM + i * 16 + c]; }
}
__device__ __forceinline__ void ssm_step2(const SsmCoef& K, const LAS float* u, float& hr, float& hi, unsigned& pk0, unsigned& pk1) {
    f32x4 ua[4], ub[4];
#pragma unroll
    for (int c4 = 0; c4 < 4; ++c4) { ua[c4] = *(const LAS f32x4*)(u + 4 * c4); ub[c4] = *(const LAS f32x4*)(u + 16 + 4 * c4); }
    float ra, ia, rb, ib;
    SMUL(ra, K.bre[0], ua[0][0]); SMUL(ia, K.bim[0], ua[0][0]); SMUL(rb, K.bre[0], ub[0][0]); SMUL(ib, K.bim[0], ub[0][0]);
#pragma unroll
    for (int c = 1; c < 16; ++c) { SFMAC(ra, K.bre[c], ua[c >> 2][c & 3]); SFMAC(ia, K.bim[c], ua[c >> 2][c & 3]); SFMAC(rb, K.bre[c], ub[c >> 2][c & 3]); SFMAC(ib, K.bim[c], ub[c >> 2][c & 3]); }
    SFMAC(ra, K.are, hr); SFMAC(ia, K.are, hi); SFMAC(ra, K.naim, hi); SFMAC(ia, K.aim, hr); hr = ra; hi = ia; pk0 = ssm_cvt_pk(hr, hi);
    SFMAC(rb, K.are, hr); SFMAC(ib, K.are, hi); SFMAC(rb, K.naim, hi); SFMAC(ib, K.aim, hr); hr = rb; hi = ib; pk1 = ssm_cvt_pk(hr, hi);
}
typedef short p1_bf16x8 __attribute__((ext_vector_type(8)));
constexpr int P1_PITCH = 132;
__device__ __forceinline__ void p1_split(const f32x4 x0, const f32x4 x1, p1_bf16x8& hi, p1_bf16x8& lo) {
    v4u h, l; float r[8] = {x0.x, x0.y, x0.z, x0.w, x1.x, x1.y, x1.z, x1.w}; unsigned hw[4], lw[4];
#pragma unroll
    for (int e = 0; e < 4; ++e) { const unsigned w = pk2(r[2 * e], r[2 * e + 1]); hw[e] = w;
        lw[e] = pk2(r[2 * e] - __uint_as_float(w << 16), r[2 * e + 1] - __uint_as_float(w & 0xffff0000u)); }
    h = (v4u){hw[0], hw[1], hw[2], hw[3]}; l = (v4u){lw[0], lw[1], lw[2], lw[3]};
    hi = __builtin_bit_cast(p1_bf16x8, h); lo = __builtin_bit_cast(p1_bf16x8, l);
}
__device__ __forceinline__ void p2_ssm_pass1(const Ctx& C) {
    const int lane = C.lane, w = C.wave, m = lane & 15, q = lane >> 4;
    LAS float* red = (LAS float*)C.lds;
    for (int it = blockIdx.x; it < NG * 8; it += C.G) {
        const int g = 4 * (it & 7) + (it >> 6), sub = (it >> 3) & 7;
        f32x4 acc[2][8];
#pragma unroll
        for (int mt = 0; mt < 2; ++mt)
#pragma unroll
            for (int nt = 0; nt < 8; ++nt) acc[mt][nt] = (f32x4){0.f, 0.f, 0.f, 0.f};
        const bf16* Wh = (const bf16*)(C.ws + WS_SSMW) + ((size_t)g * 128 + m) * 2048 + 256 * w + 8 * q;
        const bf16* Wl = Wh + (size_t)NG * 128 * 2048;
        const float* up[2];
#pragma unroll
        for (int mt = 0; mt < 2; ++mt) { const int cr = 32 * sub + 16 * mt + m, b = cr >> 6, k = cr & 63;
            up[mt] = C.U32 + ((size_t)b * LP + (size_t)k * CH + 16 * w + (q >> 1)) * 512 + g * 16 + 8 * (q & 1); }
        f32x4 xa[2][2];
#pragma unroll
        for (int mt = 0; mt < 2; ++mt) { xa[mt][0] = *(const f32x4*)(up[mt]); xa[mt][1] = *(const f32x4*)(up[mt] + 4); }
#pragma unroll 2
        for (int ks = 0; ks < 8; ++ks) {
            p1_bf16x8 ah[2], al[2];
#pragma unroll
            for (int mt = 0; mt < 2; ++mt) p1_split(xa[mt][0], xa[mt][1], ah[mt], al[mt]);
            if (ks < 7) {
#pragma unroll
                for (int mt = 0; mt < 2; ++mt) { const float* p = up[mt] + (size_t)(2 * ks + 2) * 512; xa[mt][0] = *(const f32x4*)p; xa[mt][1] = *(const f32x4*)(p + 4); } }
#pragma unroll
            for (int nt = 0; nt < 8; ++nt) {
                const p1_bf16x8 bh = *(const p1_bf16x8*)(Wh + (size_t)nt * 16 * 2048 + 32 * ks), bl = *(const p1_bf16x8*)(Wl + (size_t)nt * 16 * 2048 + 32 * ks);
#pragma unroll
                for (int mt = 0; mt < 2; ++mt) {
                    acc[mt][nt] = __builtin_amdgcn_mfma_f32_16x16x32_bf16(ah[mt], bh, acc[mt][nt], 0, 0, 0);
                    acc[mt][nt] = __builtin_amdgcn_mfma_f32_16x16x32_bf16(al[mt], bh, acc[mt][nt], 0, 0, 0);
                    acc[mt][nt] = __builtin_amdgcn_mfma_f32_16x16x32_bf16(ah[mt], bl, acc[mt][nt], 0, 0, 0); }
            }
        }
#pragma unroll
        for (int mt = 0; mt < 2; ++mt)
#pragma unroll
            for (int nt = 0; nt < 8; ++nt)
#pragma unroll
                for (int r = 0; r < 4; ++r) red[(w * 32 + 16 * mt + 4 * q + r) * P1_PITCH + 16 * nt + m] = acc[mt][nt][r];
        LDS_FENCE(); __syncthreads();
#pragma unroll
        for (int i = 0; i < 8; ++i) { const int o = C.tid + 512 * i, row = o >> 7, col = o & 127; float s = 0.f;
#pragma unroll
            for (int ww = 0; ww < 8; ++ww) s += red[(ww * 32 + row) * P1_PITCH + col];
            red[8 * 32 * P1_PITCH + row * 128 + col] = s; }
        LDS_FENCE(); __syncthreads();
        if (w == 0) { const LAS float* S2 = red + 8 * 32 * P1_PITCH; const int b = sub >> 1, k0 = 32 * (sub & 1);
            const float aLr = C.KST[K_ALRE + g * 64 + lane], aLi = C.KST[K_ALIM + g * 64 + lane]; float cr = 0.f, ci = 0.f;
#pragma unroll 8
            for (int row = 0; row < 32; ++row) { float* S = C.SEND + ((size_t)(b * NG + g) * NCHK + k0 + row) * 128; S[lane] = cr; S[64 + lane] = ci;
                const float sr = S2[row * 128 + lane], si = S2[row * 128 + 64 + lane];
                const float nr = aLr * cr - aLi * ci + sr, ni = aLr * ci + aLi * cr + si; cr = nr; ci = ni; }
            float* T = (float*)(C.ws + WS_TEND) + ((size_t)(b * NG + g) * 2 + (sub & 1)) * 128; T[lane] = cr; T[64 + lane] = ci; }
        __syncthreads();
    }
}
typedef short ssm_bf16x8 __attribute__((ext_vector_type(8)));
struct SsmRd { ssm_bf16x8 cf[4]; f32x4 dsk; };
__device__ __forceinline__ void ssm_rd(const Ctx& C, SsmRd& R, int g, int lane) {
    const bf16* CF = (const bf16*)(C.ws + WS_SSMCF) + ((size_t)g * 16 + (lane & 15)) * 128 + 8 * (lane >> 4);
#pragma unroll
    for (int ks = 0; ks < 4; ++ks) R.cf[ks] = *(const ssm_bf16x8*)(CF + 32 * ks);
    R.dsk = *(const f32x4*)(C.ssm_d + g * 16 + 4 * (lane >> 4));
}
template <int NT>
__device__ __forceinline__ void ssm_tile(const Ctx& C, const SsmCoef& K, const SsmRd& R, LAS float* U, LAS unsigned* HB, size_t row0, int g, float& hr, float& hi, f32x4& ua, f32x4& ub, const bool more) {
    constexpr int nt = NT;
    { const int t = C.lane >> 1, hf = C.lane & 1;
      if (t < nt) { *(LAS f32x4*)(U + t * 16 + hf * 8) = ua; *(LAS f32x4*)(U + t * 16 + hf * 8 + 4) = ub; }
      LDS_FENCE();
      if (more) ssm_issue_u(C, row0 + NT, g, nt, C.lane, ua, ub); }
#pragma unroll 2
    for (int t = 0; t < NT; t += 2) { unsigned p0, p1; ssm_step2(K, U + t * 16, hr, hi, p0, p1); HB[t * 68 + C.lane] = p0; HB[(t + 1) * 68 + C.lane] = p1; }
    LDS_FENCE();
    const int m = C.lane & 15, q = C.lane >> 4;
#pragma unroll
    for (int n2 = 0; n2 < 2; ++n2) {
        f32x4 y = (f32x4){0.f, 0.f, 0.f, 0.f};
#pragma unroll
        for (int ks = 0; ks < 4; ++ks) y = __builtin_amdgcn_mfma_f32_16x16x32_bf16(R.cf[ks], *(const LAS ssm_bf16x8*)((const LAS unsigned char*)HB + (16 * n2 + m) * 272 + 64 * ks + 16 * q), y, 0, 0, 0);
        const int t = 16 * n2 + m;
        if (t < nt) { const f32x4 uv = *(const LAS f32x4*)(U + t * 16 + 4 * q); const size_t o = (row0 + t) * 512 + g * 16 + 4 * q;
            f32x4 v; v.x = gelu_t(y.x + R.dsk.x * uv.x); v.y = gelu_t(y.y + R.dsk.y * uv.y); v.z = gelu_t(y.z + R.dsk.z * uv.z); v.w = gelu_t(y.w + R.dsk.w * uv.w);
            v2u pk; pk.x = pk2(v.x, v.y); pk.y = pk2(v.z, v.w); *(v2u*)(C.Y1B + o) = pk; }
    }
    LDS_FENCE();
}
__device__ __forceinline__ void p3_ssm_pass2(const Ctx& C, const bool sample_part) {
    LAS float* U = (LAS float*)(C.lds + 8192 + C.wave * 18560);
    LAS unsigned* HB = (LAS unsigned*)(U + 512);
    constexpr int BIG = NCHK / 2, NBIP = NG * BIG, NBI = NBIP + 128;
    for (int bi = (sample_part ? NBIP : 0) + blockIdx.x; bi < (sample_part ? NBI : NBIP); bi += C.G) {
        const bool smp = bi >= NBIP; const int g = smp ? (bi - NBIP) >> 2 : 2 * (bi >> 6) + (C.wave >> 2);
        SsmRd R; ssm_rd(C, R, g, C.lane);
        SsmCoef K; ssm_coef(C, K, g, C.lane);
        if (!smp) {
            const int pr = (bi & 63) * 4 + (C.wave & 3), b = pr / NCHK, k = pr % NCHK;
            float hr = 0.f, hi = 0.f; f32x4 ua = (f32x4){0.f, 0.f, 0.f, 0.f}, ub = ua; ssm_issue_u(C, (size_t)b * LP + (size_t)k * CH, g, 32, C.lane, ua, ub);
            const float aLr = C.KST[K_ALRE + g * 64 + C.lane], aLi = C.KST[K_ALIM + g * 64 + C.lane];
            { const float* S = C.SEND + ((size_t)(b * NG + g) * NCHK + k) * 128; hr = S[C.lane]; hi = S[64 + C.lane]; }
            if (k >= 32) { const float* T = (const float*)(C.ws + WS_TEND) + ((size_t)(b * NG + g) * 2) * 128; const float tr = T[C.lane], ti = T[64 + C.lane];
                float pr = 1.f, pi = 0.f, br = aLr, bi = aLi;
                for (int e = k - 32; e > 0; e >>= 1) { if (e & 1) { const float nr = pr * br - pi * bi, ni = pr * bi + pi * br; pr = nr; pi = ni; }
                    const float nr = br * br - bi * bi, ni = 2.f * br * bi; br = nr; bi = ni; }
                hr += pr * tr - pi * ti; hi += pr * ti + pi * tr; }
#pragma unroll 1
            for (int tl = 0; tl < CH / 32; ++tl) ssm_tile<32>(C, K, R, U, HB, (size_t)b * LP + (size_t)k * CH + tl * 32, g, hr, hi, ua, ub, tl < CH / 32 - 1);
            if (k == NCHK - 1) { C.out[O_SRP + (size_t)(b * NG + g) * 64 + C.lane] = hr; C.out[O_SIP + (size_t)(b * NG + g) * 64 + C.lane] = hi; }
        } else {
            const int b = ((bi - NBIP) & 3) * 8 + C.wave;
            float hr = C.st_re[(size_t)(b * NG + g) * 64 + C.lane], hi = C.st_im[(size_t)(b * NG + g) * 64 + C.lane];
            f32x4 ua = (f32x4){0.f, 0.f, 0.f, 0.f}, ub = ua; ssm_issue_u(C, (size_t)MP + (size_t)b * LS, g, LS, C.lane, ua, ub);
            ssm_tile<LS>(C, K, R, U, HB, (size_t)MP + (size_t)b * LS, g, hr, hi, ua, ub, false);
            C.out[O_SRS + (size_t)(b * NG + g) * 64 + C.lane] = hr; C.out[O_SIS + (size_t)(b * NG + g) * 64 + C.lane] = hi;
        }
    }
    __syncthreads();
}
__device__ __forceinline__ void p4_cmp2(const Ctx& C) {
    LAS float* gs = (LAS float*)(C.lds + C.wave * 256);
    const int lane = C.lane, m = lane & 15, q = lane >> 4;
    constexpr int SEQ_S = BS * 2 * 2, SEQ_P = BP * 2 * 2;
    constexpr int IT_S = SEQ_S * 32, IT_P = SEQ_P * 16;
    for (int it = C.gw; it < IT_S + IT_P; it += C.NGW) {
        const bool smp = it < IT_S; const int qq = smp ? it : it - IT_S;
        const int seq = smp ? qq >> 5 : qq >> 4, n0 = (smp ? qq & 31 : qq & 15) * 32, NC = smp ? NCS : NCP, nmax = NC - 1;
        const int slot = seq & 1, h = (seq >> 1) & 1, b = seq >> 2;
        const size_t xrow0 = (smp ? 0 : (size_t)XC_S_ROWS) + (size_t)seq * NC;
        { float cb = 0.f;
#pragma unroll 8
          for (int part = 0; part < 32; ++part) cb += C.KST[K_CBP + (slot * 32 + part) * 64 + lane];
          gs[lane] = cb; LDS_FENCE(); }
        p1_bf16x8 Bf[2][4];
#pragma unroll
        for (int ks = 0; ks < 2; ++ks)
#pragma unroll
            for (int nt = 0; nt < 4; ++nt) { const float* wp = C.cmp_w2 + (size_t)slot * 4096 + (32 * ks + 8 * q) * 64 + 16 * nt + m;
                v4u pw; pw.x = ssm_cvt_pk(wp[0], wp[64]); pw.y = ssm_cvt_pk(wp[128], wp[192]); pw.z = ssm_cvt_pk(wp[256], wp[320]); pw.w = ssm_cvt_pk(wp[384], wp[448]);
                Bf[ks][nt] = __builtin_bit_cast(p1_bf16x8, pw); }
        f32x4 acc[2][4];
#pragma unroll
        for (int mt = 0; mt < 2; ++mt)
#pragma unroll
            for (int nt = 0; nt < 4; ++nt) acc[mt][nt] = (f32x4){0.f, 0.f, 0.f, 0.f};
#pragma unroll
        for (int ks = 0; ks < 2; ++ks) { const int e0 = 32 * ks + 8 * q;
            const f32x4 c0 = *(const LAS f32x4*)(gs + e0), c1 = *(const LAS f32x4*)(gs + e0 + 4);
#pragma unroll
            for (int mt = 0; mt < 2; ++mt) { int n = n0 + 16 * mt + m; n = n < nmax ? n : nmax - 1;
                const float* pa = C.PP + (xrow0 + n) * 128 + e0; const float* pb = C.PP + (xrow0 + n + 1) * 128 + 64 + e0;
                const f32x4 h0 = c0 + *(const f32x4*)pa + *(const f32x4*)pb, h1 = c1 + *(const f32x4*)(pa + 4) + *(const f32x4*)(pb + 4);
                v4u pk; pk.x = ssm_cvt_pk(gelu_t(h0.x), gelu_t(h0.y)); pk.y = ssm_cvt_pk(gelu_t(h0.z), gelu_t(h0.w)); pk.z = ssm_cvt_pk(gelu_t(h1.x), gelu_t(h1.y)); pk.w = ssm_cvt_pk(gelu_t(h1.z), gelu_t(h1.w));
                const p1_bf16x8 A = __builtin_bit_cast(p1_bf16x8, pk);
#pragma unroll
                for (int nt = 0; nt < 4; ++nt) acc[mt][nt] = __builtin_amdgcn_mfma_f32_16x16x32_bf16(A, Bf[ks][nt], acc[mt][nt], 0, 0, 0); } }
#pragma unroll
        for (int mt = 0; mt < 2; ++mt)
#pragma unroll
            for (int nt = 0; nt < 4; ++nt) { const int nb = n0 + 16 * mt + 4 * q, d = 16 * nt + m;
                if (smp) { bf16* o = (slot ? C.VCBS : C.KCBS) + ((size_t)(b * 2 + h) * NCS + nb) * 64 + d;
#pragma unroll
                    for (int r = 0; r < 4; ++r) if (nb + r < nmax) o[r * 64] = (bf16)f2bf(acc[mt][nt][r]); }
                else { bf16* o = (slot ? C.VCT : C.KCB) + ((size_t)(b * 2 + h) * NCP + nb) * 64 + d;
#pragma unroll
                    for (int r = 0; r < 4; ++r) if (nb + r < nmax) o[r * 64] = (bf16)f2bf(acc[mt][nt][r]); } }
        LDS_FENCE();
    }
}


constexpr float QSCALE = 0.125f * 1.4426950408889634f;
__device__ __forceinline__ f32x4 unpk4(const v2u p) { return (f32x4){__uint_as_float(p.x << 16), __uint_as_float(p.x & 0xffff0000u), __uint_as_float(p.y << 16), __uint_as_float(p.y & 0xffff0000u)}; }
typedef short bf16x8 __attribute__((ext_vector_type(8)));
typedef short s16x4 __attribute__((ext_vector_type(4)));
#define MFMA16(a, b, c) __builtin_amdgcn_mfma_f32_16x16x32_bf16((a), (b), (c), 0, 0, 0)
constexpr int TP = 144, TILEB = 64 * TP;
constexpr int RSLOT = 16384  , NRING = 4;
constexpr int A_BUF = 0, A_IMP = NRING * RSLOT  , A_SELM = A_IMP + 32768, A_WUNI = A_SELM + 1024, A_LIST = A_WUNI + 128, A_MISC = A_LIST + 512, A_TUN = A_MISC + 64, A_END = A_TUN + 256;
constexpr int CW_QCTR = 8192;

struct StageRegs { v4u k, v; };
__device__ __forceinline__ void stage_load(StageRegs& R, const bf16* ksrc, size_t kpitch, const bf16* vsrc, size_t vpitch, int tid) {
    const int r = tid >> 3, ch = tid & 7; R.k = *(const v4u*)(ksrc + (size_t)r * kpitch + ch * 8); R.v = *(const v4u*)(vsrc + (size_t)r * vpitch + ch * 8); }
__device__ __forceinline__ void stage_write(const StageRegs& R, LAS unsigned char* buf, int tid) {
    const int r = tid >> 3, ch = tid & 7; *(LAS v4u*)(buf + r * TP + ch * 16) = R.k; *(LAS v4u*)(buf + TILEB + r * TP + ch * 16) = R.v; }
__device__ __forceinline__ void qk_tile(const LAS unsigned char* Kt, const bf16x8 q0, const bf16x8 q1, int c, int q, f32x4 (&s)[4]) {
    const LAS unsigned char* kp = Kt + c * TP + q * 16;
#pragma unroll
    for (int t = 0; t < 4; ++t) { const bf16x8 k0 = *(const LAS bf16x8*)(kp + t * 16 * TP), k1 = *(const LAS bf16x8*)(kp + t * 16 * TP + 64);
        s[t] = MFMA16(k0, q0, ((f32x4){0.f, 0.f, 0.f, 0.f})); s[t] = MFMA16(k1, q1, s[t]); }
}
__device__ __forceinline__ bf16x8 pack8(const f32x4 a, const f32x4 b) {
    v4u w; w.x = pg8::cvt_pk_bf16(a.x, a.y); w.y = pg8::cvt_pk_bf16(a.z, a.w); w.z = pg8::cvt_pk_bf16(b.x, b.y); w.w = pg8::cvt_pk_bf16(b.z, b.w); return __builtin_bit_cast(bf16x8, w); }
__device__ __forceinline__ void pv_tile(const LAS unsigned char* Vt, const f32x4 (&p)[4], int c, int q, f32x4 (&acc)[4]) {
    const bf16x8 P0 = pack8(p[0], p[1]), P1 = pack8(p[2], p[3]);
    const LAS unsigned char* vp = Vt + c * TP + q * 8;
#pragma unroll
    for (int dt = 0; dt < 4; ++dt) { const LAS unsigned char* vr = vp + dt * 16 * TP;
        const s16x4 a0 = *(const LAS s16x4*)(vr), a1 = *(const LAS s16x4*)(vr + 32), b0 = *(const LAS s16x4*)(vr + 64), b1 = *(const LAS s16x4*)(vr + 96);
        const bf16x8 va = (bf16x8){a0[0], a0[1], a0[2], a0[3], a1[0], a1[1], a1[2], a1[3]}, vb = (bf16x8){b0[0], b0[1], b0[2], b0[3], b1[0], b1[1], b1[2], b1[3]};
        acc[dt] = MFMA16(va, P0, acc[dt]); acc[dt] = MFMA16(vb, P1, acc[dt]); }
}
__device__ __forceinline__ void mask_tile(f32x4 (&s)[4], int q, int lo, int hi) {
    const float NINF = -__builtin_inff();
#pragma unroll
    for (int t = 0; t < 4; ++t)
#pragma unroll
        for (int r = 0; r < 4; ++r) { const int key = 16 * t + 4 * q + r; s[t][r] = (key >= lo && key <= hi) ? s[t][r] : NINF; }
}
__device__ __forceinline__ float colmax(const f32x4 (&s)[4]) {
    float mx = fmaxf(fmaxf(s[0].x, s[0].y), fmaxf(s[0].z, s[0].w));
#pragma unroll
    for (int t = 1; t < 4; ++t) mx = fmaxf(mx, fmaxf(fmaxf(s[t].x, s[t].y), fmaxf(s[t].z, s[t].w)));
    mx = fmaxf(mx, __shfl_xor(mx, 16)); mx = fmaxf(mx, __shfl_xor(mx, 32)); return mx;
}
__device__ __forceinline__ float ex2(float x) { return __builtin_amdgcn_exp2f(x); }
__device__ __forceinline__ void online_step(f32x4 (&s)[4], const bool mine, float& m, float& l, f32x4 (&acc)[4]) {
    const float NINF = -__builtin_inff(), PINF = __builtin_inff();
    float mx = colmax(s); mx = mine ? mx : NINF;
    const float mn = fmaxf(m, mx), ms = (mn > NINF) ? mn : 0.f, msub = mine ? ms : PINF;
    float sum = 0.f;
#pragma unroll
    for (int t = 0; t < 4; ++t) { s[t].x = ex2(s[t].x - msub); s[t].y = ex2(s[t].y - msub); s[t].z = ex2(s[t].z - msub); s[t].w = ex2(s[t].w - msub); sum += (s[t].x + s[t].y) + (s[t].z + s[t].w); }
    if (__any(mn != m)) { const float al = ex2(m - ms); l = l * al + sum;
#pragma unroll
        for (int dt = 0; dt < 4; ++dt) acc[dt] = acc[dt] * al; }
    else l += sum;
    m = mn;
}
__device__ __forceinline__ float dpp_xor1(float v) { return __builtin_bit_cast(float, __builtin_amdgcn_update_dpp(0, __builtin_bit_cast(int, v), 0xB1, 0xF, 0xF, true)); }
__device__ __forceinline__ float dpp_xor2(float v) { return __builtin_bit_cast(float, __builtin_amdgcn_update_dpp(0, __builtin_bit_cast(int, v), 0x4E, 0xF, 0xF, true)); }
__device__ __forceinline__ unsigned getw(const v4u v, int wi) { return wi == 0 ? v.x : (wi == 1 ? v.y : (wi == 2 ? v.z : v.w)); }

__device__ __forceinline__ v4u topk_token(const LAS float* imp, int cur, int lane) {
    const bool c0 = lane >= 1 && lane < cur, c1 = (lane + 64) < cur;
    const unsigned u0 = c0 ? __float_as_uint(imp[lane]) : 0u, u1 = c1 ? __float_as_uint(imp[64 + lane]) : 0u;
    bool s0, s1;
    const int K = cur >= 1 ? 14 : 15, ncand = cur >= 1 ? cur - 1 : 0;
    if (ncand <= K) { s0 = c0; s1 = c1; }
    else {
        unsigned prefix = 0u; int rem = K;
        for (int bit = 30; bit >= 11; --bit) {
            const unsigned cand = prefix | (1u << bit);
            const bool m0 = c0 && ((u0 >> bit) == (cand >> bit)), m1 = c1 && ((u1 >> bit) == (cand >> bit));
            const int cnt = __popcll(__ballot(m0)) + __popcll(__ballot(m1));
            if (cnt >= rem) prefix = cand; else rem -= cnt;
        }
        const unsigned ph = prefix >> 11;
        const bool e0 = c0 && (u0 >> 11) == ph, e1 = c1 && (u1 >> 11) == ph;
        const unsigned long long be0 = __ballot(e0), be1 = __ballot(e1), lt = (1ull << lane) - 1ull;
        const int r0 = __popcll(be0 & lt), r1 = __popcll(be0) + __popcll(be1 & lt);
        s0 = c0 && ((u0 >> 11) > ph || (e0 && r0 < rem)); s1 = c1 && ((u1 >> 11) > ph || (e1 && r1 < rem));
    }
    s0 = s0 || lane == 0 || lane == cur; s1 = s1 || (lane + 64) == cur;
    const unsigned long long b0 = __ballot(s0), b1 = __ballot(s1);
    return (v4u){(unsigned)b0, (unsigned)(b0 >> 32), (unsigned)b1, (unsigned)(b1 >> 32)};
}


__device__ __forceinline__ void ring_issue(LAS unsigned char* slot, const bf16* ksrc, size_t kpitch, const bf16* vsrc, size_t vpitch, int w, int lane) {
    const int row = 8 * w + (lane >> 3), cl = (lane & 7) ^ ((row >> 1) & 7);
    __builtin_amdgcn_global_load_lds((const unsigned*)(ksrc + (size_t)row * kpitch + cl * 8), (LAS unsigned*)(slot + w * 1024), 16, 0, 0);
    __builtin_amdgcn_global_load_lds((const unsigned*)(vsrc + (size_t)row * vpitch + cl * 8), (LAS unsigned*)(slot + 8192 + w * 1024), 16, 0, 0);
}
#define RING_PAIR_SYNC() do { asm volatile("s_waitcnt vmcnt(0)" ::: "memory"); __builtin_amdgcn_s_barrier(); asm volatile("" ::: "memory"); } while (0)
__device__ __forceinline__ void qk_tile_sw(const LAS unsigned char* Kt, const bf16x8 q0, const bf16x8 q1, int c, int q, f32x4 (&s)[4]) {
    const int sw = (c >> 1) & 7; const LAS unsigned char* kp = Kt + c * 128;
    const int o0 = (q ^ sw) * 16, o1 = ((4 + q) ^ sw) * 16;
#pragma unroll
    for (int t = 0; t < 4; ++t) { const bf16x8 k0 = *(const LAS bf16x8*)(kp + t * 2048 + o0), k1 = *(const LAS bf16x8*)(kp + t * 2048 + o1);
        s[t] = MFMA16(k0, q0, ((f32x4){0.f, 0.f, 0.f, 0.f})); s[t] = MFMA16(k1, q1, s[t]); }
}
typedef short v4i16_t __attribute__((ext_vector_type(4)));
__device__ __forceinline__ s16x4 vtr(const LAS unsigned char* p) { return __builtin_bit_cast(s16x4, __builtin_amdgcn_ds_read_tr16_b64_v4i16((LAS v4i16_t*)p)); }
__device__ __forceinline__ void pv_tile_sw(const LAS unsigned char* Vt, const f32x4 (&p)[4], int c, int q, f32x4 (&acc)[4]) {
    const bf16x8 P0 = pack8(p[0], p[1]), P1 = pack8(p[2], p[3]);
    const int sw = (2 * q + (c >> 3)) & 7, ch = (c & 3) >> 1;
    const LAS unsigned char* vb = Vt + (4 * q + (c >> 2)) * 128 + (c & 1) * 8;
#pragma unroll
    for (int dt = 0; dt < 4; ++dt) { const LAS unsigned char* vr = vb + (((2 * dt + ch) ^ sw) << 4);
        const s16x4 a0 = vtr(vr), a1 = vtr(vr + 16 * 128), b0 = vtr(vr + 32 * 128), b1 = vtr(vr + 48 * 128);
        const bf16x8 va = (bf16x8){a0[0], a0[1], a0[2], a0[3], a1[0], a1[1], a1[2], a1[3]}, vb8 = (bf16x8){b0[0], b0[1], b0[2], b0[3], b1[0], b1[1], b1[2], b1[3]};
        acc[dt] = MFMA16(va, P0, acc[dt]); acc[dt] = MFMA16(vb8, P1, acc[dt]); }
}
template <int MODE> __device__ __forceinline__ void attn_prompt_unit(const Ctx& C, int b, int h, int T) {
    const float NINF = -__builtin_inff();
    int tid_ = C.tid; asm volatile("" : "+v"(tid_));
    const int tid = tid_, lane = tid & 63, w = __builtin_amdgcn_readfirstlane(tid >> 6), c = lane & 15, q = lane >> 4, ti = c >> 2, g = c & 3;
    LAS unsigned char* L = C.lds;
    LAS float* impS = (LAS float*)(L + A_IMP); LAS unsigned* selm = (LAS unsigned*)(L + A_SELM); LAS unsigned* wuni = (LAS unsigned*)(L + A_WUNI); LAS int* list = (LAS int*)(L + A_LIST); LAS int* misc = (LAS int*)(L + A_MISC);
    const int q0 = 64 * T, seq = b * 2 + h;
    bf16x8 Q0[2], Q1[2]; int toff[2]; v2u outp[2][4]; float gate[2][3];
#pragma unroll
    for (int a = 0; a < 2; ++a) { toff[a] = 8 * w + 4 * a + ti; const bf16* qp = C.QB + ((size_t)b * LP + q0 + toff[a]) * 512 + h * 256 + g * 64 + 8 * q;
        Q0[a] = *(const bf16x8*)qp; Q1[a] = *(const bf16x8*)(qp + 32);
        { const float* gp = C.GN + ((size_t)b * LP + q0 + toff[a]) * 32 + (h * 4 + g) * 3; gate[a][0] = gp[0]; gate[a][1] = gp[1]; gate[a][2] = gp[2]; }
#pragma unroll
        for (int dt = 0; dt < 4; ++dt) outp[a][dt] = (v2u){0u, 0u}; }
    for (int i = tid; i < 2048; i += 512) ((LAS f32x4*)impS)[i] = (f32x4){0.f, 0.f, 0.f, 0.f};
    const int nvmax = 4 * T + 3, ntc = (MODE & 4) ? 0 : (nvmax + 63) >> 6;
    const bf16* kcb = C.KCB + (size_t)seq * NCP * 64; const bf16* vcb = C.VCT + (size_t)seq * NCP * 64;
    int nvis[2], nvmin[2]; float mC[2], lC[2];
#pragma unroll
    for (int a = 0; a < 2; ++a) { const int qpos = q0 + toff[a]; nvis[a] = qpos >= 31 ? ((qpos - 31) >> 4) + 1 : 0; mC[a] = NINF; lC[a] = 0.f;
        const int qmin = q0 + 8 * w + 4 * a; nvmin[a] = qmin >= 31 ? ((qmin - 31) >> 4) + 1 : 0; }
    for (int s = 0; s < 2 && s < ntc; ++s) ring_issue(L + s * RSLOT, kcb + (size_t)s * 4096, 64, vcb + (size_t)s * 4096, 64, w, lane);
    for (int s = 0; s < ntc; ++s) {
        if (!(s & 1)) { RING_PAIR_SYNC();
            for (int s2 = s + 2; s2 < s + 4 && s2 < ntc; ++s2) ring_issue(L + (s2 & 3) * RSLOT, kcb + (size_t)s2 * 4096, 64, vcb + (size_t)s2 * 4096, 64, w, lane); }
        const LAS unsigned char* buf = L + (s & 3) * RSLOT;
#pragma unroll
        for (int a = 0; a < 2; ++a) { __builtin_amdgcn_sched_barrier(0); f32x4 sc[4]; qk_tile_sw(buf, Q0[a], Q1[a], c, q, sc); if (64 * (s + 1) > nvmin[a]) mask_tile(sc, q, 0, nvis[a] - 64 * s - 1);
            const float mn = fmaxf(mC[a], colmax(sc)), ms = (mn > NINF) ? mn : 0.f; float sum = 0.f;
#pragma unroll
            for (int t = 0; t < 4; ++t) sum += (ex2(sc[t].x - ms) + ex2(sc[t].y - ms)) + (ex2(sc[t].z - ms) + ex2(sc[t].w - ms));
            lC[a] = lC[a] * ex2(mC[a] - ms) + sum; mC[a] = mn; }
    }
    __builtin_amdgcn_s_barrier();
    float invC[2], msC[2];
#pragma unroll
    for (int a = 0; a < 2; ++a) { float l = lC[a]; l += __shfl_xor(l, 16); l += __shfl_xor(l, 32); invC[a] = 1.0f / fmaxf(l, 1e-30f); msC[a] = (mC[a] > NINF) ? mC[a] : 0.f; }
    f32x4 acc[2][4]; float carry[2];
#pragma unroll
    for (int a = 0; a < 2; ++a) { carry[a] = 0.f;
#pragma unroll
        for (int dt = 0; dt < 4; ++dt) acc[a][dt] = (f32x4){0.f, 0.f, 0.f, 0.f}; }
    for (int s = 0; s < 2 && s < ntc; ++s) ring_issue(L + s * RSLOT, kcb + (size_t)s * 4096, 64, vcb + (size_t)s * 4096, 64, w, lane);
    for (int s = 0; s < ntc; ++s) {
        if (!(s & 1)) { RING_PAIR_SYNC();
            for (int s2 = s + 2; s2 < s + 4 && s2 < ntc; ++s2) ring_issue(L + (s2 & 3) * RSLOT, kcb + (size_t)s2 * 4096, 64, vcb + (size_t)s2 * 4096, 64, w, lane); }
        const LAS unsigned char* buf = L + (s & 3) * RSLOT;
#pragma unroll
        for (int a = 0; a < 2; ++a) { __builtin_amdgcn_sched_barrier(0); f32x4 sc[4]; qk_tile_sw(buf, Q0[a], Q1[a], c, q, sc); if (64 * (s + 1) > nvmin[a]) mask_tile(sc, q, 0, nvis[a] - 64 * s - 1);
            float x[4], A[4];
#pragma unroll
            for (int t = 0; t < 4; ++t) { sc[t].x = ex2(sc[t].x - msC[a]) * invC[a]; sc[t].y = ex2(sc[t].y - msC[a]) * invC[a]; sc[t].z = ex2(sc[t].z - msC[a]) * invC[a]; sc[t].w = ex2(sc[t].w - msC[a]) * invC[a];
                f32x4 ps = sc[t]; ps.x += dpp_xor1(ps.x); ps.y += dpp_xor1(ps.y); ps.z += dpp_xor1(ps.z); ps.w += dpp_xor1(ps.w);
                ps.x += dpp_xor2(ps.x); ps.y += dpp_xor2(ps.y); ps.z += dpp_xor2(ps.z); ps.w += dpp_xor2(ps.w);
                A[t] = (ps.x + ps.y) + (ps.z + 0.5f * ps.w); x[t] = __shfl(0.5f * ps.w, (lane + 48) & 63); }
            if (g == 0) { LAS float* ip = impS + ((2 * w + a) * 4 + ti) * 128 + 16 * s + q;
                ip[0] = A[0] + (q ? x[0] : carry[a]); ip[4] = A[1] + (q ? x[1] : x[0]); ip[8] = A[2] + (q ? x[2] : x[1]); ip[12] = A[3] + (q ? x[3] : x[2]); }
            carry[a] = x[3];
            pv_tile_sw(buf + 8192, sc, c, q, acc[a]); }
    }
    __builtin_amdgcn_s_barrier();
    {
        LDS_FENCE();
#pragma unroll
        for (int a = 0; a < 2; ++a) { const float gc = gate[a][0];
#pragma unroll
            for (int dt = 0; dt < 4; ++dt) { const f32x4 o = acc[a][dt] * gc; outp[a][dt].x = pk2(o.x, o.y); outp[a][dt].y = pk2(o.z, o.w); } }
    }
    v4u wu = (v4u){0u, 0u, 0u, 0u};
    for (int tt = 0; tt < ((MODE & 2) ? 0 : 8); ++tt) { const v4u mk = topk_token(impS + ((2 * w + (tt >> 2)) * 4 + (tt & 3)) * 128, T, lane);
        if (lane == 0) *(LAS v4u*)(selm + (8 * w + tt) * 4) = mk;
        wu.x |= mk.x; wu.y |= mk.y; wu.z |= mk.z; wu.w |= mk.w; }
    if (lane == 0) *(LAS v4u*)(wuni + 4 * w) = wu;
    __syncthreads();
    LAS unsigned* tun = (LAS unsigned*)(L + A_TUN);
    if (lane < 8) { const int a = lane >> 2, wi = lane & 3; unsigned o = 0u;
#pragma unroll
        for (int i = 0; i < 4; ++i) o |= selm[(8 * w + 4 * a + i) * 4 + wi];
        tun[(2 * w + a) * 4 + wi] = o; }
    if (w == 0) {
        v4u U = (v4u){0u, 0u, 0u, 0u};
#pragma unroll
        for (int i = 0; i < 8; ++i) { const v4u o = *(const LAS v4u*)(wuni + 4 * i); U.x |= o.x; U.y |= o.y; U.z |= o.z; U.w |= o.w; }
        const unsigned long long lt = (1ull << lane) - 1ull;
        const bool b0 = ((lane < 32 ? U.x : U.y) >> (lane & 31)) & 1u, b1 = ((lane < 32 ? U.z : U.w) >> (lane & 31)) & 1u;
        const unsigned long long m0 = __ballot(b0), m1 = __ballot(b1); const int n0 = __popcll(m0);
        if (b0) list[__popcll(m0 & lt)] = lane; if (b1) list[n0 + __popcll(m1 & lt)] = 64 + lane;
        if (lane == 0) misc[0] = n0 + __popcll(m1);
    }
    __syncthreads();
    const int nsel = (MODE & 3) ? 0 : misc[0];
    const bf16* ksb = C.KVB + ((size_t)b * LP) * 768 + 2 * 128 + h * 64; const bf16* vsb = C.KVB + ((size_t)b * LP) * 768 + 3 * 128 + h * 64;
    float mS[2], lS[2];
#pragma unroll
    for (int a = 0; a < 2; ++a) { mS[a] = NINF; lS[a] = 0.f;
#pragma unroll
        for (int dt = 0; dt < 4; ++dt) acc[a][dt] = (f32x4){0.f, 0.f, 0.f, 0.f}; }
    for (int s = 0; s < 2 && s < nsel; ++s) { const int jn = list[s]; ring_issue(L + s * RSLOT, ksb + (size_t)jn * 64 * 768, 768, vsb + (size_t)jn * 64 * 768, 768, w, lane); }
    for (int s = 0; s < nsel; ++s) {
        if (!(s & 1)) { RING_PAIR_SYNC();
            for (int s2 = s + 2; s2 < s + 4 && s2 < nsel; ++s2) { const int jn = list[s2]; ring_issue(L + (s2 & 3) * RSLOT, ksb + (size_t)jn * 64 * 768, 768, vsb + (size_t)jn * 64 * 768, 768, w, lane); } }
        const int j = list[s];
        const LAS unsigned char* buf = L + (s & 3) * RSLOT;
        const int wi = j >> 5, bt = j & 31;
#pragma unroll
        for (int a = 0; a < 2; ++a) { __builtin_amdgcn_sched_barrier(0);
            if ((__builtin_amdgcn_readfirstlane(tun[(2 * w + a) * 4 + wi]) >> bt) & 1u) {
                f32x4 sc[4]; qk_tile_sw(buf, Q0[a], Q1[a], c, q, sc);
                const bool mine = (selm[(8 * w + 4 * a + ti) * 4 + wi] >> bt) & 1u;
                if (j == T) mask_tile(sc, q, 0, toff[a]);
                online_step(sc, mine, mS[a], lS[a], acc[a]);
                pv_tile_sw(buf + 8192, sc, c, q, acc[a]); } }
    }
    __builtin_amdgcn_s_barrier();
#pragma unroll
    for (int a = 0; a < 2; ++a) { float l = lS[a]; l += __shfl_xor(l, 16); l += __shfl_xor(l, 32);
        const float gs = gate[a][1] / fmaxf(l, 1e-30f);
#pragma unroll
        for (int dt = 0; dt < 4; ++dt) { const f32x4 o = unpk4(outp[a][dt]) + acc[a][dt] * gs; outp[a][dt].x = pk2(o.x, o.y); outp[a][dt].y = pk2(o.z, o.w); } }
    const bf16* kwb = C.KVB + ((size_t)b * LP) * 768 + 4 * 128 + h * 64; const bf16* vwb = C.KVB + ((size_t)b * LP) * 768 + 5 * 128 + h * 64;
#pragma unroll
    for (int a = 0; a < 2; ++a) { mS[a] = NINF; lS[a] = 0.f;
#pragma unroll
        for (int dt = 0; dt < 4; ++dt) acc[a][dt] = (f32x4){0.f, 0.f, 0.f, 0.f}; }
    const int jw0 = T >= 8 ? T - 8 : 0, nw = (MODE & 8) ? 0 : T - jw0 + 1;
    for (int s = 0; s < 2 && s < nw; ++s) ring_issue(L + s * RSLOT, kwb + (size_t)(jw0 + s) * 64 * 768, 768, vwb + (size_t)(jw0 + s) * 64 * 768, 768, w, lane);
    for (int s = 0; s < nw; ++s) {
        if (!(s & 1)) { RING_PAIR_SYNC();
            for (int s2 = s + 2; s2 < s + 4 && s2 < nw; ++s2) ring_issue(L + (s2 & 3) * RSLOT, kwb + (size_t)(jw0 + s2) * 64 * 768, 768, vwb + (size_t)(jw0 + s2) * 64 * 768, 768, w, lane); }
        const int j = jw0 + s;
        const LAS unsigned char* buf = L + (s & 3) * RSLOT;
#pragma unroll
        for (int a = 0; a < 2; ++a) { __builtin_amdgcn_sched_barrier(0); f32x4 sc[4]; qk_tile_sw(buf, Q0[a], Q1[a], c, q, sc);
            const int lo = (j == T - 8) ? toff[a] + 1 : 0, hi = (j == T) ? toff[a] : 63;
            if (j == T - 8 || j == T) mask_tile(sc, q, lo, hi);
            online_step(sc, true, mS[a], lS[a], acc[a]);
            pv_tile_sw(buf + 8192, sc, c, q, acc[a]); }
    }
    __builtin_amdgcn_s_barrier();
#pragma unroll
    for (int a = 0; a < 2; ++a) { float l = lS[a]; l += __shfl_xor(l, 16); l += __shfl_xor(l, 32);
        const size_t row = (size_t)b * LP + q0 + toff[a];
        const float gw = gate[a][2] / fmaxf(l, 1e-30f);
#pragma unroll
        for (int dt = 0; dt < 4; ++dt) { const f32x4 o = unpk4(outp[a][dt]) + acc[a][dt] * gw; const int col = h * 256 + g * 64 + 16 * dt + 4 * q;
            const f32x4 z = unpk4(*(const v2u*)(C.SZA + row * 512 + col));
            v2u ov; ov.x = pk2(o.x * z.x, o.y * z.y); ov.y = pk2(o.z * z.z, o.w * z.w);
            if (!(MODE & 32)) *(v2u*)(C.OA + row * 512 + col) = ov; else if (ov.x == 0x12345678u) *(v2u*)(C.OA + row * 512 + col) = ov; } }
}

constexpr int S_TILE = 2 * TILEB, S_IMPA = 4 * S_TILE, S_IMPB = S_IMPA + 8448, S_SELM = S_IMPB + 8448, S_LIST = S_SELM + 512, S_MISC = S_LIST + 1088, S_TUN = S_MISC + 64, S_MRG = S_TUN + 128, S_END = S_MRG + 8 * 64 * 18 * 4;
static_assert(S_END <= MISC_OFF, "sample attention LDS map");
__device__ __forceinline__ void pv_tile_tr(const LAS unsigned char* Vt, const f32x4 (&p)[4], int lane, f32x4 (&acc)[4]) {
    const bf16x8 P0 = pack8(p[0], p[1]), P1 = pack8(p[2], p[3]);
    const int i = lane & 15, q = lane >> 4;
    const LAS unsigned char* vb = Vt + (4 * q + (i >> 2)) * TP + (i & 3) * 8;
#pragma unroll
    for (int dt = 0; dt < 4; ++dt) {
        const s16x4 a0 = vtr(vb + dt * 32), a1 = vtr(vb + dt * 32 + 16 * TP), b0 = vtr(vb + dt * 32 + 32 * TP), b1 = vtr(vb + dt * 32 + 48 * TP);
        const bf16x8 va = (bf16x8){a0[0], a0[1], a0[2], a0[3], a1[0], a1[1], a1[2], a1[3]}, vb8 = (bf16x8){b0[0], b0[1], b0[2], b0[3], b1[0], b1[1], b1[2], b1[3]};
        acc[dt] = MFMA16(va, P0, acc[dt]); acc[dt] = MFMA16(vb8, P1, acc[dt]); }
}
struct TileSrc { const float* k; const float* v; int stride; int nrows; };
__device__ __forceinline__ void stage4_f32(LAS unsigned char* L, const TileSrc (&ts)[4], int tid) {
    const int r0 = tid >> 4, d4 = (tid & 15) * 4;
    f32x4 kv[4][2], vv[4][2];
#pragma unroll
    for (int t = 0; t < 4; ++t)
#pragma unroll
        for (int hh = 0; hh < 2; ++hh) { const int r = r0 + 32 * hh; const bool ok = r < ts[t].nrows;
            kv[t][hh] = ok ? *(const f32x4*)(ts[t].k + (size_t)r * ts[t].stride + d4) : (f32x4){0.f, 0.f, 0.f, 0.f};
            vv[t][hh] = ok ? *(const f32x4*)(ts[t].v + (size_t)r * ts[t].stride + d4) : (f32x4){0.f, 0.f, 0.f, 0.f}; }
#pragma unroll
    for (int t = 0; t < 4; ++t)
#pragma unroll
        for (int hh = 0; hh < 2; ++hh) { const int r = r0 + 32 * hh; v2u a, b2; a.x = pk2(kv[t][hh].x, kv[t][hh].y); a.y = pk2(kv[t][hh].z, kv[t][hh].w); b2.x = pk2(vv[t][hh].x, vv[t][hh].y); b2.y = pk2(vv[t][hh].z, vv[t][hh].w);
            *(LAS v2u*)(L + t * S_TILE + r * TP + d4 * 2) = a; *(LAS v2u*)(L + t * S_TILE + TILEB + r * TP + d4 * 2) = b2; }
}
__device__ __forceinline__ void stage4_bf16(LAS unsigned char* L, const bf16* kb, const bf16* vb, int tid) {
    const int r = tid >> 3, ch = tid & 7;
    v4u kk[4], vv[4];
#pragma unroll
    for (int t = 0; t < 4; ++t) { kk[t] = *(const v4u*)(kb + (size_t)(64 * t + r) * 64 + ch * 8); vv[t] = *(const v4u*)(vb + (size_t)(64 * t + r) * 64 + ch * 8); }
#pragma unroll
    for (int t = 0; t < 4; ++t) { *(LAS v4u*)(L + t * S_TILE + r * TP + ch * 16) = kk[t]; *(LAS v4u*)(L + t * S_TILE + TILEB + r * TP + ch * 16) = vv[t]; }
}
__device__ __forceinline__ void merge4(LAS float* mrg, int w, int lane, float& m, float& l, f32x4 (&acc)[4]) {
    const float NINF = -__builtin_inff();
    LAS float* me = mrg + (w * 64 + lane) * 18;
    me[0] = m; me[1] = l;
#pragma unroll
    for (int dt = 0; dt < 4; ++dt) { me[2 + 4 * dt] = acc[dt].x; me[3 + 4 * dt] = acc[dt].y; me[4 + 4 * dt] = acc[dt].z; me[5 + 4 * dt] = acc[dt].w; }
    LDS_FENCE(); __syncthreads();
    const int w0 = w & 4;
    float M = NINF;
#pragma unroll
    for (int k = 0; k < 4; ++k) M = fmaxf(M, mrg[((w0 + k) * 64 + lane) * 18]);
    const float Ms = (M > NINF) ? M : 0.f; float Lx = 0.f; f32x4 A[4];
#pragma unroll
    for (int dt = 0; dt < 4; ++dt) A[dt] = (f32x4){0.f, 0.f, 0.f, 0.f};
#pragma unroll
    for (int k = 0; k < 4; ++k) { const LAS float* o = mrg + ((w0 + k) * 64 + lane) * 18; const float f = ex2(o[0] - Ms); Lx += o[1] * f;
#pragma unroll
        for (int dt = 0; dt < 4; ++dt) { A[dt].x += o[2 + 4 * dt] * f; A[dt].y += o[3 + 4 * dt] * f; A[dt].z += o[4 + 4 * dt] * f; A[dt].w += o[5 + 4 * dt] * f; } }
    m = M; l = Lx;
#pragma unroll
    for (int dt = 0; dt < 4; ++dt) acc[dt] = A[dt];
    asm volatile("" : "+v"(m), "+v"(l), "+v"(acc[0]), "+v"(acc[1]), "+v"(acc[2]), "+v"(acc[3]));
    __syncthreads();
}
__device__ __forceinline__ void topk_token_s(const LAS float* ia, const LAS float* ib, int lane, LAS unsigned* dst) {
    bool cv[5], sv[5]; unsigned u[5];
#pragma unroll
    for (int k = 0; k < 5; ++k) { const int j = lane + 64 * k; cv[k] = j >= 1 && j < 256; u[k] = cv[k] ? __float_as_uint(ia[j] + ib[j]) : 0u; }
    unsigned prefix = 0u; int rem = 14;
    for (int bit = 30; bit >= 0; --bit) {
        const unsigned cand = prefix | (1u << bit); int cnt = 0;
#pragma unroll
        for (int k = 0; k < 5; ++k) cnt += __popcll(__ballot(cv[k] && ((u[k] >> bit) == (cand >> bit))));
        if (cnt >= rem) prefix = cand; else rem -= cnt;
    }
    const unsigned long long lt = (1ull << lane) - 1ull; int before = 0;
#pragma unroll
    for (int k = 0; k < 5; ++k) { const bool e = cv[k] && u[k] == prefix; const unsigned long long be = __ballot(e); const int rk = before + __popcll(be & lt); before += __popcll(be);
        sv[k] = cv[k] && (u[k] > prefix || (e && rk < rem)); }
    sv[0] = sv[0] || lane == 0; sv[4] = sv[4] || lane == 0;
#pragma unroll
    for (int k = 0; k < 5; ++k) { const unsigned long long bb = __ballot(sv[k]); if (lane == 0) { dst[2 * k] = (unsigned)bb; dst[2 * k + 1] = (unsigned)(bb >> 32); } }
}
__device__ __forceinline__ void attn_sample_unit(const Ctx& C, int b, int h) {
    const float NINF = -__builtin_inff();
    int tid_ = C.tid; asm volatile("" : "+v"(tid_));
    const int tid = tid_, lane = tid & 63, w = __builtin_amdgcn_readfirstlane(tid >> 6), c = lane & 15, q = lane >> 4, ti = c >> 2, g = c & 3, a = w >> 2, ks = w & 3;
    LAS unsigned char* L = C.lds;
    LAS float* impA = (LAS float*)(L + S_IMPA); LAS float* impB = (LAS float*)(L + S_IMPB); LAS unsigned* selm = (LAS unsigned*)(L + S_SELM); LAS int* list = (LAS int*)(L + S_LIST);
    LAS int* misc = (LAS int*)(L + S_MISC); LAS unsigned* tun = (LAS unsigned*)(L + S_TUN); LAS float* mrg = (LAS float*)(L + S_MRG);
    const int seq = b * 2 + h, tok = 4 * a + ti;
    const size_t row = (size_t)MP + (size_t)b * LS + tok;
    const bf16* qp = C.QB + row * 512 + h * 256 + g * 64 + 8 * q;
    const bf16x8 Q0 = *(const bf16x8*)qp, Q1 = *(const bf16x8*)(qp + 32);
    for (int i = tid; i < 2 * 8448 / 4; i += 512) impA[i] = 0.f;
    const unsigned char* Lt = nullptr; (void)Lt;
    const LAS unsigned char* myK = L + ks * S_TILE; const LAS unsigned char* myV = myK + TILEB;
    f32x4 acc[4], outv[4]; float m = NINF, l = 0.f;
#pragma unroll
    for (int dt = 0; dt < 4; ++dt) { acc[dt] = (f32x4){0.f, 0.f, 0.f, 0.f}; outv[dt] = (f32x4){0.f, 0.f, 0.f, 0.f}; }
    const bf16* kcb = C.KCBS + (size_t)seq * NCS * 64; const bf16* vcb = C.VCBS + (size_t)seq * NCS * 64;
    for (int s = 0; s < 4; ++s) {
        stage4_bf16(L, kcb + (size_t)s * 256 * 64, vcb + (size_t)s * 256 * 64, tid); LDS_FENCE(); __syncthreads();
        { f32x4 sc[4]; qk_tile(myK, Q0, Q1, c, q, sc); mask_tile(sc, q, 0, 1022 - 64 * (4 * s + ks));
          const float mn = fmaxf(m, colmax(sc)), ms = (mn > NINF) ? mn : 0.f; float sum = 0.f;
#pragma unroll
          for (int t = 0; t < 4; ++t) sum += (ex2(sc[t].x - ms) + ex2(sc[t].y - ms)) + (ex2(sc[t].z - ms) + ex2(sc[t].w - ms));
          l = l * ex2(m - ms) + sum; m = mn; }
        __syncthreads();
    }
    merge4(mrg, w, lane, m, l, acc);
    float lt_ = l; lt_ += __shfl_xor(lt_, 16); lt_ += __shfl_xor(lt_, 32);
    const float invC = 1.0f / fmaxf(lt_, 1e-30f), msC = (m > NINF) ? m : 0.f;
    for (int s = 0; s < 4; ++s) {
        stage4_bf16(L, kcb + (size_t)s * 256 * 64, vcb + (size_t)s * 256 * 64, tid); LDS_FENCE(); __syncthreads();
        { f32x4 sc[4]; qk_tile(myK, Q0, Q1, c, q, sc); const int tl = 4 * s + ks; mask_tile(sc, q, 0, 1022 - 64 * tl);
#pragma unroll
          for (int t = 0; t < 4; ++t) { sc[t].x = ex2(sc[t].x - msC) * invC; sc[t].y = ex2(sc[t].y - msC) * invC; sc[t].z = ex2(sc[t].z - msC) * invC; sc[t].w = ex2(sc[t].w - msC) * invC;
              f32x4 ps = sc[t]; ps.x += dpp_xor1(ps.x); ps.y += dpp_xor1(ps.y); ps.z += dpp_xor1(ps.z); ps.w += dpp_xor1(ps.w);
              ps.x += dpp_xor2(ps.x); ps.y += dpp_xor2(ps.y); ps.z += dpp_xor2(ps.z); ps.w += dpp_xor2(ps.w);
              if (g == 0) { const int j = 16 * tl + 4 * t + q; impA[tok * 264 + j] = (ps.x + ps.y) + (ps.z + 0.5f * ps.w); impB[tok * 264 + j + 1] = 0.5f * ps.w; } }
          pv_tile_tr(myV, sc, lane, acc); }
        __syncthreads();
    }
    m = 0.f; l = 0.f;
    merge4(mrg, w, lane, m, l, acc);
    { const float gc = C.GN[row * 32 + (h * 4 + g) * 3 + 0];
#pragma unroll
      for (int dt = 0; dt < 4; ++dt) outv[dt] = acc[dt] * gc; }
    topk_token_s(impA + w * 264, impB + w * 264, lane, selm + w * 12);
    LDS_FENCE(); __syncthreads();
    if (lane < 20 && w == 0) { const int aa = lane / 10, wi = lane % 10; unsigned o = 0u;
#pragma unroll
        for (int i = 0; i < 4; ++i) o |= selm[(4 * aa + i) * 12 + wi];
        tun[aa * 12 + wi] = o; }
    if (w == 1) {
        const unsigned long long lt = (1ull << lane) - 1ull; int base = 0;
#pragma unroll
        for (int k = 0; k < 5; ++k) { unsigned o = 0u; const int wi = 2 * k + (lane >> 5);
#pragma unroll
            for (int i = 0; i < 8; ++i) o |= selm[i * 12 + wi];
            const bool bt = (o >> (lane & 31)) & 1u; const unsigned long long mm = __ballot(bt);
            if (bt) list[base + __popcll(mm & lt)] = 64 * k + lane;
            base += __popcll(mm); }
        if (lane == 0) misc[0] = base;
    }
    LDS_FENCE(); __syncthreads();
    const int nsel = misc[0];
    m = NINF; l = 0.f;
#pragma unroll
    for (int dt = 0; dt < 4; ++dt) acc[dt] = (f32x4){0.f, 0.f, 0.f, 0.f};
    for (int s0 = 0; s0 < nsel; s0 += 4) {
        TileSrc ts[4];
#pragma unroll
        for (int t = 0; t < 4; ++t) { const int j = (s0 + t < nsel) ? list[s0 + t] : -1;
            if (j < 0) { ts[t].k = C.out; ts[t].v = C.out; ts[t].stride = 0; ts[t].nrows = 0; }
            else if (j < 256) { const int page = C.page_table[b * NPAGE + (j >> 1)]; const float* base = C.cache_kv + ((size_t)page * PAGE + (size_t)(j & 1) * 64) * 512 + 2 * 128 + h * 64;
                ts[t].k = base; ts[t].v = base + 128; ts[t].stride = 512; ts[t].nrows = 64; }
            else { const float* base = C.out + O_KVS + ((size_t)b * LS) * 512 + 2 * 128 + h * 64; ts[t].k = base; ts[t].v = base + 128; ts[t].stride = 512; ts[t].nrows = LS; } }
        stage4_f32(L, ts, tid); LDS_FENCE(); __syncthreads();
        if (s0 + ks < nsel) { const int j = list[s0 + ks], wi = j >> 5, bt = j & 31;
            if ((__builtin_amdgcn_readfirstlane(tun[a * 12 + wi]) >> bt) & 1u) {
                f32x4 sc[4]; qk_tile(myK, Q0, Q1, c, q, sc);
                const bool mine = (selm[tok * 12 + wi] >> bt) & 1u;
                mask_tile(sc, q, 0, mine ? (j == 256 ? tok : 63) : -1);
                online_step(sc, true, m, l, acc);
                pv_tile_tr(myV, sc, lane, acc); } }
        __syncthreads();
    }
    merge4(mrg, w, lane, m, l, acc);
    { float lx = l; lx += __shfl_xor(lx, 16); lx += __shfl_xor(lx, 32);
      const float gs = C.GN[row * 32 + (h * 4 + g) * 3 + 1] / fmaxf(lx, 1e-30f);
#pragma unroll
      for (int dt = 0; dt < 4; ++dt) outv[dt] += acc[dt] * gs; }
    m = NINF; l = 0.f;
#pragma unroll
    for (int dt = 0; dt < 4; ++dt) acc[dt] = (f32x4){0.f, 0.f, 0.f, 0.f};
    for (int s0 = 0; s0 < 9; s0 += 4) {
        TileSrc ts[4];
#pragma unroll
        for (int t = 0; t < 4; ++t) { const int i = s0 + t;
            if (i < 8) { const float* base = C.cache_win + (((size_t)b * 512 + (size_t)i * 64) * 2) * 128 + h * 64; ts[t].k = base; ts[t].v = base + 128; ts[t].stride = 256; ts[t].nrows = 64; }
            else if (i == 8) { const float* base = C.out + O_WINS + ((size_t)b * 512 + 504) * 256 + h * 64; ts[t].k = base; ts[t].v = base + 128; ts[t].stride = 256; ts[t].nrows = LS; }
            else { ts[t].k = C.out; ts[t].v = C.out; ts[t].stride = 0; ts[t].nrows = 0; } }
        stage4_f32(L, ts, tid); LDS_FENCE(); __syncthreads();
        { const int i = s0 + ks;
          if (i < 9) { f32x4 sc[4]; qk_tile(myK, Q0, Q1, c, q, sc);
              mask_tile(sc, q, (i == 0) ? tok + 1 : 0, (i == 8) ? tok : 63);
              online_step(sc, true, m, l, acc);
              pv_tile_tr(myV, sc, lane, acc); } }
        __syncthreads();
    }
    merge4(mrg, w, lane, m, l, acc);
    if (ks == 0) { float lx = l; lx += __shfl_xor(lx, 16); lx += __shfl_xor(lx, 32);
        const float gw = C.GN[row * 32 + (h * 4 + g) * 3 + 2] / fmaxf(lx, 1e-30f);
#pragma unroll
        for (int dt = 0; dt < 4; ++dt) { const f32x4 o = outv[dt] + acc[dt] * gw; const int col = h * 256 + g * 64 + 16 * dt + 4 * q;
            const f32x4 z = unpk4(*(const v2u*)(C.SZA + row * 512 + col));
            v2u ov; ov.x = pk2(o.x * z.x, o.y * z.y); ov.y = pk2(o.z * z.z, o.w * z.w);
            *(v2u*)(C.OA + row * 512 + col) = ov; } }
}
template <int MODE> __device__ __forceinline__ void p5_attn(const Ctx& C) {
    LAS int* misc = (LAS int*)(C.lds + MISC_OFF + 128);
    unsigned* qctr = (unsigned*)(C.ws + WS_CTL) + CW_QCTR;
    for (;;) {
        if (C.tid == 0) misc[1] = (int)atomicAdd(qctr, 1u);
        __syncthreads();
        const int u = misc[1];
        __syncthreads();
        if (u >= BS * 2) break;
        if (!(MODE & 16)) attn_sample_unit(C, u >> 1, u & 1);
    }
    int nextv = 0;
    if (C.tid == 0) nextv = (int)atomicAdd(qctr + 64, 1u);
    for (;;) {
        if (C.tid == 0) misc[1] = nextv;
        __syncthreads();
        const int v = misc[1];
        __syncthreads();
        if (v >= BP * 2 * 128) break;
        if (C.tid == 0) nextv = (int)atomicAdd(qctr + 64, 1u);
        const int T = 127 - (v >> 3), sq = v & 7; attn_prompt_unit<MODE>(C, sq >> 1, sq & 1, T);
    }
}


template <class F>
__device__ __forceinline__ void skinny_gemm(const Ctx& C, const bf16* A, const bf16* Bt, int N, int K, const F& epi) {
    const int lane = C.lane, m = lane & 15, q = lane >> 4, nitems = (N >> 4) * 4;
    for (int it = C.gw; it < nitems; it += C.NGW) {
        const int s = it >> 2, rg = it & 3;
        const bf16* ap = A + (size_t)(64 * rg + m) * K + 8 * q; const bf16* bp = Bt + (size_t)(16 * s + m) * K + 8 * q;
        f32x4 acc[4];
#pragma unroll
        for (int mt = 0; mt < 4; ++mt) acc[mt] = (f32x4){0.f, 0.f, 0.f, 0.f};
#pragma unroll 8
        for (int ks = 0; ks < (K >> 5); ++ks) { const bf16x8 b = *(const bf16x8*)(bp + 32 * ks);
#pragma unroll
            for (int mt = 0; mt < 4; ++mt) acc[mt] = MFMA16(*(const bf16x8*)(ap + (size_t)mt * 16 * K + 32 * ks), b, acc[mt]); }
#pragma unroll
        for (int mt = 0; mt < 4; ++mt)
#pragma unroll
            for (int r = 0; r < 4; ++r) epi(64 * rg + 16 * mt + 4 * q + r, 16 * s + m, acc[mt][r]);
    }
}
template <class F>
__device__ __forceinline__ void skinny_gemm2(const Ctx& C, const bf16* A0, const bf16* Bt0, const bf16* A1, const bf16* Bt1, int N, int K, const F& epi) {
    const int lane = C.lane, m = lane & 15, q = lane >> 4, nitems = (N >> 4) * 4;
    for (int it = C.gw; it < nitems; it += C.NGW) {
        const int s = it >> 2, rg = it & 3;
        f32x4 acc0[4], acc1[4];
#pragma unroll
        for (int mt = 0; mt < 4; ++mt) { acc0[mt] = (f32x4){0.f, 0.f, 0.f, 0.f}; acc1[mt] = (f32x4){0.f, 0.f, 0.f, 0.f}; }
        { const bf16* ap = A0 + (size_t)(64 * rg + m) * K + 8 * q; const bf16* bp = Bt0 + (size_t)(16 * s + m) * K + 8 * q;
#pragma unroll 8
          for (int ks = 0; ks < (K >> 5); ++ks) { const bf16x8 b = *(const bf16x8*)(bp + 32 * ks);
#pragma unroll
              for (int mt = 0; mt < 4; ++mt) acc0[mt] = MFMA16(*(const bf16x8*)(ap + (size_t)mt * 16 * K + 32 * ks), b, acc0[mt]); } }
        { const bf16* ap = A1 + (size_t)(64 * rg + m) * K + 8 * q; const bf16* bp = Bt1 + (size_t)(16 * s + m) * K + 8 * q;
#pragma unroll 8
          for (int ks = 0; ks < (K >> 5); ++ks) { const bf16x8 b = *(const bf16x8*)(bp + 32 * ks);
#pragma unroll
              for (int mt = 0; mt < 4; ++mt) acc1[mt] = MFMA16(*(const bf16x8*)(ap + (size_t)mt * 16 * K + 32 * ks), b, acc1[mt]); } }
#pragma unroll
        for (int mt = 0; mt < 4; ++mt)
#pragma unroll
            for (int r = 0; r < 4; ++r) epi(64 * rg + 16 * mt + 4 * q + r, 16 * s + m, acc0[mt][r], acc1[mt][r]);
    }
}
__device__ __forceinline__ float bf2f1(bf16 v) { return __uint_as_float(((unsigned)v) << 16); }
struct SkIn {
    bf16 *QB, *KVB, *SZA, *SZS, *GM; float *U32, *GN, *out;
    __device__ __forceinline__ void operator()(int r, int c, float v) const {
        const size_t row = (size_t)MP + r;
        if (c < 512) QB[row * 512 + c] = (bf16)f2bf(v * QSCALE);
        else if (c < 1280) { const int kc = c - 512; KVB[row * 768 + kc] = (bf16)f2bf(v);
            if (kc < 512) out[O_KVS + (size_t)r * 512 + kc] = v; else out[O_WINS + ((size_t)(r >> 3) * 512 + 504 + (r & 7)) * 256 + (kc - 512)] = v; }
        else if (c < 1792) SZA[row * 512 + (c - 1280)] = (bf16)f2bf(v * sigmf(v));
        else if (c < 2304) U32[row * 512 + (c - 1792)] = v;
        else if (c < 2816) SZS[row * 512 + (c - 2304)] = (bf16)f2bf(v * sigmf(v));
        else if (c < 4864) GM[row * 2048 + (c - 2816)] = (bf16)f2bf(sigmf(v));
        else if (c < 4888) GN[row * 32 + (c - 4864)] = sigmf(v);
    }
};
struct SkGlu {
    bf16* YB; const bf16* Y1B; const bf16* SZS; const float* bias;
    __device__ __forceinline__ void operator()(int r, int c, float v) const { const size_t i = ((size_t)MP + r) * 512 + c; YB[i] = (bf16)f2bf(bf2f1(Y1B[i]) * sigmf(v + bias[c]) * bf2f1(SZS[i])); }
};
struct SkLift2 {
    bf16* MG; const bf16* GM;
    __device__ __forceinline__ void operator()(int r, int c, float vs, float va) const { const size_t row = (size_t)MP + r;
        MG[row * 1024 + c] = (bf16)f2bf(bf2f1(GM[row * 2048 + c]) * va + bf2f1(GM[row * 2048 + 1024 + c]) * vs); }
};
struct SkOut {
    bf16* YPB; const float* xs;
    __device__ __forceinline__ void operator()(int r, int c, float v) const { YPB[((size_t)MP + r) * 1024 + c] = (bf16)f2bf(xs[(size_t)r * 1024 + c] + v); }
};
__device__ __forceinline__ void p9_final(const Ctx& C) {
    const bf16* YPB = (const bf16*)(C.ws + WS_YPB);
    for (int m0 = C.gw; m0 < MT; m0 += 4 * C.NGW) {
        v4u p[4][2];
#pragma unroll
        for (int u = 0; u < 4; ++u) { const int m = m0 + u * C.NGW < MT ? m0 + u * C.NGW : m0;
#pragma unroll
            for (int j = 0; j < 2; ++j) p[u][j] = *(const v4u*)(YPB + (size_t)m * D + 512 * j + 8 * C.lane); }
#pragma unroll
        for (int u = 0; u < 4; ++u) { const int m = m0 + u * C.NGW; if (m >= MT) break;
            f32x4 v[4]; float s = 0.f;
#pragma unroll
            for (int j = 0; j < 2; ++j) { const v4u pp = p[u][j];
                v[2 * j] = (f32x4){__uint_as_float(pp.x << 16), __uint_as_float(pp.x & 0xffff0000u), __uint_as_float(pp.y << 16), __uint_as_float(pp.y & 0xffff0000u)};
                v[2 * j + 1] = (f32x4){__uint_as_float(pp.z << 16), __uint_as_float(pp.z & 0xffff0000u), __uint_as_float(pp.w << 16), __uint_as_float(pp.w & 0xffff0000u)}; }
#pragma unroll
            for (int j = 0; j < 4; ++j) s += (v[j].x * v[j].x + v[j].y * v[j].y) + (v[j].z * v[j].z + v[j].w * v[j].w);
            const float r = rsqrtf(wave_sum(s) * (1.f / D) + RMS_EPS);
#pragma unroll
            for (int j = 0; j < 4; ++j) { const int col = 512 * (j >> 1) + 8 * C.lane + 4 * (j & 1);
                *(f32x4*)(C.out + (size_t)m * D + col) = v[j] * r * *(const f32x4*)(C.final_g + col); } }
    }
    for (int it = C.gw; it < BS * 504; it += C.NGW) { const int b = it / 504, i = it % 504;
        ((f32x4*)(C.out + O_WINS + ((size_t)b * 512 + i) * 256))[C.lane] = ((const f32x4*)(C.cache_win + ((size_t)b * 512 + i + 8) * 256))[C.lane]; }
}

constexpr int N_PHASES = 8;
struct Args { const void* in[27]; float* out; unsigned char* ws; int ph_lo, ph_hi; };
__device__ __forceinline__ int lane_id() { return (int)__builtin_amdgcn_mbcnt_hi(~0u, __builtin_amdgcn_mbcnt_lo(~0u, 0u)); }
__device__ __forceinline__ void make_ctx(Ctx& C, const Args& a, unsigned char* lds_raw, const int wv) {
    C.lds = (LAS unsigned char*)lds_raw; C.wave = wv; C.lane = lane_id(); C.tid = wv * 64 + C.lane;
    C.G = gridDim.x; C.gw = blockIdx.x * NWAVES + C.wave; C.NGW = C.G * NWAVES;
    C.xp = (const float*)a.in[0]; C.xs = (const float*)a.in[1]; C.cache_kv = (const float*)a.in[2]; C.cache_win = (const float*)a.in[3]; C.st_re = (const float*)a.in[4]; C.st_im = (const float*)a.in[5];
    C.page_table = (const int*)a.in[6]; C.norm_g = (const float*)a.in[7]; C.w_in = (const float*)a.in[8]; C.cmp_pe = (const float*)a.in[9]; C.cmp_w1 = (const float*)a.in[10]; C.cmp_b1 = (const float*)a.in[11];
    C.cmp_w2 = (const float*)a.in[12]; C.lam_re = (const float*)a.in[13]; C.lam_im = (const float*)a.in[14]; C.log_dt = (const float*)a.in[15]; C.b_re = (const float*)a.in[16]; C.b_im = (const float*)a.in[17];
    C.c_re = (const float*)a.in[18]; C.c_im = (const float*)a.in[19]; C.ssm_d = (const float*)a.in[20]; C.w_glu = (const float*)a.in[21]; C.b_glu = (const float*)a.in[22]; C.w_la = (const float*)a.in[23];
    C.w_ls = (const float*)a.in[24]; C.w_out = (const float*)a.in[25]; C.final_g = (const float*)a.in[26];
    C.out = a.out; C.ws = a.ws; unsigned char* ws = a.ws;
    C.WTIN = (bf16*)(ws + WS_WTIN); C.WTGLU = (bf16*)(ws + WS_WTGLU); C.WTLA = (bf16*)(ws + WS_WTLA); C.WTLS = (bf16*)(ws + WS_WTLS); C.WTOUT = (bf16*)(ws + WS_WTOUT); C.WTC1 = (bf16*)(ws + WS_WTC1);
    C.XN = (bf16*)(ws + WS_XN); C.OA = (bf16*)(ws + WS_OA); C.Y1B = (bf16*)(ws + WS_Y1B); C.YB = (bf16*)(ws + WS_YB); C.MG = (bf16*)(ws + WS_MG); C.XC = (bf16*)(ws + WS_XC);
    C.KST = (float*)(ws + WS_CONST); C.SEND = (float*)(ws + WS_SEND); C.KC = (float*)(ws + WS_KC); C.VC = (float*)(ws + WS_VC); C.Y1 = (float*)(ws + WS_Y1); C.MB = (float*)(ws + WS_MB);
    C.PP = (float*)(ws + WS_PP); C.U32 = (float*)(ws + WS_U32); C.GN = (float*)(ws + WS_GN);
    C.KVB = (bf16*)(ws + WS_KVB); C.SZA = (bf16*)(ws + WS_SZA); C.SZS = (bf16*)(ws + WS_SZS); C.GM = (bf16*)(ws + WS_GM);
    C.QB = (bf16*)(ws + WS_QB); C.VST = (bf16*)(ws + WS_VST); C.VWT = (bf16*)(ws + WS_VWT); C.KCB = (bf16*)(ws + WS_KCB); C.VCT = (bf16*)(ws + WS_VCT); C.KCBS = (bf16*)(ws + WS_KCBS); C.VCBS = (bf16*)(ws + WS_VCBS);
}
__global__ void __launch_bounds__(NWAVES * 64, 2) mk_fwd(Args a) {
    extern __shared__ __attribute__((aligned(16))) unsigned char lds_raw[];
    unsigned char* ws = a.ws;
    volatile LAS unsigned* MISC = (volatile LAS unsigned*)((LAS unsigned char*)lds_raw + MISC_OFF);
    const int wv = __builtin_amdgcn_readfirstlane((int)threadIdx.x >> 6);
    if (wv == 0) MISC[lane_id()] = 0u;
    __syncthreads();
    const int lo = a.ph_lo, hi = a.ph_hi;
    const bool multi = (hi - lo) > 1;
    XcdBarrier bar; bar.bar = (unsigned*)(ws + WS_CTL) + CW_BAR; bar.x = 0; bar.st = nullptr;
    if (multi) bar = xcd_barrier_post((unsigned*)(ws + WS_CTL) + CW_BAR, MISC + 8, wv * 64 + lane_id());
#define IN(k) (lo <= (k) && (k) < hi)
#define MK Ctx C; make_ctx(C, a, lds_raw, wv)
#define SEAM(k) do { if (IN(k) && IN((k) + 1)) xcd_barrier(bar, wv * 64 + lane_id()); } while (0)
    if (IN(0)) { MK; p0_prep(C);
#if defined(REPEAT_WHAT) && REPEAT_WHAT == 0
        __syncthreads(); p0_prep(C);
#endif
    } SEAM(0);
    if (IN(1)) { MK; pg8::Gemm g{C.XN, C.WTIN, MP, NINP, D}; pg8::StaticOrder S; S.init(MP, NINP, C.G, (int)blockIdx.x);
        pg8::EpiIn E{C.QB, C.KVB, C.SZA, C.SZS, C.GM, C.XC, C.U32, C.GN, C.out, QSCALE, MP, O_KVP, O_KVS, O_WINP, O_WINS, (size_t)XC_S_ROWS};
        pg8::gemm_phase<pg8::EpiIn, pg8::StaticOrder, true, true>(C.lds, g, S, E, C.tid);
        SkIn K{C.QB, C.KVB, C.SZA, C.SZS, C.GM, C.U32, C.GN, C.out}; skinny_gemm(C, C.XN + (size_t)MP * D, C.WTIN, NINP, D, K);
#if defined(REPEAT_WHAT) && REPEAT_WHAT == 11
        skinny_gemm(C, C.XN + (size_t)MP * D, C.WTIN, NINP, D, K);
#endif
    } SEAM(1);
    if (IN(2)) { MK; p2_cmp1(C); __syncthreads(); p2_ssm_pass1(C); __syncthreads(); p3_ssm_pass2(C, true);
#if defined(REPEAT_WHAT) && REPEAT_WHAT == 21
        __syncthreads(); p2_cmp1(C);
#endif
#if defined(REPEAT_WHAT) && REPEAT_WHAT == 22
        __syncthreads();
#endif
#if defined(REPEAT_WHAT) && REPEAT_WHAT == 23
        __syncthreads(); p2_ssm_pass1(C);
#endif
    } SEAM(2);
    if (IN(3)) { MK; p3_ssm_pass2(C, false); __syncthreads(); p4_cmp2(C);
#if defined(REPEAT_WHAT) && REPEAT_WHAT == 31
        for (int rr = 0; rr < 4; ++rr) { __syncthreads(); p3_ssm_pass2(C, false); }
#endif
#if defined(REPEAT_WHAT) && REPEAT_WHAT == 32
        __syncthreads(); p4_cmp2(C);
#endif
    } SEAM(3);
    if (IN(4)) { MK; { pg8::Gemm g{C.Y1B, C.WTGLU, MP, 512, 512}; pg8::StaticOrder S; S.init(MP, 512, C.G, (int)blockIdx.x); pg8::EpiGlu E{C.YB, C.Y1B, C.SZS, C.b_glu};
        pg8::gemm_phase<pg8::EpiGlu, pg8::StaticOrder, true, true>(C.lds, g, S, E, C.tid);
        SkGlu K{C.YB, C.Y1B, C.SZS, C.b_glu}; skinny_gemm(C, C.Y1B + (size_t)MP * 512, C.WTGLU, 512, 512, K); }
        __syncthreads(); p5_attn<0>(C); } SEAM(4);
    if (IN(5)) { MK; pg8::Gemm g{C.YB, C.WTLS, MP, 1024, 512, C.OA, C.WTLA}; pg8::PairOrder S; S.init(MP, 1024, C.G, (int)blockIdx.x); pg8::EpiLift2 E{C.MG, C.GM};
        pg8::gemm_phase<pg8::EpiLift2, pg8::PairOrder, true, true>(C.lds, g, S, E, C.tid);
        SkLift2 K{C.MG, C.GM}; skinny_gemm2(C, C.YB + (size_t)MP * 512, C.WTLS, C.OA + (size_t)MP * 512, C.WTLA, 1024, 512, K);
#if defined(REPEAT_WHAT) && REPEAT_WHAT == 5
        __syncthreads(); pg8::gemm_phase<pg8::EpiLift2, pg8::PairOrder, true, true>(C.lds, g, S, E, C.tid);
#endif
    } SEAM(5);
    if (IN(6)) { MK; pg8::Gemm g{C.MG, C.WTOUT, MP, 1024, 1024}; pg8::StaticOrder S; S.init(MP, 1024, C.G, (int)blockIdx.x); pg8::EpiOut E{(bf16*)(C.ws + WS_YPB), C.xp, C.xs, MP};
        pg8::gemm_phase<pg8::EpiOut, pg8::StaticOrder, true, true>(C.lds, g, S, E, C.tid);
        SkOut K{(bf16*)(C.ws + WS_YPB), C.xs}; skinny_gemm(C, C.MG + (size_t)MP * 1024, C.WTOUT, 1024, 1024, K); } SEAM(6);
    if (IN(7)) { MK; p9_final(C);
#if defined(REPEAT_WHAT) && REPEAT_WHAT == 71
        __syncthreads(); { pg8::Gemm g{C.XN, C.WTIN, MP, NINP, D}; pg8::StaticOrder S; S.init(MP, NINP, C.G, (int)blockIdx.x);
        pg8::EpiIn E{C.QB, C.KVB, C.SZA, C.SZS, C.GM, C.XC, C.U32, C.GN, C.out, QSCALE, MP, O_KVP, O_KVS, O_WINP, O_WINS, (size_t)XC_S_ROWS};
        pg8::gemm_phase<pg8::EpiIn, pg8::StaticOrder, true, true>(C.lds, g, S, E, C.tid); }
#endif
#if defined(REPEAT_WHAT) && REPEAT_WHAT == 72
        __syncthreads(); { pg8::Gemm g{C.YB, C.WTLS, MP, 1024, 512, C.OA, C.WTLA}; pg8::PairOrder S; S.init(MP, 1024, C.G, (int)blockIdx.x); pg8::EpiLift2 E{C.MG, C.GM};
        pg8::gemm_phase<pg8::EpiLift2, pg8::PairOrder, true, true>(C.lds, g, S, E, C.tid); }
#endif
    }
#undef IN
#undef SEAM
}

#ifndef MK_ONE_LAUNCH
#define MK_ONE_LAUNCH 1
#endif
extern "C" void kernel_launch(void* const* d_in, const int* in_sizes, int n_in, void* d_out, int out_size, void* d_ws, size_t ws_size, hipStream_t stream) {
    static int grid = 0;
    if (grid == 0) {
        if (n_in != 27 || (size_t)out_size != O_END || ws_size < WS_END) { fprintf(stderr, "kernel_launch: unexpected shapes: n_in %d out %d ws %zu\n", n_in, out_size, ws_size); grid = -1; return; }
        int dev = 0, cus = 0, per_cu = 0;
        if (hipGetDevice(&dev) != hipSuccess || hipDeviceGetAttribute(&cus, hipDeviceAttributeMultiprocessorCount, dev) != hipSuccess) { grid = -1; return; }
        if (hipFuncSetAttribute((const void*)mk_fwd, hipFuncAttributeMaxDynamicSharedMemorySize, LDS_BYTES) != hipSuccess) { fprintf(stderr, "kernel_launch: hipFuncSetAttribute failed\n"); grid = -1; return; }
        if (hipOccupancyMaxActiveBlocksPerMultiprocessor(&per_cu, (const void*)mk_fwd, NWAVES * 64, LDS_BYTES) != hipSuccess || per_cu < 1) fprintf(stderr, "kernel_launch: occupancy query reports %d\n", per_cu);
        (void)hipGetLastError();
        grid = cus;
    }
    if (grid < 0) return;
    (void)hipMemsetAsync((char*)d_ws + WS_CTL, 0, CTL_ZERO_BYTES, stream);
    Args a{};
    for (int i = 0; i < 27; ++i) a.in[i] = d_in[i];
    a.out = (float*)d_out; a.ws = (unsigned char*)d_ws;
#if MK_ONE_LAUNCH
    a.ph_lo = 0; a.ph_hi = N_PHASES;
    hipLaunchKernelGGL(mk_fwd, dim3(grid), dim3(NWAVES * 64), LDS_BYTES, stream, a);
#else
    for (int p = 0; p < N_PHASES; ++p) { a.ph_lo = p; a.ph_hi = p + 1; hipLaunchKernelGGL(mk_fwd, dim3(grid), dim3(NWAVES * 64), LDS_BYTES, stream, a); }
#endif
}
```

```cpp
#include <hip/hip_runtime.h>
#include <cstdio>
#include <cstdint>
namespace pg8 {
#define PG8_LAS __attribute__((address_space(3)))
typedef unsigned short bf16_t;
typedef short bf16x8 __attribute__((ext_vector_type(8)));
typedef float f32x4 __attribute__((ext_vector_type(4)));
typedef unsigned u32x4 __attribute__((ext_vector_type(4)));
constexpr int BM = 256, BK = 64, HALF = 128, HTB = HALF * BK * 2  , STAGE_BYTES = 8 * HTB, NXCD = 8, WGM = 8;

__host__ __device__ __forceinline__ int lds_byte(int r, int c) { const int st = (r >> 4) * 2 + (c >> 5), rr = r & 15, cc = c & 31, ob = rr * 64 + cc * 2; return st * 1024 + (ob ^ (((ob >> 9) & 1) << 5)); }
__host__ __device__ __forceinline__ void stage_rc(int b, int& R, int& C) { const int st = b / 1024, sb = b % 1024, swz = sb ^ (((sb >> 9) & 1) << 5); R = (st >> 1) * 16 + swz / 64; C = (st & 1) * 32 + (swz % 64) / 2; }
__host__ __device__ __forceinline__ int perm32(int rho) { const int n = rho >> 4, i = rho & 15; return 8 * (i >> 2) + 4 * n + (i & 3); }

struct Unit { int pm, pn, part; };
struct Gemm { const bf16_t* A; const bf16_t* Bt; int M, N, K; const bf16_t* A2; const bf16_t* Bt2; };

struct StaticOrder {
    int nM, nN, nwg, G, c;
    __host__ __device__ void init(int M, int N, int G_, int c_) { nM = M / BM; nN = N / BM; nwg = nM * nN; G = G_; c = c_; }
    __host__ __device__ bool next(int i, Unit& u) const {
        const long L = (long)i * G + c; if (L >= nwg) return false;
        int wgid = (int)L; { const int q = nwg / NXCD, r = nwg % NXCD, xcd = wgid % NXCD, off = wgid / NXCD; wgid = (xcd < r ? xcd * (q + 1) : r * (q + 1) + (xcd - r) * q) + off; }
        const int nig = WGM * nN, gid = wgid / nig, fm = gid * WGM, gsz = (nM - fm) < WGM ? (nM - fm) : WGM;
        u.pm = fm + ((wgid % nig) % gsz); u.pn = (wgid % nig) / gsz; u.part = 0; return true;
    }
    __device__ __forceinline__ void a_ready(const Unit&) const {}
    __device__ __forceinline__ void done(const Unit&) const {}
};
struct PairOrder : StaticOrder {
    __host__ __device__ bool next(int i, Unit& u) const { if (!StaticOrder::next(i >> 1, u)) return false; u.part = i & 1; return true; }
};

__device__ __forceinline__ unsigned cvt_pk_bf16(float lo, float hi) { unsigned r; asm volatile("v_cvt_pk_bf16_f32 %0, %1, %2" : "=v"(r) : "v"(lo), "v"(hi)); return r; }
typedef float f32x2 __attribute__((ext_vector_type(2)));
__device__ __forceinline__ f32x2 gelu_pk(f32x2 v) {
    const f32x2 av = __builtin_elementwise_abs(v), d = av * 0.2316418882f + 1.0f;
    f32x2 t; t.x = __builtin_amdgcn_rcpf(d.x); t.y = __builtin_amdgcn_rcpf(d.y);
    f32x2 q = t * 0.5307027145f + (-0.7265760135f); q = q * t + 0.7107068705f; q = q * t + (-0.142248368f); q = q * t + 0.127414796f; q = q * t;
    const f32x2 s = (v * v) * (-0.72134752044f);
    f32x2 e; e.x = __builtin_amdgcn_exp2f(s.x); e.y = __builtin_amdgcn_exp2f(s.y);
    const f32x2 m = v * (q * e), r = v - m;
    f32x2 o; o.x = v.x < 0.f ? m.x : r.x; o.y = v.y < 0.f ? m.y : r.y; return o;
}

__device__ __forceinline__ float sigm(float x) { return 1.0f / (1.0f + __expf(-x)); }
__device__ __forceinline__ f32x4 sigm4(f32x4 v) { return (f32x4){sigm(v[0]), sigm(v[1]), sigm(v[2]), sigm(v[3])}; }

struct EpiF32 {
    static constexpr bool PERM = false, AFTER_DRAIN = false, TWO_PART = false;
    float* C; int ldc;
    __device__ __forceinline__ void operator()(const f32x4 (&acc)[2][2][4][2], const Unit& u, int wr, int wc, int fr, int fq) const {
        const int row0 = u.pm * BM + wr * 64 + fr, col0 = u.pn * BM + wc * 32 + 4 * fq;
#pragma unroll
        for (int ai = 0; ai < 2; ++ai)
#pragma unroll
            for (int m = 0; m < 4; ++m) { float* rowp = C + (size_t)(row0 + ai * HALF + m * 16) * ldc + col0;
#pragma unroll
                for (int bj = 0; bj < 2; ++bj)
#pragma unroll
                    for (int n = 0; n < 2; ++n) *(f32x4*)(rowp + bj * HALF + n * 16) = acc[ai][bj][m][n]; }
    }
};
__device__ __forceinline__ f32x4 bfx4(unsigned lo, unsigned hi) { return (f32x4){__uint_as_float(lo << 16), __uint_as_float(lo & 0xffff0000u), __uint_as_float(hi << 16), __uint_as_float(hi & 0xffff0000u)}; }
__device__ __forceinline__ u32x4 pack8f(f32x4 v0, f32x4 v1) { u32x4 w; w.x = cvt_pk_bf16(v0[0], v0[1]); w.y = cvt_pk_bf16(v0[2], v0[3]); w.z = cvt_pk_bf16(v1[0], v1[1]); w.w = cvt_pk_bf16(v1[2], v1[3]); return w; }
struct EpiIn {
    static constexpr bool PERM = true, AFTER_DRAIN = false, TWO_PART = false;
    bf16_t *QB, *KVB, *SZA, *SZS, *GM, *XC; float *U32, *GN, *out; float qscale; int mp;
    size_t o_kvp, o_kvs, o_winp, o_wins, xc_prow0;
    __device__ __forceinline__ void operator()(const f32x4 (&acc)[2][2][4][2], const Unit& u, int wr, int wc, int fr, int fq) const {
        const int row0 = u.pm * BM + wr * 64 + fr, pn = u.pn; const bool prm = u.pm * BM < mp;
#pragma unroll
        for (int ai = 0; ai < 2; ++ai)
#pragma unroll
            for (int m = 0; m < 4; ++m) { const size_t row = (size_t)(row0 + ai * HALF + m * 16);
#pragma unroll
                for (int bj = 0; bj < 2; ++bj) { const int c = pn * BM + bj * HALF + wc * 32 + 8 * fq; const f32x4 v0 = acc[ai][bj][m][0], v1 = acc[ai][bj][m][1];
                    if (pn < 2) { *(u32x4*)(QB + row * 512 + c) = pack8f(v0 * qscale, v1 * qscale); }
                    else if (pn < 5) { const int kc = c - 512, slot = kc >> 7;
                        *(u32x4*)(KVB + row * 768 + kc) = pack8f(v0, v1);
                        if (slot < 4) { float* d = out + (prm ? o_kvp + row * 512 : o_kvs + (row - mp) * 512) + kc; *(f32x4*)d = v0; *(f32x4*)(d + 4) = v1;
 }
                        else { const int wk = kc - 512;
                            if (prm) { const int t = (int)(row & 8191); if (t >= 7680) { float* d = out + o_winp + ((row >> 13) * 512 + (t - 7680)) * 256 + wk; *(f32x4*)d = v0; *(f32x4*)(d + 4) = v1; } }
                            else { const size_t q = row - mp; float* d = out + o_wins + ((q >> 3) * 512 + 504 + (q & 7)) * 256 + wk; *(f32x4*)d = v0; *(f32x4*)(d + 4) = v1; } } }
                    else if (pn < 7) { *(u32x4*)(SZA + row * 512 + (c - 1280)) = pack8f(v0 * sigm4(v0), v1 * sigm4(v1)); }
                    else if (pn < 9) { float* d = U32 + row * 512 + (c - 1792); *(f32x4*)d = v0; *(f32x4*)(d + 4) = v1; }
                    else if (pn < 11) { *(u32x4*)(SZS + row * 512 + (c - 2304)) = pack8f(v0 * sigm4(v0), v1 * sigm4(v1)); }
                    else if (pn < 19) { *(u32x4*)(GM + row * 2048 + (c - 2816)) = pack8f(sigm4(v0), sigm4(v1)); }
                    else if (c < 4888) { float* d = GN + row * 32 + (c - 4864); *(f32x4*)d = sigm4(v0); *(f32x4*)(d + 4) = sigm4(v1); } } }
    }
};
struct EpiGlu {
    static constexpr bool PERM = true, AFTER_DRAIN = false, TWO_PART = false;
    bf16_t* O; const bf16_t* Y1B; const bf16_t* SZS; const float* bias;
    __device__ __forceinline__ void operator()(const f32x4 (&acc)[2][2][4][2], const Unit& u, int wr, int wc, int fr, int fq) const {
        const int row0 = u.pm * BM + wr * 64 + fr, col0 = u.pn * BM + wc * 32 + 8 * fq;
#pragma unroll
        for (int ai = 0; ai < 2; ++ai)
#pragma unroll
            for (int m = 0; m < 4; ++m) { const size_t row = (size_t)(row0 + ai * HALF + m * 16);
#pragma unroll
                for (int bj = 0; bj < 2; ++bj) { const int c = col0 + bj * HALF;
                    const f32x4 b0 = *(const f32x4*)(bias + c), b1 = *(const f32x4*)(bias + c + 4);
                    const u32x4 yy = *(const u32x4*)(Y1B + row * 512 + c); const f32x4 y0 = bfx4(yy.x, yy.y), y1 = bfx4(yy.z, yy.w);
                    const u32x4 zz = *(const u32x4*)(SZS + row * 512 + c);
                    *(u32x4*)(O + row * 512 + c) = pack8f(y0 * sigm4(acc[ai][bj][m][0] + b0) * bfx4(zz.x, zz.y), y1 * sigm4(acc[ai][bj][m][1] + b1) * bfx4(zz.z, zz.w)); } }
    }
};
struct EpiLift2 {
    static constexpr bool PERM = true, AFTER_DRAIN = false, TWO_PART = true;
    bf16_t* O; const bf16_t* GM;
    __device__ __forceinline__ void mid(f32x4 (&acc)[2][2][4][2], const Unit& u, int wr, int wc, int fr, int fq) const {
        const int row0 = u.pm * BM + wr * 64 + fr, col0 = u.pn * BM + wc * 32 + 8 * fq;
#pragma unroll
        for (int ai = 0; ai < 2; ++ai)
#pragma unroll
            for (int m = 0; m < 4; ++m) { const size_t row = (size_t)(row0 + ai * HALF + m * 16);
#pragma unroll
                for (int bj = 0; bj < 2; ++bj) { const int c = col0 + bj * HALF; const u32x4 ga = *(const u32x4*)(GM + row * 2048 + c), gb = *(const u32x4*)(GM + row * 2048 + 1024 + c);
                    const f32x4 a0 = bfx4(ga.x, ga.y), a1 = bfx4(ga.z, ga.w), b0 = bfx4(gb.x, gb.y), b1 = bfx4(gb.z, gb.w);
#pragma unroll
                    for (int j = 0; j < 4; ++j) { acc[ai][bj][m][0][j] *= b0[j] * __builtin_amdgcn_rcpf(fmaxf(a0[j], 1e-30f)); acc[ai][bj][m][1][j] *= b1[j] * __builtin_amdgcn_rcpf(fmaxf(a1[j], 1e-30f)); } } }
    }
    __device__ __forceinline__ void operator()(const f32x4 (&acc)[2][2][4][2], const Unit& u, int wr, int wc, int fr, int fq) const {
        const int row0 = u.pm * BM + wr * 64 + fr, col0 = u.pn * BM + wc * 32 + 8 * fq;
#pragma unroll
        for (int ai = 0; ai < 2; ++ai)
#pragma unroll
            for (int m = 0; m < 4; ++m) { const size_t row = (size_t)(row0 + ai * HALF + m * 16);
#pragma unroll
                for (int bj = 0; bj < 2; ++bj) { const int c = col0 + bj * HALF; const u32x4 ga = *(const u32x4*)(GM + row * 2048 + c);
                    *(u32x4*)(O + row * 1024 + c) = pack8f(bfx4(ga.x, ga.y) * acc[ai][bj][m][0], bfx4(ga.z, ga.w) * acc[ai][bj][m][1]); } }
    }
};
struct EpiOut {
    static constexpr bool PERM = true, AFTER_DRAIN = false, TWO_PART = false;
    bf16_t* O; const float* xp; const float* xs; int mp;
    __device__ __forceinline__ void operator()(const f32x4 (&acc)[2][2][4][2], const Unit& u, int wr, int wc, int fr, int fq) const {
        const int row0 = u.pm * BM + wr * 64 + fr, col0 = u.pn * BM + wc * 32 + 8 * fq;
        const float* xb = (u.pm * BM < mp) ? xp : (xs - (size_t)mp * 1024);
#pragma unroll
        for (int ai = 0; ai < 2; ++ai)
#pragma unroll
            for (int m = 0; m < 4; ++m) { const size_t row = (size_t)(row0 + ai * HALF + m * 16);
#pragma unroll
                for (int bj = 0; bj < 2; ++bj) { const int c = col0 + bj * HALF;
                    const f32x4 x0 = *(const f32x4*)(xb + row * 1024 + c), x1 = *(const f32x4*)(xb + row * 1024 + c + 4);
                    *(u32x4*)(O + row * 1024 + c) = pack8f(x0 + acc[ai][bj][m][0], x1 + acc[ai][bj][m][1]); } }
    }
};

template <class Epi, class Sched, bool ALIGN_EPI = false, bool SP2 = false>
__device__ __forceinline__ void gemm_phase(PG8_LAS unsigned char* lds, const Gemm g, const Sched& S, const Epi& E, const int tid_in) {
    const int tid = tid_in, wid = __builtin_amdgcn_readfirstlane(tid >> 6), lane = tid & 63, wr = wid >> 2, wc = wid & 3, fr = lane & 15, fq = lane >> 4;
    const int K = g.K, nt = K / BK;
    unsigned voffA[2], voffB[2];
#pragma unroll
    for (int i = 0; i < 2; ++i) { int R, C; stage_rc(tid * 16 + i * 8192, R, C); const int Rb = Epi::PERM ? ((R & ~31) + perm32(R & 31)) : R;
        voffA[i] = (unsigned)(R * K + C) * 2u; voffB[i] = (unsigned)(Rb * K + C) * 2u; }
    const size_t kstep = (size_t)(BK * 2);
    const size_t hstep = (size_t)HALF * K * 2;
    const size_t tstep = 2 * hstep;
    const unsigned ldsw = (unsigned)wid * 1024u;
    const int aoff = lds_byte(wr * 64 + fr, fq * 8), boff = lds_byte(wc * 32 + fr, fq * 8);
#define PG8_SA(b, h) (((b) * 2 + (h)) * HTB)
#define PG8_SB(b, h) ((4 + (b) * 2 + (h)) * HTB)
#define PG8_STAGE(bufoff, gbase, voff) do { _Pragma("unroll") for (int _i = 0; _i < 2; ++_i) \
        __builtin_amdgcn_global_load_lds((const unsigned*)((const char*)(gbase) + (voff)[_i]), (PG8_LAS unsigned*)(lds + (bufoff) + ldsw + _i * 8192), 16, 0, 0); } while (0)
#define PG8_LDA(dst, b, h) do { _Pragma("unroll") for (int m = 0; m < 4; ++m) _Pragma("unroll") for (int k = 0; k < 2; ++k) dst[m][k] = *(const PG8_LAS bf16x8*)(lds + PG8_SA(b, h) + aoff + m * 2048 + k * 1024); } while (0)
#define PG8_LDB(dst, b, h) do { _Pragma("unroll") for (int n = 0; n < 2; ++n) _Pragma("unroll") for (int k = 0; k < 2; ++k) dst[n][k] = *(const PG8_LAS bf16x8*)(lds + PG8_SB(b, h) + boff + n * 2048 + k * 1024); } while (0)
#define PG8_MMA(ai, bj, At, Bt) do { __builtin_amdgcn_s_setprio(1); _Pragma("unroll") for (int m = 0; m < 4; ++m) _Pragma("unroll") for (int n = 0; n < 2; ++n) _Pragma("unroll") for (int k = 0; k < 2; ++k) \
        acc[ai][bj][m][n] = __builtin_amdgcn_mfma_f32_16x16x32_bf16(Bt[n][k], At[m][k], acc[ai][bj][m][n], 0, 0, 0); __builtin_amdgcn_s_setprio(0); } while (0)
#define PG8_WAIT_V(n) asm volatile("s_waitcnt vmcnt(" #n ")" ::: "memory")
#define PG8_WAIT_L(n) asm volatile("s_waitcnt lgkmcnt(" #n ")" ::: "memory")
#define PG8_BAR __builtin_amdgcn_s_barrier()
#define PG8_SCHED __builtin_amdgcn_sched_barrier(0)
    Unit cur, nxt; int ui = 0;
    if (!S.next(0, cur)) return;
    f32x4 acc[2][2][4][2];
#pragma unroll
    for (int a = 0; a < 2; ++a)
#pragma unroll
        for (int b = 0; b < 2; ++b)
#pragma unroll
            for (int m = 0; m < 4; ++m)
#pragma unroll
                for (int n = 0; n < 2; ++n) acc[a][b][m][n] = (f32x4){0.f, 0.f, 0.f, 0.f};
    bf16x8 At[4][2], B0[2][2], B1[2][2];
    const char* cA = (const char*)((Epi::TWO_PART && cur.part) ? g.A2 : g.A) + (size_t)cur.pm * tstep; const char* cB = (const char*)((Epi::TWO_PART && cur.part) ? g.Bt2 : g.Bt) + (size_t)cur.pn * tstep;
    S.a_ready(cur);
    if constexpr (SP2) {
        PG8_STAGE(PG8_SB(0, 0), cB, voffB); PG8_STAGE(PG8_SB(0, 1), cB + hstep, voffB); PG8_STAGE(PG8_SA(0, 0), cA, voffA); PG8_STAGE(PG8_SA(0, 1), cA + hstep, voffA);
        if (wr == 1) PG8_BAR;
        PG8_WAIT_V(2); PG8_BAR;
        PG8_STAGE(PG8_SB(1, 0), cB + kstep, voffB); PG8_STAGE(PG8_SA(1, 0), cA + kstep, voffA); PG8_STAGE(PG8_SB(1, 1), cB + hstep + kstep, voffB);
        PG8_WAIT_V(6); PG8_BAR;
    } else {
        PG8_STAGE(PG8_SB(0, 0), cB, voffB); PG8_STAGE(PG8_SA(0, 0), cA, voffA); PG8_STAGE(PG8_SB(0, 1), cB + hstep, voffB); PG8_STAGE(PG8_SA(0, 1), cA + hstep, voffA);
        if (wr == 1) PG8_BAR;
        PG8_WAIT_V(4); PG8_BAR;
        PG8_STAGE(PG8_SB(1, 0), cB + kstep, voffB); PG8_STAGE(PG8_SA(1, 0), cA + kstep, voffA); PG8_STAGE(PG8_SB(1, 1), cB + hstep + kstep, voffB);
        PG8_WAIT_V(6); PG8_BAR;
    }
    for (;;) {
        const bool has_next = S.next(ui + 1, nxt);
        const char* nA = has_next ? (const char*)((Epi::TWO_PART && nxt.part) ? g.A2 : g.A) + (size_t)nxt.pm * tstep : cA; const char* nB = has_next ? (const char*)((Epi::TWO_PART && nxt.part) ? g.Bt2 : g.Bt) + (size_t)nxt.pn * tstep : cB;
        for (int t = 0; t < nt; t += 2) {
            const bool last = (t == nt - 2);
            const char* a1 = cA + (size_t)(t + 1) * kstep;
            const char* a2 = last ? nA : cA + (size_t)(t + 2) * kstep; const char* b2 = last ? nB : cB + (size_t)(t + 2) * kstep;
            const char* a3 = a2 + kstep; const char* b3 = b2 + kstep;
            if (last && has_next) S.a_ready(nxt);
            if constexpr (SP2) {
            PG8_LDB(B0, 0, 0); PG8_LDB(B1, 0, 1); PG8_SCHED; PG8_LDA(At, 0, 0); PG8_STAGE(PG8_SA(1, 1), a1 + hstep, voffA);
            PG8_WAIT_V(8); PG8_WAIT_L(0); PG8_BAR; PG8_MMA(0, 0, At, B0); PG8_MMA(0, 1, At, B1); PG8_BAR; PG8_SCHED;
            PG8_LDA(At, 0, 1); PG8_STAGE(PG8_SB(0, 0), b2, voffB); PG8_STAGE(PG8_SB(0, 1), b2 + hstep, voffB); PG8_STAGE(PG8_SA(0, 0), a2, voffA);
            PG8_WAIT_V(8); PG8_WAIT_L(0); PG8_BAR; PG8_MMA(1, 0, At, B0); PG8_MMA(1, 1, At, B1); PG8_BAR; PG8_SCHED;
            PG8_LDB(B0, 1, 0); PG8_LDB(B1, 1, 1); PG8_SCHED; PG8_LDA(At, 1, 0); PG8_STAGE(PG8_SA(0, 1), a2 + hstep, voffA);
            PG8_WAIT_V(8); PG8_WAIT_L(0); PG8_BAR; PG8_MMA(0, 0, At, B0); PG8_MMA(0, 1, At, B1); PG8_BAR; PG8_SCHED;
            PG8_LDA(At, 1, 1); PG8_STAGE(PG8_SB(1, 0), b3, voffB); PG8_STAGE(PG8_SB(1, 1), b3 + hstep, voffB); PG8_STAGE(PG8_SA(1, 0), a3, voffA);
            PG8_WAIT_V(8); PG8_WAIT_L(0); PG8_BAR; PG8_MMA(1, 0, At, B0); PG8_MMA(1, 1, At, B1); PG8_BAR; PG8_SCHED;
            } else {
            PG8_LDB(B0, 0, 0); PG8_SCHED; PG8_LDA(At, 0, 0); PG8_STAGE(PG8_SA(1, 1), a1 + hstep, voffA);
            PG8_WAIT_L(8); PG8_BAR; PG8_WAIT_L(0); PG8_MMA(0, 0, At, B0); PG8_BAR; PG8_SCHED;
            PG8_LDB(B1, 0, 1); PG8_STAGE(PG8_SB(0, 0), b2, voffB);
            PG8_BAR; PG8_WAIT_L(0); PG8_MMA(0, 1, At, B1); PG8_BAR;
            PG8_LDA(At, 0, 1); PG8_STAGE(PG8_SA(0, 0), a2, voffA);
            PG8_BAR; PG8_WAIT_L(0); PG8_MMA(1, 0, At, B0); PG8_BAR; PG8_SCHED;
            PG8_STAGE(PG8_SB(0, 1), b2 + hstep, voffB);
            PG8_WAIT_V(6); PG8_BAR; PG8_MMA(1, 1, At, B1); PG8_BAR;
            PG8_LDB(B0, 1, 0); PG8_SCHED; PG8_LDA(At, 1, 0); PG8_STAGE(PG8_SA(0, 1), a2 + hstep, voffA);
            PG8_WAIT_L(8); PG8_BAR; PG8_WAIT_L(0); PG8_MMA(0, 0, At, B0); PG8_BAR; PG8_SCHED;
            PG8_LDB(B1, 1, 1); PG8_STAGE(PG8_SB(1, 0), b3, voffB);
            PG8_BAR; PG8_WAIT_L(0); PG8_MMA(0, 1, At, B1); PG8_BAR;
            PG8_LDA(At, 1, 1); PG8_STAGE(PG8_SA(1, 0), a3, voffA);
            PG8_BAR; PG8_WAIT_L(0); PG8_MMA(1, 0, At, B0); PG8_BAR; PG8_SCHED;
            PG8_STAGE(PG8_SB(1, 1), b3 + hstep, voffB);
            PG8_WAIT_V(6); PG8_BAR; PG8_MMA(1, 1, At, B1); PG8_BAR;
            }
        }
        if constexpr (ALIGN_EPI) { if (wr == 0) PG8_BAR; }
        bool keep_acc = false;
        if constexpr (Epi::TWO_PART) { if (cur.part == 0) { E.mid(acc, cur, wr, wc, fr, fq); keep_acc = true; } else { E(acc, cur, wr, wc, fr, fq); } }
        else if constexpr (!Epi::AFTER_DRAIN) { E(acc, cur, wr, wc, fr, fq); S.done(cur); }
        if (!has_next) break;
        if (!keep_acc)
#pragma unroll
        for (int a = 0; a < 2; ++a)
#pragma unroll
            for (int b = 0; b < 2; ++b)
#pragma unroll
                for (int m = 0; m < 4; ++m)
#pragma unroll
                    for (int n = 0; n < 2; ++n) acc[a][b][m][n] = (f32x4){0.f, 0.f, 0.f, 0.f};
        cur = nxt; cA = nA; cB = nB; ++ui;
        if constexpr (ALIGN_EPI) { if (wr == 1) PG8_BAR; }
    }
    PG8_WAIT_V(0);
    if constexpr (!ALIGN_EPI) { if (wr == 0) PG8_BAR; }
    PG8_BAR;
    if constexpr (Epi::AFTER_DRAIN) { E.fused(acc, cur, wr, wc, fr, fq, lds, wid, lane); S.done(cur); }
#undef PG8_SA
#undef PG8_SB
#undef PG8_STAGE
#undef PG8_LDA
#undef PG8_LDB
#undef PG8_MMA
#undef PG8_WAIT_V
#undef PG8_WAIT_L
#undef PG8_BAR
#undef PG8_SCHED
}
}
#define LAS __attribute__((address_space(3)))
#define XB_TMO      128
#define XB_XCNT(j)  (256  + 64 * (j))
#define XB_XSUB(j)  (1280 + 64 * (j))
#define XB_XGEN(j)  (2304 + 64 * (j))
#define XB_TOP      3328
#define XB_TOPGEN   3392
#define XCD_BAR_WORDS 3456
#define XB_SPIN_CAP (1u << 18)

__device__ __forceinline__ unsigned xb_ld(unsigned* p)              { return __hip_atomic_load(p, __ATOMIC_RELAXED, __HIP_MEMORY_SCOPE_AGENT); }
__device__ __forceinline__ unsigned xb_add(unsigned* p, unsigned v) { return __hip_atomic_fetch_add(p, v, __ATOMIC_RELAXED, __HIP_MEMORY_SCOPE_AGENT); }
__device__ __forceinline__ unsigned xb_xcc_id() { return (unsigned)__builtin_amdgcn_s_getreg((3 << 11) | 20) & 0xFu; }
#define XB_SPIN(cond, bar) do { unsigned _sp = 0; while (cond) { __builtin_amdgcn_s_sleep(1); \
    if ((++_sp & 255u) == 0u) { if (xb_ld(&(bar)[XB_TMO])) break; if (_sp > XB_SPIN_CAP) { atomicAdd(&(bar)[XB_TMO], 1u); break; } } } } while (0)

struct XcdBarrier {
    unsigned* bar; unsigned x;
    volatile LAS unsigned* st;
};

__device__ __forceinline__ XcdBarrier xcd_barrier_post(unsigned* bar, volatile LAS unsigned* st, const int tid) {
    XcdBarrier b; b.bar = bar; b.x = xb_xcc_id(); b.st = st;
    if (tid == 0) (void)xb_add(&bar[XB_XCNT(b.x)], 1u);
    return b;
}
__device__ __forceinline__ void xcd_barrier_complete(unsigned* bar, unsigned x, unsigned& nloc, unsigned& nx) {
    const unsigned G = gridDim.x * gridDim.y * gridDim.z;
    unsigned sum, cnt, mine, sp = 0u;
    for (;;) {
        sum = 0u; cnt = 0u; mine = 0u;
#pragma unroll
        for (unsigned j = 0; j < 16; ++j) { const unsigned c = xb_ld(&bar[XB_XCNT(j)]); sum += c; cnt += (c > 0u) ? 1u : 0u; mine = (j == x) ? c : mine; }
        if (sum == G) break;
        __builtin_amdgcn_s_sleep(1);
        if ((++sp & 255u) == 0u) { if (xb_ld(&bar[XB_TMO])) break; if (sp > XB_SPIN_CAP) { atomicAdd(&bar[XB_TMO], 1u); break; } }
    }
    nloc = mine > 0u ? mine : 1u; nx = cnt > 0u ? cnt : 1u;
}

__device__ __forceinline__ void xcd_barrier(const XcdBarrier& b, const int tid) {
    asm volatile("s_waitcnt vmcnt(0)" ::: "memory");
    __syncthreads();
    if (tid == 0) {
        unsigned* bar = b.bar;
        __builtin_amdgcn_s_waitcnt(0);
        unsigned nloc = b.st[0], nx = b.st[1];
        if (nloc == 0u) { xcd_barrier_complete(bar, b.x, nloc, nx); b.st[0] = nloc; b.st[1] = nx; }
        const unsigned old = xb_add(&bar[XB_XSUB(b.x)], 1u);
        const unsigned gen = old / nloc;
        if (old + 1u == (gen + 1u) * nloc) {
            __builtin_amdgcn_fence(__ATOMIC_RELEASE, "agent");
            asm volatile("s_waitcnt vmcnt(0)" ::: "memory");
            const unsigned og = xb_add(&bar[XB_TOP], 1u);
            const unsigned tg = og / nx;
            if (og + 1u == (tg + 1u) * nx) xb_add(&bar[XB_TOPGEN], 1u);
            else XB_SPIN(xb_ld(&bar[XB_TOPGEN]) == tg, bar);
            __builtin_amdgcn_fence(__ATOMIC_ACQUIRE, "agent");
            xb_add(&bar[XB_XGEN(b.x)], 1u);
            asm volatile("s_waitcnt vmcnt(0)" ::: "memory");
        } else {
            XB_SPIN(xb_ld(&bar[XB_XGEN(b.x)]) == gen, bar);
            __builtin_amdgcn_fence(__ATOMIC_ACQUIRE, "agent");
            asm volatile("s_waitcnt vmcnt(0)" ::: "memory");
        }
    }
    __syncthreads();
}


constexpr int D = 1024, BP = 4, LP = 8192, BS = 32, LS = 8, PAST = 16384, PAGE = 128, NPAGE = 128;
constexpr int MP = BP * LP, MS = BS * LS, MT = MP + MS;
constexpr int HD = 64, DATT = 512, DSSM = 512, NG = 32, NST = 64;
constexpr int NIN = 4888, NINP = 5120;
constexpr int C_Q = 0, C_KV = 512, C_ZA = 1280, C_U = 1792, C_ZS = 2304, C_GM = 2816, C_GN = 4864;
constexpr int NCS = 1024, NCP = 512;
constexpr int XC_S_ROWS = BS * 2 * 2 * NCS, XC_P_ROWS = BP * 2 * 2 * NCP, XC_ROWS = XC_S_ROWS + XC_P_ROWS;
constexpr int CH = 128, NCHK = LP / CH;
constexpr float RMS_EPS = 1e-6f;
constexpr size_t O_YP = 0, O_YS = 33554432, O_KVP = 33816576, O_WINP = 50593792, O_SRP = 51118080, O_SIP = 51126272, O_KVS = 51134464, O_WINS = 51265536, O_SRS = 55459840, O_SIS = 55525376, O_END = 55590912;
constexpr size_t MiB = 1u << 20;
constexpr size_t WS_CTL = 0, CTL_ZERO_BYTES = 1 * MiB;
constexpr size_t WS_WTIN = 1 * MiB, WS_WTGLU = 11 * MiB, WS_WTLA = 12 * MiB, WS_WTLS = 13 * MiB, WS_WTOUT = 14 * MiB, WS_WTC1 = 16 * MiB, WS_CONST = 17 * MiB, WS_SEND = 20 * MiB  ;
constexpr size_t WS_KC = 20 * MiB, WS_VC = 38 * MiB, WS_XN = 64 * MiB, WS_OA = 130 * MiB, WS_Y1B = 164 * MiB, WS_YB = 198 * MiB, WS_MG = 232 * MiB, WS_Y1 = 298 * MiB, WS_MB = 364 * MiB;
constexpr size_t WS_PP = 494 * MiB, WS_XC = 632 * MiB, WS_KVB = 904 * MiB, WS_SZA = 956 * MiB, WS_U32 = 992 * MiB, WS_SZS = 1060 * MiB, WS_GM = 1096 * MiB, WS_GN = 1228 * MiB;
constexpr size_t WS_QB = 1552 * MiB, WS_KSB = 1586 * MiB, WS_KWB = 1596 * MiB, WS_VST = 1606 * MiB, WS_VWT = 1614 * MiB, WS_KCB = 1622 * MiB, WS_VCT = 1623 * MiB, WS_KCBS = 1624 * MiB, WS_VCBS = 1632 * MiB, WS_END = 1640 * MiB;
constexpr int K_CB = 0  , K_CBP = 80000  , K_ARE = 256, K_AIM = K_ARE + 2048, K_ALRE = K_AIM + 2048, K_ALIM = K_ALRE + 2048, K_BBRE = K_ALIM + 2048, K_BBIM = K_BBRE + 32768;
constexpr size_t WS_SSMCF = WS_CONST + 512 * 1024;
constexpr size_t WS_SSMW = 632 * MiB;
constexpr size_t WS_TEND = WS_CONST + 1 * MiB;
constexpr size_t WS_YPB = 364 * MiB;
constexpr int CW_BAR = 4096;
constexpr int LDS_BYTES = 163840, MISC_OFF = LDS_BYTES - 256;
constexpr int NWAVES = 8;


typedef unsigned short bf16;
typedef unsigned v4u __attribute__((ext_vector_type(4)));
typedef unsigned v2u __attribute__((ext_vector_type(2)));
typedef float f32x4 __attribute__((ext_vector_type(4)));
#define LDS_FENCE() asm volatile("s_waitcnt lgkmcnt(0)" ::: "memory")
__device__ __forceinline__ unsigned f2bf(float f) { unsigned u = __builtin_bit_cast(unsigned, f); return (u + 0x7fffu + ((u >> 16) & 1u)) >> 16; }
__device__ __forceinline__ unsigned pk2(float lo, float hi) { return f2bf(lo) | (f2bf(hi) << 16); }
__device__ __forceinline__ float wave_sum(float v) {
#pragma unroll
    for (int o = 1; o < 64; o <<= 1) v += __shfl_xor(v, o);
    return v; }
__device__ __forceinline__ float wave_max(float v) {
#pragma unroll
    for (int o = 1; o < 64; o <<= 1) v = fmaxf(v, __shfl_xor(v, o));
    return v; }
__device__ __forceinline__ float sigmf(float x) { return 1.0f / (1.0f + __expf(-x)); }
__device__ __forceinline__ float gelu_t(float x) { const float u = 1.5957691216f * (x + 0.044715f * x * x * x); return x / (1.0f + __expf(-u)); }

struct Ctx {
    LAS unsigned char* lds; int tid, lane, wave, G, gw, NGW;
    const float *xp, *xs, *cache_kv, *cache_win, *st_re, *st_im; const int* page_table;
    const float *norm_g, *w_in, *cmp_pe, *cmp_w1, *cmp_b1, *cmp_w2, *lam_re, *lam_im, *log_dt, *b_re, *b_im, *c_re, *c_im, *ssm_d, *w_glu, *b_glu, *w_la, *w_ls, *w_out, *final_g;
    float* out; unsigned char* ws;
    bf16 *WTIN, *WTGLU, *WTLA, *WTLS, *WTOUT, *WTC1, *XN, *OA, *Y1B, *YB, *MG, *XC, *QB, *KSB, *KWB, *VST, *VWT, *KCB, *VCT, *KCBS, *VCBS, *KVB, *SZA, *SZS, *GM;
    float *KST, *SEND, *KC, *VC, *Y1, *MB, *PP, *U32, *GN;
};

__device__ __forceinline__ void transpose_item(const float* W, int ldw, int nvalid, int nblk, int K, bf16* WT, int row_off, LAS float* scr, int item, int lane) {
    const int kb = item / nblk, nb = item % nblk, k0 = 64 * kb, n0 = 32 * nb;
    const int n = n0 + (lane & 31);
#pragma unroll 8
    for (int i = 0; i < 32; ++i) { const int kk = 2 * i + (lane >> 5); scr[kk * 33 + (lane & 31)] = (n < nvalid) ? W[(size_t)(k0 + kk) * ldw + n] : 0.f; }
    LDS_FENCE();
    const int c = lane & 7;
#pragma unroll
    for (int j = 0; j < 4; ++j) { const int nn = (lane >> 3) + 8 * j; const LAS float* s = scr + (8 * c) * 33 + nn;
        v4u o; o.x = pk2(s[0 * 33], s[1 * 33]); o.y = pk2(s[2 * 33], s[3 * 33]); o.z = pk2(s[4 * 33], s[5 * 33]); o.w = pk2(s[6 * 33], s[7 * 33]);
        *(v4u*)(WT + (size_t)(row_off + n0 + nn) * K + k0 + 8 * c) = o; }
    LDS_FENCE();
}
__device__ __forceinline__ void rms_row_to_bf16(const float* xrow, const float* g, bf16* orow, int lane) {
    const f32x4* xr = (const f32x4*)xrow + lane; const f32x4* gr = (const f32x4*)g + lane;
    f32x4 v[4]; float s = 0.f;
#pragma unroll
    for (int j = 0; j < 4; ++j) { v[j] = xr[64 * j]; s += (v[j].x * v[j].x + v[j].y * v[j].y) + (v[j].z * v[j].z + v[j].w * v[j].w); }
    const float r = rsqrtf(wave_sum(s) * (1.f / D) + RMS_EPS);
    v2u* o8 = (v2u*)orow + lane;
#pragma unroll
    for (int j = 0; j < 4; ++j) { const f32x4 gg = gr[64 * j]; v2u o; o.x = pk2(v[j].x * r * gg.x, v[j].y * r * gg.y); o.y = pk2(v[j].z * r * gg.z, v[j].w * r * gg.w); o8[64 * j] = o; }
}
__device__ __forceinline__ void xc_chunk(const float* src0, size_t rstride, bf16* XC, size_t rowbase  , size_t hstride, size_t sstride, int lane) {
    const int col = 4 * lane, slot = col >> 7, h = (col >> 6) & 1, d = col & 63;
    bf16* dst = XC + (rowbase + (size_t)h * hstride + (size_t)slot * sstride) * 1024 + d;
#pragma unroll 4
    for (int j = 0; j < 16; ++j) { const f32x4 v = *(const f32x4*)(src0 + (size_t)j * rstride + col); v2u o; o.x = pk2(v.x, v.y); o.y = pk2(v.z, v.w); *(v2u*)(dst + j * 64) = o; }
}
__device__ __forceinline__ void p0_prep(const Ctx& C) {
    LAS float* scr = (LAS float*)(C.lds + C.wave * 16384);
    constexpr int I_IN = 16 * 160, I_GLU = 8 * 16, I_LA = 8 * 32, I_LS = 8 * 32, I_OUT = 16 * 32, I_C1 = 16 * 2;
    constexpr int NIT = I_IN + I_GLU + I_LA + I_LS + I_OUT + 4 * I_C1;
    for (int it = C.gw; it < NIT; it += C.NGW) {
        int r = it;
        if (r < I_IN) { const int nb = r % 160, n0 = 32 * nb;
            const int src0 = n0 < 1280 ? n0 : (n0 < 4864 ? n0 + 24 : 1280), nv = n0 < 4864 ? 32 : (n0 == 4864 ? 24 : 0);
            transpose_item(C.w_in + src0 - n0, NIN, n0 + nv, 160, 1024, C.WTIN, 0, scr, r, C.lane); continue; } r -= I_IN;
        if (r < I_GLU) { transpose_item(C.w_glu, 512, 512, 16, 512, C.WTGLU, 0, scr, r, C.lane); continue; } r -= I_GLU;
        if (r < I_LA) { transpose_item(C.w_la, 1024, 1024, 32, 512, C.WTLA, 0, scr, r, C.lane); continue; } r -= I_LA;
        if (r < I_LS) { transpose_item(C.w_ls, 1024, 1024, 32, 512, C.WTLS, 0, scr, r, C.lane); continue; } r -= I_LS;
        if (r < I_OUT) { transpose_item(C.w_out, 1024, 1024, 32, 1024, C.WTOUT, 0, scr, r, C.lane); continue; } r -= I_OUT;
        { const int q = r / I_C1, s = q >> 1, rr = q & 1;
          transpose_item(C.cmp_w1 + (size_t)(s * 32 + rr * 16) * 4096, 64, 64, 2, 1024, C.WTC1, s * 128 + rr * 64, scr, r % I_C1, C.lane); }
    }
    for (int m0 = C.gw; m0 < MT; m0 += 2 * C.NGW) {
        const int m1 = m0 + C.NGW < MT ? m0 + C.NGW : m0;
        const float* x0 = m0 < MP ? C.xp + (size_t)m0 * D : C.xs + (size_t)(m0 - MP) * D; const float* x1 = m1 < MP ? C.xp + (size_t)m1 * D : C.xs + (size_t)(m1 - MP) * D;
        f32x4 va[4], vb[4]; float sa = 0.f, sb = 0.f;
#pragma unroll
        for (int j = 0; j < 4; ++j) { va[j] = ((const f32x4*)x0)[C.lane + 64 * j]; vb[j] = ((const f32x4*)x1)[C.lane + 64 * j]; }
#pragma unroll
        for (int j = 0; j < 4; ++j) { sa += (va[j].x * va[j].x + va[j].y * va[j].y) + (va[j].z * va[j].z + va[j].w * va[j].w); sb += (vb[j].x * vb[j].x + vb[j].y * vb[j].y) + (vb[j].z * vb[j].z + vb[j].w * vb[j].w); }
        const float ra = rsqrtf(wave_sum(sa) * (1.f / D) + RMS_EPS), rb = rsqrtf(wave_sum(sb) * (1.f / D) + RMS_EPS);
#pragma unroll
        for (int j = 0; j < 4; ++j) { const f32x4 gg = ((const f32x4*)C.norm_g)[C.lane + 64 * j];
            v2u o; o.x = pk2(va[j].x * ra * gg.x, va[j].y * ra * gg.y); o.y = pk2(va[j].z * ra * gg.z, va[j].w * ra * gg.w); ((v2u*)(C.XN + (size_t)m0 * D))[C.lane + 64 * j] = o;
            if (m1 != m0) { v2u o1; o1.x = pk2(vb[j].x * rb * gg.x, vb[j].y * rb * gg.y); o1.y = pk2(vb[j].z * rb * gg.z, vb[j].w * rb * gg.w); ((v2u*)(C.XN + (size_t)m1 * D))[C.lane + 64 * j] = o1; } }
    }
    for (int j = C.gw * 64 + C.lane; j < NG * NST * 16; j += C.NGW * 64) {
        const int i = j >> 4, c = j & 15, g = i >> 6;
        const double dt = exp((double)C.log_dt[g]), lr = (double)C.lam_re[i], li = (double)C.lam_im[i];
        const double mag = exp(lr * dt), ar = mag * cos(li * dt), ai = mag * sin(li * dt);
        const double den = lr * lr + li * li, fr = ((ar - 1.0) * lr + ai * li) / den, fi = (ai * lr - (ar - 1.0) * li) / den;
        if (c == 0) { const double magL = exp(lr * dt * CH), aLr = magL * cos(li * dt * CH), aLi = magL * sin(li * dt * CH);
            C.KST[K_ARE + i] = (float)ar; C.KST[K_AIM + i] = (float)ai; C.KST[K_ALRE + i] = (float)aLr; C.KST[K_ALIM + i] = (float)aLi; }
        const double br = (double)C.b_re[i * 16 + c], bi = (double)C.b_im[i * 16 + c];
        C.KST[K_BBRE + i * 16 + c] = (float)(fr * br - fi * bi); C.KST[K_BBIM + i * 16 + c] = (float)(fr * bi + fi * br);
        { bf16* CF = (bf16*)(C.ws + WS_SSMCF); const int pp = i & 63; const size_t o = ((size_t)g * 16 + c) * 128 + 2 * pp;
          CF[o] = (bf16)f2bf(C.c_re[((size_t)g * 16 + c) * 64 + pp]); CF[o + 1] = (bf16)f2bf(-C.c_im[((size_t)g * 16 + c) * 64 + pp]); }
    }
    for (int j = ((C.gw + C.NGW - 512) % C.NGW) * 64 + C.lane; j < NG * NST * (CH / 8); j += C.NGW * 64) {
        const int tb = j & (CH / 8 - 1), i = j >> 4, g = i >> 6, pp = i & 63;
        const double dt = exp((double)C.log_dt[g]), lr = (double)C.lam_re[i], li = (double)C.lam_im[i];
        const double mag = exp(lr * dt), ar = mag * cos(li * dt), ai = mag * sin(li * dt);
        const double den = lr * lr + li * li, fr = ((ar - 1.0) * lr + ai * li) / den, fi = (ai * lr - (ar - 1.0) * li) / den;
        const double dd = (double)(CH - 8 - 8 * tb), magd = exp(lr * dt * dd), pr = magd * cos(li * dt * dd), pi = magd * sin(li * dt * dd);
        double gr = pr * fr - pi * fi, gi = pr * fi + pi * fr;
        bf16* W0 = (bf16*)(C.ws + WS_SSMW); const size_t olo = (size_t)NG * 128 * 2048;
#pragma unroll 1
        for (int tt = 7; tt >= 0; --tt) {
            unsigned hr[8], hi_[8], lr_[8], li_[8];
#pragma unroll
            for (int c2 = 0; c2 < 8; ++c2) { unsigned vh[2][2], vl[2][2];
#pragma unroll
                for (int e = 0; e < 2; ++e) { const int c = 2 * c2 + e; const double br = (double)C.b_re[i * 16 + c], bi = (double)C.b_im[i * 16 + c];
                    const float wr = (float)(gr * br - gi * bi), wi = (float)(gr * bi + gi * br);
                    const unsigned h0 = f2bf(wr), h1 = f2bf(wi);
                    vh[0][e] = h0; vh[1][e] = h1; vl[0][e] = f2bf(wr - __uint_as_float(h0 << 16)); vl[1][e] = f2bf(wi - __uint_as_float(h1 << 16)); }
                hr[c2] = vh[0][0] | (vh[0][1] << 16); hi_[c2] = vh[1][0] | (vh[1][1] << 16); lr_[c2] = vl[0][0] | (vl[0][1] << 16); li_[c2] = vl[1][0] | (vl[1][1] << 16); }
            const size_t ore = ((size_t)g * 128 + pp) * 2048 + (8 * tb + tt) * 16, oim = ore + (size_t)64 * 2048;
            *(v4u*)(W0 + ore) = (v4u){hr[0], hr[1], hr[2], hr[3]}; *(v4u*)(W0 + ore + 8) = (v4u){hr[4], hr[5], hr[6], hr[7]};
            *(v4u*)(W0 + oim) = (v4u){hi_[0], hi_[1], hi_[2], hi_[3]}; *(v4u*)(W0 + oim + 8) = (v4u){hi_[4], hi_[5], hi_[6], hi_[7]};
            *(v4u*)(W0 + olo + ore) = (v4u){lr_[0], lr_[1], lr_[2], lr_[3]}; *(v4u*)(W0 + olo + ore + 8) = (v4u){lr_[4], lr_[5], lr_[6], lr_[7]};
            *(v4u*)(W0 + olo + oim) = (v4u){li_[0], li_[1], li_[2], li_[3]}; *(v4u*)(W0 + olo + oim + 8) = (v4u){li_[4], li_[5], li_[6], li_[7]};
            const double ngr = gr * ar - gi * ai, ngi = gr * ai + gi * ar; gr = ngr; gi = ngi;
        }
    }
    for (int it = C.gw - 64; it >= 0 && it < 64; it += C.NGW) { const int s = it >> 5, part = it & 31;
        float acc = (part == 0) ? C.cmp_b1[s * 64 + C.lane] : 0.f;
#pragma unroll 16
        for (int k = part * 64; k < part * 64 + 64; ++k) acc += C.cmp_pe[s * 2048 + k] * C.cmp_w1[(size_t)s * 131072 + (size_t)k * 64 + C.lane];
        C.KST[K_CBP + (s * 32 + part) * 64 + C.lane] = acc;
    }
}
constexpr int C1_PITCH = 2080, C1_BUF = 16 * C1_PITCH;
constexpr int C1_ITEMS_S = BS * NPAGE, C1_ITEMS_P = BP * (LP / 128), C1_ITEMS = C1_ITEMS_S + C1_ITEMS_P;
typedef short c1_bf16x8 __attribute__((ext_vector_type(8)));
__device__ __forceinline__ void c1_issue(const Ctx& C, f32x4 (&st)[8], int item, int slot, int r0, int i5) {
    if (item < C1_ITEMS_S) { const int b = item >> 7, pg = item & 127, page = C.page_table[b * NPAGE + pg];
        const float* src = C.cache_kv + ((size_t)page * PAGE + r0) * 512 + slot * 128 + 4 * i5;
#pragma unroll
        for (int it = 0; it < 8; ++it) st[it] = *(const f32x4*)(src + (size_t)it * 16 * 512); }
    else { const int q = item - C1_ITEMS_S, b = q >> 6, pg = q & 63; const bf16* src = C.KVB + ((size_t)b * LP + (size_t)pg * 128 + r0) * 768 + slot * 128 + 4 * i5;
#pragma unroll
        for (int it = 0; it < 8; ++it) { const v2u v = *(const v2u*)(src + (size_t)it * 16 * 768); st[it] = (f32x4){__uint_as_float(v.x << 16), __uint_as_float(v.x & 0xffff0000u), __uint_as_float(v.y << 16), __uint_as_float(v.y & 0xffff0000u)}; } }
}
__device__ __forceinline__ void p2_cmp1(const Ctx& C) {
    const int tid = C.tid, lane = C.lane, w = C.wave;
    const int half = C.G / 2, slot = ((int)blockIdx.x >= half) ? 1 : 0, wg = (int)blockIdx.x - slot * half, nwg = slot ? C.G - half : half;
    c1_bf16x8 Bf[32];
    { const bf16* bp = C.WTC1 + (size_t)(slot * 128 + 16 * w + (lane & 15)) * 1024 + 8 * (lane >> 4);
#pragma unroll
      for (int ks = 0; ks < 32; ++ks) Bf[ks] = *(const c1_bf16x8*)(bp + 32 * ks); }
    const int r0 = tid >> 5, i5 = tid & 31, hh = i5 >> 4, d4 = (i5 & 15) * 4;
    f32x4 st[8];
    int item = wg, buf = 0;
    if (item < C1_ITEMS) c1_issue(C, st, item, slot, r0, i5);
    for (; item < C1_ITEMS; item += nwg, buf ^= 1) {
        LAS unsigned char* X = C.lds + buf * C1_BUF;
#pragma unroll
        for (int it = 0; it < 8; ++it) { const int r = r0 + 16 * it; v2u o; o.x = pk2(st[it].x, st[it].y); o.y = pk2(st[it].z, st[it].w);
            *(LAS v2u*)(X + ((r >> 4) * 2 + hh) * C1_PITCH + ((r & 15) * 64 + d4) * 2) = o; }
        LDS_FENCE(); __syncthreads();
        if (item + nwg < C1_ITEMS) c1_issue(C, st, item + nwg, slot, r0, i5);
        f32x4 acc = (f32x4){0.f, 0.f, 0.f, 0.f};
        const LAS unsigned char* ap = X + (lane & 15) * C1_PITCH + (lane >> 4) * 16;
#pragma unroll
        for (int ks = 0; ks < 32; ++ks) acc = __builtin_amdgcn_mfma_f32_16x16x32_bf16(*(const LAS c1_bf16x8*)(ap + 64 * ks), Bf[ks], acc, 0, 0, 0);
        const bool smp = item < C1_ITEMS_S; const int q = smp ? item : item - C1_ITEMS_S;
        const size_t seq0 = (size_t)(smp ? (q >> 7) : (q >> 6)) * 4 + slot; const int ch0 = (smp ? (q & 127) : (q & 63)) * 8, NC = smp ? NCS : NCP;
        float* pp = C.PP + (smp ? (size_t)0 : (size_t)XC_S_ROWS * 128);
#pragma unroll
        for (int r = 0; r < 4; ++r) { const int m = 4 * (lane >> 4) + r, chunk = ch0 + (m >> 1), h = m & 1;
            pp[((seq0 + 2 * h) * NC + chunk) * 128 + 16 * w + (lane & 15)] = acc[r]; }
    }
    __syncthreads();
}
__device__ __forceinline__ void ssm_load_u(const Ctx& C, LAS float* U, size_t row0, int g, int nt, int lane) {
    const int t = lane >> 1, hf = lane & 1;
    if (t < nt) { const float* p = C.U32 + (row0 + t) * 512 + g * 16 + hf * 8; const f32x4 a = *(const f32x4*)p, b = *(const f32x4*)(p + 4);
        *(LAS f32x4*)(U + t * 16 + hf * 8) = a; *(LAS f32x4*)(U + t * 16 + hf * 8 + 4) = b; }
    LDS_FENCE();
}
__device__ __forceinline__ void ssm_issue_u(const Ctx& C, size_t row0, int g, int nt, int lane, f32x4& ua, f32x4& ub) {
    const int t = lane >> 1, hf = lane & 1;
    if (t < nt) { const float* p = C.U32 + (row0 + t) * 512 + g * 16 + hf * 8; ua = *(const f32x4*)p; ub = *(const f32x4*)(p + 4); }
}
typedef float f32x2 __attribute__((ext_vector_type(2)));
#define SFMAC(acc, a, b) asm("v_fmac_f32 %0, %1, %2" : "+v"(acc) : "v"(a), "v"(b))
#define SMUL(d, a, b) asm("v_mul_f32 %0, %1, %2" : "=v"(d) : "v"(a), "v"(b))
__device__ __forceinline__ unsigned ssm_cvt_pk(float lo, float hi) { unsigned r; asm("v_cvt_pk_bf16_f32 %0, %1, %2" : "=v"(r) : "v"(lo), "v"(hi)); return r; }
struct SsmCoef { float are, aim, naim; float bre[16], bim[16]; };
__device__ __forceinline__ void ssm_coef(const Ctx& C, SsmCoef& K, int g, int lane) {
    const int i = g * 64 + lane; K.are = C.KST[K_ARE + i]; K.aim = C.KST[K_AIM + i]; K.naim = -K.aim;
#pragma unroll
    for (int c = 0; c < 16; ++c) { K.bre[c] = C.KST[K_BBRE + i * 16 + c]; K.bim[c] = C.KST[K_BBIM + i * 16 + c]; }
}
__device__ __forceinline__ void ssm_step2(const SsmCoef& K, const LAS float* u, float& hr, float& hi, unsigned& pk0, unsigned& pk1) {
    f32x4 ua[4], ub[4];
#pragma unroll
    for (int c4 = 0; c4 < 4; ++c4) { ua[c4] = *(const LAS f32x4*)(u + 4 * c4); ub[c4] = *(const LAS f32x4*)(u + 16 + 4 * c4); }
    float ra, ia, rb, ib;
    SMUL(ra, K.bre[0], ua[0][0]); SMUL(ia, K.bim[0], ua[0][0]); SMUL(rb, K.bre[0], ub[0][0]); SMUL(ib, K.bim[0], ub[0][0]);
#pragma unroll
    for (int c = 1; c < 16; ++c) { SFMAC(ra, K.bre[c], ua[c >> 2][c & 3]); SFMAC(ia, K.bim[c], ua[c >> 2][c & 3]); SFMAC(rb, K.bre[c], ub[c >> 2][c & 3]); SFMAC(ib, K.bim[c], ub[c >> 2][c & 3]); }
    SFMAC(ra, K.are, hr); SFMAC(ia, K.are, hi); SFMAC(ra, K.naim, hi); SFMAC(ia, K.aim, hr); hr = ra; hi = ia; pk0 = ssm_cvt_pk(hr, hi);
    SFMAC(rb, K.are, hr); SFMAC(ib, K.are, hi); SFMAC(rb, K.naim, hi); SFMAC(ib, K.aim, hr); hr = rb; hi = ib; pk1 = ssm_cvt_pk(hr, hi);
}
typedef short p1_bf16x8 __attribute__((ext_vector_type(8)));
constexpr int P1_PITCH = 132;
__device__ __forceinline__ void p1_split(const f32x4 x0, const f32x4 x1, p1_bf16x8& hi, p1_bf16x8& lo) {
    v4u h, l; float r[8] = {x0.x, x0.y, x0.z, x0.w, x1.x, x1.y, x1.z, x1.w}; unsigned hw[4], lw[4];
#pragma unroll
    for (int e = 0; e < 4; ++e) { const unsigned w = pk2(r[2 * e], r[2 * e + 1]); hw[e] = w;
        lw[e] = pk2(r[2 * e] - __uint_as_float(w << 16), r[2 * e + 1] - __uint_as_float(w & 0xffff0000u)); }
    h = (v4u){hw[0], hw[1], hw[2], hw[3]}; l = (v4u){lw[0], lw[1], lw[2], lw[3]};
    hi = __builtin_bit_cast(p1_bf16x8, h); lo = __builtin_bit_cast(p1_bf16x8, l);
}
__device__ __forceinline__ void p2_ssm_pass1(const Ctx& C) {
    const int lane = C.lane, w = C.wave, m = lane & 15, q = lane >> 4;
    LAS float* red = (LAS float*)C.lds;
    for (int it = blockIdx.x; it < NG * 8; it += C.G) {
        const int g = 4 * (it & 7) + (it >> 6), sub = (it >> 3) & 7;
        f32x4 acc[2][8];
#pragma unroll
        for (int mt = 0; mt < 2; ++mt)
#pragma unroll
            for (int nt = 0; nt < 8; ++nt) acc[mt][nt] = (f32x4){0.f, 0.f, 0.f, 0.f};
        const bf16* Wh = (const bf16*)(C.ws + WS_SSMW) + ((size_t)g * 128 + m) * 2048 + 256 * w + 8 * q;
        const bf16* Wl = Wh + (size_t)NG * 128 * 2048;
        const float* up[2];
#pragma unroll
        for (int mt = 0; mt < 2; ++mt) { const int cr = 32 * sub + 16 * mt + m, b = cr >> 6, k = cr & 63;
            up[mt] = C.U32 + ((size_t)b * LP + (size_t)k * CH + 16 * w + (q >> 1)) * 512 + g * 16 + 8 * (q & 1); }
        f32x4 xa[2][2];
#pragma unroll
        for (int mt = 0; mt < 2; ++mt) { xa[mt][0] = *(const f32x4*)(up[mt]); xa[mt][1] = *(const f32x4*)(up[mt] + 4); }
#pragma unroll 2
        for (int ks = 0; ks < 8; ++ks) {
            p1_bf16x8 ah[2], al[2];
#pragma unroll
            for (int mt = 0; mt < 2; ++mt) p1_split(xa[mt][0], xa[mt][1], ah[mt], al[mt]);
            if (ks < 7) {
#pragma unroll
                for (int mt = 0; mt < 2; ++mt) { const float* p = up[mt] + (size_t)(2 * ks + 2) * 512; xa[mt][0] = *(const f32x4*)p; xa[mt][1] = *(const f32x4*)(p + 4); } }
#pragma unroll
            for (int nt = 0; nt < 8; ++nt) {
                const p1_bf16x8 bh = *(const p1_bf16x8*)(Wh + (size_t)nt * 16 * 2048 + 32 * ks), bl = *(const p1_bf16x8*)(Wl + (size_t)nt * 16 * 2048 + 32 * ks);
#pragma unroll
                for (int mt = 0; mt < 2; ++mt) {
                    acc[mt][nt] = __builtin_amdgcn_mfma_f32_16x16x32_bf16(ah[mt], bh, acc[mt][nt], 0, 0, 0);
                    acc[mt][nt] = __builtin_amdgcn_mfma_f32_16x16x32_bf16(al[mt], bh, acc[mt][nt], 0, 0, 0);
                    acc[mt][nt] = __builtin_amdgcn_mfma_f32_16x16x32_bf16(ah[mt], bl, acc[mt][nt], 0, 0, 0); }
            }
        }
#pragma unroll
        for (int mt = 0; mt < 2; ++mt)
#pragma unroll
            for (int nt = 0; nt < 8; ++nt)
#pragma unroll
                for (int r = 0; r < 4; ++r) red[(w * 32 + 16 * mt + 4 * q + r) * P1_PITCH + 16 * nt + m] = acc[mt][nt][r];
        LDS_FENCE(); __syncthreads();
#pragma unroll
        for (int i = 0; i < 8; ++i) { const int o = C.tid + 512 * i, row = o >> 7, col = o & 127; float s = 0.f;
#pragma unroll
            for (int ww = 0; ww < 8; ++ww) s += red[(ww * 32 + row) * P1_PITCH + col];
            red[8 * 32 * P1_PITCH + row * 128 + col] = s; }
        LDS_FENCE(); __syncthreads();
        if (w == 0) { const LAS float* S2 = red + 8 * 32 * P1_PITCH; const int b = sub >> 1, k0 = 32 * (sub & 1);
            const float aLr = C.KST[K_ALRE + g * 64 + lane], aLi = C.KST[K_ALIM + g * 64 + lane]; float cr = 0.f, ci = 0.f;
#pragma unroll 8
            for (int row = 0; row < 32; ++row) { float* S = C.SEND + ((size_t)(b * NG + g) * NCHK + k0 + row) * 128; S[lane] = cr; S[64 + lane] = ci;
                const float sr = S2[row * 128 + lane], si = S2[row * 128 + 64 + lane];
                const float nr = aLr * cr - aLi * ci + sr, ni = aLr * ci + aLi * cr + si; cr = nr; ci = ni; }
            float* T = (float*)(C.ws + WS_TEND) + ((size_t)(b * NG + g) * 2 + (sub & 1)) * 128; T[lane] = cr; T[64 + lane] = ci; }
        __syncthreads();
    }
}
typedef short ssm_bf16x8 __attribute__((ext_vector_type(8)));
struct SsmRd { ssm_bf16x8 cf[4]; f32x4 dsk; };
__device__ __forceinline__ void ssm_rd(const Ctx& C, SsmRd& R, int g, int lane) {
    const bf16* CF = (const bf16*)(C.ws + WS_SSMCF) + ((size_t)g * 16 + (lane & 15)) * 128 + 8 * (lane >> 4);
#pragma unroll
    for (int ks = 0; ks < 4; ++ks) R.cf[ks] = *(const ssm_bf16x8*)(CF + 32 * ks);
    R.dsk = *(const f32x4*)(C.ssm_d + g * 16 + 4 * (lane >> 4));
}
template <int NT>
__device__ __forceinline__ void ssm_tile(const Ctx& C, const SsmCoef& K, const SsmRd& R, LAS float* U, LAS unsigned* HB, size_t row0, int g, float& hr, float& hi, f32x4& ua, f32x4& ub, const bool more) {
    constexpr int nt = NT;
    { const int t = C.lane >> 1, hf = C.lane & 1;
      if (t < nt) { *(LAS f32x4*)(U + t * 16 + hf * 8) = ua; *(LAS f32x4*)(U + t * 16 + hf * 8 + 4) = ub; }
      LDS_FENCE();
      if (more) ssm_issue_u(C, row0 + NT, g, nt, C.lane, ua, ub); }
#pragma unroll 2
    for (int t = 0; t < NT; t += 2) { unsigned p0, p1; ssm_step2(K, U + t * 16, hr, hi, p0, p1); HB[t * 68 + C.lane] = p0; HB[(t + 1) * 68 + C.lane] = p1; }
    LDS_FENCE();
    const int m = C.lane & 15, q = C.lane >> 4;
#pragma unroll
    for (int n2 = 0; n2 < 2; ++n2) {
        f32x4 y = (f32x4){0.f, 0.f, 0.f, 0.f};
#pragma unroll
        for (int ks = 0; ks < 4; ++ks) y = __builtin_amdgcn_mfma_f32_16x16x32_bf16(R.cf[ks], *(const LAS ssm_bf16x8*)((const LAS unsigned char*)HB + (16 * n2 + m) * 272 + 64 * ks + 16 * q), y, 0, 0, 0);
        const int t = 16 * n2 + m;
        if (t < nt) { const f32x4 uv = *(const LAS f32x4*)(U + t * 16 + 4 * q); const size_t o = (row0 + t) * 512 + g * 16 + 4 * q;
            f32x4 v; v.x = gelu_t(y.x + R.dsk.x * uv.x); v.y = gelu_t(y.y + R.dsk.y * uv.y); v.z = gelu_t(y.z + R.dsk.z * uv.z); v.w = gelu_t(y.w + R.dsk.w * uv.w);
            v2u pk; pk.x = pk2(v.x, v.y); pk.y = pk2(v.z, v.w); *(v2u*)(C.Y1B + o) = pk; }
    }
    LDS_FENCE();
}
__device__ __forceinline__ void p3_ssm_pass2(const Ctx& C, const bool sample_part) {
    LAS float* U = (LAS float*)(C.lds + 8192 + C.wave * 18560);
    LAS unsigned* HB = (LAS unsigned*)(U + 512);
    constexpr int BIG = NCHK / 2, NBIP = NG * BIG, NBI = NBIP + 128;
    for (int bi = (sample_part ? NBIP : 0) + blockIdx.x; bi < (sample_part ? NBI : NBIP); bi += C.G) {
        const bool smp = bi >= NBIP; const int g = smp ? (bi - NBIP) >> 2 : 2 * (bi >> 6) + (C.wave >> 2);
        SsmRd R; ssm_rd(C, R, g, C.lane);
        SsmCoef K; ssm_coef(C, K, g, C.lane);
        if (!smp) {
            const int pr = (bi & 63) * 4 + (C.wave & 3), b = pr / NCHK, k = pr % NCHK;
            float hr = 0.f, hi = 0.f; f32x4 ua = (f32x4){0.f, 0.f, 0.f, 0.f}, ub = ua; ssm_issue_u(C, (size_t)b * LP + (size_t)k * CH, g, 32, C.lane, ua, ub);
            const float aLr = C.KST[K_ALRE + g * 64 + C.lane], aLi = C.KST[K_ALIM + g * 64 + C.lane];
            { const float* S = C.SEND + ((size_t)(b * NG + g) * NCHK + k) * 128; hr = S[C.lane]; hi = S[64 + C.lane]; }
            if (k >= 32) { const float* T = (const float*)(C.ws + WS_TEND) + ((size_t)(b * NG + g) * 2) * 128; const float tr = T[C.lane], ti = T[64 + C.lane];
                float pr = 1.f, pi = 0.f, br = aLr, bi = aLi;
                for (int e = k - 32; e > 0; e >>= 1) { if (e & 1) { const float nr = pr * br - pi * bi, ni = pr * bi + pi * br; pr = nr; pi = ni; }
                    const float nr = br * br - bi * bi, ni = 2.f * br * bi; br = nr; bi = ni; }
                hr += pr * tr - pi * ti; hi += pr * ti + pi * tr; }
#pragma unroll 1
            for (int tl = 0; tl < CH / 32; ++tl) ssm_tile<32>(C, K, R, U, HB, (size_t)b * LP + (size_t)k * CH + tl * 32, g, hr, hi, ua, ub, tl < CH / 32 - 1);
            if (k == NCHK - 1) { C.out[O_SRP + (size_t)(b * NG + g) * 64 + C.lane] = hr; C.out[O_SIP + (size_t)(b * NG + g) * 64 + C.lane] = hi; }
        } else {
            const int b = ((bi - NBIP) & 3) * 8 + C.wave;
            float hr = C.st_re[(size_t)(b * NG + g) * 64 + C.lane], hi = C.st_im[(size_t)(b * NG + g) * 64 + C.lane];
            f32x4 ua = (f32x4){0.f, 0.f, 0.f, 0.f}, ub = ua; ssm_issue_u(C, (size_t)MP + (size_t)b * LS, g, LS, C.lane, ua, ub);
            ssm_tile<LS>(C, K, R, U, HB, (size_t)MP + (size_t)b * LS, g, hr, hi, ua, ub, false);
            C.out[O_SRS + (size_t)(b * NG + g) * 64 + C.lane] = hr; C.out[O_SIS + (size_t)(b * NG + g) * 64 + C.lane] = hi;
        }
    }
    __syncthreads();
}
__device__ __forceinline__ void p4_cmp2(const Ctx& C) {
    LAS float* gs = (LAS float*)(C.lds + C.wave * 256);
    const int lane = C.lane, m = lane & 15, q = lane >> 4;
    constexpr int SEQ_S = BS * 2 * 2, SEQ_P = BP * 2 * 2;
    constexpr int IT_S = SEQ_S * 32, IT_P = SEQ_P * 16;
    for (int it = C.gw; it < IT_S + IT_P; it += C.NGW) {
        const bool smp = it < IT_S; const int qq = smp ? it : it - IT_S;
        const int seq = smp ? qq >> 5 : qq >> 4, n0 = (smp ? qq & 31 : qq & 15) * 32, NC = smp ? NCS : NCP, nmax = NC - 1;
        const int slot = seq & 1, h = (seq >> 1) & 1, b = seq >> 2;
        const size_t xrow0 = (smp ? 0 : (size_t)XC_S_ROWS) + (size_t)seq * NC;
        { float cb = 0.f;
#pragma unroll 8
          for (int part = 0; part < 32; ++part) cb += C.KST[K_CBP + (slot * 32 + part) * 64 + lane];
          gs[lane] = cb; LDS_FENCE(); }
        p1_bf16x8 Bf[2][4];
#pragma unroll
        for (int ks = 0; ks < 2; ++ks)
#pragma unroll
            for (int nt = 0; nt < 4; ++nt) { const float* wp = C.cmp_w2 + (size_t)slot * 4096 + (32 * ks + 8 * q) * 64 + 16 * nt + m;
                v4u pw; pw.x = ssm_cvt_pk(wp[0], wp[64]); pw.y = ssm_cvt_pk(wp[128], wp[192]); pw.z = ssm_cvt_pk(wp[256], wp[320]); pw.w = ssm_cvt_pk(wp[384], wp[448]);
                Bf[ks][nt] = __builtin_bit_cast(p1_bf16x8, pw); }
        f32x4 acc[2][4];
#pragma unroll
        for (int mt = 0; mt < 2; ++mt)
#pragma unroll
            for (int nt = 0; nt < 4; ++nt) acc[mt][nt] = (f32x4){0.f, 0.f, 0.f, 0.f};
#pragma unroll
        for (int ks = 0; ks < 2; ++ks) { const int e0 = 32 * ks + 8 * q;
            const f32x4 c0 = *(const LAS f32x4*)(gs + e0), c1 = *(const LAS f32x4*)(gs + e0 + 4);
#pragma unroll
            for (int mt = 0; mt < 2; ++mt) { int n = n0 + 16 * mt + m; n = n < nmax ? n : nmax - 1;
                const float* pa = C.PP + (xrow0 + n) * 128 + e0; const float* pb = C.PP + (xrow0 + n + 1) * 128 + 64 + e0;
                const f32x4 h0 = c0 + *(const f32x4*)pa + *(const f32x4*)pb, h1 = c1 + *(const f32x4*)(pa + 4) + *(const f32x4*)(pb + 4);
                v4u pk; pk.x = ssm_cvt_pk(gelu_t(h0.x), gelu_t(h0.y)); pk.y = ssm_cvt_pk(gelu_t(h0.z), gelu_t(h0.w)); pk.z = ssm_cvt_pk(gelu_t(h1.x), gelu_t(h1.y)); pk.w = ssm_cvt_pk(gelu_t(h1.z), gelu_t(h1.w));
                const p1_bf16x8 A = __builtin_bit_cast(p1_bf16x8, pk);
#pragma unroll
                for (int nt = 0; nt < 4; ++nt) acc[mt][nt] = __builtin_amdgcn_mfma_f32_16x16x32_bf16(A, Bf[ks][nt], acc[mt][nt], 0, 0, 0); } }
#pragma unroll
        for (int mt = 0; mt < 2; ++mt)
#pragma unroll
            for (int nt = 0; nt < 4; ++nt) { const int nb = n0 + 16 * mt + 4 * q, d = 16 * nt + m;
                if (smp) { bf16* o = (slot ? C.VCBS : C.KCBS) + ((size_t)(b * 2 + h) * NCS + nb) * 64 + d;
#pragma unroll
                    for (int r = 0; r < 4; ++r) if (nb + r < nmax) o[r * 64] = (bf16)f2bf(acc[mt][nt][r]); }
                else { bf16* o = (slot ? C.VCT : C.KCB) + ((size_t)(b * 2 + h) * NCP + nb) * 64 + d;
#pragma unroll
                    for (int r = 0; r < 4; ++r) if (nb + r < nmax) o[r * 64] = (bf16)f2bf(acc[mt][nt][r]); } }
        LDS_FENCE();
    }
}


constexpr float QSCALE = 0.125f * 1.4426950408889634f;
__device__ __forceinline__ f32x4 unpk4(const v2u p) { return (f32x4){__uint_as_float(p.x << 16), __uint_as_float(p.x & 0xffff0000u), __uint_as_float(p.y << 16), __uint_as_float(p.y & 0xffff0000u)}; }
typedef short bf16x8 __attribute__((ext_vector_type(8)));
typedef short s16x4 __attribute__((ext_vector_type(4)));
#define MFMA16(a, b, c) __builtin_amdgcn_mfma_f32_16x16x32_bf16((a), (b), (c), 0, 0, 0)
constexpr int TP = 144, TILEB = 64 * TP;
constexpr int RSLOT = 16384  , NRING = 4;
constexpr int NRING2 = 8, RG2 = NRING2 / 2;
constexpr int A_BUF = 0, A_IMP = NRING * RSLOT  , A_SELM = NRING2 * RSLOT  , A_WUNI = A_SELM + 1024, A_LIST = A_WUNI + 128, A_MISC = A_LIST + 512, A_TUN = A_MISC + 64, A_END = A_TUN + 256;
static_assert(A_END <= MISC_OFF, "prompt attention LDS map");
constexpr int CW_QCTR = 8192;

struct StageRegs { v4u k, v; };
__device__ __forceinline__ void stage_load(StageRegs& R, const bf16* ksrc, size_t kpitch, const bf16* vsrc, size_t vpitch, int tid) {
    const int r = tid >> 3, ch = tid & 7; R.k = *(const v4u*)(ksrc + (size_t)r * kpitch + ch * 8); R.v = *(const v4u*)(vsrc + (size_t)r * vpitch + ch * 8); }
__device__ __forceinline__ void stage_write(const StageRegs& R, LAS unsigned char* buf, int tid) {
    const int r = tid >> 3, ch = tid & 7; *(LAS v4u*)(buf + r * TP + ch * 16) = R.k; *(LAS v4u*)(buf + TILEB + r * TP + ch * 16) = R.v; }
__device__ __forceinline__ void qk_tile(const LAS unsigned char* Kt, const bf16x8 q0, const bf16x8 q1, int c, int q, f32x4 (&s)[4]) {
    const LAS unsigned char* kp = Kt + c * TP + q * 16;
#pragma unroll
    for (int t = 0; t < 4; ++t) { const bf16x8 k0 = *(const LAS bf16x8*)(kp + t * 16 * TP), k1 = *(const LAS bf16x8*)(kp + t * 16 * TP + 64);
        s[t] = MFMA16(k0, q0, ((f32x4){0.f, 0.f, 0.f, 0.f})); s[t] = MFMA16(k1, q1, s[t]); }
}
__device__ __forceinline__ bf16x8 pack8(const f32x4 a, const f32x4 b) {
    v4u w; w.x = pg8::cvt_pk_bf16(a.x, a.y); w.y = pg8::cvt_pk_bf16(a.z, a.w); w.z = pg8::cvt_pk_bf16(b.x, b.y); w.w = pg8::cvt_pk_bf16(b.z, b.w); return __builtin_bit_cast(bf16x8, w); }
__device__ __forceinline__ void pv_tile(const LAS unsigned char* Vt, const f32x4 (&p)[4], int c, int q, f32x4 (&acc)[4]) {
    const bf16x8 P0 = pack8(p[0], p[1]), P1 = pack8(p[2], p[3]);
    const LAS unsigned char* vp = Vt + c * TP + q * 8;
#pragma unroll
    for (int dt = 0; dt < 4; ++dt) { const LAS unsigned char* vr = vp + dt * 16 * TP;
        const s16x4 a0 = *(const LAS s16x4*)(vr), a1 = *(const LAS s16x4*)(vr + 32), b0 = *(const LAS s16x4*)(vr + 64), b1 = *(const LAS s16x4*)(vr + 96);
        const bf16x8 va = (bf16x8){a0[0], a0[1], a0[2], a0[3], a1[0], a1[1], a1[2], a1[3]}, vb = (bf16x8){b0[0], b0[1], b0[2], b0[3], b1[0], b1[1], b1[2], b1[3]};
        acc[dt] = MFMA16(va, P0, acc[dt]); acc[dt] = MFMA16(vb, P1, acc[dt]); }
}
__device__ __forceinline__ void mask_tile(f32x4 (&s)[4], int q, int lo, int hi) {
    const float NINF = -__builtin_inff();
#pragma unroll
    for (int t = 0; t < 4; ++t)
#pragma unroll
        for (int r = 0; r < 4; ++r) { const int key = 16 * t + 4 * q + r; s[t][r] = (key >= lo && key <= hi) ? s[t][r] : NINF; }
}
__device__ __forceinline__ float colmax(const f32x4 (&s)[4]) {
    float mx = fmaxf(fmaxf(s[0].x, s[0].y), fmaxf(s[0].z, s[0].w));
#pragma unroll
    for (int t = 1; t < 4; ++t) mx = fmaxf(mx, fmaxf(fmaxf(s[t].x, s[t].y), fmaxf(s[t].z, s[t].w)));
    mx = fmaxf(mx, __shfl_xor(mx, 16)); mx = fmaxf(mx, __shfl_xor(mx, 32)); return mx;
}
__device__ __forceinline__ float ex2(float x) { return __builtin_amdgcn_exp2f(x); }
__device__ __forceinline__ void online_step(f32x4 (&s)[4], const bool mine, float& m, float& l, f32x4 (&acc)[4]) {
    const float NINF = -__builtin_inff(), PINF = __builtin_inff();
    float mx = colmax(s); mx = mine ? mx : NINF;
    const float mn = fmaxf(m, mx), ms = (mn > NINF) ? mn : 0.f, msub = mine ? ms : PINF;
    float sum = 0.f;
#pragma unroll
    for (int t = 0; t < 4; ++t) { s[t].x = ex2(s[t].x - msub); s[t].y = ex2(s[t].y - msub); s[t].z = ex2(s[t].z - msub); s[t].w = ex2(s[t].w - msub); sum += (s[t].x + s[t].y) + (s[t].z + s[t].w); }
    if (__any(mn != m)) { const float al = ex2(m - ms); l = l * al + sum;
#pragma unroll
        for (int dt = 0; dt < 4; ++dt) acc[dt] = acc[dt] * al; }
    else l += sum;
    m = mn;
}
__device__ __forceinline__ float dpp_xor1(float v) { return __builtin_bit_cast(float, __builtin_amdgcn_update_dpp(0, __builtin_bit_cast(int, v), 0xB1, 0xF, 0xF, true)); }
__device__ __forceinline__ float dpp_xor2(float v) { return __builtin_bit_cast(float, __builtin_amdgcn_update_dpp(0, __builtin_bit_cast(int, v), 0x4E, 0xF, 0xF, true)); }
__device__ __forceinline__ unsigned getw(const v4u v, int wi) { return wi == 0 ? v.x : (wi == 1 ? v.y : (wi == 2 ? v.z : v.w)); }

__device__ __forceinline__ v4u topk_token(const LAS float* imp, int cur, int lane) {
    const bool c0 = lane >= 1 && lane < cur, c1 = (lane + 64) < cur;
    const unsigned u0 = c0 ? __float_as_uint(imp[lane]) : 0u, u1 = c1 ? __float_as_uint(imp[64 + lane]) : 0u;
    bool s0, s1;
    const int K = cur >= 1 ? 14 : 15, ncand = cur >= 1 ? cur - 1 : 0;
    if (ncand <= K) { s0 = c0; s1 = c1; }
    else {
        unsigned prefix = 0u; int rem = K;
        for (int bit = 30; bit >= 11; --bit) {
            const unsigned cand = prefix | (1u << bit);
            const bool m0 = c0 && ((u0 >> bit) == (cand >> bit)), m1 = c1 && ((u1 >> bit) == (cand >> bit));
            const int cnt = __popcll(__ballot(m0)) + __popcll(__ballot(m1));
            if (cnt >= rem) prefix = cand; else rem -= cnt;
        }
        const unsigned ph = prefix >> 11;
        const bool e0 = c0 && (u0 >> 11) == ph, e1 = c1 && (u1 >> 11) == ph;
        const unsigned long long be0 = __ballot(e0), be1 = __ballot(e1), lt = (1ull << lane) - 1ull;
        const int r0 = __popcll(be0 & lt), r1 = __popcll(be0) + __popcll(be1 & lt);
        s0 = c0 && ((u0 >> 11) > ph || (e0 && r0 < rem)); s1 = c1 && ((u1 >> 11) > ph || (e1 && r1 < rem));
    }
    s0 = s0 || lane == 0 || lane == cur; s1 = s1 || (lane + 64) == cur;
    const unsigned long long b0 = __ballot(s0), b1 = __ballot(s1);
    return (v4u){(unsigned)b0, (unsigned)(b0 >> 32), (unsigned)b1, (unsigned)(b1 >> 32)};
}


__device__ __forceinline__ void ring_issue(LAS unsigned char* slot, const bf16* ksrc, size_t kpitch, const bf16* vsrc, size_t vpitch, int w, int lane) {
    const int row = 8 * w + (lane >> 3), cl = (lane & 7) ^ ((row >> 1) & 7);
    __builtin_amdgcn_global_load_lds((const unsigned*)(ksrc + (size_t)row * kpitch + cl * 8), (LAS unsigned*)(slot + w * 1024), 16, 0, 0);
    __builtin_amdgcn_global_load_lds((const unsigned*)(vsrc + (size_t)row * vpitch + cl * 8), (LAS unsigned*)(slot + 8192 + w * 1024), 16, 0, 0);
}
#define RING_PAIR_SYNC() do { asm volatile("s_waitcnt vmcnt(0)" ::: "memory"); __builtin_amdgcn_s_barrier(); asm volatile("" ::: "memory"); } while (0)
__device__ __forceinline__ void qk_tile_sw(const LAS unsigned char* Kt, const bf16x8 q0, const bf16x8 q1, int c, int q, f32x4 (&s)[4]) {
    const int sw = (c >> 1) & 7; const LAS unsigned char* kp = Kt + c * 128;
    const int o0 = (q ^ sw) * 16, o1 = ((4 + q) ^ sw) * 16;
#pragma unroll
    for (int t = 0; t < 4; ++t) { const bf16x8 k0 = *(const LAS bf16x8*)(kp + t * 2048 + o0), k1 = *(const LAS bf16x8*)(kp + t * 2048 + o1);
        s[t] = MFMA16(k0, q0, ((f32x4){0.f, 0.f, 0.f, 0.f})); s[t] = MFMA16(k1, q1, s[t]); }
}
typedef short v4i16_t __attribute__((ext_vector_type(4)));
__device__ __forceinline__ s16x4 vtr(const LAS unsigned char* p) { return __builtin_bit_cast(s16x4, __builtin_amdgcn_ds_read_tr16_b64_v4i16((LAS v4i16_t*)p)); }
__device__ __forceinline__ void pv_tile_sw(const LAS unsigned char* Vt, const f32x4 (&p)[4], int c, int q, f32x4 (&acc)[4]) {
    const bf16x8 P0 = pack8(p[0], p[1]), P1 = pack8(p[2], p[3]);
    const int sw = (2 * q + (c >> 3)) & 7, ch = (c & 3) >> 1;
    const LAS unsigned char* vb = Vt + (4 * q + (c >> 2)) * 128 + (c & 1) * 8;
#pragma unroll
    for (int dt = 0; dt < 4; ++dt) { const LAS unsigned char* vr = vb + (((2 * dt + ch) ^ sw) << 4);
        const s16x4 a0 = vtr(vr), a1 = vtr(vr + 16 * 128), b0 = vtr(vr + 32 * 128), b1 = vtr(vr + 48 * 128);
        const bf16x8 va = (bf16x8){a0[0], a0[1], a0[2], a0[3], a1[0], a1[1], a1[2], a1[3]}, vb8 = (bf16x8){b0[0], b0[1], b0[2], b0[3], b1[0], b1[1], b1[2], b1[3]};
        acc[dt] = MFMA16(va, P0, acc[dt]); acc[dt] = MFMA16(vb8, P1, acc[dt]); }
}
template <int MODE> __device__ __forceinline__ void attn_prompt_unit(const Ctx& C, int b, int h, int T) {
    const float NINF = -__builtin_inff();
    int tid_ = C.tid; asm volatile("" : "+v"(tid_));
    const int tid = tid_, lane = tid & 63, w = __builtin_amdgcn_readfirstlane(tid >> 6), c = lane & 15, q = lane >> 4, ti = c >> 2, g = c & 3;
    LAS unsigned char* L = C.lds;
    LAS float* impS = (LAS float*)(L + A_IMP); LAS unsigned* selm = (LAS unsigned*)(L + A_SELM); LAS unsigned* wuni = (LAS unsigned*)(L + A_WUNI); LAS int* list = (LAS int*)(L + A_LIST); LAS int* misc = (LAS int*)(L + A_MISC);
    const int q0 = 64 * T, seq = b * 2 + h;
    bf16x8 Q0[2], Q1[2]; int toff[2]; v2u outp[2][4]; float gate[2][3];
#pragma unroll
    for (int a = 0; a < 2; ++a) { toff[a] = 8 * w + 4 * a + ti; const bf16* qp = C.QB + ((size_t)b * LP + q0 + toff[a]) * 512 + h * 256 + g * 64 + 8 * q;
        Q0[a] = *(const bf16x8*)qp; Q1[a] = *(const bf16x8*)(qp + 32);
        { const float* gp = C.GN + ((size_t)b * LP + q0 + toff[a]) * 32 + (h * 4 + g) * 3; gate[a][0] = gp[0]; gate[a][1] = gp[1]; gate[a][2] = gp[2]; }
#pragma unroll
        for (int dt = 0; dt < 4; ++dt) outp[a][dt] = (v2u){0u, 0u}; }
    for (int i = tid; i < 2048; i += 512) ((LAS f32x4*)impS)[i] = (f32x4){0.f, 0.f, 0.f, 0.f};
    const int nvmax = 4 * T + 3, ntc = (MODE & 4) ? 0 : (nvmax + 63) >> 6;
    const bf16* kcb = C.KCB + (size_t)seq * NCP * 64; const bf16* vcb = C.VCT + (size_t)seq * NCP * 64;
    int nvis[2], nvmin[2]; float mC[2], lC[2];
#pragma unroll
    for (int a = 0; a < 2; ++a) { const int qpos = q0 + toff[a]; nvis[a] = qpos >= 31 ? ((qpos - 31) >> 4) + 1 : 0; mC[a] = NINF; lC[a] = 0.f;
        const int qmin = q0 + 8 * w + 4 * a; nvmin[a] = qmin >= 31 ? ((qmin - 31) >> 4) + 1 : 0; }
    for (int s = 0; s < 2 && s < ntc; ++s) ring_issue(L + s * RSLOT, kcb + (size_t)s * 4096, 64, vcb + (size_t)s * 4096, 64, w, lane);
    for (int s = 0; s < ntc; ++s) {
        if (!(s & 1)) { RING_PAIR_SYNC();
            for (int s2 = s + 2; s2 < s + 4 && s2 < ntc; ++s2) ring_issue(L + (s2 & 3) * RSLOT, kcb + (size_t)s2 * 4096, 64, vcb + (size_t)s2 * 4096, 64, w, lane); }
        const LAS unsigned char* buf = L + (s & 3) * RSLOT;
#pragma unroll
        for (int a = 0; a < 2; ++a) { __builtin_amdgcn_sched_barrier(0); f32x4 sc[4]; qk_tile_sw(buf, Q0[a], Q1[a], c, q, sc); if (64 * (s + 1) > nvmin[a]) mask_tile(sc, q, 0, nvis[a] - 64 * s - 1);
            const float mn = fmaxf(mC[a], colmax(sc)), ms = (mn > NINF) ? mn : 0.f; float sum = 0.f;
#pragma unroll
            for (int t = 0; t < 4; ++t) sum += (ex2(sc[t].x - ms) + ex2(sc[t].y - ms)) + (ex2(sc[t].z - ms) + ex2(sc[t].w - ms));
            lC[a] = lC[a] * ex2(mC[a] - ms) + sum; mC[a] = mn; }
    }
    __builtin_amdgcn_s_barrier();
    float invC[2], msC[2];
#pragma unroll
    for (int a = 0; a < 2; ++a) { float l = lC[a]; l += __shfl_xor(l, 16); l += __shfl_xor(l, 32); invC[a] = 1.0f / fmaxf(l, 1e-30f); msC[a] = (mC[a] > NINF) ? mC[a] : 0.f; }
    f32x4 acc[2][4]; float carry[2];
#pragma unroll
    for (int a = 0; a < 2; ++a) { carry[a] = 0.f;
#pragma unroll
        for (int dt = 0; dt < 4; ++dt) acc[a][dt] = (f32x4){0.f, 0.f, 0.f, 0.f}; }
    for (int s = 0; s < 2 && s < ntc; ++s) ring_issue(L + s * RSLOT, kcb + (size_t)s * 4096, 64, vcb + (size_t)s * 4096, 64, w, lane);
    for (int s = 0; s < ntc; ++s) {
        if (!(s & 1)) { RING_PAIR_SYNC();
            for (int s2 = s + 2; s2 < s + 4 && s2 < ntc; ++s2) ring_issue(L + (s2 & 3) * RSLOT, kcb + (size_t)s2 * 4096, 64, vcb + (size_t)s2 * 4096, 64, w, lane); }
        const LAS unsigned char* buf = L + (s & 3) * RSLOT;
#pragma unroll
        for (int a = 0; a < 2; ++a) { __builtin_amdgcn_sched_barrier(0); f32x4 sc[4]; qk_tile_sw(buf, Q0[a], Q1[a], c, q, sc); if (64 * (s + 1) > nvmin[a]) mask_tile(sc, q, 0, nvis[a] - 64 * s - 1);
            float x[4], A[4];
#pragma unroll
            for (int t = 0; t < 4; ++t) { sc[t].x = ex2(sc[t].x - msC[a]) * invC[a]; sc[t].y = ex2(sc[t].y - msC[a]) * invC[a]; sc[t].z = ex2(sc[t].z - msC[a]) * invC[a]; sc[t].w = ex2(sc[t].w - msC[a]) * invC[a];
                f32x4 ps = sc[t]; ps.x += dpp_xor1(ps.x); ps.y += dpp_xor1(ps.y); ps.z += dpp_xor1(ps.z); ps.w += dpp_xor1(ps.w);
                ps.x += dpp_xor2(ps.x); ps.y += dpp_xor2(ps.y); ps.z += dpp_xor2(ps.z); ps.w += dpp_xor2(ps.w);
                A[t] = (ps.x + ps.y) + (ps.z + 0.5f * ps.w); x[t] = __shfl(0.5f * ps.w, (lane + 48) & 63); }
            if (g == 0) { LAS float* ip = impS + ((2 * w + a) * 4 + ti) * 128 + 16 * s + q;
                ip[0] = A[0] + (q ? x[0] : carry[a]); ip[4] = A[1] + (q ? x[1] : x[0]); ip[8] = A[2] + (q ? x[2] : x[1]); ip[12] = A[3] + (q ? x[3] : x[2]); }
            carry[a] = x[3];
            pv_tile_sw(buf + 8192, sc, c, q, acc[a]); }
    }
    __builtin_amdgcn_s_barrier();
    {
        LDS_FENCE();
#pragma unroll
        for (int a = 0; a < 2; ++a) { const float gc = gate[a][0];
#pragma unroll
            for (int dt = 0; dt < 4; ++dt) { const f32x4 o = acc[a][dt] * gc; outp[a][dt].x = pk2(o.x, o.y); outp[a][dt].y = pk2(o.z, o.w); } }
    }
    v4u wu = (v4u){0u, 0u, 0u, 0u};
    for (int tt = 0; tt < ((MODE & 2) ? 0 : 8); ++tt) { const v4u mk = topk_token(impS + ((2 * w + (tt >> 2)) * 4 + (tt & 3)) * 128, T, lane);
        if (lane == 0) *(LAS v4u*)(selm + (8 * w + tt) * 4) = mk;
        wu.x |= mk.x; wu.y |= mk.y; wu.z |= mk.z; wu.w |= mk.w; }
    if (lane == 0) *(LAS v4u*)(wuni + 4 * w) = wu;
    __syncthreads();
    LAS unsigned* tun = (LAS unsigned*)(L + A_TUN);
    if (lane < 8) { const int a = lane >> 2, wi = lane & 3; unsigned o = 0u;
#pragma unroll
        for (int i = 0; i < 4; ++i) o |= selm[(8 * w + 4 * a + i) * 4 + wi];
        tun[(2 * w + a) * 4 + wi] = o; }
    if (w == 0) {
        v4u U = (v4u){0u, 0u, 0u, 0u};
#pragma unroll
        for (int i = 0; i < 8; ++i) { const v4u o = *(const LAS v4u*)(wuni + 4 * i); U.x |= o.x; U.y |= o.y; U.z |= o.z; U.w |= o.w; }
        const unsigned long long lt = (1ull << lane) - 1ull;
        const bool b0 = ((lane < 32 ? U.x : U.y) >> (lane & 31)) & 1u, b1 = ((lane < 32 ? U.z : U.w) >> (lane & 31)) & 1u;
        const unsigned long long m0 = __ballot(b0), m1 = __ballot(b1); const int n0 = __popcll(m0);
        if (b0) list[__popcll(m0 & lt)] = lane; if (b1) list[n0 + __popcll(m1 & lt)] = 64 + lane;
        if (lane == 0) misc[0] = n0 + __popcll(m1);
    }
    __syncthreads();
    const int nsel = (MODE & 3) ? 0 : misc[0];
    const bf16* ksb = C.KVB + ((size_t)b * LP) * 768 + 2 * 128 + h * 64; const bf16* vsb = C.KVB + ((size_t)b * LP) * 768 + 3 * 128 + h * 64;
    float mS[2], lS[2];
#pragma unroll
    for (int a = 0; a < 2; ++a) { mS[a] = NINF; lS[a] = 0.f;
#pragma unroll
        for (int dt = 0; dt < 4; ++dt) acc[a][dt] = (f32x4){0.f, 0.f, 0.f, 0.f}; }
#pragma unroll
    for (int s = 0; s < RG2; ++s) if (s < nsel) { const int jn = list[s]; ring_issue(L + s * RSLOT, ksb + (size_t)jn * 64 * 768, 768, vsb + (size_t)jn * 64 * 768, 768, w, lane); }
    for (int s = 0; s < nsel; ++s) {
        if (!(s & (RG2 - 1))) { RING_PAIR_SYNC();
#pragma unroll
            for (int u = 0; u < RG2; ++u) { const int s2 = s + RG2 + u; if (s2 < nsel) { const int jn = list[s2]; ring_issue(L + (s2 & (NRING2 - 1)) * RSLOT, ksb + (size_t)jn * 64 * 768, 768, vsb + (size_t)jn * 64 * 768, 768, w, lane); } } }
        const int j = list[s];
        const LAS unsigned char* buf = L + (s & (NRING2 - 1)) * RSLOT;
        const int wi = j >> 5, bt = j & 31;
#pragma unroll
        for (int a = 0; a < 2; ++a) { __builtin_amdgcn_sched_barrier(0);
            if ((__builtin_amdgcn_readfirstlane(tun[(2 * w + a) * 4 + wi]) >> bt) & 1u) {
                f32x4 sc[4]; qk_tile_sw(buf, Q0[a], Q1[a], c, q, sc);
                const bool mine = (selm[(8 * w + 4 * a + ti) * 4 + wi] >> bt) & 1u;
                if (j == T) mask_tile(sc, q, 0, toff[a]);
                online_step(sc, mine, mS[a], lS[a], acc[a]);
                pv_tile_sw(buf + 8192, sc, c, q, acc[a]); } }
    }
    __builtin_amdgcn_s_barrier();
#pragma unroll
    for (int a = 0; a < 2; ++a) { float l = lS[a]; l += __shfl_xor(l, 16); l += __shfl_xor(l, 32);
        const float gs = gate[a][1] / fmaxf(l, 1e-30f);
#pragma unroll
        for (int dt = 0; dt < 4; ++dt) { const f32x4 o = unpk4(outp[a][dt]) + acc[a][dt] * gs; outp[a][dt].x = pk2(o.x, o.y); outp[a][dt].y = pk2(o.z, o.w); } }
    const bf16* kwb = C.KVB + ((size_t)b * LP) * 768 + 4 * 128 + h * 64; const bf16* vwb = C.KVB + ((size_t)b * LP) * 768 + 5 * 128 + h * 64;
#pragma unroll
    for (int a = 0; a < 2; ++a) { mS[a] = NINF; lS[a] = 0.f;
#pragma unroll
        for (int dt = 0; dt < 4; ++dt) acc[a][dt] = (f32x4){0.f, 0.f, 0.f, 0.f}; }
    const int jw0 = T >= 8 ? T - 8 : 0, nw = (MODE & 8) ? 0 : T - jw0 + 1;
#pragma unroll
    for (int s = 0; s < RG2; ++s) if (s < nw) ring_issue(L + s * RSLOT, kwb + (size_t)(jw0 + s) * 64 * 768, 768, vwb + (size_t)(jw0 + s) * 64 * 768, 768, w, lane);
    for (int s = 0; s < nw; ++s) {
        if (!(s & (RG2 - 1))) { RING_PAIR_SYNC();
#pragma unroll
            for (int u = 0; u < RG2; ++u) { const int s2 = s + RG2 + u; if (s2 < nw) ring_issue(L + (s2 & (NRING2 - 1)) * RSLOT, kwb + (size_t)(jw0 + s2) * 64 * 768, 768, vwb + (size_t)(jw0 + s2) * 64 * 768, 768, w, lane); } }
        const int j = jw0 + s;
        const LAS unsigned char* buf = L + (s & (NRING2 - 1)) * RSLOT;
#pragma unroll
        for (int a = 0; a < 2; ++a) { __builtin_amdgcn_sched_barrier(0); f32x4 sc[4]; qk_tile_sw(buf, Q0[a], Q1[a], c, q, sc);
            const int lo = (j == T - 8) ? toff[a] + 1 : 0, hi = (j == T) ? toff[a] : 63;
            if (j == T - 8 || j == T) mask_tile(sc, q, lo, hi);
            online_step(sc, true, mS[a], lS[a], acc[a]);
            pv_tile_sw(buf + 8192, sc, c, q, acc[a]); }
    }
    __builtin_amdgcn_s_barrier();
#pragma unroll
    for (int a = 0; a < 2; ++a) { float l = lS[a]; l += __shfl_xor(l, 16); l += __shfl_xor(l, 32);
        const size_t row = (size_t)b * LP + q0 + toff[a];
        const float gw = gate[a][2] / fmaxf(l, 1e-30f);
#pragma unroll
        for (int dt = 0; dt < 4; ++dt) { const f32x4 o = unpk4(outp[a][dt]) + acc[a][dt] * gw; const int col = h * 256 + g * 64 + 16 * dt + 4 * q;
            const f32x4 z = unpk4(*(const v2u*)(C.SZA + row * 512 + col));
            v2u ov; ov.x = pk2(o.x * z.x, o.y * z.y); ov.y = pk2(o.z * z.z, o.w * z.w);
            if (!(MODE & 32)) *(v2u*)(C.OA + row * 512 + col) = ov; else if (ov.x == 0x12345678u) *(v2u*)(C.OA + row * 512 + col) = ov; } }
}

constexpr int S_TILE = 2 * TILEB, S_IMPA = 4 * S_TILE, S_IMPB = S_IMPA + 8448, S_SELM = S_IMPB + 8448, S_LIST = S_SELM + 512, S_MISC = S_LIST + 1088, S_TUN = S_MISC + 64, S_MRG = S_TUN + 128, S_END = S_MRG + 8 * 64 * 18 * 4;
static_assert(S_END <= MISC_OFF, "sample attention LDS map");
__device__ __forceinline__ void pv_tile_tr(const LAS unsigned char* Vt, const f32x4 (&p)[4], int lane, f32x4 (&acc)[4]) {
    const bf16x8 P0 = pack8(p[0], p[1]), P1 = pack8(p[2], p[3]);
    const int i = lane & 15, q = lane >> 4;
    const LAS unsigned char* vb = Vt + (4 * q + (i >> 2)) * TP + (i & 3) * 8;
#pragma unroll
    for (int dt = 0; dt < 4; ++dt) {
        const s16x4 a0 = vtr(vb + dt * 32), a1 = vtr(vb + dt * 32 + 16 * TP), b0 = vtr(vb + dt * 32 + 32 * TP), b1 = vtr(vb + dt * 32 + 48 * TP);
        const bf16x8 va = (bf16x8){a0[0], a0[1], a0[2], a0[3], a1[0], a1[1], a1[2], a1[3]}, vb8 = (bf16x8){b0[0], b0[1], b0[2], b0[3], b1[0], b1[1], b1[2], b1[3]};
        acc[dt] = MFMA16(va, P0, acc[dt]); acc[dt] = MFMA16(vb8, P1, acc[dt]); }
}
struct TileSrc { const float* k; const float* v; int stride; int nrows; };
__device__ __forceinline__ void stage4_f32(LAS unsigned char* L, const TileSrc (&ts)[4], int tid) {
    const int r0 = tid >> 4, d4 = (tid & 15) * 4;
    f32x4 kv[4][2], vv[4][2];
#pragma unroll
    for (int t = 0; t < 4; ++t)
#pragma unroll
        for (int hh = 0; hh < 2; ++hh) { const int r = r0 + 32 * hh; const bool ok = r < ts[t].nrows;
            kv[t][hh] = ok ? *(const f32x4*)(ts[t].k + (size_t)r * ts[t].stride + d4) : (f32x4){0.f, 0.f, 0.f, 0.f};
            vv[t][hh] = ok ? *(const f32x4*)(ts[t].v + (size_t)r * ts[t].stride + d4) : (f32x4){0.f, 0.f, 0.f, 0.f}; }
#pragma unroll
    for (int t = 0; t < 4; ++t)
#pragma unroll
        for (int hh = 0; hh < 2; ++hh) { const int r = r0 + 32 * hh; v2u a, b2; a.x = pk2(kv[t][hh].x, kv[t][hh].y); a.y = pk2(kv[t][hh].z, kv[t][hh].w); b2.x = pk2(vv[t][hh].x, vv[t][hh].y); b2.y = pk2(vv[t][hh].z, vv[t][hh].w);
            *(LAS v2u*)(L + t * S_TILE + r * TP + d4 * 2) = a; *(LAS v2u*)(L + t * S_TILE + TILEB + r * TP + d4 * 2) = b2; }
}
__device__ __forceinline__ void stage4_bf16(LAS unsigned char* L, const bf16* kb, const bf16* vb, int tid) {
    const int r = tid >> 3, ch = tid & 7;
    v4u kk[4], vv[4];
#pragma unroll
    for (int t = 0; t < 4; ++t) { kk[t] = *(const v4u*)(kb + (size_t)(64 * t + r) * 64 + ch * 8); vv[t] = *(const v4u*)(vb + (size_t)(64 * t + r) * 64 + ch * 8); }
#pragma unroll
    for (int t = 0; t < 4; ++t) { *(LAS v4u*)(L + t * S_TILE + r * TP + ch * 16) = kk[t]; *(LAS v4u*)(L + t * S_TILE + TILEB + r * TP + ch * 16) = vv[t]; }
}
__device__ __forceinline__ void merge4(LAS float* mrg, int w, int lane, float& m, float& l, f32x4 (&acc)[4]) {
    const float NINF = -__builtin_inff();
    LAS float* me = mrg + (w * 64 + lane) * 18;
    me[0] = m; me[1] = l;
#pragma unroll
    for (int dt = 0; dt < 4; ++dt) { me[2 + 4 * dt] = acc[dt].x; me[3 + 4 * dt] = acc[dt].y; me[4 + 4 * dt] = acc[dt].z; me[5 + 4 * dt] = acc[dt].w; }
    LDS_FENCE(); __syncthreads();
    const int w0 = w & 4;
    float M = NINF;
#pragma unroll
    for (int k = 0; k < 4; ++k) M = fmaxf(M, mrg[((w0 + k) * 64 + lane) * 18]);
    const float Ms = (M > NINF) ? M : 0.f; float Lx = 0.f; f32x4 A[4];
#pragma unroll
    for (int dt = 0; dt < 4; ++dt) A[dt] = (f32x4){0.f, 0.f, 0.f, 0.f};
#pragma unroll
    for (int k = 0; k < 4; ++k) { const LAS float* o = mrg + ((w0 + k) * 64 + lane) * 18; const float f = ex2(o[0] - Ms); Lx += o[1] * f;
#pragma unroll
        for (int dt = 0; dt < 4; ++dt) { A[dt].x += o[2 + 4 * dt] * f; A[dt].y += o[3 + 4 * dt] * f; A[dt].z += o[4 + 4 * dt] * f; A[dt].w += o[5 + 4 * dt] * f; } }
    m = M; l = Lx;
#pragma unroll
    for (int dt = 0; dt < 4; ++dt) acc[dt] = A[dt];
    asm volatile("" : "+v"(m), "+v"(l), "+v"(acc[0]), "+v"(acc[1]), "+v"(acc[2]), "+v"(acc[3]));
    __syncthreads();
}
__device__ __forceinline__ void topk_token_s(const LAS float* ia, const LAS float* ib, int lane, LAS unsigned* dst) {
    bool cv[5], sv[5]; unsigned u[5];
#pragma unroll
    for (int k = 0; k < 5; ++k) { const int j = lane + 64 * k; cv[k] = j >= 1 && j < 256; u[k] = cv[k] ? __float_as_uint(ia[j] + ib[j]) : 0u; }
    unsigned prefix = 0u; int rem = 14;
    for (int bit = 30; bit >= 0; --bit) {
        const unsigned cand = prefix | (1u << bit); int cnt = 0;
#pragma unroll
        for (int k = 0; k < 5; ++k) cnt += __popcll(__ballot(cv[k] && ((u[k] >> bit) == (cand >> bit))));
        if (cnt >= rem) prefix = cand; else rem -= cnt;
    }
    const unsigned long long lt = (1ull << lane) - 1ull; int before = 0;
#pragma unroll
    for (int k = 0; k < 5; ++k) { const bool e = cv[k] && u[k] == prefix; const unsigned long long be = __ballot(e); const int rk = before + __popcll(be & lt); before += __popcll(be);
        sv[k] = cv[k] && (u[k] > prefix || (e && rk < rem)); }
    sv[0] = sv[0] || lane == 0; sv[4] = sv[4] || lane == 0;
#pragma unroll
    for (int k = 0; k < 5; ++k) { const unsigned long long bb = __ballot(sv[k]); if (lane == 0) { dst[2 * k] = (unsigned)bb; dst[2 * k + 1] = (unsigned)(bb >> 32); } }
}
__device__ __forceinline__ void attn_sample_unit(const Ctx& C, int b, int h) {
    const float NINF = -__builtin_inff();
    int tid_ = C.tid; asm volatile("" : "+v"(tid_));
    const int tid = tid_, lane = tid & 63, w = __builtin_amdgcn_readfirstlane(tid >> 6), c = lane & 15, q = lane >> 4, ti = c >> 2, g = c & 3, a = w >> 2, ks = w & 3;
    LAS unsigned char* L = C.lds;
    LAS float* impA = (LAS float*)(L + S_IMPA); LAS float* impB = (LAS float*)(L + S_IMPB); LAS unsigned* selm = (LAS unsigned*)(L + S_SELM); LAS int* list = (LAS int*)(L + S_LIST);
    LAS int* misc = (LAS int*)(L + S_MISC); LAS unsigned* tun = (LAS unsigned*)(L + S_TUN); LAS float* mrg = (LAS float*)(L + S_MRG);
    const int seq = b * 2 + h, tok = 4 * a + ti;
    const size_t row = (size_t)MP + (size_t)b * LS + tok;
    const bf16* qp = C.QB + row * 512 + h * 256 + g * 64 + 8 * q;
    const bf16x8 Q0 = *(const bf16x8*)qp, Q1 = *(const bf16x8*)(qp + 32);
    for (int i = tid; i < 2 * 8448 / 4; i += 512) impA[i] = 0.f;
    const unsigned char* Lt = nullptr; (void)Lt;
    const LAS unsigned char* myK = L + ks * S_TILE; const LAS unsigned char* myV = myK + TILEB;
    f32x4 acc[4], outv[4]; float m = NINF, l = 0.f;
#pragma unroll
    for (int dt = 0; dt < 4; ++dt) { acc[dt] = (f32x4){0.f, 0.f, 0.f, 0.f}; outv[dt] = (f32x4){0.f, 0.f, 0.f, 0.f}; }
    const bf16* kcb = C.KCBS + (size_t)seq * NCS * 64; const bf16* vcb = C.VCBS + (size_t)seq * NCS * 64;
    for (int s = 0; s < 4; ++s) {
        stage4_bf16(L, kcb + (size_t)s * 256 * 64, vcb + (size_t)s * 256 * 64, tid); LDS_FENCE(); __syncthreads();
        { f32x4 sc[4]; qk_tile(myK, Q0, Q1, c, q, sc); mask_tile(sc, q, 0, 1022 - 64 * (4 * s + ks));
          const float mn = fmaxf(m, colmax(sc)), ms = (mn > NINF) ? mn : 0.f; float sum = 0.f;
#pragma unroll
          for (int t = 0; t < 4; ++t) sum += (ex2(sc[t].x - ms) + ex2(sc[t].y - ms)) + (ex2(sc[t].z - ms) + ex2(sc[t].w - ms));
          l = l * ex2(m - ms) + sum; m = mn; }
        __syncthreads();
    }
    merge4(mrg, w, lane, m, l, acc);
    float lt_ = l; lt_ += __shfl_xor(lt_, 16); lt_ += __shfl_xor(lt_, 32);
    const float invC = 1.0f / fmaxf(lt_, 1e-30f), msC = (m > NINF) ? m : 0.f;
    for (int s = 0; s < 4; ++s) {
        stage4_bf16(L, kcb + (size_t)s * 256 * 64, vcb + (size_t)s * 256 * 64, tid); LDS_FENCE(); __syncthreads();
        { f32x4 sc[4]; qk_tile(myK, Q0, Q1, c, q, sc); const int tl = 4 * s + ks; mask_tile(sc, q, 0, 1022 - 64 * tl);
#pragma unroll
          for (int t = 0; t < 4; ++t) { sc[t].x = ex2(sc[t].x - msC) * invC; sc[t].y = ex2(sc[t].y - msC) * invC; sc[t].z = ex2(sc[t].z - msC) * invC; sc[t].w = ex2(sc[t].w - msC) * invC;
              f32x4 ps = sc[t]; ps.x += dpp_xor1(ps.x); ps.y += dpp_xor1(ps.y); ps.z += dpp_xor1(ps.z); ps.w += dpp_xor1(ps.w);
              ps.x += dpp_xor2(ps.x); ps.y += dpp_xor2(ps.y); ps.z += dpp_xor2(ps.z); ps.w += dpp_xor2(ps.w);
              if (g == 0) { const int j = 16 * tl + 4 * t + q; impA[tok * 264 + j] = (ps.x + ps.y) + (ps.z + 0.5f * ps.w); impB[tok * 264 + j + 1] = 0.5f * ps.w; } }
          pv_tile_tr(myV, sc, lane, acc); }
        __syncthreads();
    }
    m = 0.f; l = 0.f;
    merge4(mrg, w, lane, m, l, acc);
    { const float gc = C.GN[row * 32 + (h * 4 + g) * 3 + 0];
#pragma unroll
      for (int dt = 0; dt < 4; ++dt) outv[dt] = acc[dt] * gc; }
    topk_token_s(impA + w * 264, impB + w * 264, lane, selm + w * 12);
    LDS_FENCE(); __syncthreads();
    if (lane < 20 && w == 0) { const int aa = lane / 10, wi = lane % 10; unsigned o = 0u;
#pragma unroll
        for (int i = 0; i < 4; ++i) o |= selm[(4 * aa + i) * 12 + wi];
        tun[aa * 12 + wi] = o; }
    if (w == 1) {
        const unsigned long long lt = (1ull << lane) - 1ull; int base = 0;
#pragma unroll
        for (int k = 0; k < 5; ++k) { unsigned o = 0u; const int wi = 2 * k + (lane >> 5);
#pragma unroll
            for (int i = 0; i < 8; ++i) o |= selm[i * 12 + wi];
            const bool bt = (o >> (lane & 31)) & 1u; const unsigned long long mm = __ballot(bt);
            if (bt) list[base + __popcll(mm & lt)] = 64 * k + lane;
            base += __popcll(mm); }
        if (lane == 0) misc[0] = base;
    }
    LDS_FENCE(); __syncthreads();
    const int nsel = misc[0];
    m = NINF; l = 0.f;
#pragma unroll
    for (int dt = 0; dt < 4; ++dt) acc[dt] = (f32x4){0.f, 0.f, 0.f, 0.f};
    for (int s0 = 0; s0 < nsel; s0 += 4) {
        TileSrc ts[4];
#pragma unroll
        for (int t = 0; t < 4; ++t) { const int j = (s0 + t < nsel) ? list[s0 + t] : -1;
            if (j < 0) { ts[t].k = C.out; ts[t].v = C.out; ts[t].stride = 0; ts[t].nrows = 0; }
            else if (j < 256) { const int page = C.page_table[b * NPAGE + (j >> 1)]; const float* base = C.cache_kv + ((size_t)page * PAGE + (size_t)(j & 1) * 64) * 512 + 2 * 128 + h * 64;
                ts[t].k = base; ts[t].v = base + 128; ts[t].stride = 512; ts[t].nrows = 64; }
            else { const float* base = C.out + O_KVS + ((size_t)b * LS) * 512 + 2 * 128 + h * 64; ts[t].k = base; ts[t].v = base + 128; ts[t].stride = 512; ts[t].nrows = LS; } }
        stage4_f32(L, ts, tid); LDS_FENCE(); __syncthreads();
        if (s0 + ks < nsel) { const int j = list[s0 + ks], wi = j >> 5, bt = j & 31;
            if ((__builtin_amdgcn_readfirstlane(tun[a * 12 + wi]) >> bt) & 1u) {
                f32x4 sc[4]; qk_tile(myK, Q0, Q1, c, q, sc);
                const bool mine = (selm[tok * 12 + wi] >> bt) & 1u;
                mask_tile(sc, q, 0, mine ? (j == 256 ? tok : 63) : -1);
                online_step(sc, true, m, l, acc);
                pv_tile_tr(myV, sc, lane, acc); } }
        __syncthreads();
    }
    merge4(mrg, w, lane, m, l, acc);
    { float lx = l; lx += __shfl_xor(lx, 16); lx += __shfl_xor(lx, 32);
      const float gs = C.GN[row * 32 + (h * 4 + g) * 3 + 1] / fmaxf(lx, 1e-30f);
#pragma unroll
      for (int dt = 0; dt < 4; ++dt) outv[dt] += acc[dt] * gs; }
    m = NINF; l = 0.f;
#pragma unroll
    for (int dt = 0; dt < 4; ++dt) acc[dt] = (f32x4){0.f, 0.f, 0.f, 0.f};
    for (int s0 = 0; s0 < 9; s0 += 4) {
        TileSrc ts[4];
#pragma unroll
        for (int t = 0; t < 4; ++t) { const int i = s0 + t;
            if (i < 8) { const float* base = C.cache_win + (((size_t)b * 512 + (size_t)i * 64) * 2) * 128 + h * 64; ts[t].k = base; ts[t].v = base + 128; ts[t].stride = 256; ts[t].nrows = 64; }
            else if (i == 8) { const float* base = C.out + O_WINS + ((size_t)b * 512 + 504) * 256 + h * 64; ts[t].k = base; ts[t].v = base + 128; ts[t].stride = 256; ts[t].nrows = LS; }
            else { ts[t].k = C.out; ts[t].v = C.out; ts[t].stride = 0; ts[t].nrows = 0; } }
        stage4_f32(L, ts, tid); LDS_FENCE(); __syncthreads();
        { const int i = s0 + ks;
          if (i < 9) { f32x4 sc[4]; qk_tile(myK, Q0, Q1, c, q, sc);
              mask_tile(sc, q, (i == 0) ? tok + 1 : 0, (i == 8) ? tok : 63);
              online_step(sc, true, m, l, acc);
              pv_tile_tr(myV, sc, lane, acc); } }
        __syncthreads();
    }
    merge4(mrg, w, lane, m, l, acc);
    if (ks == 0) { float lx = l; lx += __shfl_xor(lx, 16); lx += __shfl_xor(lx, 32);
        const float gw = C.GN[row * 32 + (h * 4 + g) * 3 + 2] / fmaxf(lx, 1e-30f);
#pragma unroll
        for (int dt = 0; dt < 4; ++dt) { const f32x4 o = outv[dt] + acc[dt] * gw; const int col = h * 256 + g * 64 + 16 * dt + 4 * q;
            const f32x4 z = unpk4(*(const v2u*)(C.SZA + row * 512 + col));
            v2u ov; ov.x = pk2(o.x * z.x, o.y * z.y); ov.y = pk2(o.z * z.z, o.w * z.w);
            *(v2u*)(C.OA + row * 512 + col) = ov; } }
}
template <int MODE> __device__ __forceinline__ void p5_attn(const Ctx& C) {
    LAS int* misc = (LAS int*)(C.lds + MISC_OFF + 128);
    unsigned* qctr = (unsigned*)(C.ws + WS_CTL) + CW_QCTR;
    for (;;) {
        if (C.tid == 0) misc[1] = (int)atomicAdd(qctr, 1u);
        __syncthreads();
        const int u = misc[1];
        __syncthreads();
        if (u >= BS * 2) break;
        if (!(MODE & 16)) attn_sample_unit(C, u >> 1, u & 1);
    }
    int nextv = 0;
    if (C.tid == 0) nextv = (int)atomicAdd(qctr + 64, 1u);
    for (;;) {
        if (C.tid == 0) misc[1] = nextv;
        __syncthreads();
        const int v = misc[1];
        __syncthreads();
        if (v >= BP * 2 * 128) break;
        if (C.tid == 0) nextv = (int)atomicAdd(qctr + 64, 1u);
        const int T = 127 - (v >> 3), sq = v & 7; attn_prompt_unit<MODE>(C, sq >> 1, sq & 1, T);
    }
}


template <class F>
__device__ __forceinline__ void skinny_gemm(const Ctx& C, const bf16* A, const bf16* Bt, int N, int K, const F& epi) {
    const int lane = C.lane, m = lane & 15, q = lane >> 4, nitems = (N >> 4) * 4;
    for (int it = C.gw; it < nitems; it += C.NGW) {
        const int s = it >> 2, rg = it & 3;
        const bf16* ap = A + (size_t)(64 * rg + m) * K + 8 * q; const bf16* bp = Bt + (size_t)(16 * s + m) * K + 8 * q;
        f32x4 acc[4];
#pragma unroll
        for (int mt = 0; mt < 4; ++mt) acc[mt] = (f32x4){0.f, 0.f, 0.f, 0.f};
#pragma unroll 8
        for (int ks = 0; ks < (K >> 5); ++ks) { const bf16x8 b = *(const bf16x8*)(bp + 32 * ks);
#pragma unroll
            for (int mt = 0; mt < 4; ++mt) acc[mt] = MFMA16(*(const bf16x8*)(ap + (size_t)mt * 16 * K + 32 * ks), b, acc[mt]); }
#pragma unroll
        for (int mt = 0; mt < 4; ++mt)
#pragma unroll
            for (int r = 0; r < 4; ++r) epi(64 * rg + 16 * mt + 4 * q + r, 16 * s + m, acc[mt][r]);
    }
}
template <class F>
__device__ __forceinline__ void skinny_gemm2(const Ctx& C, const bf16* A0, const bf16* Bt0, const bf16* A1, const bf16* Bt1, int N, int K, const F& epi) {
    const int lane = C.lane, m = lane & 15, q = lane >> 4, nitems = (N >> 4) * 4;
    for (int it = C.gw; it < nitems; it += C.NGW) {
        const int s = it >> 2, rg = it & 3;
        f32x4 acc0[4], acc1[4];
#pragma unroll
        for (int mt = 0; mt < 4; ++mt) { acc0[mt] = (f32x4){0.f, 0.f, 0.f, 0.f}; acc1[mt] = (f32x4){0.f, 0.f, 0.f, 0.f}; }
        { const bf16* ap = A0 + (size_t)(64 * rg + m) * K + 8 * q; const bf16* bp = Bt0 + (size_t)(16 * s + m) * K + 8 * q;
#pragma unroll 8
          for (int ks = 0; ks < (K >> 5); ++ks) { const bf16x8 b = *(const bf16x8*)(bp + 32 * ks);
#pragma unroll
              for (int mt = 0; mt < 4; ++mt) acc0[mt] = MFMA16(*(const bf16x8*)(ap + (size_t)mt * 16 * K + 32 * ks), b, acc0[mt]); } }
        { const bf16* ap = A1 + (size_t)(64 * rg + m) * K + 8 * q; const bf16* bp = Bt1 + (size_t)(16 * s + m) * K + 8 * q;
#pragma unroll 8
          for (int ks = 0; ks < (K >> 5); ++ks) { const bf16x8 b = *(const bf16x8*)(bp + 32 * ks);
#pragma unroll
              for (int mt = 0; mt < 4; ++mt) acc1[mt] = MFMA16(*(const bf16x8*)(ap + (size_t)mt * 16 * K + 32 * ks), b, acc1[mt]); } }
#pragma unroll
        for (int mt = 0; mt < 4; ++mt)
#pragma unroll
            for (int r = 0; r < 4; ++r) epi(64 * rg + 16 * mt + 4 * q + r, 16 * s + m, acc0[mt][r], acc1[mt][r]);
    }
}
__device__ __forceinline__ float bf2f1(bf16 v) { return __uint_as_float(((unsigned)v) << 16); }
struct SkIn {
    bf16 *QB, *KVB, *SZA, *SZS, *GM; float *U32, *GN, *out;
    __device__ __forceinline__ void operator()(int r, int c, float v) const {
        const size_t row = (size_t)MP + r;
        if (c < 512) QB[row * 512 + c] = (bf16)f2bf(v * QSCALE);
        else if (c < 1280) { const int kc = c - 512; KVB[row * 768 + kc] = (bf16)f2bf(v);
            if (kc < 512) out[O_KVS + (size_t)r * 512 + kc] = v; else out[O_WINS + ((size_t)(r >> 3) * 512 + 504 + (r & 7)) * 256 + (kc - 512)] = v; }
        else if (c < 1792) SZA[row * 512 + (c - 1280)] = (bf16)f2bf(v * sigmf(v));
        else if (c < 2304) U32[row * 512 + (c - 1792)] = v;
        else if (c < 2816) SZS[row * 512 + (c - 2304)] = (bf16)f2bf(v * sigmf(v));
        else if (c < 4864) GM[row * 2048 + (c - 2816)] = (bf16)f2bf(sigmf(v));
        else if (c < 4888) GN[row * 32 + (c - 4864)] = sigmf(v);
    }
};
struct SkGlu {
    bf16* YB; const bf16* Y1B; const bf16* SZS; const float* bias;
    __device__ __forceinline__ void operator()(int r, int c, float v) const { const size_t i = ((size_t)MP + r) * 512 + c; YB[i] = (bf16)f2bf(bf2f1(Y1B[i]) * sigmf(v + bias[c]) * bf2f1(SZS[i])); }
};
struct SkLift2 {
    bf16* MG; const bf16* GM;
    __device__ __forceinline__ void operator()(int r, int c, float vs, float va) const { const size_t row = (size_t)MP + r;
        MG[row * 1024 + c] = (bf16)f2bf(bf2f1(GM[row * 2048 + c]) * va + bf2f1(GM[row * 2048 + 1024 + c]) * vs); }
};
struct SkOut {
    bf16* YPB; const float* xs;
    __device__ __forceinline__ void operator()(int r, int c, float v) const { YPB[((size_t)MP + r) * 1024 + c] = (bf16)f2bf(xs[(size_t)r * 1024 + c] + v); }
};
__device__ __forceinline__ void p9_final(const Ctx& C) {
    const bf16* YPB = (const bf16*)(C.ws + WS_YPB);
    for (int m0 = C.gw; m0 < MT; m0 += 4 * C.NGW) {
        v4u p[4][2];
#pragma unroll
        for (int u = 0; u < 4; ++u) { const int m = m0 + u * C.NGW < MT ? m0 + u * C.NGW : m0;
#pragma unroll
            for (int j = 0; j < 2; ++j) p[u][j] = *(const v4u*)(YPB + (size_t)m * D + 512 * j + 8 * C.lane); }
#pragma unroll
        for (int u = 0; u < 4; ++u) { const int m = m0 + u * C.NGW; if (m >= MT) break;
            f32x4 v[4]; float s = 0.f;
#pragma unroll
            for (int j = 0; j < 2; ++j) { const v4u pp = p[u][j];
                v[2 * j] = (f32x4){__uint_as_float(pp.x << 16), __uint_as_float(pp.x & 0xffff0000u), __uint_as_float(pp.y << 16), __uint_as_float(pp.y & 0xffff0000u)};
                v[2 * j + 1] = (f32x4){__uint_as_float(pp.z << 16), __uint_as_float(pp.z & 0xffff0000u), __uint_as_float(pp.w << 16), __uint_as_float(pp.w & 0xffff0000u)}; }
#pragma unroll
            for (int j = 0; j < 4; ++j) s += (v[j].x * v[j].x + v[j].y * v[j].y) + (v[j].z * v[j].z + v[j].w * v[j].w);
            const float r = rsqrtf(wave_sum(s) * (1.f / D) + RMS_EPS);
#pragma unroll
            for (int j = 0; j < 4; ++j) { const int col = 512 * (j >> 1) + 8 * C.lane + 4 * (j & 1);
                *(f32x4*)(C.out + (size_t)m * D + col) = v[j] * r * *(const f32x4*)(C.final_g + col); } }
    }
    for (int it = C.gw; it < BS * 504; it += C.NGW) { const int b = it / 504, i = it % 504;
        ((f32x4*)(C.out + O_WINS + ((size_t)b * 512 + i) * 256))[C.lane] = ((const f32x4*)(C.cache_win + ((size_t)b * 512 + i + 8) * 256))[C.lane]; }
}

constexpr int N_PHASES = 8;
struct Args { const void* in[27]; float* out; unsigned char* ws; int ph_lo, ph_hi; };
__device__ __forceinline__ int lane_id() { return (int)__builtin_amdgcn_mbcnt_hi(~0u, __builtin_amdgcn_mbcnt_lo(~0u, 0u)); }
__device__ __forceinline__ void make_ctx(Ctx& C, const Args& a, unsigned char* lds_raw, const int wv) {
    C.lds = (LAS unsigned char*)lds_raw; C.wave = wv; C.lane = lane_id(); C.tid = wv * 64 + C.lane;
    C.G = gridDim.x; C.gw = blockIdx.x * NWAVES + C.wave; C.NGW = C.G * NWAVES;
    C.xp = (const float*)a.in[0]; C.xs = (const float*)a.in[1]; C.cache_kv = (const float*)a.in[2]; C.cache_win = (const float*)a.in[3]; C.st_re = (const float*)a.in[4]; C.st_im = (const float*)a.in[5];
    C.page_table = (const int*)a.in[6]; C.norm_g = (const float*)a.in[7]; C.w_in = (const float*)a.in[8]; C.cmp_pe = (const float*)a.in[9]; C.cmp_w1 = (const float*)a.in[10]; C.cmp_b1 = (const float*)a.in[11];
    C.cmp_w2 = (const float*)a.in[12]; C.lam_re = (const float*)a.in[13]; C.lam_im = (const float*)a.in[14]; C.log_dt = (const float*)a.in[15]; C.b_re = (const float*)a.in[16]; C.b_im = (const float*)a.in[17];
    C.c_re = (const float*)a.in[18]; C.c_im = (const float*)a.in[19]; C.ssm_d = (const float*)a.in[20]; C.w_glu = (const float*)a.in[21]; C.b_glu = (const float*)a.in[22]; C.w_la = (const float*)a.in[23];
    C.w_ls = (const float*)a.in[24]; C.w_out = (const float*)a.in[25]; C.final_g = (const float*)a.in[26];
    C.out = a.out; C.ws = a.ws; unsigned char* ws = a.ws;
    C.WTIN = (bf16*)(ws + WS_WTIN); C.WTGLU = (bf16*)(ws + WS_WTGLU); C.WTLA = (bf16*)(ws + WS_WTLA); C.WTLS = (bf16*)(ws + WS_WTLS); C.WTOUT = (bf16*)(ws + WS_WTOUT); C.WTC1 = (bf16*)(ws + WS_WTC1);
    C.XN = (bf16*)(ws + WS_XN); C.OA = (bf16*)(ws + WS_OA); C.Y1B = (bf16*)(ws + WS_Y1B); C.YB = (bf16*)(ws + WS_YB); C.MG = (bf16*)(ws + WS_MG); C.XC = (bf16*)(ws + WS_XC);
    C.KST = (float*)(ws + WS_CONST); C.SEND = (float*)(ws + WS_SEND); C.KC = (float*)(ws + WS_KC); C.VC = (float*)(ws + WS_VC); C.Y1 = (float*)(ws + WS_Y1); C.MB = (float*)(ws + WS_MB);
    C.PP = (float*)(ws + WS_PP); C.U32 = (float*)(ws + WS_U32); C.GN = (float*)(ws + WS_GN);
    C.KVB = (bf16*)(ws + WS_KVB); C.SZA = (bf16*)(ws + WS_SZA); C.SZS = (bf16*)(ws + WS_SZS); C.GM = (bf16*)(ws + WS_GM);
    C.QB = (bf16*)(ws + WS_QB); C.VST = (bf16*)(ws + WS_VST); C.VWT = (bf16*)(ws + WS_VWT); C.KCB = (bf16*)(ws + WS_KCB); C.VCT = (bf16*)(ws + WS_VCT); C.KCBS = (bf16*)(ws + WS_KCBS); C.VCBS = (bf16*)(ws + WS_VCBS);
}
__global__ void __launch_bounds__(NWAVES * 64, 2) mk_fwd(Args a) {
    extern __shared__ __attribute__((aligned(16))) unsigned char lds_raw[];
    unsigned char* ws = a.ws;
    volatile LAS unsigned* MISC = (volatile LAS unsigned*)((LAS unsigned char*)lds_raw + MISC_OFF);
    const int wv = __builtin_amdgcn_readfirstlane((int)threadIdx.x >> 6);
    if (wv == 0) MISC[lane_id()] = 0u;
    __syncthreads();
    const int lo = a.ph_lo, hi = a.ph_hi;
    const bool multi = (hi - lo) > 1;
    XcdBarrier bar; bar.bar = (unsigned*)(ws + WS_CTL) + CW_BAR; bar.x = 0; bar.st = nullptr;
    if (multi) bar = xcd_barrier_post((unsigned*)(ws + WS_CTL) + CW_BAR, MISC + 8, wv * 64 + lane_id());
#define IN(k) (lo <= (k) && (k) < hi)
#define MK Ctx C; make_ctx(C, a, lds_raw, wv)
#define SEAM(k) do { if (IN(k) && IN((k) + 1)) xcd_barrier(bar, wv * 64 + lane_id()); } while (0)
    if (IN(0)) { MK; p0_prep(C);
#if defined(REPEAT_WHAT) && REPEAT_WHAT == 0
        __syncthreads(); p0_prep(C);
#endif
    } SEAM(0);
    if (IN(1)) { MK; pg8::Gemm g{C.XN, C.WTIN, MP, NINP, D}; pg8::StaticOrder S; S.init(MP, NINP, C.G, (int)blockIdx.x);
        pg8::EpiIn E{C.QB, C.KVB, C.SZA, C.SZS, C.GM, C.XC, C.U32, C.GN, C.out, QSCALE, MP, O_KVP, O_KVS, O_WINP, O_WINS, (size_t)XC_S_ROWS};
        pg8::gemm_phase<pg8::EpiIn, pg8::StaticOrder, true, true>(C.lds, g, S, E, C.tid);
        SkIn K{C.QB, C.KVB, C.SZA, C.SZS, C.GM, C.U32, C.GN, C.out}; skinny_gemm(C, C.XN + (size_t)MP * D, C.WTIN, NINP, D, K);
#if defined(REPEAT_WHAT) && REPEAT_WHAT == 11
        skinny_gemm(C, C.XN + (size_t)MP * D, C.WTIN, NINP, D, K);
#endif
    } SEAM(1);
    if (IN(2)) { MK; p2_cmp1(C); __syncthreads(); p2_ssm_pass1(C); __syncthreads(); p3_ssm_pass2(C, true);
#if defined(REPEAT_WHAT) && REPEAT_WHAT == 21
        __syncthreads(); p2_cmp1(C);
#endif
#if defined(REPEAT_WHAT) && REPEAT_WHAT == 22
        __syncthreads();
#endif
#if defined(REPEAT_WHAT) && REPEAT_WHAT == 23
        __syncthreads(); p2_ssm_pass1(C);
#endif
    } SEAM(2);
    if (IN(3)) { MK; p3_ssm_pass2(C, false); __syncthreads(); p4_cmp2(C);
#if defined(REPEAT_WHAT) && REPEAT_WHAT == 31
        for (int rr = 0; rr < 4; ++rr) { __syncthreads(); p3_ssm_pass2(C, false); }
#endif
#if defined(REPEAT_WHAT) && REPEAT_WHAT == 32
        __syncthreads(); p4_cmp2(C);
#endif
    } SEAM(3);
    if (IN(4)) { MK; { pg8::Gemm g{C.Y1B, C.WTGLU, MP, 512, 512}; pg8::StaticOrder S; S.init(MP, 512, C.G, (int)blockIdx.x); pg8::EpiGlu E{C.YB, C.Y1B, C.SZS, C.b_glu};
        pg8::gemm_phase<pg8::EpiGlu, pg8::StaticOrder, true, true>(C.lds, g, S, E, C.tid);
        SkGlu K{C.YB, C.Y1B, C.SZS, C.b_glu}; skinny_gemm(C, C.Y1B + (size_t)MP * 512, C.WTGLU, 512, 512, K); }
        __syncthreads(); p5_attn<0>(C); } SEAM(4);
    if (IN(5)) { MK; pg8::Gemm g{C.YB, C.WTLS, MP, 1024, 512, C.OA, C.WTLA}; pg8::PairOrder S; S.init(MP, 1024, C.G, (int)blockIdx.x); pg8::EpiLift2 E{C.MG, C.GM};
        pg8::gemm_phase<pg8::EpiLift2, pg8::PairOrder, true, true>(C.lds, g, S, E, C.tid);
        SkLift2 K{C.MG, C.GM}; skinny_gemm2(C, C.YB + (size_t)MP * 512, C.WTLS, C.OA + (size_t)MP * 512, C.WTLA, 1024, 512, K);
#if defined(REPEAT_WHAT) && REPEAT_WHAT == 5
        __syncthreads(); pg8::gemm_phase<pg8::EpiLift2, pg8::PairOrder, true, true>(C.lds, g, S, E, C.tid);
#endif
    } SEAM(5);
    if (IN(6)) { MK; pg8::Gemm g{C.MG, C.WTOUT, MP, 1024, 1024}; pg8::StaticOrder S; S.init(MP, 1024, C.G, (int)blockIdx.x); pg8::EpiOut E{(bf16*)(C.ws + WS_YPB), C.xp, C.xs, MP};
        pg8::gemm_phase<pg8::EpiOut, pg8::StaticOrder, true, true>(C.lds, g, S, E, C.tid);
        SkOut K{(bf16*)(C.ws + WS_YPB), C.xs}; skinny_gemm(C, C.MG + (size_t)MP * 1024, C.WTOUT, 1024, 1024, K); } SEAM(6);
    if (IN(7)) { MK; p9_final(C);
#if defined(REPEAT_WHAT) && REPEAT_WHAT == 71
        __syncthreads(); { pg8::Gemm g{C.XN, C.WTIN, MP, NINP, D}; pg8::StaticOrder S; S.init(MP, NINP, C.G, (int)blockIdx.x);
        pg8::EpiIn E{C.QB, C.KVB, C.SZA, C.SZS, C.GM, C.XC, C.U32, C.GN, C.out, QSCALE, MP, O_KVP, O_KVS, O_WINP, O_WINS, (size_t)XC_S_ROWS};
        pg8::gemm_phase<pg8::EpiIn, pg8::StaticOrder, true, true>(C.lds, g, S, E, C.tid); }
#endif
#if defined(REPEAT_WHAT) && REPEAT_WHAT == 72
        __syncthreads(); { pg8::Gemm g{C.YB, C.WTLS, MP, 1024, 512, C.OA, C.WTLA}; pg8::PairOrder S; S.init(MP, 1024, C.G, (int)blockIdx.x); pg8::EpiLift2 E{C.MG, C.GM};
        pg8::gemm_phase<pg8::EpiLift2, pg8::PairOrder, true, true>(C.lds, g, S, E, C.tid); }
#endif
    }
#undef IN
#undef SEAM
}

#ifndef MK_ONE_LAUNCH
#define MK_ONE_LAUNCH 1
#endif
extern "C" void kernel_launch(void* const* d_in, const int* in_sizes, int n_in, void* d_out, int out_size, void* d_ws, size_t ws_size, hipStream_t stream) {
    static int grid = 0;
    if (grid == 0) {
        if (n_in != 27 || (size_t)out_size != O_END || ws_size < WS_END) { fprintf(stderr, "kernel_launch: unexpected shapes: n_in %d out %d ws %zu\n", n_in, out_size, ws_size); grid = -1; return; }
        int dev = 0, cus = 0, per_cu = 0;
        if (hipGetDevice(&dev) != hipSuccess || hipDeviceGetAttribute(&cus, hipDeviceAttributeMultiprocessorCount, dev) != hipSuccess) { grid = -1; return; }
        if (hipFuncSetAttribute((const void*)mk_fwd, hipFuncAttributeMaxDynamicSharedMemorySize, LDS_BYTES) != hipSuccess) { fprintf(stderr, "kernel_launch: hipFuncSetAttribute failed\n"); grid = -1; return; }
        if (hipOccupancyMaxActiveBlocksPerMultiprocessor(&per_cu, (const void*)mk_fwd, NWAVES * 64, LDS_BYTES) != hipSuccess || per_cu < 1) fprintf(stderr, "kernel_launch: occupancy query reports %d\n", per_cu);
        (void)hipGetLastError();
        grid = cus;
    }
    if (grid < 0) return;
    (void)hipMemsetAsync((char*)d_ws + WS_CTL, 0, CTL_ZERO_BYTES, stream);
    Args a{};
    for (int i = 0; i < 27; ++i) a.in[i] = d_in[i];
    a.out = (float*)d_out; a.ws = (unsigned char*)d_ws;
#if MK_ONE_LAUNCH
    a.ph_lo = 0; a.ph_hi = N_PHASES;
    hipLaunchKernelGGL(mk_fwd, dim3(grid), dim3(NWAVES * 64), LDS_BYTES, stream, a);
#else
    for (int p = 0; p < N_PHASES; ++p) { a.ph_lo = p; a.ph_hi = p + 1; hipLaunchKernelGGL(mk_fwd, dim3(grid), dim3(NWAVES * 64), LDS_BYTES, stream, a); }
#endif
}
```

```cpp
#include <hip/hip_runtime.h>
#include <cstdio>
#include <cstdint>
namespace pg8 {
#define PG8_LAS __attribute__((address_space(3)))
typedef unsigned short bf16_t;
typedef short bf16x8 __attribute__((ext_vector_type(8)));
typedef float f32x4 __attribute__((ext_vector_type(4)));
typedef unsigned u32x4 __attribute__((ext_vector_type(4)));
constexpr int BM = 256, BK = 64, HALF = 128, HTB = HALF * BK * 2  , STAGE_BYTES = 8 * HTB, NXCD = 8, WGM = 8;

__host__ __device__ __forceinline__ int lds_byte(int r, int c) { const int st = (r >> 4) * 2 + (c >> 5), rr = r & 15, cc = c & 31, ob = rr * 64 + cc * 2; return st * 1024 + (ob ^ (((ob >> 9) & 1) << 5)); }
__host__ __device__ __forceinline__ void stage_rc(int b, int& R, int& C) { const int st = b / 1024, sb = b % 1024, swz = sb ^ (((sb >> 9) & 1) << 5); R = (st >> 1) * 16 + swz / 64; C = (st & 1) * 32 + (swz % 64) / 2; }
__host__ __device__ __forceinline__ int perm32(int rho) { const int n = rho >> 4, i = rho & 15; return 8 * (i >> 2) + 4 * n + (i & 3); }

struct Unit { int pm, pn, part; };
struct Gemm { const bf16_t* A; const bf16_t* Bt; int M, N, K; const bf16_t* A2; const bf16_t* Bt2; };

struct StaticOrder {
    int nM, nN, nwg, G, c;
    __host__ __device__ void init(int M, int N, int G_, int c_) { nM = M / BM; nN = N / BM; nwg = nM * nN; G = G_; c = c_; }
    __host__ __device__ bool next(int i, Unit& u) const {
        const long L = (long)i * G + c; if (L >= nwg) return false;
        int wgid = (int)L; { const int q = nwg / NXCD, r = nwg % NXCD, xcd = wgid % NXCD, off = wgid / NXCD; wgid = (xcd < r ? xcd * (q + 1) : r * (q + 1) + (xcd - r) * q) + off; }
        const int nig = WGM * nN, gid = wgid / nig, fm = gid * WGM, gsz = (nM - fm) < WGM ? (nM - fm) : WGM;
        u.pm = fm + ((wgid % nig) % gsz); u.pn = (wgid % nig) / gsz; u.part = 0; return true;
    }
    __device__ __forceinline__ void a_ready(const Unit&) const {}
    __device__ __forceinline__ void done(const Unit&) const {}
};
struct PairOrder : StaticOrder {
    __host__ __device__ bool next(int i, Unit& u) const { if (!StaticOrder::next(i >> 1, u)) return false; u.part = i & 1; return true; }
};

__device__ __forceinline__ unsigned cvt_pk_bf16(float lo, float hi) { unsigned r; asm volatile("v_cvt_pk_bf16_f32 %0, %1, %2" : "=v"(r) : "v"(lo), "v"(hi)); return r; }
typedef float f32x2 __attribute__((ext_vector_type(2)));
__device__ __forceinline__ f32x2 gelu_pk(f32x2 v) {
    const f32x2 av = __builtin_elementwise_abs(v), d = av * 0.2316418882f + 1.0f;
    f32x2 t; t.x = __builtin_amdgcn_rcpf(d.x); t.y = __builtin_amdgcn_rcpf(d.y);
    f32x2 q = t * 0.5307027145f + (-0.7265760135f); q = q * t + 0.7107068705f; q = q * t + (-0.142248368f); q = q * t + 0.127414796f; q = q * t;
    const f32x2 s = (v * v) * (-0.72134752044f);
    f32x2 e; e.x = __builtin_amdgcn_exp2f(s.x); e.y = __builtin_amdgcn_exp2f(s.y);
    const f32x2 m = v * (q * e), r = v - m;
    f32x2 o; o.x = v.x < 0.f ? m.x : r.x; o.y = v.y < 0.f ? m.y : r.y; return o;
}

__device__ __forceinline__ float sigm(float x) { return 1.0f / (1.0f + __expf(-x)); }
__device__ __forceinline__ f32x4 sigm4(f32x4 v) { return (f32x4){sigm(v[0]), sigm(v[1]), sigm(v[2]), sigm(v[3])}; }

struct EpiF32 {
    static constexpr bool PERM = false, AFTER_DRAIN = false, TWO_PART = false;
    float* C; int ldc;
    __device__ __forceinline__ void operator()(const f32x4 (&acc)[2][2][4][2], const Unit& u, int wr, int wc, int fr, int fq) const {
        const int row0 = u.pm * BM + wr * 64 + fr, col0 = u.pn * BM + wc * 32 + 4 * fq;
#pragma unroll
        for (int ai = 0; ai < 2; ++ai)
#pragma unroll
            for (int m = 0; m < 4; ++m) { float* rowp = C + (size_t)(row0 + ai * HALF + m * 16) * ldc + col0;
#pragma unroll
                for (int bj = 0; bj < 2; ++bj)
#pragma unroll
                    for (int n = 0; n < 2; ++n) *(f32x4*)(rowp + bj * HALF + n * 16) = acc[ai][bj][m][n]; }
    }
};
__device__ __forceinline__ f32x4 bfx4(unsigned lo, unsigned hi) { return (f32x4){__uint_as_float(lo << 16), __uint_as_float(lo & 0xffff0000u), __uint_as_float(hi << 16), __uint_as_float(hi & 0xffff0000u)}; }
__device__ __forceinline__ u32x4 pack8f(f32x4 v0, f32x4 v1) { u32x4 w; w.x = cvt_pk_bf16(v0[0], v0[1]); w.y = cvt_pk_bf16(v0[2], v0[3]); w.z = cvt_pk_bf16(v1[0], v1[1]); w.w = cvt_pk_bf16(v1[2], v1[3]); return w; }
struct EpiIn {
    static constexpr bool PERM = true, AFTER_DRAIN = false, TWO_PART = false;
    bf16_t *QB, *KVB, *SZA, *SZS, *GM, *XC; float *U32, *GN, *out; float qscale; int mp;
    size_t o_kvp, o_kvs, o_winp, o_wins, xc_prow0;
    __device__ __forceinline__ void operator()(const f32x4 (&acc)[2][2][4][2], const Unit& u, int wr, int wc, int fr, int fq) const {
        const int row0 = u.pm * BM + wr * 64 + fr, pn = u.pn; const bool prm = u.pm * BM < mp;
#pragma unroll
        for (int ai = 0; ai < 2; ++ai)
#pragma unroll
            for (int m = 0; m < 4; ++m) { const size_t row = (size_t)(row0 + ai * HALF + m * 16);
#pragma unroll
                for (int bj = 0; bj < 2; ++bj) { const int c = pn * BM + bj * HALF + wc * 32 + 8 * fq; const f32x4 v0 = acc[ai][bj][m][0], v1 = acc[ai][bj][m][1];
                    if (pn < 2) { *(u32x4*)(QB + row * 512 + c) = pack8f(v0 * qscale, v1 * qscale); }
                    else if (pn < 5) { const int kc = c - 512, slot = kc >> 7;
                        *(u32x4*)(KVB + row * 768 + kc) = pack8f(v0, v1);
                        if (slot < 4) { float* d = out + (prm ? o_kvp + row * 512 : o_kvs + (row - mp) * 512) + kc; *(f32x4*)d = v0; *(f32x4*)(d + 4) = v1;
 }
                        else { const int wk = kc - 512;
                            if (prm) { const int t = (int)(row & 8191); if (t >= 7680) { float* d = out + o_winp + ((row >> 13) * 512 + (t - 7680)) * 256 + wk; *(f32x4*)d = v0; *(f32x4*)(d + 4) = v1; } }
                            else { const size_t q = row - mp; float* d = out + o_wins + ((q >> 3) * 512 + 504 + (q & 7)) * 256 + wk; *(f32x4*)d = v0; *(f32x4*)(d + 4) = v1; } } }
                    else if (pn < 7) { *(u32x4*)(SZA + row * 512 + (c - 1280)) = pack8f(v0 * sigm4(v0), v1 * sigm4(v1)); }
                    else if (pn < 9) { float* d = U32 + row * 512 + (c - 1792); *(f32x4*)d = v0; *(f32x4*)(d + 4) = v1; }
                    else if (pn < 11) { *(u32x4*)(SZS + row * 512 + (c - 2304)) = pack8f(v0 * sigm4(v0), v1 * sigm4(v1)); }
                    else if (pn < 19) { *(u32x4*)(GM + row * 2048 + (c - 2816)) = pack8f(sigm4(v0), sigm4(v1)); }
                    else if (c < 4888) { float* d = GN + row * 32 + (c - 4864); *(f32x4*)d = sigm4(v0); *(f32x4*)(d + 4) = sigm4(v1); } } }
    }
};
struct EpiGlu {
    static constexpr bool PERM = true, AFTER_DRAIN = false, TWO_PART = false;
    bf16_t* O; const bf16_t* Y1B; const bf16_t* SZS; const float* bias;
    __device__ __forceinline__ void operator()(const f32x4 (&acc)[2][2][4][2], const Unit& u, int wr, int wc, int fr, int fq) const {
        const int row0 = u.pm * BM + wr * 64 + fr, col0 = u.pn * BM + wc * 32 + 8 * fq;
#pragma unroll
        for (int ai = 0; ai < 2; ++ai)
#pragma unroll
            for (int m = 0; m < 4; ++m) { const size_t row = (size_t)(row0 + ai * HALF + m * 16);
#pragma unroll
                for (int bj = 0; bj < 2; ++bj) { const int c = col0 + bj * HALF;
                    const f32x4 b0 = *(const f32x4*)(bias + c), b1 = *(const f32x4*)(bias + c + 4);
                    const u32x4 yy = *(const u32x4*)(Y1B + row * 512 + c); const f32x4 y0 = bfx4(yy.x, yy.y), y1 = bfx4(yy.z, yy.w);
                    const u32x4 zz = *(const u32x4*)(SZS + row * 512 + c);
                    *(u32x4*)(O + row * 512 + c) = pack8f(y0 * sigm4(acc[ai][bj][m][0] + b0) * bfx4(zz.x, zz.y), y1 * sigm4(acc[ai][bj][m][1] + b1) * bfx4(zz.z, zz.w)); } }
    }
};
struct EpiLift2 {
    static constexpr bool PERM = true, AFTER_DRAIN = false, TWO_PART = true;
    bf16_t* O; const bf16_t* GM;
    __device__ __forceinline__ void mid(f32x4 (&acc)[2][2][4][2], const Unit& u, int wr, int wc, int fr, int fq) const {
        const int row0 = u.pm * BM + wr * 64 + fr, col0 = u.pn * BM + wc * 32 + 8 * fq;
#pragma unroll
        for (int ai = 0; ai < 2; ++ai)
#pragma unroll
            for (int m = 0; m < 4; ++m) { const size_t row = (size_t)(row0 + ai * HALF + m * 16);
#pragma unroll
                for (int bj = 0; bj < 2; ++bj) { const int c = col0 + bj * HALF; const u32x4 ga = *(const u32x4*)(GM + row * 2048 + c), gb = *(const u32x4*)(GM + row * 2048 + 1024 + c);
                    const f32x4 a0 = bfx4(ga.x, ga.y), a1 = bfx4(ga.z, ga.w), b0 = bfx4(gb.x, gb.y), b1 = bfx4(gb.z, gb.w);
#pragma unroll
                    for (int j = 0; j < 4; ++j) { acc[ai][bj][m][0][j] *= b0[j] * __builtin_amdgcn_rcpf(fmaxf(a0[j], 1e-30f)); acc[ai][bj][m][1][j] *= b1[j] * __builtin_amdgcn_rcpf(fmaxf(a1[j], 1e-30f)); } } }
    }
    __device__ __forceinline__ void operator()(const f32x4 (&acc)[2][2][4][2], const Unit& u, int wr, int wc, int fr, int fq) const {
        const int row0 = u.pm * BM + wr * 64 + fr, col0 = u.pn * BM + wc * 32 + 8 * fq;
#pragma unroll
        for (int ai = 0; ai < 2; ++ai)
#pragma unroll
            for (int m = 0; m < 4; ++m) { const size_t row = (size_t)(row0 + ai * HALF + m * 16);
#pragma unroll
                for (int bj = 0; bj < 2; ++bj) { const int c = col0 + bj * HALF; const u32x4 ga = *(const u32x4*)(GM + row * 2048 + c);
                    *(u32x4*)(O + row * 1024 + c) = pack8f(bfx4(ga.x, ga.y) * acc[ai][bj][m][0], bfx4(ga.z, ga.w) * acc[ai][bj][m][1]); } }
    }
};
struct EpiOut {
    static constexpr bool PERM = true, AFTER_DRAIN = false, TWO_PART = false;
    bf16_t* O; const float* xp; const float* xs; int mp;
    __device__ __forceinline__ void operator()(const f32x4 (&acc)[2][2][4][2], const Unit& u, int wr, int wc, int fr, int fq) const {
        const int row0 = u.pm * BM + wr * 64 + fr, col0 = u.pn * BM + wc * 32 + 8 * fq;
        const float* xb = (u.pm * BM < mp) ? xp : (xs - (size_t)mp * 1024);
#pragma unroll
        for (int ai = 0; ai < 2; ++ai)
#pragma unroll
            for (int m = 0; m < 4; ++m) { const size_t row = (size_t)(row0 + ai * HALF + m * 16);
#pragma unroll
                for (int bj = 0; bj < 2; ++bj) { const int c = col0 + bj * HALF;
                    const f32x4 x0 = *(const f32x4*)(xb + row * 1024 + c), x1 = *(const f32x4*)(xb + row * 1024 + c + 4);
                    *(u32x4*)(O + row * 1024 + c) = pack8f(x0 + acc[ai][bj][m][0], x1 + acc[ai][bj][m][1]); } }
    }
};

template <class Epi, class Sched, bool ALIGN_EPI = false, bool SP2 = false>
__device__ __forceinline__ void gemm_phase(PG8_LAS unsigned char* lds, const Gemm g, const Sched& S, const Epi& E, const int tid_in) {
    const int tid = tid_in, wid = __builtin_amdgcn_readfirstlane(tid >> 6), lane = tid & 63, wr = wid >> 2, wc = wid & 3, fr = lane & 15, fq = lane >> 4;
    const int K = g.K, nt = K / BK;
    unsigned voffA[2], voffB[2];
#pragma unroll
    for (int i = 0; i < 2; ++i) { int R, C; stage_rc(tid * 16 + i * 8192, R, C); const int Rb = Epi::PERM ? ((R & ~31) + perm32(R & 31)) : R;
        voffA[i] = (unsigned)(R * K + C) * 2u; voffB[i] = (unsigned)(Rb * K + C) * 2u; }
    const size_t kstep = (size_t)(BK * 2);
    const size_t hstep = (size_t)HALF * K * 2;
    const size_t tstep = 2 * hstep;
    const unsigned ldsw = (unsigned)wid * 1024u;
    const int aoff = lds_byte(wr * 64 + fr, fq * 8), boff = lds_byte(wc * 32 + fr, fq * 8);
#define PG8_SA(b, h) (((b) * 2 + (h)) * HTB)
#define PG8_SB(b, h) ((4 + (b) * 2 + (h)) * HTB)
#define PG8_STAGE(bufoff, gbase, voff) do { _Pragma("unroll") for (int _i = 0; _i < 2; ++_i) \
        __builtin_amdgcn_global_load_lds((const unsigned*)((const char*)(gbase) + (voff)[_i]), (PG8_LAS unsigned*)(lds + (bufoff) + ldsw + _i * 8192), 16, 0, 0); } while (0)
#define PG8_LDA(dst, b, h) do { _Pragma("unroll") for (int m = 0; m < 4; ++m) _Pragma("unroll") for (int k = 0; k < 2; ++k) dst[m][k] = *(const PG8_LAS bf16x8*)(lds + PG8_SA(b, h) + aoff + m * 2048 + k * 1024); } while (0)
#define PG8_LDB(dst, b, h) do { _Pragma("unroll") for (int n = 0; n < 2; ++n) _Pragma("unroll") for (int k = 0; k < 2; ++k) dst[n][k] = *(const PG8_LAS bf16x8*)(lds + PG8_SB(b, h) + boff + n * 2048 + k * 1024); } while (0)
#define PG8_MMA(ai, bj, At, Bt) do { __builtin_amdgcn_s_setprio(1); _Pragma("unroll") for (int m = 0; m < 4; ++m) _Pragma("unroll") for (int n = 0; n < 2; ++n) _Pragma("unroll") for (int k = 0; k < 2; ++k) \
        acc[ai][bj][m][n] = __builtin_amdgcn_mfma_f32_16x16x32_bf16(Bt[n][k], At[m][k], acc[ai][bj][m][n], 0, 0, 0); __builtin_amdgcn_s_setprio(0); } while (0)
#define PG8_WAIT_V(n) asm volatile("s_waitcnt vmcnt(" #n ")" ::: "memory")
#define PG8_WAIT_L(n) asm volatile("s_waitcnt lgkmcnt(" #n ")" ::: "memory")
#define PG8_BAR __builtin_amdgcn_s_barrier()
#define PG8_SCHED __builtin_amdgcn_sched_barrier(0)
    Unit cur, nxt; int ui = 0;
    if (!S.next(0, cur)) return;
    f32x4 acc[2][2][4][2];
#pragma unroll
    for (int a = 0; a < 2; ++a)
#pragma unroll
        for (int b = 0; b < 2; ++b)
#pragma unroll
            for (int m = 0; m < 4; ++m)
#pragma unroll
                for (int n = 0; n < 2; ++n) acc[a][b][m][n] = (f32x4){0.f, 0.f, 0.f, 0.f};
    bf16x8 At[4][2], B0[2][2], B1[2][2];
    const char* cA = (const char*)((Epi::TWO_PART && cur.part) ? g.A2 : g.A) + (size_t)cur.pm * tstep; const char* cB = (const char*)((Epi::TWO_PART && cur.part) ? g.Bt2 : g.Bt) + (size_t)cur.pn * tstep;
    S.a_ready(cur);
    if constexpr (SP2) {
        PG8_STAGE(PG8_SB(0, 0), cB, voffB); PG8_STAGE(PG8_SB(0, 1), cB + hstep, voffB); PG8_STAGE(PG8_SA(0, 0), cA, voffA); PG8_STAGE(PG8_SA(0, 1), cA + hstep, voffA);
        if (wr == 1) PG8_BAR;
        PG8_WAIT_V(2); PG8_BAR;
        PG8_STAGE(PG8_SB(1, 0), cB + kstep, voffB); PG8_STAGE(PG8_SA(1, 0), cA + kstep, voffA); PG8_STAGE(PG8_SB(1, 1), cB + hstep + kstep, voffB);
        PG8_WAIT_V(6); PG8_BAR;
    } else {
        PG8_STAGE(PG8_SB(0, 0), cB, voffB); PG8_STAGE(PG8_SA(0, 0), cA, voffA); PG8_STAGE(PG8_SB(0, 1), cB + hstep, voffB); PG8_STAGE(PG8_SA(0, 1), cA + hstep, voffA);
        if (wr == 1) PG8_BAR;
        PG8_WAIT_V(4); PG8_BAR;
        PG8_STAGE(PG8_SB(1, 0), cB + kstep, voffB); PG8_STAGE(PG8_SA(1, 0), cA + kstep, voffA); PG8_STAGE(PG8_SB(1, 1), cB + hstep + kstep, voffB);
        PG8_WAIT_V(6); PG8_BAR;
    }
    for (;;) {
        const bool has_next = S.next(ui + 1, nxt);
        const char* nA = has_next ? (const char*)((Epi::TWO_PART && nxt.part) ? g.A2 : g.A) + (size_t)nxt.pm * tstep : cA; const char* nB = has_next ? (const char*)((Epi::TWO_PART && nxt.part) ? g.Bt2 : g.Bt) + (size_t)nxt.pn * tstep : cB;
        for (int t = 0; t < nt; t += 2) {
            const bool last = (t == nt - 2);
            const char* a1 = cA + (size_t)(t + 1) * kstep;
            const char* a2 = last ? nA : cA + (size_t)(t + 2) * kstep; const char* b2 = last ? nB : cB + (size_t)(t + 2) * kstep;
            const char* a3 = a2 + kstep; const char* b3 = b2 + kstep;
            if (last && has_next) S.a_ready(nxt);
            if constexpr (SP2) {
            PG8_LDB(B0, 0, 0); PG8_LDB(B1, 0, 1); PG8_SCHED; PG8_LDA(At, 0, 0); PG8_STAGE(PG8_SA(1, 1), a1 + hstep, voffA);
            PG8_WAIT_V(8); PG8_WAIT_L(0); PG8_BAR; PG8_MMA(0, 0, At, B0); PG8_MMA(0, 1, At, B1); PG8_BAR; PG8_SCHED;
            PG8_LDA(At, 0, 1); PG8_STAGE(PG8_SB(0, 0), b2, voffB); PG8_STAGE(PG8_SB(0, 1), b2 + hstep, voffB); PG8_STAGE(PG8_SA(0, 0), a2, voffA);
            PG8_WAIT_V(8); PG8_WAIT_L(0); PG8_BAR; PG8_MMA(1, 0, At, B0); PG8_MMA(1, 1, At, B1); PG8_BAR; PG8_SCHED;
            PG8_LDB(B0, 1, 0); PG8_LDB(B1, 1, 1); PG8_SCHED; PG8_LDA(At, 1, 0); PG8_STAGE(PG8_SA(0, 1), a2 + hstep, voffA);
            PG8_WAIT_V(8); PG8_WAIT_L(0); PG8_BAR; PG8_MMA(0, 0, At, B0); PG8_MMA(0, 1, At, B1); PG8_BAR; PG8_SCHED;
            PG8_LDA(At, 1, 1); PG8_STAGE(PG8_SB(1, 0), b3, voffB); PG8_STAGE(PG8_SB(1, 1), b3 + hstep, voffB); PG8_STAGE(PG8_SA(1, 0), a3, voffA);
            PG8_WAIT_V(8); PG8_WAIT_L(0); PG8_BAR; PG8_MMA(1, 0, At, B0); PG8_MMA(1, 1, At, B1); PG8_BAR; PG8_SCHED;
            } else {
            PG8_LDB(B0, 0, 0); PG8_SCHED; PG8_LDA(At, 0, 0); PG8_STAGE(PG8_SA(1, 1), a1 + hstep, voffA);
            PG8_WAIT_L(8); PG8_BAR; PG8_WAIT_L(0); PG8_MMA(0, 0, At, B0); PG8_BAR; PG8_SCHED;
            PG8_LDB(B1, 0, 1); PG8_STAGE(PG8_SB(0, 0), b2, voffB);
            PG8_BAR; PG8_WAIT_L(0); PG8_MMA(0, 1, At, B1); PG8_BAR;
            PG8_LDA(At, 0, 1); PG8_STAGE(PG8_SA(0, 0), a2, voffA);
            PG8_BAR; PG8_WAIT_L(0); PG8_MMA(1, 0, At, B0); PG8_BAR; PG8_SCHED;
            PG8_STAGE(PG8_SB(0, 1), b2 + hstep, voffB);
            PG8_WAIT_V(6); PG8_BAR; PG8_MMA(1, 1, At, B1); PG8_BAR;
            PG8_LDB(B0, 1, 0); PG8_SCHED; PG8_LDA(At, 1, 0); PG8_STAGE(PG8_SA(0, 1), a2 + hstep, voffA);
            PG8_WAIT_L(8); PG8_BAR; PG8_WAIT_L(0); PG8_MMA(0, 0, At, B0); PG8_BAR; PG8_SCHED;
            PG8_LDB(B1, 1, 1); PG8_STAGE(PG8_SB(1, 0), b3, voffB);
            PG8_BAR; PG8_WAIT_L(0); PG8_MMA(0, 1, At, B1); PG8_BAR;
            PG8_LDA(At, 1, 1); PG8_STAGE(PG8_SA(1, 0), a3, voffA);
            PG8_BAR; PG8_WAIT_L(0); PG8_MMA(1, 0, At, B0); PG8_BAR; PG8_SCHED;
            PG8_STAGE(PG8_SB(1, 1), b3 + hstep, voffB);
            PG8_WAIT_V(6); PG8_BAR; PG8_MMA(1, 1, At, B1); PG8_BAR;
            }
        }
        if constexpr (ALIGN_EPI) { if (wr == 0) PG8_BAR; }
        bool keep_acc = false;
        if constexpr (Epi::TWO_PART) { if (cur.part == 0) { E.mid(acc, cur, wr, wc, fr, fq); keep_acc = true; } else { E(acc, cur, wr, wc, fr, fq); } }
        else if constexpr (!Epi::AFTER_DRAIN) { E(acc, cur, wr, wc, fr, fq); S.done(cur); }
        if (!has_next) break;
        if (!keep_acc)
#pragma unroll
        for (int a = 0; a < 2; ++a)
#pragma unroll
            for (int b = 0; b < 2; ++b)
#pragma unroll
                for (int m = 0; m < 4; ++m)
#pragma unroll
                    for (int n = 0; n < 2; ++n) acc[a][b][m][n] = (f32x4){0.f, 0.f, 0.f, 0.f};
        cur = nxt; cA = nA; cB = nB; ++ui;
        if constexpr (ALIGN_EPI) { if (wr == 1) PG8_BAR; }
    }
    PG8_WAIT_V(0);
    if constexpr (!ALIGN_EPI) { if (wr == 0) PG8_BAR; }
    PG8_BAR;
    if constexpr (Epi::AFTER_DRAIN) { E.fused(acc, cur, wr, wc, fr, fq, lds, wid, lane); S.done(cur); }
#undef PG8_SA
#undef PG8_SB
#undef PG8_STAGE
#undef PG8_LDA
#undef PG8_LDB
#undef PG8_MMA
#undef PG8_WAIT_V
#undef PG8_WAIT_L
#undef PG8_BAR
#undef PG8_SCHED
}
}
#define LAS __attribute__((address_space(3)))
#define XB_TMO      128
#define XB_XCNT(j)  (256  + 64 * (j))
#define XB_XSUB(j)  (1280 + 64 * (j))
#define XB_XGEN(j)  (2304 + 64 * (j))
#define XB_TOP      3328
#define XB_TOPGEN   3392
#define XCD_BAR_WORDS 3456
#define XB_SPIN_CAP (1u << 18)

__device__ __forceinline__ unsigned xb_ld(unsigned* p)              { return __hip_atomic_load(p, __ATOMIC_RELAXED, __HIP_MEMORY_SCOPE_AGENT); }
__device__ __forceinline__ unsigned xb_add(unsigned* p, unsigned v) { return __hip_atomic_fetch_add(p, v, __ATOMIC_RELAXED, __HIP_MEMORY_SCOPE_AGENT); }
__device__ __forceinline__ unsigned xb_xcc_id() { return (unsigned)__builtin_amdgcn_s_getreg((3 << 11) | 20) & 0xFu; }
#define XB_SPIN(cond, bar) do { unsigned _sp = 0; while (cond) { __builtin_amdgcn_s_sleep(1); \
    if ((++_sp & 255u) == 0u) { if (xb_ld(&(bar)[XB_TMO])) break; if (_sp > XB_SPIN_CAP) { atomicAdd(&(bar)[XB_TMO], 1u); break; } } } } while (0)

struct XcdBarrier {
    unsigned* bar; unsigned x;
    volatile LAS unsigned* st;
};

__device__ __forceinline__ XcdBarrier xcd_barrier_post(unsigned* bar, volatile LAS unsigned* st, const int tid) {
    XcdBarrier b; b.bar = bar; b.x = xb_xcc_id(); b.st = st;
    if (tid == 0) (void)xb_add(&bar[XB_XCNT(b.x)], 1u);
    return b;
}
__device__ __forceinline__ void xcd_barrier_complete(unsigned* bar, unsigned x, unsigned& nloc, unsigned& nx) {
    const unsigned G = gridDim.x * gridDim.y * gridDim.z;
    unsigned sum, cnt, mine, sp = 0u;
    for (;;) {
        sum = 0u; cnt = 0u; mine = 0u;
#pragma unroll
        for (unsigned j = 0; j < 16; ++j) { const unsigned c = xb_ld(&bar[XB_XCNT(j)]); sum += c; cnt += (c > 0u) ? 1u : 0u; mine = (j == x) ? c : mine; }
        if (sum == G) break;
        __builtin_amdgcn_s_sleep(1);
        if ((++sp & 255u) == 0u) { if (xb_ld(&bar[XB_TMO])) break; if (sp > XB_SPIN_CAP) { atomicAdd(&bar[XB_TMO], 1u); break; } }
    }
    nloc = mine > 0u ? mine : 1u; nx = cnt > 0u ? cnt : 1u;
}

__device__ __forceinline__ void xcd_barrier(const XcdBarrier& b, const int tid) {
    asm volatile("s_waitcnt vmcnt(0)" ::: "memory");
    __syncthreads();
    if (tid == 0) {
        unsigned* bar = b.bar;
        __builtin_amdgcn_s_waitcnt(0);
        unsigned nloc = b.st[0], nx = b.st[1];
        if (nloc == 0u) { xcd_barrier_complete(bar, b.x, nloc, nx); b.st[0] = nloc; b.st[1] = nx; }
        const unsigned old = xb_add(&bar[XB_XSUB(b.x)], 1u);
        const unsigned gen = old / nloc;
        if (old + 1u == (gen + 1u) * nloc) {
            __builtin_amdgcn_fence(__ATOMIC_RELEASE, "agent");
            asm volatile("s_waitcnt vmcnt(0)" ::: "memory");
            const unsigned og = xb_add(&bar[XB_TOP], 1u);
            const unsigned tg = og / nx;
            if (og + 1u == (tg + 1u) * nx) xb_add(&bar[XB_TOPGEN], 1u);
            else XB_SPIN(xb_ld(&bar[XB_TOPGEN]) == tg, bar);
            __builtin_amdgcn_fence(__ATOMIC_ACQUIRE, "agent");
            xb_add(&bar[XB_XGEN(b.x)], 1u);
            asm volatile("s_waitcnt vmcnt(0)" ::: "memory");
        } else {
            XB_SPIN(xb_ld(&bar[XB_XGEN(b.x)]) == gen, bar);
            __builtin_amdgcn_fence(__ATOMIC_ACQUIRE, "agent");
            asm volatile("s_waitcnt vmcnt(0)" ::: "memory");
        }
    }
    __syncthreads();
}


constexpr int D = 1024, BP = 4, LP = 8192, BS = 32, LS = 8, PAST = 16384, PAGE = 128, NPAGE = 128;
constexpr int MP = BP * LP, MS = BS * LS, MT = MP + MS;
constexpr int HD = 64, DATT = 512, DSSM = 512, NG = 32, NST = 64;
constexpr int NIN = 4888, NINP = 5120;
constexpr int C_Q = 0, C_KV = 512, C_ZA = 1280, C_U = 1792, C_ZS = 2304, C_GM = 2816, C_GN = 4864;
constexpr int NCS = 1024, NCP = 512;
constexpr int XC_S_ROWS = BS * 2 * 2 * NCS, XC_P_ROWS = BP * 2 * 2 * NCP, XC_ROWS = XC_S_ROWS + XC_P_ROWS;
constexpr int CH = 128, NCHK = LP / CH;
constexpr float RMS_EPS = 1e-6f;
constexpr size_t O_YP = 0, O_YS = 33554432, O_KVP = 33816576, O_WINP = 50593792, O_SRP = 51118080, O_SIP = 51126272, O_KVS = 51134464, O_WINS = 51265536, O_SRS = 55459840, O_SIS = 55525376, O_END = 55590912;
constexpr size_t MiB = 1u << 20;
constexpr size_t WS_CTL = 0, CTL_ZERO_BYTES = 1 * MiB;
constexpr size_t WS_WTIN = 1 * MiB, WS_WTGLU = 11 * MiB, WS_WTLA = 12 * MiB, WS_WTLS = 13 * MiB, WS_WTOUT = 14 * MiB, WS_WTC1 = 16 * MiB, WS_CONST = 17 * MiB, WS_SEND = 20 * MiB  ;
constexpr size_t WS_KC = 20 * MiB, WS_VC = 38 * MiB, WS_XN = 64 * MiB, WS_OA = 130 * MiB, WS_Y1B = 164 * MiB, WS_YB = 198 * MiB, WS_MG = 232 * MiB, WS_Y1 = 298 * MiB, WS_MB = 364 * MiB;
constexpr size_t WS_PP = 494 * MiB, WS_XC = 632 * MiB, WS_KVB = 904 * MiB, WS_SZA = 956 * MiB, WS_U32 = 992 * MiB, WS_SZS = 1060 * MiB, WS_GM = 1096 * MiB, WS_GN = 1228 * MiB;
constexpr size_t WS_QB = 1552 * MiB, WS_KSB = 1586 * MiB, WS_KWB = 1596 * MiB, WS_VST = 1606 * MiB, WS_VWT = 1614 * MiB, WS_KCB = 1622 * MiB, WS_VCT = 1623 * MiB, WS_KCBS = 1624 * MiB, WS_VCBS = 1632 * MiB, WS_END = 1640 * MiB;
constexpr int K_CB = 0  , K_CBP = 80000  , K_ARE = 256, K_AIM = K_ARE + 2048, K_ALRE = K_AIM + 2048, K_ALIM = K_ALRE + 2048, K_BBRE = K_ALIM + 2048, K_BBIM = K_BBRE + 32768;
constexpr size_t WS_SSMCF = WS_CONST + 512 * 1024;
constexpr size_t WS_SSMW = 632 * MiB;
constexpr size_t WS_TEND = WS_CONST + 1 * MiB;
constexpr size_t WS_YPB = 364 * MiB;
constexpr int CW_BAR = 4096;
constexpr int LDS_BYTES = 163840, MISC_OFF = LDS_BYTES - 256;
constexpr int NWAVES = 8;


typedef unsigned short bf16;
typedef unsigned v4u __attribute__((ext_vector_type(4)));
typedef unsigned v2u __attribute__((ext_vector_type(2)));
typedef float f32x4 __attribute__((ext_vector_type(4)));
#define LDS_FENCE() asm volatile("s_waitcnt lgkmcnt(0)" ::: "memory")
__device__ __forceinline__ unsigned f2bf(float f) { unsigned u = __builtin_bit_cast(unsigned, f); return (u + 0x7fffu + ((u >> 16) & 1u)) >> 16; }
__device__ __forceinline__ unsigned pk2(float lo, float hi) { return f2bf(lo) | (f2bf(hi) << 16); }
__device__ __forceinline__ float wave_sum(float v) {
#pragma unroll
    for (int o = 1; o < 64; o <<= 1) v += __shfl_xor(v, o);
    return v; }
__device__ __forceinline__ float wave_max(float v) {
#pragma unroll
    for (int o = 1; o < 64; o <<= 1) v = fmaxf(v, __shfl_xor(v, o));
    return v; }
__device__ __forceinline__ float sigmf(float x) { return 1.0f / (1.0f + __expf(-x)); }
__device__ __forceinline__ float gelu_t(float x) { const float u = 1.5957691216f * (x + 0.044715f * x * x * x); return x / (1.0f + __expf(-u)); }

struct Ctx {
    LAS unsigned char* lds; int tid, lane, wave, G, gw, NGW;
    const float *xp, *xs, *cache_kv, *cache_win, *st_re, *st_im; const int* page_table;
    const float *norm_g, *w_in, *cmp_pe, *cmp_w1, *cmp_b1, *cmp_w2, *lam_re, *lam_im, *log_dt, *b_re, *b_im, *c_re, *c_im, *ssm_d, *w_glu, *b_glu, *w_la, *w_ls, *w_out, *final_g;
    float* out; unsigned char* ws;
    bf16 *WTIN, *WTGLU, *WTLA, *WTLS, *WTOUT, *WTC1, *XN, *OA, *Y1B, *YB, *MG, *XC, *QB, *KSB, *KWB, *VST, *VWT, *KCB, *VCT, *KCBS, *VCBS, *KVB, *SZA, *SZS, *GM;
    float *KST, *SEND, *KC, *VC, *Y1, *MB, *PP, *U32, *GN;
};

__device__ __forceinline__ void transpose_item(const float* W, int ldw, int nvalid, int nblk, int K, bf16* WT, int row_off, LAS float* scr, int item, int lane) {
    const int kb = item / nblk, nb = item % nblk, k0 = 64 * kb, n0 = 32 * nb;
    const int n = n0 + (lane & 31);
#pragma unroll 8
    for (int i = 0; i < 32; ++i) { const int kk = 2 * i + (lane >> 5); scr[kk * 33 + (lane & 31)] = (n < nvalid) ? W[(size_t)(k0 + kk) * ldw + n] : 0.f; }
    LDS_FENCE();
    const int c = lane & 7;
#pragma unroll
    for (int j = 0; j < 4; ++j) { const int nn = (lane >> 3) + 8 * j; const LAS float* s = scr + (8 * c) * 33 + nn;
        v4u o; o.x = pk2(s[0 * 33], s[1 * 33]); o.y = pk2(s[2 * 33], s[3 * 33]); o.z = pk2(s[4 * 33], s[5 * 33]); o.w = pk2(s[6 * 33], s[7 * 33]);
        *(v4u*)(WT + (size_t)(row_off + n0 + nn) * K + k0 + 8 * c) = o; }
    LDS_FENCE();
}
__device__ __forceinline__ void rms_row_to_bf16(const float* xrow, const float* g, bf16* orow, int lane) {
    const f32x4* xr = (const f32x4*)xrow + lane; const f32x4* gr = (const f32x4*)g + lane;
    f32x4 v[4]; float s = 0.f;
#pragma unroll
    for (int j = 0; j < 4; ++j) { v[j] = xr[64 * j]; s += (v[j].x * v[j].x + v[j].y * v[j].y) + (v[j].z * v[j].z + v[j].w * v[j].w); }
    const float r = rsqrtf(wave_sum(s) * (1.f / D) + RMS_EPS);
    v2u* o8 = (v2u*)orow + lane;
#pragma unroll
    for (int j = 0; j < 4; ++j) { const f32x4 gg = gr[64 * j]; v2u o; o.x = pk2(v[j].x * r * gg.x, v[j].y * r * gg.y); o.y = pk2(v[j].z * r * gg.z, v[j].w * r * gg.w); o8[64 * j] = o; }
}
__device__ __forceinline__ void xc_chunk(const float* src0, size_t rstride, bf16* XC, size_t rowbase  , size_t hstride, size_t sstride, int lane) {
    const int col = 4 * lane, slot = col >> 7, h = (col >> 6) & 1, d = col & 63;
    bf16* dst = XC + (rowbase + (size_t)h * hstride + (size_t)slot * sstride) * 1024 + d;
#pragma unroll 4
    for (int j = 0; j < 16; ++j) { const f32x4 v = *(const f32x4*)(src0 + (size_t)j * rstride + col); v2u o; o.x = pk2(v.x, v.y); o.y = pk2(v.z, v.w); *(v2u*)(dst + j * 64) = o; }
}
__device__ __forceinline__ void p0_prep(const Ctx& C) {
    LAS float* scr = (LAS float*)(C.lds + C.wave * 16384);
    constexpr int I_IN = 16 * 160, I_GLU = 8 * 16, I_LA = 8 * 32, I_LS = 8 * 32, I_OUT = 16 * 32, I_C1 = 16 * 2;
    constexpr int NIT = I_IN + I_GLU + I_LA + I_LS + I_OUT + 4 * I_C1;
    for (int it = C.gw; it < NIT; it += C.NGW) {
        int r = it;
        if (r < I_IN) { const int nb = r % 160, n0 = 32 * nb;
            const int src0 = n0 < 1280 ? n0 : (n0 < 4864 ? n0 + 24 : 1280), nv = n0 < 4864 ? 32 : (n0 == 4864 ? 24 : 0);
            transpose_item(C.w_in + src0 - n0, NIN, n0 + nv, 160, 1024, C.WTIN, 0, scr, r, C.lane); continue; } r -= I_IN;
        if (r < I_GLU) { transpose_item(C.w_glu, 512, 512, 16, 512, C.WTGLU, 0, scr, r, C.lane); continue; } r -= I_GLU;
        if (r < I_LA) { transpose_item(C.w_la, 1024, 1024, 32, 512, C.WTLA, 0, scr, r, C.lane); continue; } r -= I_LA;
        if (r < I_LS) { transpose_item(C.w_ls, 1024, 1024, 32, 512, C.WTLS, 0, scr, r, C.lane); continue; } r -= I_LS;
        if (r < I_OUT) { transpose_item(C.w_out, 1024, 1024, 32, 1024, C.WTOUT, 0, scr, r, C.lane); continue; } r -= I_OUT;
        { const int q = r / I_C1, s = q >> 1, rr = q & 1;
          transpose_item(C.cmp_w1 + (size_t)(s * 32 + rr * 16) * 4096, 64, 64, 2, 1024, C.WTC1, s * 128 + rr * 64, scr, r % I_C1, C.lane); }
    }
    for (int m0 = C.gw; m0 < MT; m0 += 2 * C.NGW) {
        const int m1 = m0 + C.NGW < MT ? m0 + C.NGW : m0;
        const float* x0 = m0 < MP ? C.xp + (size_t)m0 * D : C.xs + (size_t)(m0 - MP) * D; const float* x1 = m1 < MP ? C.xp + (size_t)m1 * D : C.xs + (size_t)(m1 - MP) * D;
        f32x4 va[4], vb[4]; float sa = 0.f, sb = 0.f;
#pragma unroll
        for (int j = 0; j < 4; ++j) { va[j] = ((const f32x4*)x0)[C.lane + 64 * j]; vb[j] = ((const f32x4*)x1)[C.lane + 64 * j]; }
#pragma unroll
        for (int j = 0; j < 4; ++j) { sa += (va[j].x * va[j].x + va[j].y * va[j].y) + (va[j].z * va[j].z + va[j].w * va[j].w); sb += (vb[j].x * vb[j].x + vb[j].y * vb[j].y) + (vb[j].z * vb[j].z + vb[j].w * vb[j].w); }
        const float ra = rsqrtf(wave_sum(sa) * (1.f / D) + RMS_EPS), rb = rsqrtf(wave_sum(sb) * (1.f / D) + RMS_EPS);
#pragma unroll
        for (int j = 0; j < 4; ++j) { const f32x4 gg = ((const f32x4*)C.norm_g)[C.lane + 64 * j];
            v2u o; o.x = pk2(va[j].x * ra * gg.x, va[j].y * ra * gg.y); o.y = pk2(va[j].z * ra * gg.z, va[j].w * ra * gg.w); ((v2u*)(C.XN + (size_t)m0 * D))[C.lane + 64 * j] = o;
            if (m1 != m0) { v2u o1; o1.x = pk2(vb[j].x * rb * gg.x, vb[j].y * rb * gg.y); o1.y = pk2(vb[j].z * rb * gg.z, vb[j].w * rb * gg.w); ((v2u*)(C.XN + (size_t)m1 * D))[C.lane + 64 * j] = o1; } }
    }
    for (int j = C.gw * 64 + C.lane; j < NG * NST * 16; j += C.NGW * 64) {
        const int i = j >> 4, c = j & 15, g = i >> 6;
        const double dt = exp((double)C.log_dt[g]), lr = (double)C.lam_re[i], li = (double)C.lam_im[i];
        const double mag = exp(lr * dt), ar = mag * cos(li * dt), ai = mag * sin(li * dt);
        const double den = lr * lr + li * li, fr = ((ar - 1.0) * lr + ai * li) / den, fi = (ai * lr - (ar - 1.0) * li) / den;
        if (c == 0) { const double magL = exp(lr * dt * CH), aLr = magL * cos(li * dt * CH), aLi = magL * sin(li * dt * CH);
            C.KST[K_ARE + i] = (float)ar; C.KST[K_AIM + i] = (float)ai; C.KST[K_ALRE + i] = (float)aLr; C.KST[K_ALIM + i] = (float)aLi; }
        const double br = (double)C.b_re[i * 16 + c], bi = (double)C.b_im[i * 16 + c];
        C.KST[K_BBRE + i * 16 + c] = (float)(fr * br - fi * bi); C.KST[K_BBIM + i * 16 + c] = (float)(fr * bi + fi * br);
        { bf16* CF = (bf16*)(C.ws + WS_SSMCF); const int pp = i & 63; const size_t o = ((size_t)g * 16 + c) * 128 + 2 * pp;
          CF[o] = (bf16)f2bf(C.c_re[((size_t)g * 16 + c) * 64 + pp]); CF[o + 1] = (bf16)f2bf(-C.c_im[((size_t)g * 16 + c) * 64 + pp]); }
    }
    for (int j = ((C.gw + C.NGW - 512) % C.NGW) * 64 + C.lane; j < NG * NST * (CH / 8); j += C.NGW * 64) {
        const int tb = j & (CH / 8 - 1), i = j >> 4, g = i >> 6, pp = i & 63;
        const double dt = exp((double)C.log_dt[g]), lr = (double)C.lam_re[i], li = (double)C.lam_im[i];
        const double mag = exp(lr * dt), ar = mag * cos(li * dt), ai = mag * sin(li * dt);
        const double den = lr * lr + li * li, fr = ((ar - 1.0) * lr + ai * li) / den, fi = (ai * lr - (ar - 1.0) * li) / den;
        const double dd = (double)(CH - 8 - 8 * tb), magd = exp(lr * dt * dd), pr = magd * cos(li * dt * dd), pi = magd * sin(li * dt * dd);
        double gr = pr * fr - pi * fi, gi = pr * fi + pi * fr;
        bf16* W0 = (bf16*)(C.ws + WS_SSMW); const size_t olo = (size_t)NG * 128 * 2048;
#pragma unroll 1
        for (int tt = 7; tt >= 0; --tt) {
            unsigned hr[8], hi_[8], lr_[8], li_[8];
#pragma unroll
            for (int c2 = 0; c2 < 8; ++c2) { unsigned vh[2][2], vl[2][2];
#pragma unroll
                for (int e = 0; e < 2; ++e) { const int c = 2 * c2 + e; const double br = (double)C.b_re[i * 16 + c], bi = (double)C.b_im[i * 16 + c];
                    const float wr = (float)(gr * br - gi * bi), wi = (float)(gr * bi + gi * br);
                    const unsigned h0 = f2bf(wr), h1 = f2bf(wi);
                    vh[0][e] = h0; vh[1][e] = h1; vl[0][e] = f2bf(wr - __uint_as_float(h0 << 16)); vl[1][e] = f2bf(wi - __uint_as_float(h1 << 16)); }
                hr[c2] = vh[0][0] | (vh[0][1] << 16); hi_[c2] = vh[1][0] | (vh[1][1] << 16); lr_[c2] = vl[0][0] | (vl[0][1] << 16); li_[c2] = vl[1][0] | (vl[1][1] << 16); }
            const size_t ore = ((size_t)g * 128 + pp) * 2048 + (8 * tb + tt) * 16, oim = ore + (size_t)64 * 2048;
            *(v4u*)(W0 + ore) = (v4u){hr[0], hr[1], hr[2], hr[3]}; *(v4u*)(W0 + ore + 8) = (v4u){hr[4], hr[5], hr[6], hr[7]};
            *(v4u*)(W0 + oim) = (v4u){hi_[0], hi_[1], hi_[2], hi_[3]}; *(v4u*)(W0 + oim + 8) = (v4u){hi_[4], hi_[5], hi_[6], hi_[7]};
            *(v4u*)(W0 + olo + ore) = (v4u){lr_[0], lr_[1], lr_[2], lr_[3]}; *(v4u*)(W0 + olo + ore + 8) = (v4u){lr_[4], lr_[5], lr_[6], lr_[7]};
            *(v4u*)(W0 + olo + oim) = (v4u){li_[0], li_[1], li_[2], li_[3]}; *(v4u*)(W0 + olo + oim + 8) = (v4u){li_[4], li_[5], li_[6], li_[7]};
            const double ngr = gr * ar - gi * ai, ngi = gr * ai + gi * ar; gr = ngr; gi = ngi;
        }
    }
    for (int it = C.gw - 64; it >= 0 && it < 64; it += C.NGW) { const int s = it >> 5, part = it & 31;
        float acc = (part == 0) ? C.cmp_b1[s * 64 + C.lane] : 0.f;
#pragma unroll 16
        for (int k = part * 64; k < part * 64 + 64; ++k) acc += C.cmp_pe[s * 2048 + k] * C.cmp_w1[(size_t)s * 131072 + (size_t)k * 64 + C.lane];
        C.KST[K_CBP + (s * 32 + part) * 64 + C.lane] = acc;
    }
}
constexpr int C1_PITCH = 2080, C1_BUF = 16 * C1_PITCH;
constexpr int C1_ITEMS_S = BS * NPAGE, C1_ITEMS_P = BP * (LP / 128), C1_ITEMS = C1_ITEMS_S + C1_ITEMS_P;
typedef short c1_bf16x8 __attribute__((ext_vector_type(8)));
__device__ __forceinline__ void c1_issue(const Ctx& C, f32x4 (&st)[8], int item, int slot, int r0, int i5) {
    if (item < C1_ITEMS_S) { const int b = item >> 7, pg = item & 127, page = C.page_table[b * NPAGE + pg];
        const float* src = C.cache_kv + ((size_t)page * PAGE + r0) * 512 + slot * 128 + 4 * i5;
#pragma unroll
        for (int it = 0; it < 8; ++it) st[it] = *(const f32x4*)(src + (size_t)it * 16 * 512); }
    else { const int q = item - C1_ITEMS_S, b = q >> 6, pg = q & 63; const bf16* src = C.KVB + ((size_t)b * LP + (size_t)pg * 128 + r0) * 768 + slot * 128 + 4 * i5;
#pragma unroll
        for (int it = 0; it < 8; ++it) { const v2u v = *(const v2u*)(src + (size_t)it * 16 * 768); st[it] = (f32x4){__uint_as_float(v.x << 16), __uint_as_float(v.x & 0xffff0000u), __uint_as_float(v.y << 16), __uint_as_float(v.y & 0xffff0000u)}; } }
}
__device__ __forceinline__ void p2_cmp1(const Ctx& C) {
    const int tid = C.tid, lane = C.lane, w = C.wave;
    const int half = C.G / 2, slot = ((int)blockIdx.x >= half) ? 1 : 0, wg = (int)blockIdx.x - slot * half, nwg = slot ? C.G - half : half;
    c1_bf16x8 Bf[32];
    { const bf16* bp = C.WTC1 + (size_t)(slot * 128 + 16 * w + (lane & 15)) * 1024 + 8 * (lane >> 4);
#pragma unroll
      for (int ks = 0; ks < 32; ++ks) Bf[ks] = *(const c1_bf16x8*)(bp + 32 * ks); }
    const int r0 = tid >> 5, i5 = tid & 31, hh = i5 >> 4, d4 = (i5 & 15) * 4;
    f32x4 st[8];
    int item = wg, buf = 0;
    if (item < C1_ITEMS) c1_issue(C, st, item, slot, r0, i5);
    for (; item < C1_ITEMS; item += nwg, buf ^= 1) {
        LAS unsigned char* X = C.lds + buf * C1_BUF;
#pragma unroll
        for (int it = 0; it < 8; ++it) { const int r = r0 + 16 * it; v2u o; o.x = pk2(st[it].x, st[it].y); o.y = pk2(st[it].z, st[it].w);
            *(LAS v2u*)(X + ((r >> 4) * 2 + hh) * C1_PITCH + ((r & 15) * 64 + d4) * 2) = o; }
        LDS_FENCE(); __syncthreads();
        if (item + nwg < C1_ITEMS) c1_issue(C, st, item + nwg, slot, r0, i5);
        f32x4 acc = (f32x4){0.f, 0.f, 0.f, 0.f};
        const LAS unsigned char* ap = X + (lane & 15) * C1_PITCH + (lane >> 4) * 16;
#pragma unroll
        for (int ks = 0; ks < 32; ++ks) acc = __builtin_amdgcn_mfma_f32_16x16x32_bf16(*(const LAS c1_bf16x8*)(ap + 64 * ks), Bf[ks], acc, 0, 0, 0);
        const bool smp = item < C1_ITEMS_S; const int q = smp ? item : item - C1_ITEMS_S;
        const size_t seq0 = (size_t)(smp ? (q >> 7) : (q >> 6)) * 4 + slot; const int ch0 = (smp ? (q & 127) : (q & 63)) * 8, NC = smp ? NCS : NCP;
        float* pp = C.PP + (smp ? (size_t)0 : (size_t)XC_S_ROWS * 128);
#pragma unroll
        for (int r = 0; r < 4; ++r) { const int m = 4 * (lane >> 4) + r, chunk = ch0 + (m >> 1), h = m & 1;
            pp[((seq0 + 2 * h) * NC + chunk) * 128 + 16 * w + (lane & 15)] = acc[r]; }
    }
    __syncthreads();
}
__device__ __forceinline__ void ssm_load_u(const Ctx& C, LAS float* U, size_t row0, int g, int nt, int lane) {
    const int t = lane >> 1, hf = lane & 1;
    if (t < nt) { const float* p = C.U32 + (row0 + t) * 512 + g * 16 + hf * 8; const f32x4 a = *(const f32x4*)p, b = *(const f32x4*)(p + 4);
        *(LAS f32x4*)(U + t * 16 + hf * 8) = a; *(LAS f32x4*)(U + t * 16 + hf * 8 + 4) = b; }
    LDS_FENCE();
}
__device__ __forceinline__ void ssm_issue_u(const Ctx& C, size_t row0, int g, int nt, int lane, f32x4& ua, f32x4& ub) {
    const int t = lane >> 1, hf = lane & 1;
    if (t < nt) { const float* p = C.U32 + (row0 + t) * 512 + g * 16 + hf * 8; ua = *(const f32x4*)p; ub = *(const f32x4*)(p + 4); }
}
typedef float f32x2 __attribute__((ext_vector_type(2)));
#define SFMAC(acc, a, b) asm("v_fmac_f32 %0, %1, %2" : "+v"(acc) : "v"(a), "v"(b))
#define SMUL(d, a, b) asm("v_mul_f32 %0, %1, %2" : "=v"(d) : "v"(a), "v"(b))
__device__ __forceinline__ unsigned ssm_cvt_pk(float lo, float hi) { unsigned r; asm("v_cvt_pk_bf16_f32 %0, %1, %2" : "=v"(r) : "v"(lo), "v"(hi)); return r; }
struct SsmCoef { float are, aim, naim; float bre[16], bim[16]; };
__device__ __forceinline__ void ssm_coef(const Ctx& C, SsmCoef& K, int g, int lane) {
    const int i = g * 64 + lane; K.are = C.KST[K_ARE + i]; K.aim = C.KST[K_AIM + i]; K.naim = -K.aim;
#pragma unroll
    for (int c = 0; c < 16; ++c) { K.bre[c] = C.KST[K_BBRE + i * 16 + c]; K.bim[c] = C.KST[K_BBIM + i * 16 + c]; }
}
__device__ __forceinline__ void ssm_step2(const SsmCoef& K, const LAS float* u, float& hr, float& hi, unsigned& pk0, unsigned& pk1) {
    f32x4 ua[4], ub[4];
#pragma unroll
    for (int c4 = 0; c4 < 4; ++c4) { ua[c4] = *(const LAS f32x4*)(u + 4 * c4); ub[c4] = *(const LAS f32x4*)(u + 16 + 4 * c4); }
    float ra, ia, rb, ib;
    SMUL(ra, K.bre[0], ua[0][0]); SMUL(ia, K.bim[0], ua[0][0]); SMUL(rb, K.bre[0], ub[0][0]); SMUL(ib, K.bim[0], ub[0][0]);
#pragma unroll
    for (int c = 1; c < 16; ++c) { SFMAC(ra, K.bre[c], ua[c >> 2][c & 3]); SFMAC(ia, K.bim[c], ua[c >> 2][c & 3]); SFMAC(rb, K.bre[c], ub[c >> 2][c & 3]); SFMAC(ib, K.bim[c], ub[c >> 2][c & 3]); }
    SFMAC(ra, K.are, hr); SFMAC(ia, K.are, hi); SFMAC(ra, K.naim, hi); SFMAC(ia, K.aim, hr); hr = ra; hi = ia; pk0 = ssm_cvt_pk(hr, hi);
    SFMAC(rb, K.are, hr); SFMAC(ib, K.are, hi); SFMAC(rb, K.naim, hi); SFMAC(ib, K.aim, hr); hr = rb; hi = ib; pk1 = ssm_cvt_pk(hr, hi);
}
typedef short p1_bf16x8 __attribute__((ext_vector_type(8)));
constexpr int P1_PITCH = 132;
__device__ __forceinline__ void p1_split(const f32x4 x0, const f32x4 x1, p1_bf16x8& hi, p1_bf16x8& lo) {
    v4u h, l; float r[8] = {x0.x, x0.y, x0.z, x0.w, x1.x, x1.y, x1.z, x1.w}; unsigned hw[4], lw[4];
#pragma unroll
    for (int e = 0; e < 4; ++e) { const unsigned w = pk2(r[2 * e], r[2 * e + 1]); hw[e] = w;
        lw[e] = pk2(r[2 * e] - __uint_as_float(w << 16), r[2 * e + 1] - __uint_as_float(w & 0xffff0000u)); }
    h = (v4u){hw[0], hw[1], hw[2], hw[3]}; l = (v4u){lw[0], lw[1], lw[2], lw[3]};
    hi = __builtin_bit_cast(p1_bf16x8, h); lo = __builtin_bit_cast(p1_bf16x8, l);
}
__device__ __forceinline__ void p2_ssm_pass1(const Ctx& C) {
    const int lane = C.lane, w = C.wave, m = lane & 15, q = lane >> 4;
    LAS float* red = (LAS float*)C.lds;
    for (int it = blockIdx.x; it < NG * 8; it += C.G) {
        const int g = 4 * (it & 7) + (it >> 6), sub = (it >> 3) & 7;
        f32x4 acc[2][8];
#pragma unroll
        for (int mt = 0; mt < 2; ++mt)
#pragma unroll
            for (int nt = 0; nt < 8; ++nt) acc[mt][nt] = (f32x4){0.f, 0.f, 0.f, 0.f};
        const bf16* Wh = (const bf16*)(C.ws + WS_SSMW) + ((size_t)g * 128 + m) * 2048 + 256 * w + 8 * q;
        const bf16* Wl = Wh + (size_t)NG * 128 * 2048;
        const float* up[2];
#pragma unroll
        for (int mt = 0; mt < 2; ++mt) { const int cr = 32 * sub + 16 * mt + m, b = cr >> 6, k = cr & 63;
            up[mt] = C.U32 + ((size_t)b * LP + (size_t)k * CH + 16 * w + (q >> 1)) * 512 + g * 16 + 8 * (q & 1); }
        f32x4 xa[2][2];
#pragma unroll
        for (int mt = 0; mt < 2; ++mt) { xa[mt][0] = *(const f32x4*)(up[mt]); xa[mt][1] = *(const f32x4*)(up[mt] + 4); }
#pragma unroll 2
        for (int ks = 0; ks < 8; ++ks) {
            p1_bf16x8 ah[2], al[2];
#pragma unroll
            for (int mt = 0; mt < 2; ++mt) p1_split(xa[mt][0], xa[mt][1], ah[mt], al[mt]);
            if (ks < 7) {
#pragma unroll
                for (int mt = 0; mt < 2; ++mt) { const float* p = up[mt] + (size_t)(2 * ks + 2) * 512; xa[mt][0] = *(const f32x4*)p; xa[mt][1] = *(const f32x4*)(p + 4); } }
#pragma unroll
            for (int nt = 0; nt < 8; ++nt) {
                const p1_bf16x8 bh = *(const p1_bf16x8*)(Wh + (size_t)nt * 16 * 2048 + 32 * ks), bl = *(const p1_bf16x8*)(Wl + (size_t)nt * 16 * 2048 + 32 * ks);
#pragma unroll
                for (int mt = 0; mt < 2; ++mt) {
                    acc[mt][nt] = __builtin_amdgcn_mfma_f32_16x16x32_bf16(ah[mt], bh, acc[mt][nt], 0, 0, 0);
                    acc[mt][nt] = __builtin_amdgcn_mfma_f32_16x16x32_bf16(al[mt], bh, acc[mt][nt], 0, 0, 0);
                    acc[mt][nt] = __builtin_amdgcn_mfma_f32_16x16x32_bf16(ah[mt], bl, acc[mt][nt], 0, 0, 0); }
            }
        }
#pragma unroll
        for (int mt = 0; mt < 2; ++mt)
#pragma unroll
            for (int nt = 0; nt < 8; ++nt)
#pragma unroll
                for (int r = 0; r < 4; ++r) red[(w * 32 + 16 * mt + 4 * q + r) * P1_PITCH + 16 * nt + m] = acc[mt][nt][r];
        LDS_FENCE(); __syncthreads();
#pragma unroll
        for (int i = 0; i < 8; ++i) { const int o = C.tid + 512 * i, row = o >> 7, col = o & 127; float s = 0.f;
#pragma unroll
            for (int ww = 0; ww < 8; ++ww) s += red[(ww * 32 + row) * P1_PITCH + col];
            red[8 * 32 * P1_PITCH + row * 128 + col] = s; }
        LDS_FENCE(); __syncthreads();
        if (w == 0) { const LAS float* S2 = red + 8 * 32 * P1_PITCH; const int b = sub >> 1, k0 = 32 * (sub & 1);
            const float aLr = C.KST[K_ALRE + g * 64 + lane], aLi = C.KST[K_ALIM + g * 64 + lane]; float cr = 0.f, ci = 0.f;
#pragma unroll 8
            for (int row = 0; row < 32; ++row) { float* S = C.SEND + ((size_t)(b * NG + g) * NCHK + k0 + row) * 128; S[lane] = cr; S[64 + lane] = ci;
                const float sr = S2[row * 128 + lane], si = S2[row * 128 + 64 + lane];
                const float nr = aLr * cr - aLi * ci + sr, ni = aLr * ci + aLi * cr + si; cr = nr; ci = ni; }
            float* T = (float*)(C.ws + WS_TEND) + ((size_t)(b * NG + g) * 2 + (sub & 1)) * 128; T[lane] = cr; T[64 + lane] = ci; }
        __syncthreads();
    }
}
typedef short ssm_bf16x8 __attribute__((ext_vector_type(8)));
struct SsmRd { ssm_bf16x8 cf[4]; f32x4 dsk; };
__device__ __forceinline__ void ssm_rd(const Ctx& C, SsmRd& R, int g, int lane) {
    const bf16* CF = (const bf16*)(C.ws + WS_SSMCF) + ((size_t)g * 16 + (lane & 15)) * 128 + 8 * (lane >> 4);
#pragma unroll
    for (int ks = 0; ks < 4; ++ks) R.cf[ks] = *(const ssm_bf16x8*)(CF + 32 * ks);
    R.dsk = *(const f32x4*)(C.ssm_d + g * 16 + 4 * (lane >> 4));
}
template <int NT>
__device__ __forceinline__ void ssm_tile(const Ctx& C, const SsmCoef& K, const SsmRd& R, LAS float* U, LAS unsigned* HB, size_t row0, int g, float& hr, float& hi, f32x4& ua, f32x4& ub, const bool more) {
    constexpr int nt = NT;
    { const int t = C.lane >> 1, hf = C.lane & 1;
      if (t < nt) { *(LAS f32x4*)(U + t * 16 + hf * 8) = ua; *(LAS f32x4*)(U + t * 16 + hf * 8 + 4) = ub; }
      LDS_FENCE();
      if (more) ssm_issue_u(C, row0 + NT, g, nt, C.lane, ua, ub); }
#pragma unroll 2
    for (int t = 0; t < NT; t += 2) { unsigned p0, p1; ssm_step2(K, U + t * 16, hr, hi, p0, p1); HB[t * 68 + C.lane] = p0; HB[(t + 1) * 68 + C.lane] = p1; }
    LDS_FENCE();
    const int m = C.lane & 15, q = C.lane >> 4;
#pragma unroll
    for (int n2 = 0; n2 < 2; ++n2) {
        f32x4 y = (f32x4){0.f, 0.f, 0.f, 0.f};
#pragma unroll
        for (int ks = 0; ks < 4; ++ks) y = __builtin_amdgcn_mfma_f32_16x16x32_bf16(R.cf[ks], *(const LAS ssm_bf16x8*)((const LAS unsigned char*)HB + (16 * n2 + m) * 272 + 64 * ks + 16 * q), y, 0, 0, 0);
        const int t = 16 * n2 + m;
        if (t < nt) { const f32x4 uv = *(const LAS f32x4*)(U + t * 16 + 4 * q); const size_t o = (row0 + t) * 512 + g * 16 + 4 * q;
            f32x4 v; v.x = gelu_t(y.x + R.dsk.x * uv.x); v.y = gelu_t(y.y + R.dsk.y * uv.y); v.z = gelu_t(y.z + R.dsk.z * uv.z); v.w = gelu_t(y.w + R.dsk.w * uv.w);
            v2u pk; pk.x = pk2(v.x, v.y); pk.y = pk2(v.z, v.w); *(v2u*)(C.Y1B + o) = pk; }
    }
    LDS_FENCE();
}
__device__ __forceinline__ void p3_ssm_pass2(const Ctx& C, const bool sample_part) {
    LAS float* U = (LAS float*)(C.lds + 8192 + C.wave * 18560);
    LAS unsigned* HB = (LAS unsigned*)(U + 512);
    constexpr int BIG = NCHK / 2, NBIP = NG * BIG, NBI = NBIP + 128;
    for (int bi = (sample_part ? NBIP : 0) + blockIdx.x; bi < (sample_part ? NBI : NBIP); bi += C.G) {
        const bool smp = bi >= NBIP; const int g = smp ? (bi - NBIP) >> 2 : 2 * (bi >> 6) + (C.wave >> 2);
        SsmRd R; ssm_rd(C, R, g, C.lane);
        SsmCoef K; ssm_coef(C, K, g, C.lane);
        if (!smp) {
            const int pr = (bi & 63) * 4 + (C.wave & 3), b = pr / NCHK, k = pr % NCHK;
            float hr = 0.f, hi = 0.f; f32x4 ua = (f32x4){0.f, 0.f, 0.f, 0.f}, ub = ua; ssm_issue_u(C, (size_t)b * LP + (size_t)k * CH, g, 32, C.lane, ua, ub);
            const float aLr = C.KST[K_ALRE + g * 64 + C.lane], aLi = C.KST[K_ALIM + g * 64 + C.lane];
            { const float* S = C.SEND + ((size_t)(b * NG + g) * NCHK + k) * 128; hr = S[C.lane]; hi = S[64 + C.lane]; }
            if (k >= 32) { const float* T = (const float*)(C.ws + WS_TEND) + ((size_t)(b * NG + g) * 2) * 128; const float tr = T[C.lane], ti = T[64 + C.lane];
                float pr = 1.f, pi = 0.f, br = aLr, bi = aLi;
                for (int e = k - 32; e > 0; e >>= 1) { if (e & 1) { const float nr = pr * br - pi * bi, ni = pr * bi + pi * br; pr = nr; pi = ni; }
                    const float nr = br * br - bi * bi, ni = 2.f * br * bi; br = nr; bi = ni; }
                hr += pr * tr - pi * ti; hi += pr * ti + pi * tr; }
#pragma unroll 1
            for (int tl = 0; tl < CH / 32; ++tl) ssm_tile<32>(C, K, R, U, HB, (size_t)b * LP + (size_t)k * CH + tl * 32, g, hr, hi, ua, ub, tl < CH / 32 - 1);
            if (k == NCHK - 1) { C.out[O_SRP + (size_t)(b * NG + g) * 64 + C.lane] = hr; C.out[O_SIP + (size_t)(b * NG + g) * 64 + C.lane] = hi; }
        } else {
            const int b = ((bi - NBIP) & 3) * 8 + C.wave;
            float hr = C.st_re[(size_t)(b * NG + g) * 64 + C.lane], hi = C.st_im[(size_t)(b * NG + g) * 64 + C.lane];
            f32x4 ua = (f32x4){0.f, 0.f, 0.f, 0.f}, ub = ua; ssm_issue_u(C, (size_t)MP + (size_t)b * LS, g, LS, C.lane, ua, ub);
            ssm_tile<LS>(C, K, R, U, HB, (size_t)MP + (size_t)b * LS, g, hr, hi, ua, ub, false);
            C.out[O_SRS + (size_t)(b * NG + g) * 64 + C.lane] = hr; C.out[O_SIS + (size_t)(b * NG + g) * 64 + C.lane] = hi;
        }
    }
    __syncthreads();
}
__device__ __forceinline__ void p4_cmp2(const Ctx& C) {
    LAS float* gs = (LAS float*)(C.lds + C.wave * 256);
    const int lane = C.lane, m = lane & 15, q = lane >> 4;
    constexpr int SEQ_S = BS * 2 * 2, SEQ_P = BP * 2 * 2;
    constexpr int IT_S = SEQ_S * 32, IT_P = SEQ_P * 16;
    for (int it = C.gw; it < IT_S + IT_P; it += C.NGW) {
        const bool smp = it < IT_S; const int qq = smp ? it : it - IT_S;
        const int seq = smp ? qq >> 5 : qq >> 4, n0 = (smp ? qq & 31 : qq & 15) * 32, NC = smp ? NCS : NCP, nmax = NC - 1;
        const int slot = seq & 1, h = (seq >> 1) & 1, b = seq >> 2;
        const size_t xrow0 = (smp ? 0 : (size_t)XC_S_ROWS) + (size_t)seq * NC;
        { float cb = 0.f;
#pragma unroll 8
          for (int part = 0; part < 32; ++part) cb += C.KST[K_CBP + (slot * 32 + part) * 64 + lane];
          gs[lane] = cb; LDS_FENCE(); }
        p1_bf16x8 Bf[2][4];
#pragma unroll
        for (int ks = 0; ks < 2; ++ks)
#pragma unroll
            for (int nt = 0; nt < 4; ++nt) { const float* wp = C.cmp_w2 + (size_t)slot * 4096 + (32 * ks + 8 * q) * 64 + 16 * nt + m;
                v4u pw; pw.x = ssm_cvt_pk(wp[0], wp[64]); pw.y = ssm_cvt_pk(wp[128], wp[192]); pw.z = ssm_cvt_pk(wp[256], wp[320]); pw.w = ssm_cvt_pk(wp[384], wp[448]);
                Bf[ks][nt] = __builtin_bit_cast(p1_bf16x8, pw); }
        f32x4 acc[2][4];
#pragma unroll
        for (int mt = 0; mt < 2; ++mt)
#pragma unroll
            for (int nt = 0; nt < 4; ++nt) acc[mt][nt] = (f32x4){0.f, 0.f, 0.f, 0.f};
#pragma unroll
        for (int ks = 0; ks < 2; ++ks) { const int e0 = 32 * ks + 8 * q;
            const f32x4 c0 = *(const LAS f32x4*)(gs + e0), c1 = *(const LAS f32x4*)(gs + e0 + 4);
#pragma unroll
            for (int mt = 0; mt < 2; ++mt) { int n = n0 + 16 * mt + m; n = n < nmax ? n : nmax - 1;
                const float* pa = C.PP + (xrow0 + n) * 128 + e0; const float* pb = C.PP + (xrow0 + n + 1) * 128 + 64 + e0;
                const f32x4 h0 = c0 + *(const f32x4*)pa + *(const f32x4*)pb, h1 = c1 + *(const f32x4*)(pa + 4) + *(const f32x4*)(pb + 4);
                v4u pk; pk.x = ssm_cvt_pk(gelu_t(h0.x), gelu_t(h0.y)); pk.y = ssm_cvt_pk(gelu_t(h0.z), gelu_t(h0.w)); pk.z = ssm_cvt_pk(gelu_t(h1.x), gelu_t(h1.y)); pk.w = ssm_cvt_pk(gelu_t(h1.z), gelu_t(h1.w));
                const p1_bf16x8 A = __builtin_bit_cast(p1_bf16x8, pk);
#pragma unroll
                for (int nt = 0; nt < 4; ++nt) acc[mt][nt] = __builtin_amdgcn_mfma_f32_16x16x32_bf16(A, Bf[ks][nt], acc[mt][nt], 0, 0, 0); } }
#pragma unroll
        for (int mt = 0; mt < 2; ++mt)
#pragma unroll
            for (int nt = 0; nt < 4; ++nt) { const int nb = n0 + 16 * mt + 4 * q, d = 16 * nt + m;
                if (smp) { bf16* o = (slot ? C.VCBS : C.KCBS) + ((size_t)(b * 2 + h) * NCS + nb) * 64 + d;
#pragma unroll
                    for (int r = 0; r < 4; ++r) if (nb + r < nmax) o[r * 64] = (bf16)f2bf(acc[mt][nt][r]); }
                else { bf16* o = (slot ? C.VCT : C.KCB) + ((size_t)(b * 2 + h) * NCP + nb) * 64 + d;
#pragma unroll
                    for (int r = 0; r < 4; ++r) if (nb + r < nmax) o[r * 64] = (bf16)f2bf(acc[mt][nt][r]); } }
        LDS_FENCE();
    }
}


constexpr float QSCALE = 0.125f * 1.4426950408889634f;
__device__ __forceinline__ f32x4 unpk4(const v2u p) { return (f32x4){__uint_as_float(p.x << 16), __uint_as_float(p.x & 0xffff0000u), __uint_as_float(p.y << 16), __uint_as_float(p.y & 0xffff0000u)}; }
typedef short bf16x8 __attribute__((ext_vector_type(8)));
typedef short s16x4 __attribute__((ext_vector_type(4)));
#define MFMA16(a, b, c) __builtin_amdgcn_mfma_f32_16x16x32_bf16((a), (b), (c), 0, 0, 0)
constexpr int TP = 144, TILEB = 64 * TP;
constexpr int RSLOT = 16384  , NRING = 4;
constexpr int NRING2 = 8, RG2 = NRING2 / 2;
constexpr int A_BUF = 0, A_IMP = NRING * RSLOT  , A_SELM = NRING2 * RSLOT  , A_WUNI = A_SELM + 1024, A_LIST = A_WUNI + 128, A_MISC = A_LIST + 512, A_TUN = A_MISC + 64, A_END = A_TUN + 256;
static_assert(A_END <= MISC_OFF, "prompt attention LDS map");
constexpr int CW_QCTR = 8192;

struct StageRegs { v4u k, v; };
__device__ __forceinline__ void stage_load(StageRegs& R, const bf16* ksrc, size_t kpitch, const bf16* vsrc, size_t vpitch, int tid) {
    const int r = tid >> 3, ch = tid & 7; R.k = *(const v4u*)(ksrc + (size_t)r * kpitch + ch * 8); R.v = *(const v4u*)(vsrc + (size_t)r * vpitch + ch * 8); }
__device__ __forceinline__ void stage_write(const StageRegs& R, LAS unsigned char* buf, int tid) {
    const int r = tid >> 3, ch = tid & 7; *(LAS v4u*)(buf + r * TP + ch * 16) = R.k; *(LAS v4u*)(buf + TILEB + r * TP + ch * 16) = R.v; }
__device__ __forceinline__ void qk_tile(const LAS unsigned char* Kt, const bf16x8 q0, const bf16x8 q1, int c, int q, f32x4 (&s)[4]) {
    const LAS unsigned char* kp = Kt + c * TP + q * 16;
#pragma unroll
    for (int t = 0; t < 4; ++t) { const bf16x8 k0 = *(const LAS bf16x8*)(kp + t * 16 * TP), k1 = *(const LAS bf16x8*)(kp + t * 16 * TP + 64);
        s[t] = MFMA16(k0, q0, ((f32x4){0.f, 0.f, 0.f, 0.f})); s[t] = MFMA16(k1, q1, s[t]); }
}
__device__ __forceinline__ bf16x8 pack8(const f32x4 a, const f32x4 b) {
    v4u w; w.x = pg8::cvt_pk_bf16(a.x, a.y); w.y = pg8::cvt_pk_bf16(a.z, a.w); w.z = pg8::cvt_pk_bf16(b.x, b.y); w.w = pg8::cvt_pk_bf16(b.z, b.w); return __builtin_bit_cast(bf16x8, w); }
__device__ __forceinline__ void pv_tile(const LAS unsigned char* Vt, const f32x4 (&p)[4], int c, int q, f32x4 (&acc)[4]) {
    const bf16x8 P0 = pack8(p[0], p[1]), P1 = pack8(p[2], p[3]);
    const LAS unsigned char* vp = Vt + c * TP + q * 8;
#pragma unroll
    for (int dt = 0; dt < 4; ++dt) { const LAS unsigned char* vr = vp + dt * 16 * TP;
        const s16x4 a0 = *(const LAS s16x4*)(vr), a1 = *(const LAS s16x4*)(vr + 32), b0 = *(const LAS s16x4*)(vr + 64), b1 = *(const LAS s16x4*)(vr + 96);
        const bf16x8 va = (bf16x8){a0[0], a0[1], a0[2], a0[3], a1[0], a1[1], a1[2], a1[3]}, vb = (bf16x8){b0[0], b0[1], b0[2], b0[3], b1[0], b1[1], b1[2], b1[3]};
        acc[dt] = MFMA16(va, P0, acc[dt]); acc[dt] = MFMA16(vb, P1, acc[dt]); }
}
__device__ __forceinline__ void mask_tile(f32x4 (&s)[4], int q, int lo, int hi) {
    const float NINF = -__builtin_inff();
#pragma unroll
    for (int t = 0; t < 4; ++t)
#pragma unroll
        for (int r = 0; r < 4; ++r) { const int key = 16 * t + 4 * q + r; s[t][r] = (key >= lo && key <= hi) ? s[t][r] : NINF; }
}
__device__ __forceinline__ float xor16_max(float v) { const auto r = __builtin_amdgcn_permlane16_swap(__float_as_uint(v), __float_as_uint(v), false, false); return fmaxf(__uint_as_float(r[0]), __uint_as_float(r[1])); }
__device__ __forceinline__ float xor32_max(float v) { const auto r = __builtin_amdgcn_permlane32_swap(__float_as_uint(v), __float_as_uint(v), false, false); return fmaxf(__uint_as_float(r[0]), __uint_as_float(r[1])); }
__device__ __forceinline__ float xor16_sum(float v) { const auto r = __builtin_amdgcn_permlane16_swap(__float_as_uint(v), __float_as_uint(v), false, false); return __uint_as_float(r[0]) + __uint_as_float(r[1]); }
__device__ __forceinline__ float xor32_sum(float v) { const auto r = __builtin_amdgcn_permlane32_swap(__float_as_uint(v), __float_as_uint(v), false, false); return __uint_as_float(r[0]) + __uint_as_float(r[1]); }
__device__ __forceinline__ float colmax(const f32x4 (&s)[4]) {
    float mx = fmaxf(fmaxf(s[0].x, s[0].y), fmaxf(s[0].z, s[0].w));
#pragma unroll
    for (int t = 1; t < 4; ++t) mx = fmaxf(mx, fmaxf(fmaxf(s[t].x, s[t].y), fmaxf(s[t].z, s[t].w)));
    return xor32_max(xor16_max(mx));
}
__device__ __forceinline__ float ex2(float x) { return __builtin_amdgcn_exp2f(x); }
__device__ __forceinline__ void online_step(f32x4 (&s)[4], const bool mine, float& m, float& l, f32x4 (&acc)[4]) {
    const float NINF = -__builtin_inff(), PINF = __builtin_inff();
    float mx = colmax(s); mx = mine ? mx : NINF;
    const float mn = fmaxf(m, mx), ms = (mn > NINF) ? mn : 0.f, msub = mine ? ms : PINF;
    float sum = 0.f;
#pragma unroll
    for (int t = 0; t < 4; ++t) { s[t].x = ex2(s[t].x - msub); s[t].y = ex2(s[t].y - msub); s[t].z = ex2(s[t].z - msub); s[t].w = ex2(s[t].w - msub); sum += (s[t].x + s[t].y) + (s[t].z + s[t].w); }
    if (__any(mn != m)) { const float al = ex2(m - ms); l = l * al + sum;
#pragma unroll
        for (int dt = 0; dt < 4; ++dt) acc[dt] = acc[dt] * al; }
    else l += sum;
    m = mn;
}
__device__ __forceinline__ float dpp_xor1(float v) { return __builtin_bit_cast(float, __builtin_amdgcn_update_dpp(0, __builtin_bit_cast(int, v), 0xB1, 0xF, 0xF, true)); }
__device__ __forceinline__ float dpp_xor2(float v) { return __builtin_bit_cast(float, __builtin_amdgcn_update_dpp(0, __builtin_bit_cast(int, v), 0x4E, 0xF, 0xF, true)); }
__device__ __forceinline__ unsigned getw(const v4u v, int wi) { return wi == 0 ? v.x : (wi == 1 ? v.y : (wi == 2 ? v.z : v.w)); }

__device__ __forceinline__ v4u topk_token(const LAS float* imp, int cur, int lane) {
    const bool c0 = lane >= 1 && lane < cur, c1 = (lane + 64) < cur;
    const unsigned u0 = c0 ? __float_as_uint(imp[lane]) : 0u, u1 = c1 ? __float_as_uint(imp[64 + lane]) : 0u;
    bool s0, s1;
    const int K = cur >= 1 ? 14 : 15, ncand = cur >= 1 ? cur - 1 : 0;
    if (ncand <= K) { s0 = c0; s1 = c1; }
    else {
        unsigned prefix = 0u; int rem = K;
        for (int bit = 30; bit >= 11; --bit) {
            const unsigned cand = prefix | (1u << bit);
            const bool m0 = c0 && ((u0 >> bit) == (cand >> bit)), m1 = c1 && ((u1 >> bit) == (cand >> bit));
            const int cnt = __popcll(__ballot(m0)) + __popcll(__ballot(m1));
            if (cnt >= rem) prefix = cand; else rem -= cnt;
        }
        const unsigned ph = prefix >> 11;
        const bool e0 = c0 && (u0 >> 11) == ph, e1 = c1 && (u1 >> 11) == ph;
        const unsigned long long be0 = __ballot(e0), be1 = __ballot(e1), lt = (1ull << lane) - 1ull;
        const int r0 = __popcll(be0 & lt), r1 = __popcll(be0) + __popcll(be1 & lt);
        s0 = c0 && ((u0 >> 11) > ph || (e0 && r0 < rem)); s1 = c1 && ((u1 >> 11) > ph || (e1 && r1 < rem));
    }
    s0 = s0 || lane == 0 || lane == cur; s1 = s1 || (lane + 64) == cur;
    const unsigned long long b0 = __ballot(s0), b1 = __ballot(s1);
    return (v4u){(unsigned)b0, (unsigned)(b0 >> 32), (unsigned)b1, (unsigned)(b1 >> 32)};
}


__device__ __forceinline__ void ring_issue(LAS unsigned char* slot, const bf16* ksrc, size_t kpitch, const bf16* vsrc, size_t vpitch, int w, int lane) {
    const int row = 8 * w + (lane >> 3), cl = (lane & 7) ^ ((row >> 1) & 7);
    __builtin_amdgcn_global_load_lds((const unsigned*)(ksrc + (size_t)row * kpitch + cl * 8), (LAS unsigned*)(slot + w * 1024), 16, 0, 0);
    __builtin_amdgcn_global_load_lds((const unsigned*)(vsrc + (size_t)row * vpitch + cl * 8), (LAS unsigned*)(slot + 8192 + w * 1024), 16, 0, 0);
}
#define RING_PAIR_SYNC() do { asm volatile("s_waitcnt vmcnt(0)" ::: "memory"); __builtin_amdgcn_s_barrier(); asm volatile("" ::: "memory"); } while (0)
__device__ __forceinline__ void qk_tile_sw(const LAS unsigned char* Kt, const bf16x8 q0, const bf16x8 q1, int c, int q, f32x4 (&s)[4]) {
    const int sw = (c >> 1) & 7; const LAS unsigned char* kp = Kt + c * 128;
    const int o0 = (q ^ sw) * 16, o1 = ((4 + q) ^ sw) * 16;
#pragma unroll
    for (int t = 0; t < 4; ++t) { const bf16x8 k0 = *(const LAS bf16x8*)(kp + t * 2048 + o0), k1 = *(const LAS bf16x8*)(kp + t * 2048 + o1);
        s[t] = MFMA16(k0, q0, ((f32x4){0.f, 0.f, 0.f, 0.f})); s[t] = MFMA16(k1, q1, s[t]); }
}
typedef short v4i16_t __attribute__((ext_vector_type(4)));
__device__ __forceinline__ s16x4 vtr(const LAS unsigned char* p) { return __builtin_bit_cast(s16x4, __builtin_amdgcn_ds_read_tr16_b64_v4i16((LAS v4i16_t*)p)); }
__device__ __forceinline__ void pv_tile_sw(const LAS unsigned char* Vt, const f32x4 (&p)[4], int c, int q, f32x4 (&acc)[4]) {
    const bf16x8 P0 = pack8(p[0], p[1]), P1 = pack8(p[2], p[3]);
    const int sw = (2 * q + (c >> 3)) & 7, ch = (c & 3) >> 1;
    const LAS unsigned char* vb = Vt + (4 * q + (c >> 2)) * 128 + (c & 1) * 8;
#pragma unroll
    for (int dt = 0; dt < 4; ++dt) { const LAS unsigned char* vr = vb + (((2 * dt + ch) ^ sw) << 4);
        const s16x4 a0 = vtr(vr), a1 = vtr(vr + 16 * 128), b0 = vtr(vr + 32 * 128), b1 = vtr(vr + 48 * 128);
        const bf16x8 va = (bf16x8){a0[0], a0[1], a0[2], a0[3], a1[0], a1[1], a1[2], a1[3]}, vb8 = (bf16x8){b0[0], b0[1], b0[2], b0[3], b1[0], b1[1], b1[2], b1[3]};
        acc[dt] = MFMA16(va, P0, acc[dt]); acc[dt] = MFMA16(vb8, P1, acc[dt]); }
}
template <int MODE> __device__ __forceinline__ void attn_prompt_unit(const Ctx& C, int b, int h, int T) {
    const float NINF = -__builtin_inff();
    int tid_ = C.tid; asm volatile("" : "+v"(tid_));
    const int tid = tid_, lane = tid & 63, w = __builtin_amdgcn_readfirstlane(tid >> 6), c = lane & 15, q = lane >> 4, ti = c >> 2, g = c & 3;
    LAS unsigned char* L = C.lds;
    LAS float* impS = (LAS float*)(L + A_IMP); LAS unsigned* selm = (LAS unsigned*)(L + A_SELM); LAS unsigned* wuni = (LAS unsigned*)(L + A_WUNI); LAS int* list = (LAS int*)(L + A_LIST); LAS int* misc = (LAS int*)(L + A_MISC);
    const int q0 = 64 * T, seq = b * 2 + h;
    bf16x8 Q0[2], Q1[2]; int toff[2]; v2u outp[2][4]; float gate[2][3];
#pragma unroll
    for (int a = 0; a < 2; ++a) { toff[a] = 8 * w + 4 * a + ti; const bf16* qp = C.QB + ((size_t)b * LP + q0 + toff[a]) * 512 + h * 256 + g * 64 + 8 * q;
        Q0[a] = *(const bf16x8*)qp; Q1[a] = *(const bf16x8*)(qp + 32);
        { const float* gp = C.GN + ((size_t)b * LP + q0 + toff[a]) * 32 + (h * 4 + g) * 3; gate[a][0] = gp[0]; gate[a][1] = gp[1]; gate[a][2] = gp[2]; }
#pragma unroll
        for (int dt = 0; dt < 4; ++dt) outp[a][dt] = (v2u){0u, 0u}; }
    for (int i = tid; i < 2048; i += 512) ((LAS f32x4*)impS)[i] = (f32x4){0.f, 0.f, 0.f, 0.f};
    const int nvmax = 4 * T + 3, ntc = (MODE & 4) ? 0 : (nvmax + 63) >> 6;
    const bf16* kcb = C.KCB + (size_t)seq * NCP * 64; const bf16* vcb = C.VCT + (size_t)seq * NCP * 64;
    int nvis[2], nvmin[2]; float mC[2], lC[2];
#pragma unroll
    for (int a = 0; a < 2; ++a) { const int qpos = q0 + toff[a]; nvis[a] = qpos >= 31 ? ((qpos - 31) >> 4) + 1 : 0; mC[a] = NINF; lC[a] = 0.f;
        const int qmin = q0 + 8 * w + 4 * a; nvmin[a] = qmin >= 31 ? ((qmin - 31) >> 4) + 1 : 0; }
    for (int s = 0; s < 2 && s < ntc; ++s) ring_issue(L + s * RSLOT, kcb + (size_t)s * 4096, 64, vcb + (size_t)s * 4096, 64, w, lane);
    for (int s = 0; s < ntc; ++s) {
        if (!(s & 1)) { RING_PAIR_SYNC();
            for (int s2 = s + 2; s2 < s + 4 && s2 < ntc; ++s2) ring_issue(L + (s2 & 3) * RSLOT, kcb + (size_t)s2 * 4096, 64, vcb + (size_t)s2 * 4096, 64, w, lane); }
        const LAS unsigned char* buf = L + (s & 3) * RSLOT;
#pragma unroll
        for (int a = 0; a < 2; ++a) { __builtin_amdgcn_sched_barrier(0); f32x4 sc[4]; qk_tile_sw(buf, Q0[a], Q1[a], c, q, sc); if (64 * (s + 1) > nvmin[a]) mask_tile(sc, q, 0, nvis[a] - 64 * s - 1);
            const float mn = fmaxf(mC[a], colmax(sc)), ms = (mn > NINF) ? mn : 0.f; float sum = 0.f;
#pragma unroll
            for (int t = 0; t < 4; ++t) sum += (ex2(sc[t].x - ms) + ex2(sc[t].y - ms)) + (ex2(sc[t].z - ms) + ex2(sc[t].w - ms));
            lC[a] = lC[a] * ex2(mC[a] - ms) + sum; mC[a] = mn; }
    }
    __builtin_amdgcn_s_barrier();
    float invC[2], msC[2];
#pragma unroll
    for (int a = 0; a < 2; ++a) { float l = lC[a]; l += __shfl_xor(l, 16); l += __shfl_xor(l, 32); invC[a] = 1.0f / fmaxf(l, 1e-30f); msC[a] = (mC[a] > NINF) ? mC[a] : 0.f; }
    f32x4 acc[2][4]; float carry[2];
#pragma unroll
    for (int a = 0; a < 2; ++a) { carry[a] = 0.f;
#pragma unroll
        for (int dt = 0; dt < 4; ++dt) acc[a][dt] = (f32x4){0.f, 0.f, 0.f, 0.f}; }
    for (int s = 0; s < 2 && s < ntc; ++s) ring_issue(L + s * RSLOT, kcb + (size_t)s * 4096, 64, vcb + (size_t)s * 4096, 64, w, lane);
    for (int s = 0; s < ntc; ++s) {
        if (!(s & 1)) { RING_PAIR_SYNC();
            for (int s2 = s + 2; s2 < s + 4 && s2 < ntc; ++s2) ring_issue(L + (s2 & 3) * RSLOT, kcb + (size_t)s2 * 4096, 64, vcb + (size_t)s2 * 4096, 64, w, lane); }
        const LAS unsigned char* buf = L + (s & 3) * RSLOT;
#pragma unroll
        for (int a = 0; a < 2; ++a) { __builtin_amdgcn_sched_barrier(0); f32x4 sc[4]; qk_tile_sw(buf, Q0[a], Q1[a], c, q, sc); if (64 * (s + 1) > nvmin[a]) mask_tile(sc, q, 0, nvis[a] - 64 * s - 1);
            float x[4], A[4];
#pragma unroll
            for (int t = 0; t < 4; ++t) { sc[t].x = ex2(sc[t].x - msC[a]) * invC[a]; sc[t].y = ex2(sc[t].y - msC[a]) * invC[a]; sc[t].z = ex2(sc[t].z - msC[a]) * invC[a]; sc[t].w = ex2(sc[t].w - msC[a]) * invC[a];
                f32x4 ps = sc[t]; ps.x += dpp_xor1(ps.x); ps.y += dpp_xor1(ps.y); ps.z += dpp_xor1(ps.z); ps.w += dpp_xor1(ps.w);
                ps.x += dpp_xor2(ps.x); ps.y += dpp_xor2(ps.y); ps.z += dpp_xor2(ps.z); ps.w += dpp_xor2(ps.w);
                A[t] = (ps.x + ps.y) + (ps.z + 0.5f * ps.w); x[t] = __shfl(0.5f * ps.w, (lane + 48) & 63); }
            if (g == 0) { LAS float* ip = impS + ((2 * w + a) * 4 + ti) * 128 + 16 * s + q;
                ip[0] = A[0] + (q ? x[0] : carry[a]); ip[4] = A[1] + (q ? x[1] : x[0]); ip[8] = A[2] + (q ? x[2] : x[1]); ip[12] = A[3] + (q ? x[3] : x[2]); }
            carry[a] = x[3];
            pv_tile_sw(buf + 8192, sc, c, q, acc[a]); }
    }
    __builtin_amdgcn_s_barrier();
    {
        LDS_FENCE();
#pragma unroll
        for (int a = 0; a < 2; ++a) { const float gc = gate[a][0];
#pragma unroll
            for (int dt = 0; dt < 4; ++dt) { const f32x4 o = acc[a][dt] * gc; outp[a][dt].x = pk2(o.x, o.y); outp[a][dt].y = pk2(o.z, o.w); } }
    }
    v4u wu = (v4u){0u, 0u, 0u, 0u};
    for (int tt = 0; tt < ((MODE & 2) ? 0 : 8); ++tt) { const v4u mk = topk_token(impS + ((2 * w + (tt >> 2)) * 4 + (tt & 3)) * 128, T, lane);
        if (lane == 0) *(LAS v4u*)(selm + (8 * w + tt) * 4) = mk;
        wu.x |= mk.x; wu.y |= mk.y; wu.z |= mk.z; wu.w |= mk.w; }
    if (lane == 0) *(LAS v4u*)(wuni + 4 * w) = wu;
    __syncthreads();
    LAS unsigned* tun = (LAS unsigned*)(L + A_TUN);
    if (lane < 8) { const int a = lane >> 2, wi = lane & 3; unsigned o = 0u;
#pragma unroll
        for (int i = 0; i < 4; ++i) o |= selm[(8 * w + 4 * a + i) * 4 + wi];
        tun[(2 * w + a) * 4 + wi] = o; }
    if (w == 0) {
        v4u U = (v4u){0u, 0u, 0u, 0u};
#pragma unroll
        for (int i = 0; i < 8; ++i) { const v4u o = *(const LAS v4u*)(wuni + 4 * i); U.x |= o.x; U.y |= o.y; U.z |= o.z; U.w |= o.w; }
        const unsigned long long lt = (1ull << lane) - 1ull;
        const bool b0 = ((lane < 32 ? U.x : U.y) >> (lane & 31)) & 1u, b1 = ((lane < 32 ? U.z : U.w) >> (lane & 31)) & 1u;
        const unsigned long long m0 = __ballot(b0), m1 = __ballot(b1); const int n0 = __popcll(m0);
        if (b0) list[__popcll(m0 & lt)] = lane; if (b1) list[n0 + __popcll(m1 & lt)] = 64 + lane;
        if (lane == 0) misc[0] = n0 + __popcll(m1);
    }
    __syncthreads();
    const int nsel = (MODE & 3) ? 0 : misc[0];
    const bf16* ksb = C.KVB + ((size_t)b * LP) * 768 + 2 * 128 + h * 64; const bf16* vsb = C.KVB + ((size_t)b * LP) * 768 + 3 * 128 + h * 64;
    float mS[2], lS[2];
#pragma unroll
    for (int a = 0; a < 2; ++a) { mS[a] = NINF; lS[a] = 0.f;
#pragma unroll
        for (int dt = 0; dt < 4; ++dt) acc[a][dt] = (f32x4){0.f, 0.f, 0.f, 0.f}; }
#pragma unroll
    for (int s = 0; s < RG2; ++s) if (s < nsel) { const int jn = list[s]; ring_issue(L + s * RSLOT, ksb + (size_t)jn * 64 * 768, 768, vsb + (size_t)jn * 64 * 768, 768, w, lane); }
    for (int s = 0; s < nsel; ++s) {
        if (!(s & (RG2 - 1))) { RING_PAIR_SYNC();
#pragma unroll
            for (int u = 0; u < RG2; ++u) { const int s2 = s + RG2 + u; if (s2 < nsel) { const int jn = list[s2]; ring_issue(L + (s2 & (NRING2 - 1)) * RSLOT, ksb + (size_t)jn * 64 * 768, 768, vsb + (size_t)jn * 64 * 768, 768, w, lane); } } }
        const int j = list[s];
        const LAS unsigned char* buf = L + (s & (NRING2 - 1)) * RSLOT;
        const int wi = j >> 5, bt = j & 31;
#pragma unroll
        for (int a = 0; a < 2; ++a) { __builtin_amdgcn_sched_barrier(0);
            if ((__builtin_amdgcn_readfirstlane(tun[(2 * w + a) * 4 + wi]) >> bt) & 1u) {
                f32x4 sc[4]; qk_tile_sw(buf, Q0[a], Q1[a], c, q, sc);
                const bool mine = (selm[(8 * w + 4 * a + ti) * 4 + wi] >> bt) & 1u;
                if (j == T) mask_tile(sc, q, 0, toff[a]);
                online_step(sc, mine, mS[a], lS[a], acc[a]);
                pv_tile_sw(buf + 8192, sc, c, q, acc[a]); } }
    }
    __builtin_amdgcn_s_barrier();
#pragma unroll
    for (int a = 0; a < 2; ++a) { float l = lS[a]; l += __shfl_xor(l, 16); l += __shfl_xor(l, 32);
        const float gs = gate[a][1] / fmaxf(l, 1e-30f);
#pragma unroll
        for (int dt = 0; dt < 4; ++dt) { const f32x4 o = unpk4(outp[a][dt]) + acc[a][dt] * gs; outp[a][dt].x = pk2(o.x, o.y); outp[a][dt].y = pk2(o.z, o.w); } }
    const bf16* kwb = C.KVB + ((size_t)b * LP) * 768 + 4 * 128 + h * 64; const bf16* vwb = C.KVB + ((size_t)b * LP) * 768 + 5 * 128 + h * 64;
#pragma unroll
    for (int a = 0; a < 2; ++a) { mS[a] = NINF; lS[a] = 0.f;
#pragma unroll
        for (int dt = 0; dt < 4; ++dt) acc[a][dt] = (f32x4){0.f, 0.f, 0.f, 0.f}; }
    const int jw0 = T >= 8 ? T - 8 : 0, nw = (MODE & 8) ? 0 : T - jw0 + 1;
#pragma unroll
    for (int s = 0; s < RG2; ++s) if (s < nw) ring_issue(L + s * RSLOT, kwb + (size_t)(jw0 + s) * 64 * 768, 768, vwb + (size_t)(jw0 + s) * 64 * 768, 768, w, lane);
    for (int s = 0; s < nw; ++s) {
        if (!(s & (RG2 - 1))) { RING_PAIR_SYNC();
#pragma unroll
            for (int u = 0; u < RG2; ++u) { const int s2 = s + RG2 + u; if (s2 < nw) ring_issue(L + (s2 & (NRING2 - 1)) * RSLOT, kwb + (size_t)(jw0 + s2) * 64 * 768, 768, vwb + (size_t)(jw0 + s2) * 64 * 768, 768, w, lane); } }
        const int j = jw0 + s;
        const LAS unsigned char* buf = L + (s & (NRING2 - 1)) * RSLOT;
#pragma unroll
        for (int a = 0; a < 2; ++a) { __builtin_amdgcn_sched_barrier(0); f32x4 sc[4]; qk_tile_sw(buf, Q0[a], Q1[a], c, q, sc);
            const int lo = (j == T - 8) ? toff[a] + 1 : 0, hi = (j == T) ? toff[a] : 63;
            if (j == T - 8 || j == T) mask_tile(sc, q, lo, hi);
            online_step(sc, true, mS[a], lS[a], acc[a]);
            pv_tile_sw(buf + 8192, sc, c, q, acc[a]); }
    }
    __builtin_amdgcn_s_barrier();
#pragma unroll
    for (int a = 0; a < 2; ++a) { float l = lS[a]; l += __shfl_xor(l, 16); l += __shfl_xor(l, 32);
        const size_t row = (size_t)b * LP + q0 + toff[a];
        const float gw = gate[a][2] / fmaxf(l, 1e-30f);
#pragma unroll
        for (int dt = 0; dt < 4; ++dt) { const f32x4 o = unpk4(outp[a][dt]) + acc[a][dt] * gw; const int col = h * 256 + g * 64 + 16 * dt + 4 * q;
            const f32x4 z = unpk4(*(const v2u*)(C.SZA + row * 512 + col));
            v2u ov; ov.x = pk2(o.x * z.x, o.y * z.y); ov.y = pk2(o.z * z.z, o.w * z.w);
            if (!(MODE & 32)) *(v2u*)(C.OA + row * 512 + col) = ov; else if (ov.x == 0x12345678u) *(v2u*)(C.OA + row * 512 + col) = ov; } }
}

constexpr int S_TILE = 2 * TILEB, S_IMPA = 4 * S_TILE, S_IMPB = S_IMPA + 8448, S_SELM = S_IMPB + 8448, S_LIST = S_SELM + 512, S_MISC = S_LIST + 1088, S_TUN = S_MISC + 64, S_MRG = S_TUN + 128, S_END = S_MRG + 8 * 64 * 18 * 4;
static_assert(S_END <= MISC_OFF, "sample attention LDS map");
__device__ __forceinline__ void pv_tile_tr(const LAS unsigned char* Vt, const f32x4 (&p)[4], int lane, f32x4 (&acc)[4]) {
    const bf16x8 P0 = pack8(p[0], p[1]), P1 = pack8(p[2], p[3]);
    const int i = lane & 15, q = lane >> 4;
    const LAS unsigned char* vb = Vt + (4 * q + (i >> 2)) * TP + (i & 3) * 8;
#pragma unroll
    for (int dt = 0; dt < 4; ++dt) {
        const s16x4 a0 = vtr(vb + dt * 32), a1 = vtr(vb + dt * 32 + 16 * TP), b0 = vtr(vb + dt * 32 + 32 * TP), b1 = vtr(vb + dt * 32 + 48 * TP);
        const bf16x8 va = (bf16x8){a0[0], a0[1], a0[2], a0[3], a1[0], a1[1], a1[2], a1[3]}, vb8 = (bf16x8){b0[0], b0[1], b0[2], b0[3], b1[0], b1[1], b1[2], b1[3]};
        acc[dt] = MFMA16(va, P0, acc[dt]); acc[dt] = MFMA16(vb8, P1, acc[dt]); }
}
struct TileSrc { const float* k; const float* v; int stride; int nrows; };
__device__ __forceinline__ void stage4_f32(LAS unsigned char* L, const TileSrc (&ts)[4], int tid) {
    const int r0 = tid >> 4, d4 = (tid & 15) * 4;
    f32x4 kv[4][2], vv[4][2];
#pragma unroll
    for (int t = 0; t < 4; ++t)
#pragma unroll
        for (int hh = 0; hh < 2; ++hh) { const int r = r0 + 32 * hh; const bool ok = r < ts[t].nrows;
            kv[t][hh] = ok ? *(const f32x4*)(ts[t].k + (size_t)r * ts[t].stride + d4) : (f32x4){0.f, 0.f, 0.f, 0.f};
            vv[t][hh] = ok ? *(const f32x4*)(ts[t].v + (size_t)r * ts[t].stride + d4) : (f32x4){0.f, 0.f, 0.f, 0.f}; }
#pragma unroll
    for (int t = 0; t < 4; ++t)
#pragma unroll
        for (int hh = 0; hh < 2; ++hh) { const int r = r0 + 32 * hh; v2u a, b2; a.x = pk2(kv[t][hh].x, kv[t][hh].y); a.y = pk2(kv[t][hh].z, kv[t][hh].w); b2.x = pk2(vv[t][hh].x, vv[t][hh].y); b2.y = pk2(vv[t][hh].z, vv[t][hh].w);
            *(LAS v2u*)(L + t * S_TILE + r * TP + d4 * 2) = a; *(LAS v2u*)(L + t * S_TILE + TILEB + r * TP + d4 * 2) = b2; }
}
__device__ __forceinline__ void stage4_bf16(LAS unsigned char* L, const bf16* kb, const bf16* vb, int tid) {
    const int r = tid >> 3, ch = tid & 7;
    v4u kk[4], vv[4];
#pragma unroll
    for (int t = 0; t < 4; ++t) { kk[t] = *(const v4u*)(kb + (size_t)(64 * t + r) * 64 + ch * 8); vv[t] = *(const v4u*)(vb + (size_t)(64 * t + r) * 64 + ch * 8); }
#pragma unroll
    for (int t = 0; t < 4; ++t) { *(LAS v4u*)(L + t * S_TILE + r * TP + ch * 16) = kk[t]; *(LAS v4u*)(L + t * S_TILE + TILEB + r * TP + ch * 16) = vv[t]; }
}
__device__ __forceinline__ void merge4(LAS float* mrg, int w, int lane, float& m, float& l, f32x4 (&acc)[4]) {
    const float NINF = -__builtin_inff();
    LAS float* me = mrg + (w * 64 + lane) * 18;
    me[0] = m; me[1] = l;
#pragma unroll
    for (int dt = 0; dt < 4; ++dt) { me[2 + 4 * dt] = acc[dt].x; me[3 + 4 * dt] = acc[dt].y; me[4 + 4 * dt] = acc[dt].z; me[5 + 4 * dt] = acc[dt].w; }
    LDS_FENCE(); __syncthreads();
    const int w0 = w & 4;
    float M = NINF;
#pragma unroll
    for (int k = 0; k < 4; ++k) M = fmaxf(M, mrg[((w0 + k) * 64 + lane) * 18]);
    const float Ms = (M > NINF) ? M : 0.f; float Lx = 0.f; f32x4 A[4];
#pragma unroll
    for (int dt = 0; dt < 4; ++dt) A[dt] = (f32x4){0.f, 0.f, 0.f, 0.f};
#pragma unroll
    for (int k = 0; k < 4; ++k) { const LAS float* o = mrg + ((w0 + k) * 64 + lane) * 18; const float f = ex2(o[0] - Ms); Lx += o[1] * f;
#pragma unroll
        for (int dt = 0; dt < 4; ++dt) { A[dt].x += o[2 + 4 * dt] * f; A[dt].y += o[3 + 4 * dt] * f; A[dt].z += o[4 + 4 * dt] * f; A[dt].w += o[5 + 4 * dt] * f; } }
    m = M; l = Lx;
#pragma unroll
    for (int dt = 0; dt < 4; ++dt) acc[dt] = A[dt];
    asm volatile("" : "+v"(m), "+v"(l), "+v"(acc[0]), "+v"(acc[1]), "+v"(acc[2]), "+v"(acc[3]));
    __syncthreads();
}
__device__ __forceinline__ void topk_token_s(const LAS float* ia, const LAS float* ib, int lane, LAS unsigned* dst) {
    bool cv[5], sv[5]; unsigned u[5];
#pragma unroll
    for (int k = 0; k < 5; ++k) { const int j = lane + 64 * k; cv[k] = j >= 1 && j < 256; u[k] = cv[k] ? __float_as_uint(ia[j] + ib[j]) : 0u; }
    unsigned prefix = 0u; int rem = 14;
    for (int bit = 30; bit >= 0; --bit) {
        const unsigned cand = prefix | (1u << bit); int cnt = 0;
#pragma unroll
        for (int k = 0; k < 5; ++k) cnt += __popcll(__ballot(cv[k] && ((u[k] >> bit) == (cand >> bit))));
        if (cnt >= rem) prefix = cand; else rem -= cnt;
    }
    const unsigned long long lt = (1ull << lane) - 1ull; int before = 0;
#pragma unroll
    for (int k = 0; k < 5; ++k) { const bool e = cv[k] && u[k] == prefix; const unsigned long long be = __ballot(e); const int rk = before + __popcll(be & lt); before += __popcll(be);
        sv[k] = cv[k] && (u[k] > prefix || (e && rk < rem)); }
    sv[0] = sv[0] || lane == 0; sv[4] = sv[4] || lane == 0;
#pragma unroll
    for (int k = 0; k < 5; ++k) { const unsigned long long bb = __ballot(sv[k]); if (lane == 0) { dst[2 * k] = (unsigned)bb; dst[2 * k + 1] = (unsigned)(bb >> 32); } }
}
__device__ __forceinline__ void attn_sample_unit(const Ctx& C, int b, int h) {
    const float NINF = -__builtin_inff();
    int tid_ = C.tid; asm volatile("" : "+v"(tid_));
    const int tid = tid_, lane = tid & 63, w = __builtin_amdgcn_readfirstlane(tid >> 6), c = lane & 15, q = lane >> 4, ti = c >> 2, g = c & 3, a = w >> 2, ks = w & 3;
    LAS unsigned char* L = C.lds;
    LAS float* impA = (LAS float*)(L + S_IMPA); LAS float* impB = (LAS float*)(L + S_IMPB); LAS unsigned* selm = (LAS unsigned*)(L + S_SELM); LAS int* list = (LAS int*)(L + S_LIST);
    LAS int* misc = (LAS int*)(L + S_MISC); LAS unsigned* tun = (LAS unsigned*)(L + S_TUN); LAS float* mrg = (LAS float*)(L + S_MRG);
    const int seq = b * 2 + h, tok = 4 * a + ti;
    const size_t row = (size_t)MP + (size_t)b * LS + tok;
    const bf16* qp = C.QB + row * 512 + h * 256 + g * 64 + 8 * q;
    const bf16x8 Q0 = *(const bf16x8*)qp, Q1 = *(const bf16x8*)(qp + 32);
    for (int i = tid; i < 2 * 8448 / 4; i += 512) impA[i] = 0.f;
    const unsigned char* Lt = nullptr; (void)Lt;
    const LAS unsigned char* myK = L + ks * S_TILE; const LAS unsigned char* myV = myK + TILEB;
    f32x4 acc[4], outv[4]; float m = NINF, l = 0.f;
#pragma unroll
    for (int dt = 0; dt < 4; ++dt) { acc[dt] = (f32x4){0.f, 0.f, 0.f, 0.f}; outv[dt] = (f32x4){0.f, 0.f, 0.f, 0.f}; }
    const bf16* kcb = C.KCBS + (size_t)seq * NCS * 64; const bf16* vcb = C.VCBS + (size_t)seq * NCS * 64;
    for (int s = 0; s < 4; ++s) {
        stage4_bf16(L, kcb + (size_t)s * 256 * 64, vcb + (size_t)s * 256 * 64, tid); LDS_FENCE(); __syncthreads();
        { f32x4 sc[4]; qk_tile(myK, Q0, Q1, c, q, sc); mask_tile(sc, q, 0, 1022 - 64 * (4 * s + ks));
          const float mn = fmaxf(m, colmax(sc)), ms = (mn > NINF) ? mn : 0.f; float sum = 0.f;
#pragma unroll
          for (int t = 0; t < 4; ++t) sum += (ex2(sc[t].x - ms) + ex2(sc[t].y - ms)) + (ex2(sc[t].z - ms) + ex2(sc[t].w - ms));
          l = l * ex2(m - ms) + sum; m = mn; }
        __syncthreads();
    }
    merge4(mrg, w, lane, m, l, acc);
    float lt_ = l; lt_ += __shfl_xor(lt_, 16); lt_ += __shfl_xor(lt_, 32);
    const float invC = 1.0f / fmaxf(lt_, 1e-30f), msC = (m > NINF) ? m : 0.f;
    for (int s = 0; s < 4; ++s) {
        stage4_bf16(L, kcb + (size_t)s * 256 * 64, vcb + (size_t)s * 256 * 64, tid); LDS_FENCE(); __syncthreads();
        { f32x4 sc[4]; qk_tile(myK, Q0, Q1, c, q, sc); const int tl = 4 * s + ks; mask_tile(sc, q, 0, 1022 - 64 * tl);
#pragma unroll
          for (int t = 0; t < 4; ++t) { sc[t].x = ex2(sc[t].x - msC) * invC; sc[t].y = ex2(sc[t].y - msC) * invC; sc[t].z = ex2(sc[t].z - msC) * invC; sc[t].w = ex2(sc[t].w - msC) * invC;
              f32x4 ps = sc[t]; ps.x += dpp_xor1(ps.x); ps.y += dpp_xor1(ps.y); ps.z += dpp_xor1(ps.z); ps.w += dpp_xor1(ps.w);
              ps.x += dpp_xor2(ps.x); ps.y += dpp_xor2(ps.y); ps.z += dpp_xor2(ps.z); ps.w += dpp_xor2(ps.w);
              if (g == 0) { const int j = 16 * tl + 4 * t + q; impA[tok * 264 + j] = (ps.x + ps.y) + (ps.z + 0.5f * ps.w); impB[tok * 264 + j + 1] = 0.5f * ps.w; } }
          pv_tile_tr(myV, sc, lane, acc); }
        __syncthreads();
    }
    m = 0.f; l = 0.f;
    merge4(mrg, w, lane, m, l, acc);
    { const float gc = C.GN[row * 32 + (h * 4 + g) * 3 + 0];
#pragma unroll
      for (int dt = 0; dt < 4; ++dt) outv[dt] = acc[dt] * gc; }
    topk_token_s(impA + w * 264, impB + w * 264, lane, selm + w * 12);
    LDS_FENCE(); __syncthreads();
    if (lane < 20 && w == 0) { const int aa = lane / 10, wi = lane % 10; unsigned o = 0u;
#pragma unroll
        for (int i = 0; i < 4; ++i) o |= selm[(4 * aa + i) * 12 + wi];
        tun[aa * 12 + wi] = o; }
    if (w == 1) {
        const unsigned long long lt = (1ull << lane) - 1ull; int base = 0;
#pragma unroll
        for (int k = 0; k < 5; ++k) { unsigned o = 0u; const int wi = 2 * k + (lane >> 5);
#pragma unroll
            for (int i = 0; i < 8; ++i) o |= selm[i * 12 + wi];
            const bool bt = (o >> (lane & 31)) & 1u; const unsigned long long mm = __ballot(bt);
            if (bt) list[base + __popcll(mm & lt)] = 64 * k + lane;
            base += __popcll(mm); }
        if (lane == 0) misc[0] = base;
    }
    LDS_FENCE(); __syncthreads();
    const int nsel = misc[0];
    m = NINF; l = 0.f;
#pragma unroll
    for (int dt = 0; dt < 4; ++dt) acc[dt] = (f32x4){0.f, 0.f, 0.f, 0.f};
    for (int s0 = 0; s0 < nsel; s0 += 4) {
        TileSrc ts[4];
#pragma unroll
        for (int t = 0; t < 4; ++t) { const int j = (s0 + t < nsel) ? list[s0 + t] : -1;
            if (j < 0) { ts[t].k = C.out; ts[t].v = C.out; ts[t].stride = 0; ts[t].nrows = 0; }
            else if (j < 256) { const int page = C.page_table[b * NPAGE + (j >> 1)]; const float* base = C.cache_kv + ((size_t)page * PAGE + (size_t)(j & 1) * 64) * 512 + 2 * 128 + h * 64;
                ts[t].k = base; ts[t].v = base + 128; ts[t].stride = 512; ts[t].nrows = 64; }
            else { const float* base = C.out + O_KVS + ((size_t)b * LS) * 512 + 2 * 128 + h * 64; ts[t].k = base; ts[t].v = base + 128; ts[t].stride = 512; ts[t].nrows = LS; } }
        stage4_f32(L, ts, tid); LDS_FENCE(); __syncthreads();
        if (s0 + ks < nsel) { const int j = list[s0 + ks], wi = j >> 5, bt = j & 31;
            if ((__builtin_amdgcn_readfirstlane(tun[a * 12 + wi]) >> bt) & 1u) {
                f32x4 sc[4]; qk_tile(myK, Q0, Q1, c, q, sc);
                const bool mine = (selm[tok * 12 + wi] >> bt) & 1u;
                mask_tile(sc, q, 0, mine ? (j == 256 ? tok : 63) : -1);
                online_step(sc, true, m, l, acc);
                pv_tile_tr(myV, sc, lane, acc); } }
        __syncthreads();
    }
    merge4(mrg, w, lane, m, l, acc);
    { float lx = l; lx += __shfl_xor(lx, 16); lx += __shfl_xor(lx, 32);
      const float gs = C.GN[row * 32 + (h * 4 + g) * 3 + 1] / fmaxf(lx, 1e-30f);
#pragma unroll
      for (int dt = 0; dt < 4; ++dt) outv[dt] += acc[dt] * gs; }
    m = NINF; l = 0.f;
#pragma unroll
    for (int dt = 0; dt < 4; ++dt) acc[dt] = (f32x4){0.f, 0.f, 0.f, 0.f};
    for (int s0 = 0; s0 < 9; s0 += 4) {
        TileSrc ts[4];
#pragma unroll
        for (int t = 0; t < 4; ++t) { const int i = s0 + t;
            if (i < 8) { const float* base = C.cache_win + (((size_t)b * 512 + (size_t)i * 64) * 2) * 128 + h * 64; ts[t].k = base; ts[t].v = base + 128; ts[t].stride = 256; ts[t].nrows = 64; }
            else if (i == 8) { const float* base = C.out + O_WINS + ((size_t)b * 512 + 504) * 256 + h * 64; ts[t].k = base; ts[t].v = base + 128; ts[t].stride = 256; ts[t].nrows = LS; }
            else { ts[t].k = C.out; ts[t].v = C.out; ts[t].stride = 0; ts[t].nrows = 0; } }
        stage4_f32(L, ts, tid); LDS_FENCE(); __syncthreads();
        { const int i = s0 + ks;
          if (i < 9) { f32x4 sc[4]; qk_tile(myK, Q0, Q1, c, q, sc);
              mask_tile(sc, q, (i == 0) ? tok + 1 : 0, (i == 8) ? tok : 63);
              online_step(sc, true, m, l, acc);
              pv_tile_tr(myV, sc, lane, acc); } }
        __syncthreads();
    }
    merge4(mrg, w, lane, m, l, acc);
    if (ks == 0) { float lx = l; lx += __shfl_xor(lx, 16); lx += __shfl_xor(lx, 32);
        const float gw = C.GN[row * 32 + (h * 4 + g) * 3 + 2] / fmaxf(lx, 1e-30f);
#pragma unroll
        for (int dt = 0; dt < 4; ++dt) { const f32x4 o = outv[dt] + acc[dt] * gw; const int col = h * 256 + g * 64 + 16 * dt + 4 * q;
            const f32x4 z = unpk4(*(const v2u*)(C.SZA + row * 512 + col));
            v2u ov; ov.x = pk2(o.x * z.x, o.y * z.y); ov.y = pk2(o.z * z.z, o.w * z.w);
            *(v2u*)(C.OA + row * 512 + col) = ov; } }
}
template <int MODE> __device__ __forceinline__ void p5_attn(const Ctx& C) {
    LAS int* misc = (LAS int*)(C.lds + MISC_OFF + 128);
    unsigned* qctr = (unsigned*)(C.ws + WS_CTL) + CW_QCTR;
    for (;;) {
        if (C.tid == 0) misc[1] = (int)atomicAdd(qctr, 1u);
        __syncthreads();
        const int u = misc[1];
        __syncthreads();
        if (u >= BS * 2) break;
        if (!(MODE & 16)) attn_sample_unit(C, u >> 1, u & 1);
    }
    int nextv = 0;
    if (C.tid == 0) nextv = (int)atomicAdd(qctr + 64, 1u);
    for (;;) {
        if (C.tid == 0) misc[1] = nextv;
        __syncthreads();
        const int v = misc[1];
        __syncthreads();
        if (v >= BP * 2 * 128) break;
        if (C.tid == 0) nextv = (int)atomicAdd(qctr + 64, 1u);
        const int T = 127 - (v >> 3), sq = v & 7; attn_prompt_unit<MODE>(C, sq >> 1, sq & 1, T);
    }
}


template <class F>
__device__ __forceinline__ void skinny_gemm(const Ctx& C, const bf16* A, const bf16* Bt, int N, int K, const F& epi) {
    const int lane = C.lane, m = lane & 15, q = lane >> 4, nitems = (N >> 4) * 4;
    for (int it = C.gw; it < nitems; it += C.NGW) {
        const int s = it >> 2, rg = it & 3;
        const bf16* ap = A + (size_t)(64 * rg + m) * K + 8 * q; const bf16* bp = Bt + (size_t)(16 * s + m) * K + 8 * q;
        f32x4 acc[4];
#pragma unroll
        for (int mt = 0; mt < 4; ++mt) acc[mt] = (f32x4){0.f, 0.f, 0.f, 0.f};
#pragma unroll 8
        for (int ks = 0; ks < (K >> 5); ++ks) { const bf16x8 b = *(const bf16x8*)(bp + 32 * ks);
#pragma unroll
            for (int mt = 0; mt < 4; ++mt) acc[mt] = MFMA16(*(const bf16x8*)(ap + (size_t)mt * 16 * K + 32 * ks), b, acc[mt]); }
#pragma unroll
        for (int mt = 0; mt < 4; ++mt)
#pragma unroll
            for (int r = 0; r < 4; ++r) epi(64 * rg + 16 * mt + 4 * q + r, 16 * s + m, acc[mt][r]);
    }
}
template <class F>
__device__ __forceinline__ void skinny_gemm2(const Ctx& C, const bf16* A0, const bf16* Bt0, const bf16* A1, const bf16* Bt1, int N, int K, const F& epi) {
    const int lane = C.lane, m = lane & 15, q = lane >> 4, nitems = (N >> 4) * 4;
    for (int it = C.gw; it < nitems; it += C.NGW) {
        const int s = it >> 2, rg = it & 3;
        f32x4 acc0[4], acc1[4];
#pragma unroll
        for (int mt = 0; mt < 4; ++mt) { acc0[mt] = (f32x4){0.f, 0.f, 0.f, 0.f}; acc1[mt] = (f32x4){0.f, 0.f, 0.f, 0.f}; }
        { const bf16* ap = A0 + (size_t)(64 * rg + m) * K + 8 * q; const bf16* bp = Bt0 + (size_t)(16 * s + m) * K + 8 * q;
#pragma unroll 8
          for (int ks = 0; ks < (K >> 5); ++ks) { const bf16x8 b = *(const bf16x8*)(bp + 32 * ks);
#pragma unroll
              for (int mt = 0; mt < 4; ++mt) acc0[mt] = MFMA16(*(const bf16x8*)(ap + (size_t)mt * 16 * K + 32 * ks), b, acc0[mt]); } }
        { const bf16* ap = A1 + (size_t)(64 * rg + m) * K + 8 * q; const bf16* bp = Bt1 + (size_t)(16 * s + m) * K + 8 * q;
#pragma unroll 8
          for (int ks = 0; ks < (K >> 5); ++ks) { const bf16x8 b = *(const bf16x8*)(bp + 32 * ks);
#pragma unroll
              for (int mt = 0; mt < 4; ++mt) acc1[mt] = MFMA16(*(const bf16x8*)(ap + (size_t)mt * 16 * K + 32 * ks), b, acc1[mt]); } }
#pragma unroll
        for (int mt = 0; mt < 4; ++mt)
#pragma unroll
            for (int r = 0; r < 4; ++r) epi(64 * rg + 16 * mt + 4 * q + r, 16 * s + m, acc0[mt][r], acc1[mt][r]);
    }
}
__device__ __forceinline__ float bf2f1(bf16 v) { return __uint_as_float(((unsigned)v) << 16); }
struct SkIn {
    bf16 *QB, *KVB, *SZA, *SZS, *GM; float *U32, *GN, *out;
    __device__ __forceinline__ void operator()(int r, int c, float v) const {
        const size_t row = (size_t)MP + r;
        if (c < 512) QB[row * 512 + c] = (bf16)f2bf(v * QSCALE);
        else if (c < 1280) { const int kc = c - 512; KVB[row * 768 + kc] = (bf16)f2bf(v);
            if (kc < 512) out[O_KVS + (size_t)r * 512 + kc] = v; else out[O_WINS + ((size_t)(r >> 3) * 512 + 504 + (r & 7)) * 256 + (kc - 512)] = v; }
        else if (c < 1792) SZA[row * 512 + (c - 1280)] = (bf16)f2bf(v * sigmf(v));
        else if (c < 2304) U32[row * 512 + (c - 1792)] = v;
        else if (c < 2816) SZS[row * 512 + (c - 2304)] = (bf16)f2bf(v * sigmf(v));
        else if (c < 4864) GM[row * 2048 + (c - 2816)] = (bf16)f2bf(sigmf(v));
        else if (c < 4888) GN[row * 32 + (c - 4864)] = sigmf(v);
    }
};
struct SkGlu {
    bf16* YB; const bf16* Y1B; const bf16* SZS; const float* bias;
    __device__ __forceinline__ void operator()(int r, int c, float v) const { const size_t i = ((size_t)MP + r) * 512 + c; YB[i] = (bf16)f2bf(bf2f1(Y1B[i]) * sigmf(v + bias[c]) * bf2f1(SZS[i])); }
};
struct SkLift2 {
    bf16* MG; const bf16* GM;
    __device__ __forceinline__ void operator()(int r, int c, float vs, float va) const { const size_t row = (size_t)MP + r;
        MG[row * 1024 + c] = (bf16)f2bf(bf2f1(GM[row * 2048 + c]) * va + bf2f1(GM[row * 2048 + 1024 + c]) * vs); }
};
struct SkOut {
    bf16* YPB; const float* xs;
    __device__ __forceinline__ void operator()(int r, int c, float v) const { YPB[((size_t)MP + r) * 1024 + c] = (bf16)f2bf(xs[(size_t)r * 1024 + c] + v); }
};
__device__ __forceinline__ void p9_final(const Ctx& C) {
    const bf16* YPB = (const bf16*)(C.ws + WS_YPB);
    for (int m0 = C.gw; m0 < MT; m0 += 4 * C.NGW) {
        v4u p[4][2];
#pragma unroll
        for (int u = 0; u < 4; ++u) { const int m = m0 + u * C.NGW < MT ? m0 + u * C.NGW : m0;
#pragma unroll
            for (int j = 0; j < 2; ++j) p[u][j] = *(const v4u*)(YPB + (size_t)m * D + 512 * j + 8 * C.lane); }
#pragma unroll
        for (int u = 0; u < 4; ++u) { const int m = m0 + u * C.NGW; if (m >= MT) break;
            f32x4 v[4]; float s = 0.f;
#pragma unroll
            for (int j = 0; j < 2; ++j) { const v4u pp = p[u][j];
                v[2 * j] = (f32x4){__uint_as_float(pp.x << 16), __uint_as_float(pp.x & 0xffff0000u), __uint_as_float(pp.y << 16), __uint_as_float(pp.y & 0xffff0000u)};
                v[2 * j + 1] = (f32x4){__uint_as_float(pp.z << 16), __uint_as_float(pp.z & 0xffff0000u), __uint_as_float(pp.w << 16), __uint_as_float(pp.w & 0xffff0000u)}; }
#pragma unroll
            for (int j = 0; j < 4; ++j) s += (v[j].x * v[j].x + v[j].y * v[j].y) + (v[j].z * v[j].z + v[j].w * v[j].w);
            const float r = rsqrtf(wave_sum(s) * (1.f / D) + RMS_EPS);
#pragma unroll
            for (int j = 0; j < 4; ++j) { const int col = 512 * (j >> 1) + 8 * C.lane + 4 * (j & 1);
                *(f32x4*)(C.out + (size_t)m * D + col) = v[j] * r * *(const f32x4*)(C.final_g + col); } }
    }
    for (int it = C.gw; it < BS * 504; it += C.NGW) { const int b = it / 504, i = it % 504;
        ((f32x4*)(C.out + O_WINS + ((size_t)b * 512 + i) * 256))[C.lane] = ((const f32x4*)(C.cache_win + ((size_t)b * 512 + i + 8) * 256))[C.lane]; }
}

constexpr int N_PHASES = 8;
struct Args { const void* in[27]; float* out; unsigned char* ws; int ph_lo, ph_hi; };
__device__ __forceinline__ int lane_id() { return (int)__builtin_amdgcn_mbcnt_hi(~0u, __builtin_amdgcn_mbcnt_lo(~0u, 0u)); }
__device__ __forceinline__ void make_ctx(Ctx& C, const Args& a, unsigned char* lds_raw, const int wv) {
    C.lds = (LAS unsigned char*)lds_raw; C.wave = wv; C.lane = lane_id(); C.tid = wv * 64 + C.lane;
    C.G = gridDim.x; C.gw = blockIdx.x * NWAVES + C.wave; C.NGW = C.G * NWAVES;
    C.xp = (const float*)a.in[0]; C.xs = (const float*)a.in[1]; C.cache_kv = (const float*)a.in[2]; C.cache_win = (const float*)a.in[3]; C.st_re = (const float*)a.in[4]; C.st_im = (const float*)a.in[5];
    C.page_table = (const int*)a.in[6]; C.norm_g = (const float*)a.in[7]; C.w_in = (const float*)a.in[8]; C.cmp_pe = (const float*)a.in[9]; C.cmp_w1 = (const float*)a.in[10]; C.cmp_b1 = (const float*)a.in[11];
    C.cmp_w2 = (const float*)a.in[12]; C.lam_re = (const float*)a.in[13]; C.lam_im = (const float*)a.in[14]; C.log_dt = (const float*)a.in[15]; C.b_re = (const float*)a.in[16]; C.b_im = (const float*)a.in[17];
    C.c_re = (const float*)a.in[18]; C.c_im = (const float*)a.in[19]; C.ssm_d = (const float*)a.in[20]; C.w_glu = (const float*)a.in[21]; C.b_glu = (const float*)a.in[22]; C.w_la = (const float*)a.in[23];
    C.w_ls = (const float*)a.in[24]; C.w_out = (const float*)a.in[25]; C.final_g = (const float*)a.in[26];
    C.out = a.out; C.ws = a.ws; unsigned char* ws = a.ws;
    C.WTIN = (bf16*)(ws + WS_WTIN); C.WTGLU = (bf16*)(ws + WS_WTGLU); C.WTLA = (bf16*)(ws + WS_WTLA); C.WTLS = (bf16*)(ws + WS_WTLS); C.WTOUT = (bf16*)(ws + WS_WTOUT); C.WTC1 = (bf16*)(ws + WS_WTC1);
    C.XN = (bf16*)(ws + WS_XN); C.OA = (bf16*)(ws + WS_OA); C.Y1B = (bf16*)(ws + WS_Y1B); C.YB = (bf16*)(ws + WS_YB); C.MG = (bf16*)(ws + WS_MG); C.XC = (bf16*)(ws + WS_XC);
    C.KST = (float*)(ws + WS_CONST); C.SEND = (float*)(ws + WS_SEND); C.KC = (float*)(ws + WS_KC); C.VC = (float*)(ws + WS_VC); C.Y1 = (float*)(ws + WS_Y1); C.MB = (float*)(ws + WS_MB);
    C.PP = (float*)(ws + WS_PP); C.U32 = (float*)(ws + WS_U32); C.GN = (float*)(ws + WS_GN);
    C.KVB = (bf16*)(ws + WS_KVB); C.SZA = (bf16*)(ws + WS_SZA); C.SZS = (bf16*)(ws + WS_SZS); C.GM = (bf16*)(ws + WS_GM);
    C.QB = (bf16*)(ws + WS_QB); C.VST = (bf16*)(ws + WS_VST); C.VWT = (bf16*)(ws + WS_VWT); C.KCB = (bf16*)(ws + WS_KCB); C.VCT = (bf16*)(ws + WS_VCT); C.KCBS = (bf16*)(ws + WS_KCBS); C.VCBS = (bf16*)(ws + WS_VCBS);
}
__global__ void __launch_bounds__(NWAVES * 64, 2) mk_fwd(Args a) {
    extern __shared__ __attribute__((aligned(16))) unsigned char lds_raw[];
    unsigned char* ws = a.ws;
    volatile LAS unsigned* MISC = (volatile LAS unsigned*)((LAS unsigned char*)lds_raw + MISC_OFF);
    const int wv = __builtin_amdgcn_readfirstlane((int)threadIdx.x >> 6);
    if (wv == 0) MISC[lane_id()] = 0u;
    __syncthreads();
    const int lo = a.ph_lo, hi = a.ph_hi;
    const bool multi = (hi - lo) > 1;
    XcdBarrier bar; bar.bar = (unsigned*)(ws + WS_CTL) + CW_BAR; bar.x = 0; bar.st = nullptr;
    if (multi) bar = xcd_barrier_post((unsigned*)(ws + WS_CTL) + CW_BAR, MISC + 8, wv * 64 + lane_id());
#define IN(k) (lo <= (k) && (k) < hi)
#define MK Ctx C; make_ctx(C, a, lds_raw, wv)
#define SEAM(k) do { if (IN(k) && IN((k) + 1)) xcd_barrier(bar, wv * 64 + lane_id()); } while (0)
    if (IN(0)) { MK; p0_prep(C);
#if defined(REPEAT_WHAT) && REPEAT_WHAT == 0
        __syncthreads(); p0_prep(C);
#endif
    } SEAM(0);
    if (IN(1)) { MK; pg8::Gemm g{C.XN, C.WTIN, MP, NINP, D}; pg8::StaticOrder S; S.init(MP, NINP, C.G, (int)blockIdx.x);
        pg8::EpiIn E{C.QB, C.KVB, C.SZA, C.SZS, C.GM, C.XC, C.U32, C.GN, C.out, QSCALE, MP, O_KVP, O_KVS, O_WINP, O_WINS, (size_t)XC_S_ROWS};
        pg8::gemm_phase<pg8::EpiIn, pg8::StaticOrder, true, true>(C.lds, g, S, E, C.tid);
        SkIn K{C.QB, C.KVB, C.SZA, C.SZS, C.GM, C.U32, C.GN, C.out}; skinny_gemm(C, C.XN + (size_t)MP * D, C.WTIN, NINP, D, K);
#if defined(REPEAT_WHAT) && REPEAT_WHAT == 11
        skinny_gemm(C, C.XN + (size_t)MP * D, C.WTIN, NINP, D, K);
#endif
    } SEAM(1);
    if (IN(2)) { MK; p2_cmp1(C); __syncthreads(); p2_ssm_pass1(C); __syncthreads(); p3_ssm_pass2(C, true);
#if defined(REPEAT_WHAT) && REPEAT_WHAT == 21
        __syncthreads(); p2_cmp1(C);
#endif
#if defined(REPEAT_WHAT) && REPEAT_WHAT == 22
        __syncthreads();
#endif
#if defined(REPEAT_WHAT) && REPEAT_WHAT == 23
        __syncthreads(); p2_ssm_pass1(C);
#endif
    } SEAM(2);
    if (IN(3)) { MK; p3_ssm_pass2(C, false); __syncthreads(); p4_cmp2(C);
#if defined(REPEAT_WHAT) && REPEAT_WHAT == 31
        for (int rr = 0; rr < 4; ++rr) { __syncthreads(); p3_ssm_pass2(C, false); }
#endif
#if defined(REPEAT_WHAT) && REPEAT_WHAT == 32
        __syncthreads(); p4_cmp2(C);
#endif
    } SEAM(3);
    if (IN(4)) { MK; { pg8::Gemm g{C.Y1B, C.WTGLU, MP, 512, 512}; pg8::StaticOrder S; S.init(MP, 512, C.G, (int)blockIdx.x); pg8::EpiGlu E{C.YB, C.Y1B, C.SZS, C.b_glu};
        pg8::gemm_phase<pg8::EpiGlu, pg8::StaticOrder, true, true>(C.lds, g, S, E, C.tid);
        SkGlu K{C.YB, C.Y1B, C.SZS, C.b_glu}; skinny_gemm(C, C.Y1B + (size_t)MP * 512, C.WTGLU, 512, 512, K); }
        __syncthreads(); p5_attn<0>(C); } SEAM(4);
    if (IN(5)) { MK; pg8::Gemm g{C.YB, C.WTLS, MP, 1024, 512, C.OA, C.WTLA}; pg8::PairOrder S; S.init(MP, 1024, C.G, (int)blockIdx.x); pg8::EpiLift2 E{C.MG, C.GM};
        pg8::gemm_phase<pg8::EpiLift2, pg8::PairOrder, true, true>(C.lds, g, S, E, C.tid);
        SkLift2 K{C.MG, C.GM}; skinny_gemm2(C, C.YB + (size_t)MP * 512, C.WTLS, C.OA + (size_t)MP * 512, C.WTLA, 1024, 512, K);
#if defined(REPEAT_WHAT) && REPEAT_WHAT == 5
        __syncthreads(); pg8::gemm_phase<pg8::EpiLift2, pg8::PairOrder, true, true>(C.lds, g, S, E, C.tid);
#endif
    } SEAM(5);
    if (IN(6)) { MK; pg8::Gemm g{C.MG, C.WTOUT, MP, 1024, 1024}; pg8::StaticOrder S; S.init(MP, 1024, C.G, (int)blockIdx.x); pg8::EpiOut E{(bf16*)(C.ws + WS_YPB), C.xp, C.xs, MP};
        pg8::gemm_phase<pg8::EpiOut, pg8::StaticOrder, true, true>(C.lds, g, S, E, C.tid);
        SkOut K{(bf16*)(C.ws + WS_YPB), C.xs}; skinny_gemm(C, C.MG + (size_t)MP * 1024, C.WTOUT, 1024, 1024, K); } SEAM(6);
    if (IN(7)) { MK; p9_final(C);
#if defined(REPEAT_WHAT) && REPEAT_WHAT == 71
        __syncthreads(); { pg8::Gemm g{C.XN, C.WTIN, MP, NINP, D}; pg8::StaticOrder S; S.init(MP, NINP, C.G, (int)blockIdx.x);
        pg8::EpiIn E{C.QB, C.KVB, C.SZA, C.SZS, C.GM, C.XC, C.U32, C.GN, C.out, QSCALE, MP, O_KVP, O_KVS, O_WINP, O_WINS, (size_t)XC_S_ROWS};
        pg8::gemm_phase<pg8::EpiIn, pg8::StaticOrder, true, true>(C.lds, g, S, E, C.tid); }
#endif
#if defined(REPEAT_WHAT) && REPEAT_WHAT == 72
        __syncthreads(); { pg8::Gemm g{C.YB, C.WTLS, MP, 1024, 512, C.OA, C.WTLA}; pg8::PairOrder S; S.init(MP, 1024, C.G, (int)blockIdx.x); pg8::EpiLift2 E{C.MG, C.GM};
        pg8::gemm_phase<pg8::EpiLift2, pg8::PairOrder, true, true>(C.lds, g, S, E, C.tid); }
#endif
    }
#undef IN
#undef SEAM
}

#ifndef MK_ONE_LAUNCH
#define MK_ONE_LAUNCH 1
#endif
extern "C" void kernel_launch(void* const* d_in, const int* in_sizes, int n_in, void* d_out, int out_size, void* d_ws, size_t ws_size, hipStream_t stream) {
    static int grid = 0;
    if (grid == 0) {
        if (n_in != 27 || (size_t)out_size != O_END || ws_size < WS_END) { fprintf(stderr, "kernel_launch: unexpected shapes: n_in %d out %d ws %zu\n", n_in, out_size, ws_size); grid = -1; return; }
        int dev = 0, cus = 0, per_cu = 0;
        if (hipGetDevice(&dev) != hipSuccess || hipDeviceGetAttribute(&cus, hipDeviceAttributeMultiprocessorCount, dev) != hipSuccess) { grid = -1; return; }
        if (hipFuncSetAttribute((const void*)mk_fwd, hipFuncAttributeMaxDynamicSharedMemorySize, LDS_BYTES) != hipSuccess) { fprintf(stderr, "kernel_launch: hipFuncSetAttribute failed\n"); grid = -1; return; }
        if (hipOccupancyMaxActiveBlocksPerMultiprocessor(&per_cu, (const void*)mk_fwd, NWAVES * 64, LDS_BYTES) != hipSuccess || per_cu < 1) fprintf(stderr, "kernel_launch: occupancy query reports %d\n", per_cu);
        (void)hipGetLastError();
        grid = cus;
    }
    if (grid < 0) return;
    (void)hipMemsetAsync((char*)d_ws + WS_CTL, 0, CTL_ZERO_BYTES, stream);
    Args a{};
    for (int i = 0; i < 27; ++i) a.in[i] = d_in[i];
    a.out = (float*)d_out; a.ws = (unsigned char*)d_ws;
#if MK_ONE_LAUNCH
    a.ph_lo = 0; a.ph_hi = N_PHASES;
    hipLaunchKernelGGL(mk_fwd, dim3(grid), dim3(NWAVES * 64), LDS_BYTES, stream, a);
#else
    for (int p = 0; p < N_PHASES; ++p) { a.ph_lo = p; a.ph_hi = p + 1; hipLaunchKernelGGL(mk_fwd, dim3(grid), dim3(NWAVES * 64), LDS_BYTES, stream, a); }
#endif
}
```

```cpp
#include <hip/hip_runtime.h>
#include <cstdio>
#include <cstdint>
namespace pg8 {
#define PG8_LAS __attribute__((address_space(3)))
typedef unsigned short bf16_t;
typedef short bf16x8 __attribute__((ext_vector_type(8)));
typedef float f32x4 __attribute__((ext_vector_type(4)));
typedef unsigned u32x4 __attribute__((ext_vector_type(4)));
constexpr int BM = 256, BK = 64, HALF = 128, HTB = HALF * BK * 2  , STAGE_BYTES = 8 * HTB, NXCD = 8, WGM = 8;

__host__ __device__ __forceinline__ int lds_byte(int r, int c) { const int st = (r >> 4) * 2 + (c >> 5), rr = r & 15, cc = c & 31, ob = rr * 64 + cc * 2; return st * 1024 + (ob ^ (((ob >> 9) & 1) << 5)); }
__host__ __device__ __forceinline__ void stage_rc(int b, int& R, int& C) { const int st = b / 1024, sb = b % 1024, swz = sb ^ (((sb >> 9) & 1) << 5); R = (st >> 1) * 16 + swz / 64; C = (st & 1) * 32 + (swz % 64) / 2; }
__host__ __device__ __forceinline__ int perm32(int rho) { const int n = rho >> 4, i = rho & 15; return 8 * (i >> 2) + 4 * n + (i & 3); }

struct Unit { int pm, pn, part; };
struct Gemm { const bf16_t* A; const bf16_t* Bt; int M, N, K; const bf16_t* A2; const bf16_t* Bt2; };

struct StaticOrder {
    int nM, nN, nwg, G, c;
    __host__ __device__ void init(int M, int N, int G_, int c_) { nM = M / BM; nN = N / BM; nwg = nM * nN; G = G_; c = c_; }
    __host__ __device__ bool next(int i, Unit& u) const {
        const long L = (long)i * G + c; if (L >= nwg) return false;
        int wgid = (int)L; { const int q = nwg / NXCD, r = nwg % NXCD, xcd = wgid % NXCD, off = wgid / NXCD; wgid = (xcd < r ? xcd * (q + 1) : r * (q + 1) + (xcd - r) * q) + off; }
        const int nig = WGM * nN, gid = wgid / nig, fm = gid * WGM, gsz = (nM - fm) < WGM ? (nM - fm) : WGM;
        u.pm = fm + ((wgid % nig) % gsz); u.pn = (wgid % nig) / gsz; u.part = 0; return true;
    }
    __device__ __forceinline__ void a_ready(const Unit&) const {}
    __device__ __forceinline__ void done(const Unit&) const {}
};
struct PairOrder : StaticOrder {
    __host__ __device__ bool next(int i, Unit& u) const { if (!StaticOrder::next(i >> 1, u)) return false; u.part = i & 1; return true; }
};

__device__ __forceinline__ unsigned cvt_pk_bf16(float lo, float hi) { unsigned r; asm volatile("v_cvt_pk_bf16_f32 %0, %1, %2" : "=v"(r) : "v"(lo), "v"(hi)); return r; }
typedef float f32x2 __attribute__((ext_vector_type(2)));
__device__ __forceinline__ f32x2 gelu_pk(f32x2 v) {
    const f32x2 av = __builtin_elementwise_abs(v), d = av * 0.2316418882f + 1.0f;
    f32x2 t; t.x = __builtin_amdgcn_rcpf(d.x); t.y = __builtin_amdgcn_rcpf(d.y);
    f32x2 q = t * 0.5307027145f + (-0.7265760135f); q = q * t + 0.7107068705f; q = q * t + (-0.142248368f); q = q * t + 0.127414796f; q = q * t;
    const f32x2 s = (v * v) * (-0.72134752044f);
    f32x2 e; e.x = __builtin_amdgcn_exp2f(s.x); e.y = __builtin_amdgcn_exp2f(s.y);
    const f32x2 m = v * (q * e), r = v - m;
    f32x2 o; o.x = v.x < 0.f ? m.x : r.x; o.y = v.y < 0.f ? m.y : r.y; return o;
}

__device__ __forceinline__ float sigm(float x) { return 1.0f / (1.0f + __expf(-x)); }
__device__ __forceinline__ f32x4 sigm4(f32x4 v) { return (f32x4){sigm(v[0]), sigm(v[1]), sigm(v[2]), sigm(v[3])}; }

struct EpiF32 {
    static constexpr bool PERM = false, AFTER_DRAIN = false, TWO_PART = false;
    float* C; int ldc;
    __device__ __forceinline__ void operator()(const f32x4 (&acc)[2][2][4][2], const Unit& u, int wr, int wc, int fr, int fq) const {
        const int row0 = u.pm * BM + wr * 64 + fr, col0 = u.pn * BM + wc * 32 + 4 * fq;
#pragma unroll
        for (int ai = 0; ai < 2; ++ai)
#pragma unroll
            for (int m = 0; m < 4; ++m) { float* rowp = C + (size_t)(row0 + ai * HALF + m * 16) * ldc + col0;
#pragma unroll
                for (int bj = 0; bj < 2; ++bj)
#pragma unroll
                    for (int n = 0; n < 2; ++n) *(f32x4*)(rowp + bj * HALF + n * 16) = acc[ai][bj][m][n]; }
    }
};
__device__ __forceinline__ f32x4 bfx4(unsigned lo, unsigned hi) { return (f32x4){__uint_as_float(lo << 16), __uint_as_float(lo & 0xffff0000u), __uint_as_float(hi << 16), __uint_as_float(hi & 0xffff0000u)}; }
__device__ __forceinline__ u32x4 pack8f(f32x4 v0, f32x4 v1) { u32x4 w; w.x = cvt_pk_bf16(v0[0], v0[1]); w.y = cvt_pk_bf16(v0[2], v0[3]); w.z = cvt_pk_bf16(v1[0], v1[1]); w.w = cvt_pk_bf16(v1[2], v1[3]); return w; }
struct EpiIn {
    static constexpr bool PERM = true, AFTER_DRAIN = false, TWO_PART = false;
    bf16_t *QB, *KVB, *SZA, *SZS, *GM, *XC; float *U32, *GN, *out; float qscale; int mp;
    size_t o_kvp, o_kvs, o_winp, o_wins, xc_prow0;
    __device__ __forceinline__ void operator()(const f32x4 (&acc)[2][2][4][2], const Unit& u, int wr, int wc, int fr, int fq) const {
        const int row0 = u.pm * BM + wr * 64 + fr, pn = u.pn; const bool prm = u.pm * BM < mp;
#pragma unroll
        for (int ai = 0; ai < 2; ++ai)
#pragma unroll
            for (int m = 0; m < 4; ++m) { const size_t row = (size_t)(row0 + ai * HALF + m * 16);
#pragma unroll
                for (int bj = 0; bj < 2; ++bj) { const int c = pn * BM + bj * HALF + wc * 32 + 8 * fq; const f32x4 v0 = acc[ai][bj][m][0], v1 = acc[ai][bj][m][1];
                    if (pn < 2) { *(u32x4*)(QB + row * 512 + c) = pack8f(v0 * qscale, v1 * qscale); }
                    else if (pn < 5) { const int kc = c - 512, slot = kc >> 7;
                        *(u32x4*)(KVB + row * 768 + kc) = pack8f(v0, v1);
                        if (slot < 4) { float* d = out + (prm ? o_kvp + row * 512 : o_kvs + (row - mp) * 512) + kc; *(f32x4*)d = v0; *(f32x4*)(d + 4) = v1;
 }
                        else { const int wk = kc - 512;
                            if (prm) { const int t = (int)(row & 8191); if (t >= 7680) { float* d = out + o_winp + ((row >> 13) * 512 + (t - 7680)) * 256 + wk; *(f32x4*)d = v0; *(f32x4*)(d + 4) = v1; } }
                            else { const size_t q = row - mp; float* d = out + o_wins + ((q >> 3) * 512 + 504 + (q & 7)) * 256 + wk; *(f32x4*)d = v0; *(f32x4*)(d + 4) = v1; } } }
                    else if (pn < 7) { *(u32x4*)(SZA + row * 512 + (c - 1280)) = pack8f(v0 * sigm4(v0), v1 * sigm4(v1)); }
                    else if (pn < 9) { float* d = U32 + row * 512 + (c - 1792); *(f32x4*)d = v0; *(f32x4*)(d + 4) = v1; }
                    else if (pn < 11) { *(u32x4*)(SZS + row * 512 + (c - 2304)) = pack8f(v0 * sigm4(v0), v1 * sigm4(v1)); }
                    else if (pn < 19) { *(u32x4*)(GM + row * 2048 + (c - 2816)) = pack8f(sigm4(v0), sigm4(v1)); }
                    else if (c < 4888) { float* d = GN + row * 32 + (c - 4864); *(f32x4*)d = sigm4(v0); *(f32x4*)(d + 4) = sigm4(v1); } } }
    }
};
struct EpiGlu {
    static constexpr bool PERM = true, AFTER_DRAIN = false, TWO_PART = false;
    bf16_t* O; const bf16_t* Y1B; const bf16_t* SZS; const float* bias;
    __device__ __forceinline__ void operator()(const f32x4 (&acc)[2][2][4][2], const Unit& u, int wr, int wc, int fr, int fq) const {
        const int row0 = u.pm * BM + wr * 64 + fr, col0 = u.pn * BM + wc * 32 + 8 * fq;
#pragma unroll
        for (int ai = 0; ai < 2; ++ai)
#pragma unroll
            for (int m = 0; m < 4; ++m) { const size_t row = (size_t)(row0 + ai * HALF + m * 16);
#pragma unroll
                for (int bj = 0; bj < 2; ++bj) { const int c = col0 + bj * HALF;
                    const f32x4 b0 = *(const f32x4*)(bias + c), b1 = *(const f32x4*)(bias + c + 4);
                    const u32x4 yy = *(const u32x4*)(Y1B + row * 512 + c); const f32x4 y0 = bfx4(yy.x, yy.y), y1 = bfx4(yy.z, yy.w);
                    const u32x4 zz = *(const u32x4*)(SZS + row * 512 + c);
                    *(u32x4*)(O + row * 512 + c) = pack8f(y0 * sigm4(acc[ai][bj][m][0] + b0) * bfx4(zz.x, zz.y), y1 * sigm4(acc[ai][bj][m][1] + b1) * bfx4(zz.z, zz.w)); } }
    }
};
struct EpiLift2 {
    static constexpr bool PERM = true, AFTER_DRAIN = false, TWO_PART = true;
    bf16_t* O; const bf16_t* GM;
    __device__ __forceinline__ void mid(f32x4 (&acc)[2][2][4][2], const Unit& u, int wr, int wc, int fr, int fq) const {
        const int row0 = u.pm * BM + wr * 64 + fr, col0 = u.pn * BM + wc * 32 + 8 * fq;
#pragma unroll
        for (int ai = 0; ai < 2; ++ai)
#pragma unroll
            for (int m = 0; m < 4; ++m) { const size_t row = (size_t)(row0 + ai * HALF + m * 16);
#pragma unroll
                for (int bj = 0; bj < 2; ++bj) { const int c = col0 + bj * HALF; const u32x4 ga = *(const u32x4*)(GM + row * 2048 + c), gb = *(const u32x4*)(GM + row * 2048 + 1024 + c);
                    const f32x4 a0 = bfx4(ga.x, ga.y), a1 = bfx4(ga.z, ga.w), b0 = bfx4(gb.x, gb.y), b1 = bfx4(gb.z, gb.w);
#pragma unroll
                    for (int j = 0; j < 4; ++j) { acc[ai][bj][m][0][j] *= b0[j] * __builtin_amdgcn_rcpf(fmaxf(a0[j], 1e-30f)); acc[ai][bj][m][1][j] *= b1[j] * __builtin_amdgcn_rcpf(fmaxf(a1[j], 1e-30f)); } } }
    }
    __device__ __forceinline__ void operator()(const f32x4 (&acc)[2][2][4][2], const Unit& u, int wr, int wc, int fr, int fq) const {
        const int row0 = u.pm * BM + wr * 64 + fr, col0 = u.pn * BM + wc * 32 + 8 * fq;
#pragma unroll
        for (int ai = 0; ai < 2; ++ai)
#pragma unroll
            for (int m = 0; m < 4; ++m) { const size_t row = (size_t)(row0 + ai * HALF + m * 16);
#pragma unroll
                for (int bj = 0; bj < 2; ++bj) { const int c = col0 + bj * HALF; const u32x4 ga = *(const u32x4*)(GM + row * 2048 + c);
                    *(u32x4*)(O + row * 1024 + c) = pack8f(bfx4(ga.x, ga.y) * acc[ai][bj][m][0], bfx4(ga.z, ga.w) * acc[ai][bj][m][1]); } }
    }
};
struct EpiOut {
    static constexpr bool PERM = true, AFTER_DRAIN = false, TWO_PART = false;
    bf16_t* O; const float* xp; const float* xs; int mp;
    __device__ __forceinline__ void operator()(const f32x4 (&acc)[2][2][4][2], const Unit& u, int wr, int wc, int fr, int fq) const {
        const int row0 = u.pm * BM + wr * 64 + fr, col0 = u.pn * BM + wc * 32 + 8 * fq;
        const float* xb = (u.pm * BM < mp) ? xp : (xs - (size_t)mp * 1024);
#pragma unroll
        for (int ai = 0; ai < 2; ++ai)
#pragma unroll
            for (int m = 0; m < 4; ++m) { const size_t row = (size_t)(row0 + ai * HALF + m * 16);
#pragma unroll
                for (int bj = 0; bj < 2; ++bj) { const int c = col0 + bj * HALF;
                    const f32x4 x0 = *(const f32x4*)(xb + row * 1024 + c), x1 = *(const f32x4*)(xb + row * 1024 + c + 4);
                    *(u32x4*)(O + row * 1024 + c) = pack8f(x0 + acc[ai][bj][m][0], x1 + acc[ai][bj][m][1]); } }
    }
};

template <class Epi, class Sched, bool ALIGN_EPI = false, bool SP2 = false>
__device__ __forceinline__ void gemm_phase(PG8_LAS unsigned char* lds, const Gemm g, const Sched& S, const Epi& E, const int tid_in) {
    const int tid = tid_in, wid = __builtin_amdgcn_readfirstlane(tid >> 6), lane = tid & 63, wr = wid >> 2, wc = wid & 3, fr = lane & 15, fq = lane >> 4;
    const int K = g.K, nt = K / BK;
    unsigned voffA[2], voffB[2];
#pragma unroll
    for (int i = 0; i < 2; ++i) { int R, C; stage_rc(tid * 16 + i * 8192, R, C); const int Rb = Epi::PERM ? ((R & ~31) + perm32(R & 31)) : R;
        voffA[i] = (unsigned)(R * K + C) * 2u; voffB[i] = (unsigned)(Rb * K + C) * 2u; }
    const size_t kstep = (size_t)(BK * 2);
    const size_t hstep = (size_t)HALF * K * 2;
    const size_t tstep = 2 * hstep;
    const unsigned ldsw = (unsigned)wid * 1024u;
    const int aoff = lds_byte(wr * 64 + fr, fq * 8), boff = lds_byte(wc * 32 + fr, fq * 8);
#define PG8_SA(b, h) (((b) * 2 + (h)) * HTB)
#define PG8_SB(b, h) ((4 + (b) * 2 + (h)) * HTB)
#define PG8_STAGE(bufoff, gbase, voff) do { _Pragma("unroll") for (int _i = 0; _i < 2; ++_i) \
        __builtin_amdgcn_global_load_lds((const unsigned*)((const char*)(gbase) + (voff)[_i]), (PG8_LAS unsigned*)(lds + (bufoff) + ldsw + _i * 8192), 16, 0, 0); } while (0)
#define PG8_LDA(dst, b, h) do { _Pragma("unroll") for (int m = 0; m < 4; ++m) _Pragma("unroll") for (int k = 0; k < 2; ++k) dst[m][k] = *(const PG8_LAS bf16x8*)(lds + PG8_SA(b, h) + aoff + m * 2048 + k * 1024); } while (0)
#define PG8_LDB(dst, b, h) do { _Pragma("unroll") for (int n = 0; n < 2; ++n) _Pragma("unroll") for (int k = 0; k < 2; ++k) dst[n][k] = *(const PG8_LAS bf16x8*)(lds + PG8_SB(b, h) + boff + n * 2048 + k * 1024); } while (0)
#define PG8_MMA(ai, bj, At, Bt) do { __builtin_amdgcn_s_setprio(1); _Pragma("unroll") for (int m = 0; m < 4; ++m) _Pragma("unroll") for (int n = 0; n < 2; ++n) _Pragma("unroll") for (int k = 0; k < 2; ++k) \
        acc[ai][bj][m][n] = __builtin_amdgcn_mfma_f32_16x16x32_bf16(Bt[n][k], At[m][k], acc[ai][bj][m][n], 0, 0, 0); __builtin_amdgcn_s_setprio(0); } while (0)
#define PG8_WAIT_V(n) asm volatile("s_waitcnt vmcnt(" #n ")" ::: "memory")
#define PG8_WAIT_L(n) asm volatile("s_waitcnt lgkmcnt(" #n ")" ::: "memory")
#define PG8_BAR __builtin_amdgcn_s_barrier()
#define PG8_SCHED __builtin_amdgcn_sched_barrier(0)
    Unit cur, nxt; int ui = 0;
    if (!S.next(0, cur)) return;
    f32x4 acc[2][2][4][2];
#pragma unroll
    for (int a = 0; a < 2; ++a)
#pragma unroll
        for (int b = 0; b < 2; ++b)
#pragma unroll
            for (int m = 0; m < 4; ++m)
#pragma unroll
                for (int n = 0; n < 2; ++n) acc[a][b][m][n] = (f32x4){0.f, 0.f, 0.f, 0.f};
    bf16x8 At[4][2], B0[2][2], B1[2][2];
    const char* cA = (const char*)((Epi::TWO_PART && cur.part) ? g.A2 : g.A) + (size_t)cur.pm * tstep; const char* cB = (const char*)((Epi::TWO_PART && cur.part) ? g.Bt2 : g.Bt) + (size_t)cur.pn * tstep;
    S.a_ready(cur);
    if constexpr (SP2) {
        PG8_STAGE(PG8_SB(0, 0), cB, voffB); PG8_STAGE(PG8_SB(0, 1), cB + hstep, voffB); PG8_STAGE(PG8_SA(0, 0), cA, voffA); PG8_STAGE(PG8_SA(0, 1), cA + hstep, voffA);
        if (wr == 1) PG8_BAR;
        PG8_WAIT_V(2); PG8_BAR;
        PG8_STAGE(PG8_SB(1, 0), cB + kstep, voffB); PG8_STAGE(PG8_SA(1, 0), cA + kstep, voffA); PG8_STAGE(PG8_SB(1, 1), cB + hstep + kstep, voffB);
        PG8_WAIT_V(6); PG8_BAR;
    } else {
        PG8_STAGE(PG8_SB(0, 0), cB, voffB); PG8_STAGE(PG8_SA(0, 0), cA, voffA); PG8_STAGE(PG8_SB(0, 1), cB + hstep, voffB); PG8_STAGE(PG8_SA(0, 1), cA + hstep, voffA);
        if (wr == 1) PG8_BAR;
        PG8_WAIT_V(4); PG8_BAR;
        PG8_STAGE(PG8_SB(1, 0), cB + kstep, voffB); PG8_STAGE(PG8_SA(1, 0), cA + kstep, voffA); PG8_STAGE(PG8_SB(1, 1), cB + hstep + kstep, voffB);
        PG8_WAIT_V(6); PG8_BAR;
    }
    for (;;) {
        const bool has_next = S.next(ui + 1, nxt);
        const char* nA = has_next ? (const char*)((Epi::TWO_PART && nxt.part) ? g.A2 : g.A) + (size_t)nxt.pm * tstep : cA; const char* nB = has_next ? (const char*)((Epi::TWO_PART && nxt.part) ? g.Bt2 : g.Bt) + (size_t)nxt.pn * tstep : cB;
        for (int t = 0; t < nt; t += 2) {
            const bool last = (t == nt - 2);
            const char* a1 = cA + (size_t)(t + 1) * kstep;
            const char* a2 = last ? nA : cA + (size_t)(t + 2) * kstep; const char* b2 = last ? nB : cB + (size_t)(t + 2) * kstep;
            const char* a3 = a2 + kstep; const char* b3 = b2 + kstep;
            if (last && has_next) S.a_ready(nxt);
            if constexpr (SP2) {
            PG8_LDB(B0, 0, 0); PG8_LDB(B1, 0, 1); PG8_SCHED; PG8_LDA(At, 0, 0); PG8_STAGE(PG8_SA(1, 1), a1 + hstep, voffA);
            PG8_WAIT_V(8); PG8_WAIT_L(0); PG8_BAR; PG8_MMA(0, 0, At, B0); PG8_MMA(0, 1, At, B1); PG8_BAR; PG8_SCHED;
            PG8_LDA(At, 0, 1); PG8_STAGE(PG8_SB(0, 0), b2, voffB); PG8_STAGE(PG8_SB(0, 1), b2 + hstep, voffB); PG8_STAGE(PG8_SA(0, 0), a2, voffA);
            PG8_WAIT_V(8); PG8_WAIT_L(0); PG8_BAR; PG8_MMA(1, 0, At, B0); PG8_MMA(1, 1, At, B1); PG8_BAR; PG8_SCHED;
            PG8_LDB(B0, 1, 0); PG8_LDB(B1, 1, 1); PG8_SCHED; PG8_LDA(At, 1, 0); PG8_STAGE(PG8_SA(0, 1), a2 + hstep, voffA);
            PG8_WAIT_V(8); PG8_WAIT_L(0); PG8_BAR; PG8_MMA(0, 0, At, B0); PG8_MMA(0, 1, At, B1); PG8_BAR; PG8_SCHED;
            PG8_LDA(At, 1, 1); PG8_STAGE(PG8_SB(1, 0), b3, voffB); PG8_STAGE(PG8_SB(1, 1), b3 + hstep, voffB); PG8_STAGE(PG8_SA(1, 0), a3, voffA);
            PG8_WAIT_V(8); PG8_WAIT_L(0); PG8_BAR; PG8_MMA(1, 0, At, B0); PG8_MMA(1, 1, At, B1); PG8_BAR; PG8_SCHED;
            } else {
            PG8_LDB(B0, 0, 0); PG8_SCHED; PG8_LDA(At, 0, 0); PG8_STAGE(PG8_SA(1, 1), a1 + hstep, voffA);
            PG8_WAIT_L(8); PG8_BAR; PG8_WAIT_L(0); PG8_MMA(0, 0, At, B0); PG8_BAR; PG8_SCHED;
            PG8_LDB(B1, 0, 1); PG8_STAGE(PG8_SB(0, 0), b2, voffB);
            PG8_BAR; PG8_WAIT_L(0); PG8_MMA(0, 1, At, B1); PG8_BAR;
            PG8_LDA(At, 0, 1); PG8_STAGE(PG8_SA(0, 0), a2, voffA);
            PG8_BAR; PG8_WAIT_L(0); PG8_MMA(1, 0, At, B0); PG8_BAR; PG8_SCHED;
            PG8_STAGE(PG8_SB(0, 1), b2 + hstep, voffB);
            PG8_WAIT_V(6); PG8_BAR; PG8_MMA(1, 1, At, B1); PG8_BAR;
            PG8_LDB(B0, 1, 0); PG8_SCHED; PG8_LDA(At, 1, 0); PG8_STAGE(PG8_SA(0, 1), a2 + hstep, voffA);
            PG8_WAIT_L(8); PG8_BAR; PG8_WAIT_L(0); PG8_MMA(0, 0, At, B0); PG8_BAR; PG8_SCHED;
            PG8_LDB(B1, 1, 1); PG8_STAGE(PG8_SB(1, 0), b3, voffB);
            PG8_BAR; PG8_WAIT_L(0); PG8_MMA(0, 1, At, B1); PG8_BAR;
            PG8_LDA(At, 1, 1); PG8_STAGE(PG8_SA(1, 0), a3, voffA);
            PG8_BAR; PG8_WAIT_L(0); PG8_MMA(1, 0, At, B0); PG8_BAR; PG8_SCHED;
            PG8_STAGE(PG8_SB(1, 1), b3 + hstep, voffB);
            PG8_WAIT_V(6); PG8_BAR; PG8_MMA(1, 1, At, B1); PG8_BAR;
            }
        }
        if constexpr (ALIGN_EPI) { if (wr == 0) PG8_BAR; }
        bool keep_acc = false;
        if constexpr (Epi::TWO_PART) { if (cur.part == 0) { E.mid(acc, cur, wr, wc, fr, fq); keep_acc = true; } else { E(acc, cur, wr, wc, fr, fq); } }
        else if constexpr (!Epi::AFTER_DRAIN) { E(acc, cur, wr, wc, fr, fq); S.done(cur); }
        if (!has_next) break;
        if (!keep_acc)
#pragma unroll
        for (int a = 0; a < 2; ++a)
#pragma unroll
            for (int b = 0; b < 2; ++b)
#pragma unroll
                for (int m = 0; m < 4; ++m)
#pragma unroll
                    for (int n = 0; n < 2; ++n) acc[a][b][m][n] = (f32x4){0.f, 0.f, 0.f, 0.f};
        cur = nxt; cA = nA; cB = nB; ++ui;
        if constexpr (ALIGN_EPI) { if (wr == 1) PG8_BAR; }
    }
    PG8_WAIT_V(0);
    if constexpr (!ALIGN_EPI) { if (wr == 0) PG8_BAR; }
    PG8_BAR;
    if constexpr (Epi::AFTER_DRAIN) { E.fused(acc, cur, wr, wc, fr, fq, lds, wid, lane); S.done(cur); }
#undef PG8_SA
#undef PG8_SB
#undef PG8_STAGE
#undef PG8_LDA
#undef PG8_LDB
#undef PG8_MMA
#undef PG8_WAIT_V
#undef PG8_WAIT_L
#undef PG8_BAR
#undef PG8_SCHED
}
}
#define LAS __attribute__((address_space(3)))
#define XB_TMO      128
#define XB_XCNT(j)  (256  + 64 * (j))
#define XB_XSUB(j)  (1280 + 64 * (j))
#define XB_XGEN(j)  (2304 + 64 * (j))
#define XB_TOP      3328
#define XB_TOPGEN   3392
#define XCD_BAR_WORDS 3456
#define XB_SPIN_CAP (1u << 18)

__device__ __forceinline__ unsigned xb_ld(unsigned* p)              { return __hip_atomic_load(p, __ATOMIC_RELAXED, __HIP_MEMORY_SCOPE_AGENT); }
__device__ __forceinline__ unsigned xb_add(unsigned* p, unsigned v) { return __hip_atomic_fetch_add(p, v, __ATOMIC_RELAXED, __HIP_MEMORY_SCOPE_AGENT); }
__device__ __forceinline__ unsigned xb_xcc_id() { return (unsigned)__builtin_amdgcn_s_getreg((3 << 11) | 20) & 0xFu; }
#define XB_SPIN(cond, bar) do { unsigned _sp = 0; while (cond) { __builtin_amdgcn_s_sleep(1); \
    if ((++_sp & 255u) == 0u) { if (xb_ld(&(bar)[XB_TMO])) break; if (_sp > XB_SPIN_CAP) { atomicAdd(&(bar)[XB_TMO], 1u); break; } } } } while (0)

struct XcdBarrier {
    unsigned* bar; unsigned x;
    volatile LAS unsigned* st;
};

__device__ __forceinline__ XcdBarrier xcd_barrier_post(unsigned* bar, volatile LAS unsigned* st, const int tid) {
    XcdBarrier b; b.bar = bar; b.x = xb_xcc_id(); b.st = st;
    if (tid == 0) (void)xb_add(&bar[XB_XCNT(b.x)], 1u);
    return b;
}
__device__ __forceinline__ void xcd_barrier_complete(unsigned* bar, unsigned x, unsigned& nloc, unsigned& nx) {
    const unsigned G = gridDim.x * gridDim.y * gridDim.z;
    unsigned sum, cnt, mine, sp = 0u;
    for (;;) {
        sum = 0u; cnt = 0u; mine = 0u;
#pragma unroll
        for (unsigned j = 0; j < 16; ++j) { const unsigned c = xb_ld(&bar[XB_XCNT(j)]); sum += c; cnt += (c > 0u) ? 1u : 0u; mine = (j == x) ? c : mine; }
        if (sum == G) break;
        __builtin_amdgcn_s_sleep(1);
        if ((++sp & 255u) == 0u) { if (xb_ld(&bar[XB_TMO])) break; if (sp > XB_SPIN_CAP) { atomicAdd(&bar[XB_TMO], 1u); break; } }
    }
    nloc = mine > 0u ? mine : 1u; nx = cnt > 0u ? cnt : 1u;
}

__device__ __forceinline__ void xcd_barrier(const XcdBarrier& b, const int tid) {
    asm volatile("s_waitcnt vmcnt(0)" ::: "memory");
    __syncthreads();
    if (tid == 0) {
        unsigned* bar = b.bar;
        __builtin_amdgcn_s_waitcnt(0);
        unsigned nloc = b.st[0], nx = b.st[1];
        if (nloc == 0u) { xcd_barrier_complete(bar, b.x, nloc, nx); b.st[0] = nloc; b.st[1] = nx; }
        const unsigned old = xb_add(&bar[XB_XSUB(b.x)], 1u);
        const unsigned gen = old / nloc;
        if (old + 1u == (gen + 1u) * nloc) {
            __builtin_amdgcn_fence(__ATOMIC_RELEASE, "agent");
            asm volatile("s_waitcnt vmcnt(0)" ::: "memory");
            const unsigned og = xb_add(&bar[XB_TOP], 1u);
            const unsigned tg = og / nx;
            if (og + 1u == (tg + 1u) * nx) xb_add(&bar[XB_TOPGEN], 1u);
            else XB_SPIN(xb_ld(&bar[XB_TOPGEN]) == tg, bar);
            __builtin_amdgcn_fence(__ATOMIC_ACQUIRE, "agent");
            xb_add(&bar[XB_XGEN(b.x)], 1u);
            asm volatile("s_waitcnt vmcnt(0)" ::: "memory");
        } else {
            XB_SPIN(xb_ld(&bar[XB_XGEN(b.x)]) == gen, bar);
            __builtin_amdgcn_fence(__ATOMIC_ACQUIRE, "agent");
            asm volatile("s_waitcnt vmcnt(0)" ::: "memory");
        }
    }
    __syncthreads();
}


constexpr int D = 1024, BP = 4, LP = 8192, BS = 32, LS = 8, PAST = 16384, PAGE = 128, NPAGE = 128;
constexpr int MP = BP * LP, MS = BS * LS, MT = MP + MS;
constexpr int HD = 64, DATT = 512, DSSM = 512, NG = 32, NST = 64;
constexpr int NIN = 4888, NINP = 5120;
constexpr int C_Q = 0, C_KV = 512, C_ZA = 1280, C_U = 1792, C_ZS = 2304, C_GM = 2816, C_GN = 4864;
constexpr int NCS = 1024, NCP = 512;
constexpr int XC_S_ROWS = BS * 2 * 2 * NCS, XC_P_ROWS = BP * 2 * 2 * NCP, XC_ROWS = XC_S_ROWS + XC_P_ROWS;
constexpr int CH = 128, NCHK = LP / CH;
constexpr float RMS_EPS = 1e-6f;
constexpr size_t O_YP = 0, O_YS = 33554432, O_KVP = 33816576, O_WINP = 50593792, O_SRP = 51118080, O_SIP = 51126272, O_KVS = 51134464, O_WINS = 51265536, O_SRS = 55459840, O_SIS = 55525376, O_END = 55590912;
constexpr size_t MiB = 1u << 20;
constexpr size_t WS_CTL = 0, CTL_ZERO_BYTES = 1 * MiB;
constexpr size_t WS_WTIN = 1 * MiB, WS_WTGLU = 11 * MiB, WS_WTLA = 12 * MiB, WS_WTLS = 13 * MiB, WS_WTOUT = 14 * MiB, WS_WTC1 = 16 * MiB, WS_CONST = 17 * MiB, WS_SEND = 20 * MiB  ;
constexpr size_t WS_KC = 20 * MiB, WS_VC = 38 * MiB, WS_XN = 64 * MiB, WS_OA = 130 * MiB, WS_Y1B = 164 * MiB, WS_YB = 198 * MiB, WS_MG = 232 * MiB, WS_Y1 = 298 * MiB, WS_MB = 364 * MiB;
constexpr size_t WS_PP = 494 * MiB, WS_XC = 632 * MiB, WS_KVB = 904 * MiB, WS_SZA = 956 * MiB, WS_U32 = 992 * MiB, WS_SZS = 1060 * MiB, WS_GM = 1096 * MiB, WS_GN = 1228 * MiB;
constexpr size_t WS_QB = 1552 * MiB, WS_KSB = 1586 * MiB, WS_KWB = 1596 * MiB, WS_VST = 1606 * MiB, WS_VWT = 1614 * MiB, WS_KCB = 1622 * MiB, WS_VCT = 1623 * MiB, WS_KCBS = 1624 * MiB, WS_VCBS = 1632 * MiB, WS_OT = 1640 * MiB  , WS_END = 1672 * MiB;
constexpr int K_CB = 0  , K_CBP = 80000  , K_ARE = 256, K_AIM = K_ARE + 2048, K_ALRE = K_AIM + 2048, K_ALIM = K_ALRE + 2048, K_BBRE = K_ALIM + 2048, K_BBIM = K_BBRE + 32768;
constexpr size_t WS_SSMCF = WS_CONST + 512 * 1024;
constexpr size_t WS_SSMW = 632 * MiB;
constexpr size_t WS_TEND = WS_CONST + 1 * MiB;
constexpr size_t WS_YPB = 364 * MiB;
constexpr int CW_BAR = 4096;
constexpr int LDS_BYTES = 163840, MISC_OFF = LDS_BYTES - 256;
constexpr int NWAVES = 8;


typedef unsigned short bf16;
typedef unsigned v4u __attribute__((ext_vector_type(4)));
typedef unsigned v2u __attribute__((ext_vector_type(2)));
typedef float f32x4 __attribute__((ext_vector_type(4)));
#define LDS_FENCE() asm volatile("s_waitcnt lgkmcnt(0)" ::: "memory")
__device__ __forceinline__ unsigned f2bf(float f) { unsigned u = __builtin_bit_cast(unsigned, f); return (u + 0x7fffu + ((u >> 16) & 1u)) >> 16; }
__device__ __forceinline__ unsigned pk2(float lo, float hi) { return f2bf(lo) | (f2bf(hi) << 16); }
__device__ __forceinline__ float wave_sum(float v) {
#pragma unroll
    for (int o = 1; o < 64; o <<= 1) v += __shfl_xor(v, o);
    return v; }
__device__ __forceinline__ float wave_max(float v) {
#pragma unroll
    for (int o = 1; o < 64; o <<= 1) v = fmaxf(v, __shfl_xor(v, o));
    return v; }
__device__ __forceinline__ float sigmf(float x) { return 1.0f / (1.0f + __expf(-x)); }
__device__ __forceinline__ float gelu_t(float x) { const float u = 1.5957691216f * (x + 0.044715f * x * x * x); return x / (1.0f + __expf(-u)); }

struct Ctx {
    LAS unsigned char* lds; int tid, lane, wave, G, gw, NGW;
    const float *xp, *xs, *cache_kv, *cache_win, *st_re, *st_im; const int* page_table;
    const float *norm_g, *w_in, *cmp_pe, *cmp_w1, *cmp_b1, *cmp_w2, *lam_re, *lam_im, *log_dt, *b_re, *b_im, *c_re, *c_im, *ssm_d, *w_glu, *b_glu, *w_la, *w_ls, *w_out, *final_g;
    float* out; unsigned char* ws;
    bf16 *WTIN, *WTGLU, *WTLA, *WTLS, *WTOUT, *WTC1, *XN, *OA, *Y1B, *YB, *MG, *XC, *QB, *KSB, *KWB, *VST, *VWT, *KCB, *VCT, *KCBS, *VCBS, *KVB, *SZA, *SZS, *GM;
    float *KST, *SEND, *KC, *VC, *Y1, *MB, *PP, *U32, *GN;
};

__device__ __forceinline__ void transpose_item(const float* W, int ldw, int nvalid, int nblk, int K, bf16* WT, int row_off, LAS float* scr, int item, int lane) {
    const int kb = item / nblk, nb = item % nblk, k0 = 64 * kb, n0 = 32 * nb;
    const int n = n0 + (lane & 31);
#pragma unroll 8
    for (int i = 0; i < 32; ++i) { const int kk = 2 * i + (lane >> 5); scr[kk * 33 + (lane & 31)] = (n < nvalid) ? W[(size_t)(k0 + kk) * ldw + n] : 0.f; }
    LDS_FENCE();
    const int c = lane & 7;
#pragma unroll
    for (int j = 0; j < 4; ++j) { const int nn = (lane >> 3) + 8 * j; const LAS float* s = scr + (8 * c) * 33 + nn;
        v4u o; o.x = pk2(s[0 * 33], s[1 * 33]); o.y = pk2(s[2 * 33], s[3 * 33]); o.z = pk2(s[4 * 33], s[5 * 33]); o.w = pk2(s[6 * 33], s[7 * 33]);
        *(v4u*)(WT + (size_t)(row_off + n0 + nn) * K + k0 + 8 * c) = o; }
    LDS_FENCE();
}
__device__ __forceinline__ void rms_row_to_bf16(const float* xrow, const float* g, bf16* orow, int lane) {
    const f32x4* xr = (const f32x4*)xrow + lane; const f32x4* gr = (const f32x4*)g + lane;
    f32x4 v[4]; float s = 0.f;
#pragma unroll
    for (int j = 0; j < 4; ++j) { v[j] = xr[64 * j]; s += (v[j].x * v[j].x + v[j].y * v[j].y) + (v[j].z * v[j].z + v[j].w * v[j].w); }
    const float r = rsqrtf(wave_sum(s) * (1.f / D) + RMS_EPS);
    v2u* o8 = (v2u*)orow + lane;
#pragma unroll
    for (int j = 0; j < 4; ++j) { const f32x4 gg = gr[64 * j]; v2u o; o.x = pk2(v[j].x * r * gg.x, v[j].y * r * gg.y); o.y = pk2(v[j].z * r * gg.z, v[j].w * r * gg.w); o8[64 * j] = o; }
}
__device__ __forceinline__ void xc_chunk(const float* src0, size_t rstride, bf16* XC, size_t rowbase  , size_t hstride, size_t sstride, int lane) {
    const int col = 4 * lane, slot = col >> 7, h = (col >> 6) & 1, d = col & 63;
    bf16* dst = XC + (rowbase + (size_t)h * hstride + (size_t)slot * sstride) * 1024 + d;
#pragma unroll 4
    for (int j = 0; j < 16; ++j) { const f32x4 v = *(const f32x4*)(src0 + (size_t)j * rstride + col); v2u o; o.x = pk2(v.x, v.y); o.y = pk2(v.z, v.w); *(v2u*)(dst + j * 64) = o; }
}
__device__ __forceinline__ void p0_prep(const Ctx& C) {
    LAS float* scr = (LAS float*)(C.lds + C.wave * 16384);
    constexpr int I_IN = 16 * 160, I_GLU = 8 * 16, I_LA = 8 * 32, I_LS = 8 * 32, I_OUT = 16 * 32, I_C1 = 16 * 2;
    constexpr int NIT = I_IN + I_GLU + I_LA + I_LS + I_OUT + 4 * I_C1;
    for (int it = C.gw; it < NIT; it += C.NGW) {
        int r = it;
        if (r < I_IN) { const int nb = r % 160, n0 = 32 * nb;
            const int src0 = n0 < 1280 ? n0 : (n0 < 4864 ? n0 + 24 : 1280), nv = n0 < 4864 ? 32 : (n0 == 4864 ? 24 : 0);
            transpose_item(C.w_in + src0 - n0, NIN, n0 + nv, 160, 1024, C.WTIN, 0, scr, r, C.lane); continue; } r -= I_IN;
        if (r < I_GLU) { transpose_item(C.w_glu, 512, 512, 16, 512, C.WTGLU, 0, scr, r, C.lane); continue; } r -= I_GLU;
        if (r < I_LA) { transpose_item(C.w_la, 1024, 1024, 32, 512, C.WTLA, 0, scr, r, C.lane); continue; } r -= I_LA;
        if (r < I_LS) { transpose_item(C.w_ls, 1024, 1024, 32, 512, C.WTLS, 0, scr, r, C.lane); continue; } r -= I_LS;
        if (r < I_OUT) { transpose_item(C.w_out, 1024, 1024, 32, 1024, C.WTOUT, 0, scr, r, C.lane); continue; } r -= I_OUT;
        { const int q = r / I_C1, s = q >> 1, rr = q & 1;
          transpose_item(C.cmp_w1 + (size_t)(s * 32 + rr * 16) * 4096, 64, 64, 2, 1024, C.WTC1, s * 128 + rr * 64, scr, r % I_C1, C.lane); }
    }
    for (int m0 = C.gw; m0 < MT; m0 += 2 * C.NGW) {
        const int m1 = m0 + C.NGW < MT ? m0 + C.NGW : m0;
        const float* x0 = m0 < MP ? C.xp + (size_t)m0 * D : C.xs + (size_t)(m0 - MP) * D; const float* x1 = m1 < MP ? C.xp + (size_t)m1 * D : C.xs + (size_t)(m1 - MP) * D;
        f32x4 va[4], vb[4]; float sa = 0.f, sb = 0.f;
#pragma unroll
        for (int j = 0; j < 4; ++j) { va[j] = ((const f32x4*)x0)[C.lane + 64 * j]; vb[j] = ((const f32x4*)x1)[C.lane + 64 * j]; }
#pragma unroll
        for (int j = 0; j < 4; ++j) { sa += (va[j].x * va[j].x + va[j].y * va[j].y) + (va[j].z * va[j].z + va[j].w * va[j].w); sb += (vb[j].x * vb[j].x + vb[j].y * vb[j].y) + (vb[j].z * vb[j].z + vb[j].w * vb[j].w); }
        const float ra = rsqrtf(wave_sum(sa) * (1.f / D) + RMS_EPS), rb = rsqrtf(wave_sum(sb) * (1.f / D) + RMS_EPS);
#pragma unroll
        for (int j = 0; j < 4; ++j) { const f32x4 gg = ((const f32x4*)C.norm_g)[C.lane + 64 * j];
            v2u o; o.x = pk2(va[j].x * ra * gg.x, va[j].y * ra * gg.y); o.y = pk2(va[j].z * ra * gg.z, va[j].w * ra * gg.w); ((v2u*)(C.XN + (size_t)m0 * D))[C.lane + 64 * j] = o;
            if (m1 != m0) { v2u o1; o1.x = pk2(vb[j].x * rb * gg.x, vb[j].y * rb * gg.y); o1.y = pk2(vb[j].z * rb * gg.z, vb[j].w * rb * gg.w); ((v2u*)(C.XN + (size_t)m1 * D))[C.lane + 64 * j] = o1; } }
    }
    for (int j = C.gw * 64 + C.lane; j < NG * NST * 16; j += C.NGW * 64) {
        const int i = j >> 4, c = j & 15, g = i >> 6;
        const double dt = exp((double)C.log_dt[g]), lr = (double)C.lam_re[i], li = (double)C.lam_im[i];
        const double mag = exp(lr * dt), ar = mag * cos(li * dt), ai = mag * sin(li * dt);
        const double den = lr * lr + li * li, fr = ((ar - 1.0) * lr + ai * li) / den, fi = (ai * lr - (ar - 1.0) * li) / den;
        if (c == 0) { const double magL = exp(lr * dt * CH), aLr = magL * cos(li * dt * CH), aLi = magL * sin(li * dt * CH);
            C.KST[K_ARE + i] = (float)ar; C.KST[K_AIM + i] = (float)ai; C.KST[K_ALRE + i] = (float)aLr; C.KST[K_ALIM + i] = (float)aLi; }
        const double br = (double)C.b_re[i * 16 + c], bi = (double)C.b_im[i * 16 + c];
        C.KST[K_BBRE + i * 16 + c] = (float)(fr * br - fi * bi); C.KST[K_BBIM + i * 16 + c] = (float)(fr * bi + fi * br);
        { bf16* CF = (bf16*)(C.ws + WS_SSMCF); const int pp = i & 63; const size_t o = ((size_t)g * 16 + c) * 128 + 2 * pp;
          CF[o] = (bf16)f2bf(C.c_re[((size_t)g * 16 + c) * 64 + pp]); CF[o + 1] = (bf16)f2bf(-C.c_im[((size_t)g * 16 + c) * 64 + pp]); }
    }
    for (int j = ((C.gw + C.NGW - 512) % C.NGW) * 64 + C.lane; j < NG * NST * (CH / 8); j += C.NGW * 64) {
        const int tb = j & (CH / 8 - 1), i = j >> 4, g = i >> 6, pp = i & 63;
        const double dt = exp((double)C.log_dt[g]), lr = (double)C.lam_re[i], li = (double)C.lam_im[i];
        const double mag = exp(lr * dt), ar = mag * cos(li * dt), ai = mag * sin(li * dt);
        const double den = lr * lr + li * li, fr = ((ar - 1.0) * lr + ai * li) / den, fi = (ai * lr - (ar - 1.0) * li) / den;
        const double dd = (double)(CH - 8 - 8 * tb), magd = exp(lr * dt * dd), pr = magd * cos(li * dt * dd), pi = magd * sin(li * dt * dd);
        double gr = pr * fr - pi * fi, gi = pr * fi + pi * fr;
        bf16* W0 = (bf16*)(C.ws + WS_SSMW); const size_t olo = (size_t)NG * 128 * 2048;
#pragma unroll 1
        for (int tt = 7; tt >= 0; --tt) {
            unsigned hr[8], hi_[8], lr_[8], li_[8];
#pragma unroll
            for (int c2 = 0; c2 < 8; ++c2) { unsigned vh[2][2], vl[2][2];
#pragma unroll
                for (int e = 0; e < 2; ++e) { const int c = 2 * c2 + e; const double br = (double)C.b_re[i * 16 + c], bi = (double)C.b_im[i * 16 + c];
                    const float wr = (float)(gr * br - gi * bi), wi = (float)(gr * bi + gi * br);
                    const unsigned h0 = f2bf(wr), h1 = f2bf(wi);
                    vh[0][e] = h0; vh[1][e] = h1; vl[0][e] = f2bf(wr - __uint_as_float(h0 << 16)); vl[1][e] = f2bf(wi - __uint_as_float(h1 << 16)); }
                hr[c2] = vh[0][0] | (vh[0][1] << 16); hi_[c2] = vh[1][0] | (vh[1][1] << 16); lr_[c2] = vl[0][0] | (vl[0][1] << 16); li_[c2] = vl[1][0] | (vl[1][1] << 16); }
            const size_t ore = ((size_t)g * 128 + pp) * 2048 + (8 * tb + tt) * 16, oim = ore + (size_t)64 * 2048;
            *(v4u*)(W0 + ore) = (v4u){hr[0], hr[1], hr[2], hr[3]}; *(v4u*)(W0 + ore + 8) = (v4u){hr[4], hr[5], hr[6], hr[7]};
            *(v4u*)(W0 + oim) = (v4u){hi_[0], hi_[1], hi_[2], hi_[3]}; *(v4u*)(W0 + oim + 8) = (v4u){hi_[4], hi_[5], hi_[6], hi_[7]};
            *(v4u*)(W0 + olo + ore) = (v4u){lr_[0], lr_[1], lr_[2], lr_[3]}; *(v4u*)(W0 + olo + ore + 8) = (v4u){lr_[4], lr_[5], lr_[6], lr_[7]};
            *(v4u*)(W0 + olo + oim) = (v4u){li_[0], li_[1], li_[2], li_[3]}; *(v4u*)(W0 + olo + oim + 8) = (v4u){li_[4], li_[5], li_[6], li_[7]};
            const double ngr = gr * ar - gi * ai, ngi = gr * ai + gi * ar; gr = ngr; gi = ngi;
        }
    }
    for (int it = C.gw - 64; it >= 0 && it < 64; it += C.NGW) { const int s = it >> 5, part = it & 31;
        float acc = (part == 0) ? C.cmp_b1[s * 64 + C.lane] : 0.f;
#pragma unroll 16
        for (int k = part * 64; k < part * 64 + 64; ++k) acc += C.cmp_pe[s * 2048 + k] * C.cmp_w1[(size_t)s * 131072 + (size_t)k * 64 + C.lane];
        C.KST[K_CBP + (s * 32 + part) * 64 + C.lane] = acc;
    }
}
constexpr int C1_PITCH = 2080, C1_BUF = 16 * C1_PITCH;
constexpr int C1_ITEMS_S = BS * NPAGE, C1_ITEMS_P = BP * (LP / 128), C1_ITEMS = C1_ITEMS_S + C1_ITEMS_P;
typedef short c1_bf16x8 __attribute__((ext_vector_type(8)));
__device__ __forceinline__ void c1_issue(const Ctx& C, f32x4 (&st)[8], int item, int slot, int r0, int i5) {
    if (item < C1_ITEMS_S) { const int b = item >> 7, pg = item & 127, page = C.page_table[b * NPAGE + pg];
        const float* src = C.cache_kv + ((size_t)page * PAGE + r0) * 512 + slot * 128 + 4 * i5;
#pragma unroll
        for (int it = 0; it < 8; ++it) st[it] = *(const f32x4*)(src + (size_t)it * 16 * 512); }
    else { const int q = item - C1_ITEMS_S, b = q >> 6, pg = q & 63; const bf16* src = C.KVB + ((size_t)b * LP + (size_t)pg * 128 + r0) * 768 + slot * 128 + 4 * i5;
#pragma unroll
        for (int it = 0; it < 8; ++it) { const v2u v = *(const v2u*)(src + (size_t)it * 16 * 768); st[it] = (f32x4){__uint_as_float(v.x << 16), __uint_as_float(v.x & 0xffff0000u), __uint_as_float(v.y << 16), __uint_as_float(v.y & 0xffff0000u)}; } }
}
__device__ __forceinline__ void p2_cmp1(const Ctx& C) {
    const int tid = C.tid, lane = C.lane, w = C.wave;
    const int half = C.G / 2, slot = ((int)blockIdx.x >= half) ? 1 : 0, wg = (int)blockIdx.x - slot * half, nwg = slot ? C.G - half : half;
    c1_bf16x8 Bf[32];
    { const bf16* bp = C.WTC1 + (size_t)(slot * 128 + 16 * w + (lane & 15)) * 1024 + 8 * (lane >> 4);
#pragma unroll
      for (int ks = 0; ks < 32; ++ks) Bf[ks] = *(const c1_bf16x8*)(bp + 32 * ks); }
    const int r0 = tid >> 5, i5 = tid & 31, hh = i5 >> 4, d4 = (i5 & 15) * 4;
    f32x4 st[8];
    int item = wg, buf = 0;
    if (item < C1_ITEMS) c1_issue(C, st, item, slot, r0, i5);
    for (; item < C1_ITEMS; item += nwg, buf ^= 1) {
        LAS unsigned char* X = C.lds + buf * C1_BUF;
#pragma unroll
        for (int it = 0; it < 8; ++it) { const int r = r0 + 16 * it; v2u o; o.x = pk2(st[it].x, st[it].y); o.y = pk2(st[it].z, st[it].w);
            *(LAS v2u*)(X + ((r >> 4) * 2 + hh) * C1_PITCH + ((r & 15) * 64 + d4) * 2) = o; }
        LDS_FENCE(); __syncthreads();
        if (item + nwg < C1_ITEMS) c1_issue(C, st, item + nwg, slot, r0, i5);
        f32x4 acc = (f32x4){0.f, 0.f, 0.f, 0.f};
        const LAS unsigned char* ap = X + (lane & 15) * C1_PITCH + (lane >> 4) * 16;
#pragma unroll
        for (int ks = 0; ks < 32; ++ks) acc = __builtin_amdgcn_mfma_f32_16x16x32_bf16(*(const LAS c1_bf16x8*)(ap + 64 * ks), Bf[ks], acc, 0, 0, 0);
        const bool smp = item < C1_ITEMS_S; const int q = smp ? item : item - C1_ITEMS_S;
        const size_t seq0 = (size_t)(smp ? (q >> 7) : (q >> 6)) * 4 + slot; const int ch0 = (smp ? (q & 127) : (q & 63)) * 8, NC = smp ? NCS : NCP;
        float* pp = C.PP + (smp ? (size_t)0 : (size_t)XC_S_ROWS * 128);
#pragma unroll
        for (int r = 0; r < 4; ++r) { const int m = 4 * (lane >> 4) + r, chunk = ch0 + (m >> 1), h = m & 1;
            pp[((seq0 + 2 * h) * NC + chunk) * 128 + 16 * w + (lane & 15)] = acc[r]; }
    }
    __syncthreads();
}
__device__ __forceinline__ void ssm_load_u(const Ctx& C, LAS float* U, size_t row0, int g, int nt, int lane) {
    const int t = lane >> 1, hf = lane & 1;
    if (t < nt) { const float* p = C.U32 + (row0 + t) * 512 + g * 16 + hf * 8; const f32x4 a = *(const f32x4*)p, b = *(const f32x4*)(p + 4);
        *(LAS f32x4*)(U + t * 16 + hf * 8) = a; *(LAS f32x4*)(U + t * 16 + hf * 8 + 4) = b; }
    LDS_FENCE();
}
__device__ __forceinline__ void ssm_issue_u(const Ctx& C, size_t row0, int g, int nt, int lane, f32x4& ua, f32x4& ub) {
    const int t = lane >> 1, hf = lane & 1;
    if (t < nt) { const float* p = C.U32 + (row0 + t) * 512 + g * 16 + hf * 8; ua = *(const f32x4*)p; ub = *(const f32x4*)(p + 4); }
}
typedef float f32x2 __attribute__((ext_vector_type(2)));
#define SFMAC(acc, a, b) asm("v_fmac_f32 %0, %1, %2" : "+v"(acc) : "v"(a), "v"(b))
#define SMUL(d, a, b) asm("v_mul_f32 %0, %1, %2" : "=v"(d) : "v"(a), "v"(b))
__device__ __forceinline__ unsigned ssm_cvt_pk(float lo, float hi) { unsigned r; asm("v_cvt_pk_bf16_f32 %0, %1, %2" : "=v"(r) : "v"(lo), "v"(hi)); return r; }
struct SsmCoef { float are, aim, naim; float bre[16], bim[16]; };
__device__ __forceinline__ void ssm_coef(const Ctx& C, SsmCoef& K, int g, int lane) {
    const int i = g * 64 + lane; K.are = C.KST[K_ARE + i]; K.aim = C.KST[K_AIM + i]; K.naim = -K.aim;
#pragma unroll
    for (int c = 0; c < 16; ++c) { K.bre[c] = C.KST[K_BBRE + i * 16 + c]; K.bim[c] = C.KST[K_BBIM + i * 16 + c]; }
}
__device__ __forceinline__ void ssm_step2(const SsmCoef& K, const LAS float* u, float& hr, float& hi, unsigned& pk0, unsigned& pk1) {
    f32x4 ua[4], ub[4];
#pragma unroll
    for (int c4 = 0; c4 < 4; ++c4) { ua[c4] = *(const LAS f32x4*)(u + 4 * c4); ub[c4] = *(const LAS f32x4*)(u + 16 + 4 * c4); }
    float ra, ia, rb, ib;
    SMUL(ra, K.bre[0], ua[0][0]); SMUL(ia, K.bim[0], ua[0][0]); SMUL(rb, K.bre[0], ub[0][0]); SMUL(ib, K.bim[0], ub[0][0]);
#pragma unroll
    for (int c = 1; c < 16; ++c) { SFMAC(ra, K.bre[c], ua[c >> 2][c & 3]); SFMAC(ia, K.bim[c], ua[c >> 2][c & 3]); SFMAC(rb, K.bre[c], ub[c >> 2][c & 3]); SFMAC(ib, K.bim[c], ub[c >> 2][c & 3]); }
    SFMAC(ra, K.are, hr); SFMAC(ia, K.are, hi); SFMAC(ra, K.naim, hi); SFMAC(ia, K.aim, hr); hr = ra; hi = ia; pk0 = ssm_cvt_pk(hr, hi);
    SFMAC(rb, K.are, hr); SFMAC(ib, K.are, hi); SFMAC(rb, K.naim, hi); SFMAC(ib, K.aim, hr); hr = rb; hi = ib; pk1 = ssm_cvt_pk(hr, hi);
}
typedef short p1_bf16x8 __attribute__((ext_vector_type(8)));
constexpr int P1_PITCH = 132;
__device__ __forceinline__ void p1_split(const f32x4 x0, const f32x4 x1, p1_bf16x8& hi, p1_bf16x8& lo) {
    v4u h, l; float r[8] = {x0.x, x0.y, x0.z, x0.w, x1.x, x1.y, x1.z, x1.w}; unsigned hw[4], lw[4];
#pragma unroll
    for (int e = 0; e < 4; ++e) { const unsigned w = pk2(r[2 * e], r[2 * e + 1]); hw[e] = w;
        lw[e] = pk2(r[2 * e] - __uint_as_float(w << 16), r[2 * e + 1] - __uint_as_float(w & 0xffff0000u)); }
    h = (v4u){hw[0], hw[1], hw[2], hw[3]}; l = (v4u){lw[0], lw[1], lw[2], lw[3]};
    hi = __builtin_bit_cast(p1_bf16x8, h); lo = __builtin_bit_cast(p1_bf16x8, l);
}
__device__ __forceinline__ void p2_ssm_pass1(const Ctx& C) {
    const int lane = C.lane, w = C.wave, m = lane & 15, q = lane >> 4;
    LAS float* red = (LAS float*)C.lds;
    for (int it = blockIdx.x; it < NG * 8; it += C.G) {
        const int g = 4 * (it & 7) + (it >> 6), sub = (it >> 3) & 7;
        f32x4 acc[2][8];
#pragma unroll
        for (int mt = 0; mt < 2; ++mt)
#pragma unroll
            for (int nt = 0; nt < 8; ++nt) acc[mt][nt] = (f32x4){0.f, 0.f, 0.f, 0.f};
        const bf16* Wh = (const bf16*)(C.ws + WS_SSMW) + ((size_t)g * 128 + m) * 2048 + 256 * w + 8 * q;
        const bf16* Wl = Wh + (size_t)NG * 128 * 2048;
        const float* up[2];
#pragma unroll
        for (int mt = 0; mt < 2; ++mt) { const int cr = 32 * sub + 16 * mt + m, b = cr >> 6, k = cr & 63;
            up[mt] = C.U32 + ((size_t)b * LP + (size_t)k * CH + 16 * w + (q >> 1)) * 512 + g * 16 + 8 * (q & 1); }
        f32x4 xa[2][2];
#pragma unroll
        for (int mt = 0; mt < 2; ++mt) { xa[mt][0] = *(const f32x4*)(up[mt]); xa[mt][1] = *(const f32x4*)(up[mt] + 4); }
#pragma unroll 2
        for (int ks = 0; ks < 8; ++ks) {
            p1_bf16x8 ah[2], al[2];
#pragma unroll
            for (int mt = 0; mt < 2; ++mt) p1_split(xa[mt][0], xa[mt][1], ah[mt], al[mt]);
            if (ks < 7) {
#pragma unroll
                for (int mt = 0; mt < 2; ++mt) { const float* p = up[mt] + (size_t)(2 * ks + 2) * 512; xa[mt][0] = *(const f32x4*)p; xa[mt][1] = *(const f32x4*)(p + 4); } }
#pragma unroll
            for (int nt = 0; nt < 8; ++nt) {
                const p1_bf16x8 bh = *(const p1_bf16x8*)(Wh + (size_t)nt * 16 * 2048 + 32 * ks), bl = *(const p1_bf16x8*)(Wl + (size_t)nt * 16 * 2048 + 32 * ks);
#pragma unroll
                for (int mt = 0; mt < 2; ++mt) {
                    acc[mt][nt] = __builtin_amdgcn_mfma_f32_16x16x32_bf16(ah[mt], bh, acc[mt][nt], 0, 0, 0);
                    acc[mt][nt] = __builtin_amdgcn_mfma_f32_16x16x32_bf16(al[mt], bh, acc[mt][nt], 0, 0, 0);
                    acc[mt][nt] = __builtin_amdgcn_mfma_f32_16x16x32_bf16(ah[mt], bl, acc[mt][nt], 0, 0, 0); }
            }
        }
#pragma unroll
        for (int mt = 0; mt < 2; ++mt)
#pragma unroll
            for (int nt = 0; nt < 8; ++nt)
#pragma unroll
                for (int r = 0; r < 4; ++r) red[(w * 32 + 16 * mt + 4 * q + r) * P1_PITCH + 16 * nt + m] = acc[mt][nt][r];
        LDS_FENCE(); __syncthreads();
#pragma unroll
        for (int i = 0; i < 8; ++i) { const int o = C.tid + 512 * i, row = o >> 7, col = o & 127; float s = 0.f;
#pragma unroll
            for (int ww = 0; ww < 8; ++ww) s += red[(ww * 32 + row) * P1_PITCH + col];
            red[8 * 32 * P1_PITCH + row * 128 + col] = s; }
        LDS_FENCE(); __syncthreads();
        if (w == 0) { const LAS float* S2 = red + 8 * 32 * P1_PITCH; const int b = sub >> 1, k0 = 32 * (sub & 1);
            const float aLr = C.KST[K_ALRE + g * 64 + lane], aLi = C.KST[K_ALIM + g * 64 + lane]; float cr = 0.f, ci = 0.f;
#pragma unroll 8
            for (int row = 0; row < 32; ++row) { float* S = C.SEND + ((size_t)(b * NG + g) * NCHK + k0 + row) * 128; S[lane] = cr; S[64 + lane] = ci;
                const float sr = S2[row * 128 + lane], si = S2[row * 128 + 64 + lane];
                const float nr = aLr * cr - aLi * ci + sr, ni = aLr * ci + aLi * cr + si; cr = nr; ci = ni; }
            float* T = (float*)(C.ws + WS_TEND) + ((size_t)(b * NG + g) * 2 + (sub & 1)) * 128; T[lane] = cr; T[64 + lane] = ci; }
        __syncthreads();
    }
}
typedef short ssm_bf16x8 __attribute__((ext_vector_type(8)));
struct SsmRd { ssm_bf16x8 cf[4]; f32x4 dsk; };
__device__ __forceinline__ void ssm_rd(const Ctx& C, SsmRd& R, int g, int lane) {
    const bf16* CF = (const bf16*)(C.ws + WS_SSMCF) + ((size_t)g * 16 + (lane & 15)) * 128 + 8 * (lane >> 4);
#pragma unroll
    for (int ks = 0; ks < 4; ++ks) R.cf[ks] = *(const ssm_bf16x8*)(CF + 32 * ks);
    R.dsk = *(const f32x4*)(C.ssm_d + g * 16 + 4 * (lane >> 4));
}
template <int NT>
__device__ __forceinline__ void ssm_tile(const Ctx& C, const SsmCoef& K, const SsmRd& R, LAS float* U, LAS unsigned* HB, size_t row0, int g, float& hr, float& hi, f32x4& ua, f32x4& ub, const bool more) {
    constexpr int nt = NT;
    { const int t = C.lane >> 1, hf = C.lane & 1;
      if (t < nt) { *(LAS f32x4*)(U + t * 16 + hf * 8) = ua; *(LAS f32x4*)(U + t * 16 + hf * 8 + 4) = ub; }
      LDS_FENCE();
      if (more) ssm_issue_u(C, row0 + NT, g, nt, C.lane, ua, ub); }
#pragma unroll 2
    for (int t = 0; t < NT; t += 2) { unsigned p0, p1; ssm_step2(K, U + t * 16, hr, hi, p0, p1); HB[t * 68 + C.lane] = p0; HB[(t + 1) * 68 + C.lane] = p1; }
    LDS_FENCE();
    const int m = C.lane & 15, q = C.lane >> 4;
#pragma unroll
    for (int n2 = 0; n2 < 2; ++n2) {
        f32x4 y = (f32x4){0.f, 0.f, 0.f, 0.f};
#pragma unroll
        for (int ks = 0; ks < 4; ++ks) y = __builtin_amdgcn_mfma_f32_16x16x32_bf16(R.cf[ks], *(const LAS ssm_bf16x8*)((const LAS unsigned char*)HB + (16 * n2 + m) * 272 + 64 * ks + 16 * q), y, 0, 0, 0);
        const int t = 16 * n2 + m;
        if (t < nt) { const f32x4 uv = *(const LAS f32x4*)(U + t * 16 + 4 * q); const size_t o = (row0 + t) * 512 + g * 16 + 4 * q;
            f32x4 v; v.x = gelu_t(y.x + R.dsk.x * uv.x); v.y = gelu_t(y.y + R.dsk.y * uv.y); v.z = gelu_t(y.z + R.dsk.z * uv.z); v.w = gelu_t(y.w + R.dsk.w * uv.w);
            v2u pk; pk.x = pk2(v.x, v.y); pk.y = pk2(v.z, v.w); *(v2u*)(C.Y1B + o) = pk; }
    }
    LDS_FENCE();
}
__device__ __forceinline__ void p3_ssm_pass2(const Ctx& C, const bool sample_part) {
    LAS float* U = (LAS float*)(C.lds + 8192 + C.wave * 18560);
    LAS unsigned* HB = (LAS unsigned*)(U + 512);
    constexpr int BIG = NCHK / 2, NBIP = NG * BIG, NBI = NBIP + 128;
    for (int bi = (sample_part ? NBIP : 0) + blockIdx.x; bi < (sample_part ? NBI : NBIP); bi += C.G) {
        const bool smp = bi >= NBIP; const int g = smp ? (bi - NBIP) >> 2 : 2 * (bi >> 6) + (C.wave >> 2);
        SsmRd R; ssm_rd(C, R, g, C.lane);
        SsmCoef K; ssm_coef(C, K, g, C.lane);
        if (!smp) {
            const int pr = (bi & 63) * 4 + (C.wave & 3), b = pr / NCHK, k = pr % NCHK;
            float hr = 0.f, hi = 0.f; f32x4 ua = (f32x4){0.f, 0.f, 0.f, 0.f}, ub = ua; ssm_issue_u(C, (size_t)b * LP + (size_t)k * CH, g, 32, C.lane, ua, ub);
            const float aLr = C.KST[K_ALRE + g * 64 + C.lane], aLi = C.KST[K_ALIM + g * 64 + C.lane];
            { const float* S = C.SEND + ((size_t)(b * NG + g) * NCHK + k) * 128; hr = S[C.lane]; hi = S[64 + C.lane]; }
            if (k >= 32) { const float* T = (const float*)(C.ws + WS_TEND) + ((size_t)(b * NG + g) * 2) * 128; const float tr = T[C.lane], ti = T[64 + C.lane];
                float pr = 1.f, pi = 0.f, br = aLr, bi = aLi;
                for (int e = k - 32; e > 0; e >>= 1) { if (e & 1) { const float nr = pr * br - pi * bi, ni = pr * bi + pi * br; pr = nr; pi = ni; }
                    const float nr = br * br - bi * bi, ni = 2.f * br * bi; br = nr; bi = ni; }
                hr += pr * tr - pi * ti; hi += pr * ti + pi * tr; }
#pragma unroll 1
            for (int tl = 0; tl < CH / 32; ++tl) ssm_tile<32>(C, K, R, U, HB, (size_t)b * LP + (size_t)k * CH + tl * 32, g, hr, hi, ua, ub, tl < CH / 32 - 1);
            if (k == NCHK - 1) { C.out[O_SRP + (size_t)(b * NG + g) * 64 + C.lane] = hr; C.out[O_SIP + (size_t)(b * NG + g) * 64 + C.lane] = hi; }
        } else {
            const int b = ((bi - NBIP) & 3) * 8 + C.wave;
            float hr = C.st_re[(size_t)(b * NG + g) * 64 + C.lane], hi = C.st_im[(size_t)(b * NG + g) * 64 + C.lane];
            f32x4 ua = (f32x4){0.f, 0.f, 0.f, 0.f}, ub = ua; ssm_issue_u(C, (size_t)MP + (size_t)b * LS, g, LS, C.lane, ua, ub);
            ssm_tile<LS>(C, K, R, U, HB, (size_t)MP + (size_t)b * LS, g, hr, hi, ua, ub, false);
            C.out[O_SRS + (size_t)(b * NG + g) * 64 + C.lane] = hr; C.out[O_SIS + (size_t)(b * NG + g) * 64 + C.lane] = hi;
        }
    }
    __syncthreads();
}
__device__ __forceinline__ void p4_cmp2(const Ctx& C) {
    LAS float* gs = (LAS float*)(C.lds + C.wave * 256);
    const int lane = C.lane, m = lane & 15, q = lane >> 4;
    constexpr int SEQ_S = BS * 2 * 2, SEQ_P = BP * 2 * 2;
    constexpr int IT_S = SEQ_S * 32, IT_P = SEQ_P * 16;
    for (int it = C.gw; it < IT_S + IT_P; it += C.NGW) {
        const bool smp = it < IT_S; const int qq = smp ? it : it - IT_S;
        const int seq = smp ? qq >> 5 : qq >> 4, n0 = (smp ? qq & 31 : qq & 15) * 32, NC = smp ? NCS : NCP, nmax = NC - 1;
        const int slot = seq & 1, h = (seq >> 1) & 1, b = seq >> 2;
        const size_t xrow0 = (smp ? 0 : (size_t)XC_S_ROWS) + (size_t)seq * NC;
        { float cb = 0.f;
#pragma unroll 8
          for (int part = 0; part < 32; ++part) cb += C.KST[K_CBP + (slot * 32 + part) * 64 + lane];
          gs[lane] = cb; LDS_FENCE(); }
        p1_bf16x8 Bf[2][4];
#pragma unroll
        for (int ks = 0; ks < 2; ++ks)
#pragma unroll
            for (int nt = 0; nt < 4; ++nt) { const float* wp = C.cmp_w2 + (size_t)slot * 4096 + (32 * ks + 8 * q) * 64 + 16 * nt + m;
                v4u pw; pw.x = ssm_cvt_pk(wp[0], wp[64]); pw.y = ssm_cvt_pk(wp[128], wp[192]); pw.z = ssm_cvt_pk(wp[256], wp[320]); pw.w = ssm_cvt_pk(wp[384], wp[448]);
                Bf[ks][nt] = __builtin_bit_cast(p1_bf16x8, pw); }
        f32x4 acc[2][4];
#pragma unroll
        for (int mt = 0; mt < 2; ++mt)
#pragma unroll
            for (int nt = 0; nt < 4; ++nt) acc[mt][nt] = (f32x4){0.f, 0.f, 0.f, 0.f};
#pragma unroll
        for (int ks = 0; ks < 2; ++ks) { const int e0 = 32 * ks + 8 * q;
            const f32x4 c0 = *(const LAS f32x4*)(gs + e0), c1 = *(const LAS f32x4*)(gs + e0 + 4);
#pragma unroll
            for (int mt = 0; mt < 2; ++mt) { int n = n0 + 16 * mt + m; n = n < nmax ? n : nmax - 1;
                const float* pa = C.PP + (xrow0 + n) * 128 + e0; const float* pb = C.PP + (xrow0 + n + 1) * 128 + 64 + e0;
                const f32x4 h0 = c0 + *(const f32x4*)pa + *(const f32x4*)pb, h1 = c1 + *(const f32x4*)(pa + 4) + *(const f32x4*)(pb + 4);
                v4u pk; pk.x = ssm_cvt_pk(gelu_t(h0.x), gelu_t(h0.y)); pk.y = ssm_cvt_pk(gelu_t(h0.z), gelu_t(h0.w)); pk.z = ssm_cvt_pk(gelu_t(h1.x), gelu_t(h1.y)); pk.w = ssm_cvt_pk(gelu_t(h1.z), gelu_t(h1.w));
                const p1_bf16x8 A = __builtin_bit_cast(p1_bf16x8, pk);
#pragma unroll
                for (int nt = 0; nt < 4; ++nt) acc[mt][nt] = __builtin_amdgcn_mfma_f32_16x16x32_bf16(A, Bf[ks][nt], acc[mt][nt], 0, 0, 0); } }
#pragma unroll
        for (int mt = 0; mt < 2; ++mt)
#pragma unroll
            for (int nt = 0; nt < 4; ++nt) { const int nb = n0 + 16 * mt + 4 * q, d = 16 * nt + m;
                if (smp) { bf16* o = (slot ? C.VCBS : C.KCBS) + ((size_t)(b * 2 + h) * NCS + nb) * 64 + d;
#pragma unroll
                    for (int r = 0; r < 4; ++r) if (nb + r < nmax) o[r * 64] = (bf16)f2bf(acc[mt][nt][r]); }
                else { bf16* o = (slot ? C.VCT : C.KCB) + ((size_t)(b * 2 + h) * NCP + nb) * 64 + d;
#pragma unroll
                    for (int r = 0; r < 4; ++r) if (nb + r < nmax) o[r * 64] = (bf16)f2bf(acc[mt][nt][r]); } }
        LDS_FENCE();
    }
}


constexpr float QSCALE = 0.125f * 1.4426950408889634f;
__device__ __forceinline__ f32x4 unpk4(const v2u p) { return (f32x4){__uint_as_float(p.x << 16), __uint_as_float(p.x & 0xffff0000u), __uint_as_float(p.y << 16), __uint_as_float(p.y & 0xffff0000u)}; }
typedef short bf16x8 __attribute__((ext_vector_type(8)));
typedef short s16x4 __attribute__((ext_vector_type(4)));
#define MFMA16(a, b, c) __builtin_amdgcn_mfma_f32_16x16x32_bf16((a), (b), (c), 0, 0, 0)
constexpr int TP = 144, TILEB = 64 * TP;
constexpr int RSLOT = 16384  , NRING = 4;
constexpr int NRING2 = 8, RG2 = NRING2 / 2;
constexpr int A_BUF = 0, A_IMP = NRING * RSLOT  , A_SELM = NRING2 * RSLOT  , A_WUNI = A_SELM + 1024, A_LIST = A_WUNI + 128, A_MISC = A_LIST + 512, A_TUN = A_MISC + 64, A_END = A_TUN + 256;
static_assert(A_END <= MISC_OFF, "prompt attention LDS map");
constexpr int CW_QCTR = 8192;

struct StageRegs { v4u k, v; };
__device__ __forceinline__ void stage_load(StageRegs& R, const bf16* ksrc, size_t kpitch, const bf16* vsrc, size_t vpitch, int tid) {
    const int r = tid >> 3, ch = tid & 7; R.k = *(const v4u*)(ksrc + (size_t)r * kpitch + ch * 8); R.v = *(const v4u*)(vsrc + (size_t)r * vpitch + ch * 8); }
__device__ __forceinline__ void stage_write(const StageRegs& R, LAS unsigned char* buf, int tid) {
    const int r = tid >> 3, ch = tid & 7; *(LAS v4u*)(buf + r * TP + ch * 16) = R.k; *(LAS v4u*)(buf + TILEB + r * TP + ch * 16) = R.v; }
__device__ __forceinline__ void qk_tile(const LAS unsigned char* Kt, const bf16x8 q0, const bf16x8 q1, int c, int q, f32x4 (&s)[4]) {
    const LAS unsigned char* kp = Kt + c * TP + q * 16;
#pragma unroll
    for (int t = 0; t < 4; ++t) { const bf16x8 k0 = *(const LAS bf16x8*)(kp + t * 16 * TP), k1 = *(const LAS bf16x8*)(kp + t * 16 * TP + 64);
        s[t] = MFMA16(k0, q0, ((f32x4){0.f, 0.f, 0.f, 0.f})); s[t] = MFMA16(k1, q1, s[t]); }
}
__device__ __forceinline__ bf16x8 pack8(const f32x4 a, const f32x4 b) {
    v4u w; w.x = pg8::cvt_pk_bf16(a.x, a.y); w.y = pg8::cvt_pk_bf16(a.z, a.w); w.z = pg8::cvt_pk_bf16(b.x, b.y); w.w = pg8::cvt_pk_bf16(b.z, b.w); return __builtin_bit_cast(bf16x8, w); }
__device__ __forceinline__ void pv_tile(const LAS unsigned char* Vt, const f32x4 (&p)[4], int c, int q, f32x4 (&acc)[4]) {
    const bf16x8 P0 = pack8(p[0], p[1]), P1 = pack8(p[2], p[3]);
    const LAS unsigned char* vp = Vt + c * TP + q * 8;
#pragma unroll
    for (int dt = 0; dt < 4; ++dt) { const LAS unsigned char* vr = vp + dt * 16 * TP;
        const s16x4 a0 = *(const LAS s16x4*)(vr), a1 = *(const LAS s16x4*)(vr + 32), b0 = *(const LAS s16x4*)(vr + 64), b1 = *(const LAS s16x4*)(vr + 96);
        const bf16x8 va = (bf16x8){a0[0], a0[1], a0[2], a0[3], a1[0], a1[1], a1[2], a1[3]}, vb = (bf16x8){b0[0], b0[1], b0[2], b0[3], b1[0], b1[1], b1[2], b1[3]};
        acc[dt] = MFMA16(va, P0, acc[dt]); acc[dt] = MFMA16(vb, P1, acc[dt]); }
}
__device__ __forceinline__ void mask_tile(f32x4 (&s)[4], int q, int lo, int hi) {
    const float NINF = -__builtin_inff();
#pragma unroll
    for (int t = 0; t < 4; ++t)
#pragma unroll
        for (int r = 0; r < 4; ++r) { const int key = 16 * t + 4 * q + r; s[t][r] = (key >= lo && key <= hi) ? s[t][r] : NINF; }
}
__device__ __forceinline__ float xor16_max(float v) { const auto r = __builtin_amdgcn_permlane16_swap(__float_as_uint(v), __float_as_uint(v), false, false); return fmaxf(__uint_as_float(r[0]), __uint_as_float(r[1])); }
__device__ __forceinline__ float xor32_max(float v) { const auto r = __builtin_amdgcn_permlane32_swap(__float_as_uint(v), __float_as_uint(v), false, false); return fmaxf(__uint_as_float(r[0]), __uint_as_float(r[1])); }
__device__ __forceinline__ float xor16_sum(float v) { const auto r = __builtin_amdgcn_permlane16_swap(__float_as_uint(v), __float_as_uint(v), false, false); return __uint_as_float(r[0]) + __uint_as_float(r[1]); }
__device__ __forceinline__ float xor32_sum(float v) { const auto r = __builtin_amdgcn_permlane32_swap(__float_as_uint(v), __float_as_uint(v), false, false); return __uint_as_float(r[0]) + __uint_as_float(r[1]); }
__device__ __forceinline__ float colmax(const f32x4 (&s)[4]) {
    float mx = fmaxf(fmaxf(s[0].x, s[0].y), fmaxf(s[0].z, s[0].w));
#pragma unroll
    for (int t = 1; t < 4; ++t) mx = fmaxf(mx, fmaxf(fmaxf(s[t].x, s[t].y), fmaxf(s[t].z, s[t].w)));
    return xor32_max(xor16_max(mx));
}
__device__ __forceinline__ float ex2(float x) { return __builtin_amdgcn_exp2f(x); }
__device__ __forceinline__ void online_step(f32x4 (&s)[4], const bool mine, float& m, float& l, f32x4 (&acc)[4]) {
    const float NINF = -__builtin_inff(), PINF = __builtin_inff();
    float mx = colmax(s); mx = mine ? mx : NINF;
    const float mn = fmaxf(m, mx), ms = (mn > NINF) ? mn : 0.f, msub = mine ? ms : PINF;
    float sum = 0.f;
#pragma unroll
    for (int t = 0; t < 4; ++t) { s[t].x = ex2(s[t].x - msub); s[t].y = ex2(s[t].y - msub); s[t].z = ex2(s[t].z - msub); s[t].w = ex2(s[t].w - msub); sum += (s[t].x + s[t].y) + (s[t].z + s[t].w); }
    if (__any(mn != m)) { const float al = ex2(m - ms); l = l * al + sum;
#pragma unroll
        for (int dt = 0; dt < 4; ++dt) acc[dt] = acc[dt] * al; }
    else l += sum;
    m = mn;
}
__device__ __forceinline__ float dpp_xor1(float v) { return __builtin_bit_cast(float, __builtin_amdgcn_update_dpp(0, __builtin_bit_cast(int, v), 0xB1, 0xF, 0xF, true)); }
__device__ __forceinline__ float dpp_xor2(float v) { return __builtin_bit_cast(float, __builtin_amdgcn_update_dpp(0, __builtin_bit_cast(int, v), 0x4E, 0xF, 0xF, true)); }
__device__ __forceinline__ unsigned getw(const v4u v, int wi) { return wi == 0 ? v.x : (wi == 1 ? v.y : (wi == 2 ? v.z : v.w)); }

__device__ __forceinline__ v4u topk_token(const LAS float* imp, int cur, int lane) {
    const bool c0 = lane >= 1 && lane < cur, c1 = (lane + 64) < cur;
    const unsigned u0 = c0 ? __float_as_uint(imp[lane]) : 0u, u1 = c1 ? __float_as_uint(imp[64 + lane]) : 0u;
    bool s0, s1;
    const int K = cur >= 1 ? 14 : 15, ncand = cur >= 1 ? cur - 1 : 0;
    if (ncand <= K) { s0 = c0; s1 = c1; }
    else {
        unsigned prefix = 0u; int rem = K;
        for (int bit = 30; bit >= 11; --bit) {
            const unsigned cand = prefix | (1u << bit);
            const bool m0 = c0 && ((u0 >> bit) == (cand >> bit)), m1 = c1 && ((u1 >> bit) == (cand >> bit));
            const int cnt = __popcll(__ballot(m0)) + __popcll(__ballot(m1));
            if (cnt >= rem) prefix = cand; else rem -= cnt;
        }
        const unsigned ph = prefix >> 11;
        const bool e0 = c0 && (u0 >> 11) == ph, e1 = c1 && (u1 >> 11) == ph;
        const unsigned long long be0 = __ballot(e0), be1 = __ballot(e1), lt = (1ull << lane) - 1ull;
        const int r0 = __popcll(be0 & lt), r1 = __popcll(be0) + __popcll(be1 & lt);
        s0 = c0 && ((u0 >> 11) > ph || (e0 && r0 < rem)); s1 = c1 && ((u1 >> 11) > ph || (e1 && r1 < rem));
    }
    s0 = s0 || lane == 0 || lane == cur; s1 = s1 || (lane + 64) == cur;
    const unsigned long long b0 = __ballot(s0), b1 = __ballot(s1);
    return (v4u){(unsigned)b0, (unsigned)(b0 >> 32), (unsigned)b1, (unsigned)(b1 >> 32)};
}


__device__ __forceinline__ void ring_issue(LAS unsigned char* slot, const bf16* ksrc, size_t kpitch, const bf16* vsrc, size_t vpitch, int w, int lane) {
    const int row = 8 * w + (lane >> 3), cl = (lane & 7) ^ ((row >> 1) & 7);
    __builtin_amdgcn_global_load_lds((const unsigned*)(ksrc + (size_t)row * kpitch + cl * 8), (LAS unsigned*)(slot + w * 1024), 16, 0, 0);
    __builtin_amdgcn_global_load_lds((const unsigned*)(vsrc + (size_t)row * vpitch + cl * 8), (LAS unsigned*)(slot + 8192 + w * 1024), 16, 0, 0);
}
#define RING_PAIR_SYNC() do { asm volatile("s_waitcnt vmcnt(0)" ::: "memory"); __builtin_amdgcn_s_barrier(); asm volatile("" ::: "memory"); } while (0)
__device__ __forceinline__ void qk_tile_sw(const LAS unsigned char* Kt, const bf16x8 q0, const bf16x8 q1, int c, int q, f32x4 (&s)[4]) {
    const int sw = (c >> 1) & 7; const LAS unsigned char* kp = Kt + c * 128;
    const int o0 = (q ^ sw) * 16, o1 = ((4 + q) ^ sw) * 16;
#pragma unroll
    for (int t = 0; t < 4; ++t) { const bf16x8 k0 = *(const LAS bf16x8*)(kp + t * 2048 + o0), k1 = *(const LAS bf16x8*)(kp + t * 2048 + o1);
        s[t] = MFMA16(k0, q0, ((f32x4){0.f, 0.f, 0.f, 0.f})); s[t] = MFMA16(k1, q1, s[t]); }
}
typedef short v4i16_t __attribute__((ext_vector_type(4)));
__device__ __forceinline__ s16x4 vtr(const LAS unsigned char* p) { return __builtin_bit_cast(s16x4, __builtin_amdgcn_ds_read_tr16_b64_v4i16((LAS v4i16_t*)p)); }
__device__ __forceinline__ void pv_tile_sw(const LAS unsigned char* Vt, const f32x4 (&p)[4], int c, int q, f32x4 (&acc)[4]) {
    const bf16x8 P0 = pack8(p[0], p[1]), P1 = pack8(p[2], p[3]);
    const int sw = (2 * q + (c >> 3)) & 7, ch = (c & 3) >> 1;
    const LAS unsigned char* vb = Vt + (4 * q + (c >> 2)) * 128 + (c & 1) * 8;
#pragma unroll
    for (int dt = 0; dt < 4; ++dt) { const LAS unsigned char* vr = vb + (((2 * dt + ch) ^ sw) << 4);
        const s16x4 a0 = vtr(vr), a1 = vtr(vr + 16 * 128), b0 = vtr(vr + 32 * 128), b1 = vtr(vr + 48 * 128);
        const bf16x8 va = (bf16x8){a0[0], a0[1], a0[2], a0[3], a1[0], a1[1], a1[2], a1[3]}, vb8 = (bf16x8){b0[0], b0[1], b0[2], b0[3], b1[0], b1[1], b1[2], b1[3]};
        acc[dt] = MFMA16(va, P0, acc[dt]); acc[dt] = MFMA16(vb8, P1, acc[dt]); }
}

struct KFr { bf16x8 k0[4], k1[4]; };
__device__ __forceinline__ void attn_ld_k(const LAS unsigned char* Kt, int c, int q, KFr& F) {
    const int sw = (c >> 1) & 7; const LAS unsigned char* kp = Kt + c * 128;
    const int o0 = (q ^ sw) * 16, o1 = ((4 + q) ^ sw) * 16;
#pragma unroll
    for (int t = 0; t < 4; ++t) F.k0[t] = *(const LAS bf16x8*)(kp + t * 2048 + o0);
#pragma unroll
    for (int t = 0; t < 4; ++t) F.k1[t] = *(const LAS bf16x8*)(kp + t * 2048 + o1);
}
__device__ __forceinline__ void attn_qk(const KFr& F, const bf16x8 q0, const bf16x8 q1, const f32x4 cinit, f32x4 (&s)[4]) {
#pragma unroll
    for (int t = 0; t < 4; ++t) s[t] = MFMA16(F.k0[t], q0, cinit);
#pragma unroll
    for (int t = 0; t < 4; ++t) s[t] = MFMA16(F.k1[t], q1, s[t]);
}
struct VFr { v2u r[4][4]; };
__device__ __forceinline__ void attn_v_issue(const LAS unsigned char* Vt, int c, int q, VFr& V) {
    const int sw = (2 * q + (c >> 3)) & 7, ch = (c & 3) >> 1;
    const unsigned vb = (unsigned)(size_t)Vt + (unsigned)((4 * q + (c >> 2)) * 128 + (c & 1) * 8);
#pragma unroll
    for (int dt = 0; dt < 4; ++dt) { const unsigned a = vb + (unsigned)(((2 * dt + ch) ^ sw) << 4);
        asm volatile("ds_read_b64_tr_b16 %0, %4\n\tds_read_b64_tr_b16 %1, %4 offset:2048\n\tds_read_b64_tr_b16 %2, %4 offset:4096\n\tds_read_b64_tr_b16 %3, %4 offset:6144"
                     : "=&v"(V.r[dt][0]), "=&v"(V.r[dt][1]), "=&v"(V.r[dt][2]), "=&v"(V.r[dt][3]) : "v"(a)); }
}
__device__ __forceinline__ void attn_v_wait(VFr& V) {
    asm volatile("s_waitcnt lgkmcnt(0)" : "+v"(V.r[0][0]), "+v"(V.r[0][1]), "+v"(V.r[0][2]), "+v"(V.r[0][3]), "+v"(V.r[1][0]), "+v"(V.r[1][1]), "+v"(V.r[1][2]), "+v"(V.r[1][3]),
                                          "+v"(V.r[2][0]), "+v"(V.r[2][1]), "+v"(V.r[2][2]), "+v"(V.r[2][3]), "+v"(V.r[3][0]), "+v"(V.r[3][1]), "+v"(V.r[3][2]), "+v"(V.r[3][3]));
}
__device__ __forceinline__ bf16x8 pack8n(const f32x4 a, const f32x4 b) {
    v4u w; w.x = ssm_cvt_pk(a.x, a.y); w.y = ssm_cvt_pk(a.z, a.w); w.z = ssm_cvt_pk(b.x, b.y); w.w = ssm_cvt_pk(b.z, b.w); return __builtin_bit_cast(bf16x8, w); }
__device__ __forceinline__ void attn_pv(const VFr& V, const bf16x8 P0, const bf16x8 P1, f32x4 (&acc)[4]) {
#pragma unroll
    for (int dt = 0; dt < 4; ++dt) { const v4u va = (v4u){V.r[dt][0].x, V.r[dt][0].y, V.r[dt][1].x, V.r[dt][1].y}; acc[dt] = MFMA16(__builtin_bit_cast(bf16x8, va), P0, acc[dt]); }
#pragma unroll
    for (int dt = 0; dt < 4; ++dt) { const v4u vb = (v4u){V.r[dt][2].x, V.r[dt][2].y, V.r[dt][3].x, V.r[dt][3].y}; acc[dt] = MFMA16(__builtin_bit_cast(bf16x8, vb), P1, acc[dt]); }
}
#define A_VADD(d, a, b) asm("v_add_f32 %0, %1, %2" : "=v"(d) : "v"(a), "v"(b))
#define A_VMAX(d, a, b) asm("v_max_f32 %0, %1, %2" : "=v"(d) : "v"(a), "v"(b))
#define A_VMAX3(d, a, b, c) asm("v_max3_f32 %0, %1, %2, %3" : "=v"(d) : "v"(a), "v"(b), "v"(c))
__device__ __forceinline__ float colmax2(const f32x4 (&s)[4]) {
    float r, r2; A_VMAX3(r, s[0].x, s[0].y, s[0].z); A_VMAX3(r2, s[2].x, s[2].y, s[2].z); A_VMAX3(r, r, s[0].w, s[1].x); A_VMAX3(r2, r2, s[2].w, s[3].x);
    A_VMAX3(r, r, s[1].y, s[1].z); A_VMAX3(r2, r2, s[3].y, s[3].z); A_VMAX3(r, r, s[1].w, s[3].w); A_VMAX(r, r, r2);
    { const auto x = __builtin_amdgcn_permlane16_swap(__float_as_uint(r), __float_as_uint(r), false, false); A_VMAX(r, __uint_as_float(x[0]), __uint_as_float(x[1])); }
    { const auto x = __builtin_amdgcn_permlane32_swap(__float_as_uint(r), __float_as_uint(r), false, false); A_VMAX(r, __uint_as_float(x[0]), __uint_as_float(x[1])); }
    return r;
}
__device__ __forceinline__ void online_step2(f32x4 (&s)[4], const bool mine, float& m, float& l, f32x4& Cn, f32x4 (&acc)[4], bf16x8& P0, bf16x8& P1) {
    const float NINF = -__builtin_inff();
    float mx = colmax2(s); mx = mine ? mx : NINF;
    const float mref = -Cn.x, mn = fmaxf(m, mref + mx);
    if (__any(mn != m)) {
        const float mnew = (mn > NINF) ? mn : 0.f, d = mnew - mref, al = ex2(m - mnew);
#pragma unroll
        for (int t = 0; t < 4; ++t) { s[t].x -= d; s[t].y -= d; s[t].z -= d; s[t].w -= d; }
        l *= al;
#pragma unroll
        for (int dt = 0; dt < 4; ++dt) acc[dt] = acc[dt] * al;
        m = mn; Cn = (f32x4){-mnew, -mnew, -mnew, -mnew};
    }
#pragma unroll
    for (int t = 0; t < 4; ++t) { s[t].x = ex2(s[t].x); s[t].y = ex2(s[t].y); s[t].z = ex2(s[t].z); s[t].w = ex2(s[t].w); }
    float a0, a1, a2, a3, a4, a5, a6, a7;
    A_VADD(a0, s[0].x, s[0].y); A_VADD(a1, s[0].z, s[0].w); A_VADD(a2, s[1].x, s[1].y); A_VADD(a3, s[1].z, s[1].w); A_VADD(a4, s[2].x, s[2].y); A_VADD(a5, s[2].z, s[2].w); A_VADD(a6, s[3].x, s[3].y); A_VADD(a7, s[3].z, s[3].w);
    A_VADD(a0, a0, a1); A_VADD(a2, a2, a3); A_VADD(a4, a4, a5); A_VADD(a6, a6, a7); A_VADD(a0, a0, a2); A_VADD(a4, a4, a6); A_VADD(a0, a0, a4);
    l += mine ? a0 : 0.f;
    const unsigned mm = mine ? 0xffffffffu : 0u;
    v4u w0, w1; w0.x = ssm_cvt_pk(s[0].x, s[0].y) & mm; w0.y = ssm_cvt_pk(s[0].z, s[0].w) & mm; w0.z = ssm_cvt_pk(s[1].x, s[1].y) & mm; w0.w = ssm_cvt_pk(s[1].z, s[1].w) & mm;
    w1.x = ssm_cvt_pk(s[2].x, s[2].y) & mm; w1.y = ssm_cvt_pk(s[2].z, s[2].w) & mm; w1.z = ssm_cvt_pk(s[3].x, s[3].y) & mm; w1.w = ssm_cvt_pk(s[3].z, s[3].w) & mm;
    P0 = __builtin_bit_cast(bf16x8, w0); P1 = __builtin_bit_cast(bf16x8, w1);
}
template <bool A0, bool A1, bool MSK>
__device__ __forceinline__ void attn_step(const LAS unsigned char* buf, const bf16x8 (&Q0)[2], const bf16x8 (&Q1)[2], const int c, const int q, const bool mine0, const bool mine1,
                                          const int lo0, const int hi0, const int lo1, const int hi1, float (&m)[2], float (&l)[2], f32x4 (&Cn)[2], f32x4 (&acc)[2][4]) {
    f32x4 s0[4], s1[4];
    { KFr F; attn_ld_k(buf, c, q, F);
      if (A0) attn_qk(F, Q0[0], Q1[0], Cn[0], s0);
      if (A1) attn_qk(F, Q0[1], Q1[1], Cn[1], s1); }
    bf16x8 P00, P01, P10, P11;
    if (A0) { if (MSK) mask_tile(s0, q, lo0, hi0); online_step2(s0, mine0, m[0], l[0], Cn[0], acc[0], P00, P01); }
    if (A1) { if (MSK) mask_tile(s1, q, lo1, hi1); online_step2(s1, mine1, m[1], l[1], Cn[1], acc[1], P10, P11); }
    VFr V; attn_v_issue(buf + 8192, c, q, V); attn_v_wait(V);
    if (A0) attn_pv(V, P00, P01, acc[0]);
    if (A1) attn_pv(V, P10, P11, acc[1]);
}
template <int MODE> __device__ __forceinline__ void attn_prompt_unit(const Ctx& C, int b, int h, int T) {
    const float NINF = -__builtin_inff();
    int tid_ = C.tid; asm volatile("" : "+v"(tid_));
    const int tid = tid_, lane = tid & 63, w = __builtin_amdgcn_readfirstlane(tid >> 6), c = lane & 15, q = lane >> 4, ti = c >> 2, g = c & 3;
    LAS unsigned char* L = C.lds;
    LAS float* impS = (LAS float*)(L + A_IMP); LAS unsigned* selm = (LAS unsigned*)(L + A_SELM); LAS unsigned* wuni = (LAS unsigned*)(L + A_WUNI); LAS int* list = (LAS int*)(L + A_LIST); LAS int* misc = (LAS int*)(L + A_MISC);
    const int q0 = 64 * T, seq = b * 2 + h;
    bf16x8 Q0[2], Q1[2]; int toff[2];
    f32x4* OT = (f32x4*)(C.ws + WS_OT) + (size_t)blockIdx.x * 4096 + tid;
#pragma unroll
    for (int a = 0; a < 2; ++a) { toff[a] = 8 * w + 4 * a + ti; const bf16* qp = C.QB + ((size_t)b * LP + q0 + toff[a]) * 512 + h * 256 + g * 64 + 8 * q;
        Q0[a] = *(const bf16x8*)qp; Q1[a] = *(const bf16x8*)(qp + 32);
    }
    for (int i = tid; i < 2048; i += 512) ((LAS f32x4*)impS)[i] = (f32x4){0.f, 0.f, 0.f, 0.f};
    const int nvmax = 4 * T + 3, ntc = (MODE & 4) ? 0 : (nvmax + 63) >> 6;
    const bf16* kcb = C.KCB + (size_t)seq * NCP * 64; const bf16* vcb = C.VCT + (size_t)seq * NCP * 64;
    int nvis[2], nvmin[2]; float mC[2], lC[2];
#pragma unroll
    for (int a = 0; a < 2; ++a) { const int qpos = q0 + toff[a]; nvis[a] = qpos >= 31 ? ((qpos - 31) >> 4) + 1 : 0; mC[a] = NINF; lC[a] = 0.f;
        const int qmin = q0 + 8 * w + 4 * a; nvmin[a] = qmin >= 31 ? ((qmin - 31) >> 4) + 1 : 0; }
    for (int s = 0; s < 2 && s < ntc; ++s) ring_issue(L + s * RSLOT, kcb + (size_t)s * 4096, 64, vcb + (size_t)s * 4096, 64, w, lane);
    for (int s = 0; s < ntc; ++s) {
        if (!(s & 1)) { RING_PAIR_SYNC();
            for (int s2 = s + 2; s2 < s + 4 && s2 < ntc; ++s2) ring_issue(L + (s2 & 3) * RSLOT, kcb + (size_t)s2 * 4096, 64, vcb + (size_t)s2 * 4096, 64, w, lane); }
        const LAS unsigned char* buf = L + (s & 3) * RSLOT;
#pragma unroll
        for (int a = 0; a < 2; ++a) { __builtin_amdgcn_sched_barrier(0); f32x4 sc[4]; qk_tile_sw(buf, Q0[a], Q1[a], c, q, sc); if (64 * (s + 1) > nvmin[a]) mask_tile(sc, q, 0, nvis[a] - 64 * s - 1);
            const float mn = fmaxf(mC[a], colmax(sc)), ms = (mn > NINF) ? mn : 0.f; float sum = 0.f;
#pragma unroll
            for (int t = 0; t < 4; ++t) sum += (ex2(sc[t].x - ms) + ex2(sc[t].y - ms)) + (ex2(sc[t].z - ms) + ex2(sc[t].w - ms));
            lC[a] = lC[a] * ex2(mC[a] - ms) + sum; mC[a] = mn; }
    }
    __builtin_amdgcn_s_barrier();
    float invC[2], msC[2];
#pragma unroll
    for (int a = 0; a < 2; ++a) { float l = lC[a]; l += __shfl_xor(l, 16); l += __shfl_xor(l, 32); invC[a] = 1.0f / fmaxf(l, 1e-30f); msC[a] = (mC[a] > NINF) ? mC[a] : 0.f; }
    f32x4 acc[2][4]; float carry[2];
#pragma unroll
    for (int a = 0; a < 2; ++a) { carry[a] = 0.f;
#pragma unroll
        for (int dt = 0; dt < 4; ++dt) acc[a][dt] = (f32x4){0.f, 0.f, 0.f, 0.f}; }
    for (int s = 0; s < 2 && s < ntc; ++s) ring_issue(L + s * RSLOT, kcb + (size_t)s * 4096, 64, vcb + (size_t)s * 4096, 64, w, lane);
    for (int s = 0; s < ntc; ++s) {
        if (!(s & 1)) { RING_PAIR_SYNC();
            for (int s2 = s + 2; s2 < s + 4 && s2 < ntc; ++s2) ring_issue(L + (s2 & 3) * RSLOT, kcb + (size_t)s2 * 4096, 64, vcb + (size_t)s2 * 4096, 64, w, lane); }
        const LAS unsigned char* buf = L + (s & 3) * RSLOT;
#pragma unroll
        for (int a = 0; a < 2; ++a) { __builtin_amdgcn_sched_barrier(0); f32x4 sc[4]; qk_tile_sw(buf, Q0[a], Q1[a], c, q, sc); if (64 * (s + 1) > nvmin[a]) mask_tile(sc, q, 0, nvis[a] - 64 * s - 1);
            float x[4], A[4];
#pragma unroll
            for (int t = 0; t < 4; ++t) { sc[t].x = ex2(sc[t].x - msC[a]) * invC[a]; sc[t].y = ex2(sc[t].y - msC[a]) * invC[a]; sc[t].z = ex2(sc[t].z - msC[a]) * invC[a]; sc[t].w = ex2(sc[t].w - msC[a]) * invC[a];
                f32x4 ps = sc[t]; ps.x += dpp_xor1(ps.x); ps.y += dpp_xor1(ps.y); ps.z += dpp_xor1(ps.z); ps.w += dpp_xor1(ps.w);
                ps.x += dpp_xor2(ps.x); ps.y += dpp_xor2(ps.y); ps.z += dpp_xor2(ps.z); ps.w += dpp_xor2(ps.w);
                A[t] = (ps.x + ps.y) + (ps.z + 0.5f * ps.w); x[t] = __shfl(0.5f * ps.w, (lane + 48) & 63); }
            if (g == 0) { LAS float* ip = impS + ((2 * w + a) * 4 + ti) * 128 + 16 * s + q;
                ip[0] = A[0] + (q ? x[0] : carry[a]); ip[4] = A[1] + (q ? x[1] : x[0]); ip[8] = A[2] + (q ? x[2] : x[1]); ip[12] = A[3] + (q ? x[3] : x[2]); }
            carry[a] = x[3];
            pv_tile_sw(buf + 8192, sc, c, q, acc[a]); }
    }
    __builtin_amdgcn_s_barrier();
    {
        LDS_FENCE();
#pragma unroll
        for (int a = 0; a < 2; ++a) { const float gc = C.GN[((size_t)b * LP + q0 + toff[a]) * 32 + (h * 4 + g) * 3 + 0];
#pragma unroll
            for (int dt = 0; dt < 4; ++dt) OT[(a * 4 + dt) * 512] = acc[a][dt] * gc; }
    }
    v4u wu = (v4u){0u, 0u, 0u, 0u};
    for (int tt = 0; tt < ((MODE & 2) ? 0 : 8); ++tt) { const v4u mk = topk_token(impS + ((2 * w + (tt >> 2)) * 4 + (tt & 3)) * 128, T, lane);
        if (lane == 0) *(LAS v4u*)(selm + (8 * w + tt) * 4) = mk;
        wu.x |= mk.x; wu.y |= mk.y; wu.z |= mk.z; wu.w |= mk.w; }
    if (lane == 0) *(LAS v4u*)(wuni + 4 * w) = wu;
    __syncthreads();
    LAS unsigned* tun = (LAS unsigned*)(L + A_TUN);
    if (lane < 8) { const int a = lane >> 2, wi = lane & 3; unsigned o = 0u;
#pragma unroll
        for (int i = 0; i < 4; ++i) o |= selm[(8 * w + 4 * a + i) * 4 + wi];
        tun[(2 * w + a) * 4 + wi] = o; }
    if (w == 0) {
        v4u U = (v4u){0u, 0u, 0u, 0u};
#pragma unroll
        for (int i = 0; i < 8; ++i) { const v4u o = *(const LAS v4u*)(wuni + 4 * i); U.x |= o.x; U.y |= o.y; U.z |= o.z; U.w |= o.w; }
        const unsigned long long lt = (1ull << lane) - 1ull;
        const bool b0 = ((lane < 32 ? U.x : U.y) >> (lane & 31)) & 1u, b1 = ((lane < 32 ? U.z : U.w) >> (lane & 31)) & 1u;
        const unsigned long long m0 = __ballot(b0), m1 = __ballot(b1); const int n0 = __popcll(m0);
        if (b0) list[__popcll(m0 & lt)] = lane; if (b1) list[n0 + __popcll(m1 & lt)] = 64 + lane;
        if (lane == 0) { misc[0] = n0 + __popcll(m1); misc[4] = (int)U.x; misc[5] = (int)U.y; misc[6] = (int)U.z; misc[7] = (int)U.w; }
    }
    __syncthreads();
    const int nsel = (MODE & 3) ? 0 : misc[0];
#define RFL(x) ((unsigned)__builtin_amdgcn_readfirstlane((int)(x)))
    const unsigned long long Ulo = RFL(misc[4]) | ((unsigned long long)RFL(misc[5]) << 32), Uhi = RFL(misc[6]) | ((unsigned long long)RFL(misc[7]) << 32);
    const unsigned long long tm0lo = RFL(tun[(2 * w) * 4 + 0]) | ((unsigned long long)RFL(tun[(2 * w) * 4 + 1]) << 32), tm0hi = RFL(tun[(2 * w) * 4 + 2]) | ((unsigned long long)RFL(tun[(2 * w) * 4 + 3]) << 32);
    const unsigned long long tm1lo = RFL(tun[(2 * w + 1) * 4 + 0]) | ((unsigned long long)RFL(tun[(2 * w + 1) * 4 + 1]) << 32), tm1hi = RFL(tun[(2 * w + 1) * 4 + 2]) | ((unsigned long long)RFL(tun[(2 * w + 1) * 4 + 3]) << 32);
#undef RFL
#define NEXTJ(lo, hi, j) do { if (lo) { j = __builtin_ctzll(lo); lo &= lo - 1ull; } else { j = 64 + __builtin_ctzll(hi); hi &= hi - 1ull; } } while (0)
    unsigned long long curLo = Ulo, curHi = Uhi, preLo = Ulo, preHi = Uhi;
    const bf16* ksb = C.KVB + ((size_t)b * LP) * 768 + 2 * 128 + h * 64; const bf16* vsb = C.KVB + ((size_t)b * LP) * 768 + 3 * 128 + h * 64;
    float mS[2], lS[2]; f32x4 Cn[2];
#pragma unroll
    for (int a = 0; a < 2; ++a) { mS[a] = NINF; lS[a] = 0.f; Cn[a] = (f32x4){0.f, 0.f, 0.f, 0.f};
#pragma unroll
        for (int dt = 0; dt < 4; ++dt) acc[a][dt] = (f32x4){0.f, 0.f, 0.f, 0.f}; }
#pragma unroll
    for (int s = 0; s < RG2; ++s) if (s < nsel) { int jn; NEXTJ(preLo, preHi, jn); ring_issue(L + s * RSLOT, ksb + (size_t)jn * 64 * 768, 768, vsb + (size_t)jn * 64 * 768, 768, w, lane); }
    for (int s = 0; s < nsel; ++s) {
        if (!(s & (RG2 - 1))) { RING_PAIR_SYNC();
#pragma unroll
            for (int u = 0; u < RG2; ++u) { const int s2 = s + RG2 + u; if (s2 < nsel) { int jn; NEXTJ(preLo, preHi, jn); ring_issue(L + (s2 & (NRING2 - 1)) * RSLOT, ksb + (size_t)jn * 64 * 768, 768, vsb + (size_t)jn * 64 * 768, 768, w, lane); } } }
        int j; NEXTJ(curLo, curHi, j);
        const LAS unsigned char* buf = L + (s & (NRING2 - 1)) * RSLOT;
        const int wi = j >> 5, bt = j & 31;
        const bool p0 = (MODE & 512) ? true : (MODE & 1024) ? false : (bool)(((j < 64 ? tm0lo : tm0hi) >> (j & 63)) & 1ull), p1 = (MODE & 512) ? true : (MODE & 1024) ? false : (bool)(((j < 64 ? tm1lo : tm1hi) >> (j & 63)) & 1ull);
        if (!(p0 || p1)) continue;
        const bool mine0 = (selm[(8 * w + ti) * 4 + wi] >> bt) & 1u, mine1 = (selm[(8 * w + 4 + ti) * 4 + wi] >> bt) & 1u;
        __builtin_amdgcn_sched_barrier(0);
        if (j == T && !(MODE & 1024)) attn_step<true, true, true>(buf, Q0, Q1, c, q, mine0, mine1, 0, toff[0], 0, toff[1], mS, lS, Cn, acc);
        else if (p0 && p1) attn_step<true, true, false>(buf, Q0, Q1, c, q, mine0, mine1, 0, 63, 0, 63, mS, lS, Cn, acc);
        else if (p0) attn_step<true, false, false>(buf, Q0, Q1, c, q, mine0, mine1, 0, 63, 0, 63, mS, lS, Cn, acc);
        else if (p1) attn_step<false, true, false>(buf, Q0, Q1, c, q, mine0, mine1, 0, 63, 0, 63, mS, lS, Cn, acc);
        __builtin_amdgcn_sched_barrier(0);
    }
    __builtin_amdgcn_s_barrier();
#pragma unroll
    for (int a = 0; a < 2; ++a) { float l = lS[a]; l += __shfl_xor(l, 16); l += __shfl_xor(l, 32);
        const float gs = C.GN[((size_t)b * LP + q0 + toff[a]) * 32 + (h * 4 + g) * 3 + 1] / fmaxf(l, 1e-30f);
#pragma unroll
        for (int dt = 0; dt < 4; ++dt) OT[(a * 4 + dt) * 512] = OT[(a * 4 + dt) * 512] + acc[a][dt] * gs; }
    const bf16* kwb = C.KVB + ((size_t)b * LP) * 768 + 4 * 128 + h * 64; const bf16* vwb = C.KVB + ((size_t)b * LP) * 768 + 5 * 128 + h * 64;
#pragma unroll
    for (int a = 0; a < 2; ++a) { mS[a] = NINF; lS[a] = 0.f; Cn[a] = (f32x4){0.f, 0.f, 0.f, 0.f};
#pragma unroll
        for (int dt = 0; dt < 4; ++dt) acc[a][dt] = (f32x4){0.f, 0.f, 0.f, 0.f}; }
    const int jw0 = T >= 8 ? T - 8 : 0, nw = (MODE & 8) ? 0 : T - jw0 + 1;
#pragma unroll
    for (int s = 0; s < RG2; ++s) if (s < nw) ring_issue(L + s * RSLOT, kwb + (size_t)(jw0 + s) * 64 * 768, 768, vwb + (size_t)(jw0 + s) * 64 * 768, 768, w, lane);
    for (int s = 0; s < nw; ++s) {
        if (!(s & (RG2 - 1))) { RING_PAIR_SYNC();
#pragma unroll
            for (int u = 0; u < RG2; ++u) { const int s2 = s + RG2 + u; if (s2 < nw) ring_issue(L + (s2 & (NRING2 - 1)) * RSLOT, kwb + (size_t)(jw0 + s2) * 64 * 768, 768, vwb + (size_t)(jw0 + s2) * 64 * 768, 768, w, lane); } }
        const int j = jw0 + s;
        const LAS unsigned char* buf = L + (s & (NRING2 - 1)) * RSLOT;
        __builtin_amdgcn_sched_barrier(0);
        if (j == T - 8 || j == T) attn_step<true, true, true>(buf, Q0, Q1, c, q, true, true, (j == T - 8) ? toff[0] + 1 : 0, (j == T) ? toff[0] : 63, (j == T - 8) ? toff[1] + 1 : 0, (j == T) ? toff[1] : 63, mS, lS, Cn, acc);
        else attn_step<true, true, false>(buf, Q0, Q1, c, q, true, true, 0, 63, 0, 63, mS, lS, Cn, acc);
        __builtin_amdgcn_sched_barrier(0);
    }
    __builtin_amdgcn_s_barrier();
#pragma unroll
    for (int a = 0; a < 2; ++a) { float l = lS[a]; l += __shfl_xor(l, 16); l += __shfl_xor(l, 32);
        const size_t row = (size_t)b * LP + q0 + toff[a];
        const float gw = C.GN[row * 32 + (h * 4 + g) * 3 + 2] / fmaxf(l, 1e-30f);
#pragma unroll
        for (int dt = 0; dt < 4; ++dt) { const f32x4 o = OT[(a * 4 + dt) * 512] + acc[a][dt] * gw; const int col = h * 256 + g * 64 + 16 * dt + 4 * q;
            const f32x4 z = unpk4(*(const v2u*)(C.SZA + row * 512 + col));
            v2u ov; ov.x = pk2(o.x * z.x, o.y * z.y); ov.y = pk2(o.z * z.z, o.w * z.w);
            if (!(MODE & 32)) *(v2u*)(C.OA + row * 512 + col) = ov; else if (ov.x == 0x12345678u) *(v2u*)(C.OA + row * 512 + col) = ov; } }
}

constexpr int S_TILE = 2 * TILEB, S_IMPA = 4 * S_TILE, S_IMPB = S_IMPA + 8448, S_SELM = S_IMPB + 8448, S_LIST = S_SELM + 512, S_MISC = S_LIST + 1088, S_TUN = S_MISC + 64, S_MRG = S_TUN + 128, S_END = S_MRG + 8 * 64 * 18 * 4;
static_assert(S_END <= MISC_OFF, "sample attention LDS map");
__device__ __forceinline__ void pv_tile_tr(const LAS unsigned char* Vt, const f32x4 (&p)[4], int lane, f32x4 (&acc)[4]) {
    const bf16x8 P0 = pack8(p[0], p[1]), P1 = pack8(p[2], p[3]);
    const int i = lane & 15, q = lane >> 4;
    const LAS unsigned char* vb = Vt + (4 * q + (i >> 2)) * TP + (i & 3) * 8;
#pragma unroll
    for (int dt = 0; dt < 4; ++dt) {
        const s16x4 a0 = vtr(vb + dt * 32), a1 = vtr(vb + dt * 32 + 16 * TP), b0 = vtr(vb + dt * 32 + 32 * TP), b1 = vtr(vb + dt * 32 + 48 * TP);
        const bf16x8 va = (bf16x8){a0[0], a0[1], a0[2], a0[3], a1[0], a1[1], a1[2], a1[3]}, vb8 = (bf16x8){b0[0], b0[1], b0[2], b0[3], b1[0], b1[1], b1[2], b1[3]};
        acc[dt] = MFMA16(va, P0, acc[dt]); acc[dt] = MFMA16(vb8, P1, acc[dt]); }
}
struct TileSrc { const float* k; const float* v; int stride; int nrows; };
__device__ __forceinline__ void stage4_f32(LAS unsigned char* L, const TileSrc (&ts)[4], int tid) {
    const int r0 = tid >> 4, d4 = (tid & 15) * 4;
    f32x4 kv[4][2], vv[4][2];
#pragma unroll
    for (int t = 0; t < 4; ++t)
#pragma unroll
        for (int hh = 0; hh < 2; ++hh) { const int r = r0 + 32 * hh; const bool ok = r < ts[t].nrows;
            kv[t][hh] = ok ? *(const f32x4*)(ts[t].k + (size_t)r * ts[t].stride + d4) : (f32x4){0.f, 0.f, 0.f, 0.f};
            vv[t][hh] = ok ? *(const f32x4*)(ts[t].v + (size_t)r * ts[t].stride + d4) : (f32x4){0.f, 0.f, 0.f, 0.f}; }
#pragma unroll
    for (int t = 0; t < 4; ++t)
#pragma unroll
        for (int hh = 0; hh < 2; ++hh) { const int r = r0 + 32 * hh; v2u a, b2; a.x = pk2(kv[t][hh].x, kv[t][hh].y); a.y = pk2(kv[t][hh].z, kv[t][hh].w); b2.x = pk2(vv[t][hh].x, vv[t][hh].y); b2.y = pk2(vv[t][hh].z, vv[t][hh].w);
            *(LAS v2u*)(L + t * S_TILE + r * TP + d4 * 2) = a; *(LAS v2u*)(L + t * S_TILE + TILEB + r * TP + d4 * 2) = b2; }
}
__device__ __forceinline__ void stage4_bf16(LAS unsigned char* L, const bf16* kb, const bf16* vb, int tid) {
    const int r = tid >> 3, ch = tid & 7;
    v4u kk[4], vv[4];
#pragma unroll
    for (int t = 0; t < 4; ++t) { kk[t] = *(const v4u*)(kb + (size_t)(64 * t + r) * 64 + ch * 8); vv[t] = *(const v4u*)(vb + (size_t)(64 * t + r) * 64 + ch * 8); }
#pragma unroll
    for (int t = 0; t < 4; ++t) { *(LAS v4u*)(L + t * S_TILE + r * TP + ch * 16) = kk[t]; *(LAS v4u*)(L + t * S_TILE + TILEB + r * TP + ch * 16) = vv[t]; }
}
__device__ __forceinline__ void merge4(LAS float* mrg, int w, int lane, float& m, float& l, f32x4 (&acc)[4]) {
    const float NINF = -__builtin_inff();
    LAS float* me = mrg + (w * 64 + lane) * 18;
    me[0] = m; me[1] = l;
#pragma unroll
    for (int dt = 0; dt < 4; ++dt) { me[2 + 4 * dt] = acc[dt].x; me[3 + 4 * dt] = acc[dt].y; me[4 + 4 * dt] = acc[dt].z; me[5 + 4 * dt] = acc[dt].w; }
    LDS_FENCE(); __syncthreads();
    const int w0 = w & 4;
    float M = NINF;
#pragma unroll
    for (int k = 0; k < 4; ++k) M = fmaxf(M, mrg[((w0 + k) * 64 + lane) * 18]);
    const float Ms = (M > NINF) ? M : 0.f; float Lx = 0.f; f32x4 A[4];
#pragma unroll
    for (int dt = 0; dt < 4; ++dt) A[dt] = (f32x4){0.f, 0.f, 0.f, 0.f};
#pragma unroll
    for (int k = 0; k < 4; ++k) { const LAS float* o = mrg + ((w0 + k) * 64 + lane) * 18; const float f = ex2(o[0] - Ms); Lx += o[1] * f;
#pragma unroll
        for (int dt = 0; dt < 4; ++dt) { A[dt].x += o[2 + 4 * dt] * f; A[dt].y += o[3 + 4 * dt] * f; A[dt].z += o[4 + 4 * dt] * f; A[dt].w += o[5 + 4 * dt] * f; } }
    m = M; l = Lx;
#pragma unroll
    for (int dt = 0; dt < 4; ++dt) acc[dt] = A[dt];
    asm volatile("" : "+v"(m), "+v"(l), "+v"(acc[0]), "+v"(acc[1]), "+v"(acc[2]), "+v"(acc[3]));
    __syncthreads();
}
__device__ __forceinline__ void topk_token_s(const LAS float* ia, const LAS float* ib, int lane, LAS unsigned* dst) {
    bool cv[5], sv[5]; unsigned u[5];
#pragma unroll
    for (int k = 0; k < 5; ++k) { const int j = lane + 64 * k; cv[k] = j >= 1 && j < 256; u[k] = cv[k] ? __float_as_uint(ia[j] + ib[j]) : 0u; }
    unsigned prefix = 0u; int rem = 14;
    for (int bit = 30; bit >= 0; --bit) {
        const unsigned cand = prefix | (1u << bit); int cnt = 0;
#pragma unroll
        for (int k = 0; k < 5; ++k) cnt += __popcll(__ballot(cv[k] && ((u[k] >> bit) == (cand >> bit))));
        if (cnt >= rem) prefix = cand; else rem -= cnt;
    }
    const unsigned long long lt = (1ull << lane) - 1ull; int before = 0;
#pragma unroll
    for (int k = 0; k < 5; ++k) { const bool e = cv[k] && u[k] == prefix; const unsigned long long be = __ballot(e); const int rk = before + __popcll(be & lt); before += __popcll(be);
        sv[k] = cv[k] && (u[k] > prefix || (e && rk < rem)); }
    sv[0] = sv[0] || lane == 0; sv[4] = sv[4] || lane == 0;
#pragma unroll
    for (int k = 0; k < 5; ++k) { const unsigned long long bb = __ballot(sv[k]); if (lane == 0) { dst[2 * k] = (unsigned)bb; dst[2 * k + 1] = (unsigned)(bb >> 32); } }
}
__device__ __forceinline__ void attn_sample_unit(const Ctx& C, int b, int h) {
    const float NINF = -__builtin_inff();
    int tid_ = C.tid; asm volatile("" : "+v"(tid_));
    const int tid = tid_, lane = tid & 63, w = __builtin_amdgcn_readfirstlane(tid >> 6), c = lane & 15, q = lane >> 4, ti = c >> 2, g = c & 3, a = w >> 2, ks = w & 3;
    LAS unsigned char* L = C.lds;
    LAS float* impA = (LAS float*)(L + S_IMPA); LAS float* impB = (LAS float*)(L + S_IMPB); LAS unsigned* selm = (LAS unsigned*)(L + S_SELM); LAS int* list = (LAS int*)(L + S_LIST);
    LAS int* misc = (LAS int*)(L + S_MISC); LAS unsigned* tun = (LAS unsigned*)(L + S_TUN); LAS float* mrg = (LAS float*)(L + S_MRG);
    const int seq = b * 2 + h, tok = 4 * a + ti;
    const size_t row = (size_t)MP + (size_t)b * LS + tok;
    const bf16* qp = C.QB + row * 512 + h * 256 + g * 64 + 8 * q;
    const bf16x8 Q0 = *(const bf16x8*)qp, Q1 = *(const bf16x8*)(qp + 32);
    for (int i = tid; i < 2 * 8448 / 4; i += 512) impA[i] = 0.f;
    const unsigned char* Lt = nullptr; (void)Lt;
    const LAS unsigned char* myK = L + ks * S_TILE; const LAS unsigned char* myV = myK + TILEB;
    f32x4 acc[4], outv[4]; float m = NINF, l = 0.f;
#pragma unroll
    for (int dt = 0; dt < 4; ++dt) { acc[dt] = (f32x4){0.f, 0.f, 0.f, 0.f}; outv[dt] = (f32x4){0.f, 0.f, 0.f, 0.f}; }
    const bf16* kcb = C.KCBS + (size_t)seq * NCS * 64; const bf16* vcb = C.VCBS + (size_t)seq * NCS * 64;
    for (int s = 0; s < 4; ++s) {
        stage4_bf16(L, kcb + (size_t)s * 256 * 64, vcb + (size_t)s * 256 * 64, tid); LDS_FENCE(); __syncthreads();
        { f32x4 sc[4]; qk_tile(myK, Q0, Q1, c, q, sc); mask_tile(sc, q, 0, 1022 - 64 * (4 * s + ks));
          const float mn = fmaxf(m, colmax(sc)), ms = (mn > NINF) ? mn : 0.f; float sum = 0.f;
#pragma unroll
          for (int t = 0; t < 4; ++t) sum += (ex2(sc[t].x - ms) + ex2(sc[t].y - ms)) + (ex2(sc[t].z - ms) + ex2(sc[t].w - ms));
          l = l * ex2(m - ms) + sum; m = mn; }
        __syncthreads();
    }
    merge4(mrg, w, lane, m, l, acc);
    float lt_ = l; lt_ += __shfl_xor(lt_, 16); lt_ += __shfl_xor(lt_, 32);
    const float invC = 1.0f / fmaxf(lt_, 1e-30f), msC = (m > NINF) ? m : 0.f;
    for (int s = 0; s < 4; ++s) {
        stage4_bf16(L, kcb + (size_t)s * 256 * 64, vcb + (size_t)s * 256 * 64, tid); LDS_FENCE(); __syncthreads();
        { f32x4 sc[4]; qk_tile(myK, Q0, Q1, c, q, sc); const int tl = 4 * s + ks; mask_tile(sc, q, 0, 1022 - 64 * tl);
#pragma unroll
          for (int t = 0; t < 4; ++t) { sc[t].x = ex2(sc[t].x - msC) * invC; sc[t].y = ex2(sc[t].y - msC) * invC; sc[t].z = ex2(sc[t].z - msC) * invC; sc[t].w = ex2(sc[t].w - msC) * invC;
              f32x4 ps = sc[t]; ps.x += dpp_xor1(ps.x); ps.y += dpp_xor1(ps.y); ps.z += dpp_xor1(ps.z); ps.w += dpp_xor1(ps.w);
              ps.x += dpp_xor2(ps.x); ps.y += dpp_xor2(ps.y); ps.z += dpp_xor2(ps.z); ps.w += dpp_xor2(ps.w);
              if (g == 0) { const int j = 16 * tl + 4 * t + q; impA[tok * 264 + j] = (ps.x + ps.y) + (ps.z + 0.5f * ps.w); impB[tok * 264 + j + 1] = 0.5f * ps.w; } }
          pv_tile_tr(myV, sc, lane, acc); }
        __syncthreads();
    }
    m = 0.f; l = 0.f;
    merge4(mrg, w, lane, m, l, acc);
    { const float gc = C.GN[row * 32 + (h * 4 + g) * 3 + 0];
#pragma unroll
      for (int dt = 0; dt < 4; ++dt) outv[dt] = acc[dt] * gc; }
    topk_token_s(impA + w * 264, impB + w * 264, lane, selm + w * 12);
    LDS_FENCE(); __syncthreads();
    if (lane < 20 && w == 0) { const int aa = lane / 10, wi = lane % 10; unsigned o = 0u;
#pragma unroll
        for (int i = 0; i < 4; ++i) o |= selm[(4 * aa + i) * 12 + wi];
        tun[aa * 12 + wi] = o; }
    if (w == 1) {
        const unsigned long long lt = (1ull << lane) - 1ull; int base = 0;
#pragma unroll
        for (int k = 0; k < 5; ++k) { unsigned o = 0u; const int wi = 2 * k + (lane >> 5);
#pragma unroll
            for (int i = 0; i < 8; ++i) o |= selm[i * 12 + wi];
            const bool bt = (o >> (lane & 31)) & 1u; const unsigned long long mm = __ballot(bt);
            if (bt) list[base + __popcll(mm & lt)] = 64 * k + lane;
            base += __popcll(mm); }
        if (lane == 0) misc[0] = base;
    }
    LDS_FENCE(); __syncthreads();
    const int nsel = misc[0];
    m = NINF; l = 0.f;
#pragma unroll
    for (int dt = 0; dt < 4; ++dt) acc[dt] = (f32x4){0.f, 0.f, 0.f, 0.f};
    for (int s0 = 0; s0 < nsel; s0 += 4) {
        TileSrc ts[4];
#pragma unroll
        for (int t = 0; t < 4; ++t) { const int j = (s0 + t < nsel) ? list[s0 + t] : -1;
            if (j < 0) { ts[t].k = C.out; ts[t].v = C.out; ts[t].stride = 0; ts[t].nrows = 0; }
            else if (j < 256) { const int page = C.page_table[b * NPAGE + (j >> 1)]; const float* base = C.cache_kv + ((size_t)page * PAGE + (size_t)(j & 1) * 64) * 512 + 2 * 128 + h * 64;
                ts[t].k = base; ts[t].v = base + 128; ts[t].stride = 512; ts[t].nrows = 64; }
            else { const float* base = C.out + O_KVS + ((size_t)b * LS) * 512 + 2 * 128 + h * 64; ts[t].k = base; ts[t].v = base + 128; ts[t].stride = 512; ts[t].nrows = LS; } }
        stage4_f32(L, ts, tid); LDS_FENCE(); __syncthreads();
        if (s0 + ks < nsel) { const int j = list[s0 + ks], wi = j >> 5, bt = j & 31;
            if ((__builtin_amdgcn_readfirstlane(tun[a * 12 + wi]) >> bt) & 1u) {
                f32x4 sc[4]; qk_tile(myK, Q0, Q1, c, q, sc);
                const bool mine = (selm[tok * 12 + wi] >> bt) & 1u;
                mask_tile(sc, q, 0, mine ? (j == 256 ? tok : 63) : -1);
                online_step(sc, true, m, l, acc);
                pv_tile_tr(myV, sc, lane, acc); } }
        __syncthreads();
    }
    merge4(mrg, w, lane, m, l, acc);
    { float lx = l; lx += __shfl_xor(lx, 16); lx += __shfl_xor(lx, 32);
      const float gs = C.GN[row * 32 + (h * 4 + g) * 3 + 1] / fmaxf(lx, 1e-30f);
#pragma unroll
      for (int dt = 0; dt < 4; ++dt) outv[dt] += acc[dt] * gs; }
    m = NINF; l = 0.f;
#pragma unroll
    for (int dt = 0; dt < 4; ++dt) acc[dt] = (f32x4){0.f, 0.f, 0.f, 0.f};
    for (int s0 = 0; s0 < 9; s0 += 4) {
        TileSrc ts[4];
#pragma unroll
        for (int t = 0; t < 4; ++t) { const int i = s0 + t;
            if (i < 8) { const float* base = C.cache_win + (((size_t)b * 512 + (size_t)i * 64) * 2) * 128 + h * 64; ts[t].k = base; ts[t].v = base + 128; ts[t].stride = 256; ts[t].nrows = 64; }
            else if (i == 8) { const float* base = C.out + O_WINS + ((size_t)b * 512 + 504) * 256 + h * 64; ts[t].k = base; ts[t].v = base + 128; ts[t].stride = 256; ts[t].nrows = LS; }
            else { ts[t].k = C.out; ts[t].v = C.out; ts[t].stride = 0; ts[t].nrows = 0; } }
        stage4_f32(L, ts, tid); LDS_FENCE(); __syncthreads();
        { const int i = s0 + ks;
          if (i < 9) { f32x4 sc[4]; qk_tile(myK, Q0, Q1, c, q, sc);
              mask_tile(sc, q, (i == 0) ? tok + 1 : 0, (i == 8) ? tok : 63);
              online_step(sc, true, m, l, acc);
              pv_tile_tr(myV, sc, lane, acc); } }
        __syncthreads();
    }
    merge4(mrg, w, lane, m, l, acc);
    if (ks == 0) { float lx = l; lx += __shfl_xor(lx, 16); lx += __shfl_xor(lx, 32);
        const float gw = C.GN[row * 32 + (h * 4 + g) * 3 + 2] / fmaxf(lx, 1e-30f);
#pragma unroll
        for (int dt = 0; dt < 4; ++dt) { const f32x4 o = outv[dt] + acc[dt] * gw; const int col = h * 256 + g * 64 + 16 * dt + 4 * q;
            const f32x4 z = unpk4(*(const v2u*)(C.SZA + row * 512 + col));
            v2u ov; ov.x = pk2(o.x * z.x, o.y * z.y); ov.y = pk2(o.z * z.z, o.w * z.w);
            *(v2u*)(C.OA + row * 512 + col) = ov; } }
}
template <int MODE> __device__ __forceinline__ void p5_attn(const Ctx& C, const int qoff = 0, const bool do_s = true, const bool do_p = true) {
    LAS int* misc = (LAS int*)(C.lds + MISC_OFF + 128);
    unsigned* qctr = (unsigned*)(C.ws + WS_CTL) + CW_QCTR + qoff;
    for (;;) {
        if (C.tid == 0) misc[1] = (int)atomicAdd(qctr, 1u);
        __syncthreads();
        const int u = misc[1];
        __syncthreads();
        if (u >= BS * 2) break;
        if (!(MODE & 16) && do_s) attn_sample_unit(C, u >> 1, u & 1);
    }
    int nextv = 0;
    if (C.tid == 0) nextv = (int)atomicAdd(qctr + 64, 1u);
    for (;;) {
        if (C.tid == 0) misc[1] = nextv;
        __syncthreads();
        const int v = misc[1];
        __syncthreads();
        if (v >= BP * 2 * 128) break;
        if (C.tid == 0) nextv = (int)atomicAdd(qctr + 64, 1u);
        const int T = 127 - (v >> 3), sq = v & 7; if (do_p) attn_prompt_unit<MODE>(C, sq >> 1, sq & 1, T);
    }
}


template <class F>
__device__ __forceinline__ void skinny_gemm(const Ctx& C, const bf16* A, const bf16* Bt, int N, int K, const F& epi) {
    const int lane = C.lane, m = lane & 15, q = lane >> 4, nitems = (N >> 4) * 4;
    for (int it = C.gw; it < nitems; it += C.NGW) {
        const int s = it >> 2, rg = it & 3;
        const bf16* ap = A + (size_t)(64 * rg + m) * K + 8 * q; const bf16* bp = Bt + (size_t)(16 * s + m) * K + 8 * q;
        f32x4 acc[4];
#pragma unroll
        for (int mt = 0; mt < 4; ++mt) acc[mt] = (f32x4){0.f, 0.f, 0.f, 0.f};
#pragma unroll 8
        for (int ks = 0; ks < (K >> 5); ++ks) { const bf16x8 b = *(const bf16x8*)(bp + 32 * ks);
#pragma unroll
            for (int mt = 0; mt < 4; ++mt) acc[mt] = MFMA16(*(const bf16x8*)(ap + (size_t)mt * 16 * K + 32 * ks), b, acc[mt]); }
#pragma unroll
        for (int mt = 0; mt < 4; ++mt)
#pragma unroll
            for (int r = 0; r < 4; ++r) epi(64 * rg + 16 * mt + 4 * q + r, 16 * s + m, acc[mt][r]);
    }
}
template <class F>
__device__ __forceinline__ void skinny_gemm2(const Ctx& C, const bf16* A0, const bf16* Bt0, const bf16* A1, const bf16* Bt1, int N, int K, const F& epi) {
    const int lane = C.lane, m = lane & 15, q = lane >> 4, nitems = (N >> 4) * 4;
    for (int it = C.gw; it < nitems; it += C.NGW) {
        const int s = it >> 2, rg = it & 3;
        f32x4 acc0[4], acc1[4];
#pragma unroll
        for (int mt = 0; mt < 4; ++mt) { acc0[mt] = (f32x4){0.f, 0.f, 0.f, 0.f}; acc1[mt] = (f32x4){0.f, 0.f, 0.f, 0.f}; }
        { const bf16* ap = A0 + (size_t)(64 * rg + m) * K + 8 * q; const bf16* bp = Bt0 + (size_t)(16 * s + m) * K + 8 * q;
#pragma unroll 8
          for (int ks = 0; ks < (K >> 5); ++ks) { const bf16x8 b = *(const bf16x8*)(bp + 32 * ks);
#pragma unroll
              for (int mt = 0; mt < 4; ++mt) acc0[mt] = MFMA16(*(const bf16x8*)(ap + (size_t)mt * 16 * K + 32 * ks), b, acc0[mt]); } }
        { const bf16* ap = A1 + (size_t)(64 * rg + m) * K + 8 * q; const bf16* bp = Bt1 + (size_t)(16 * s + m) * K + 8 * q;
#pragma unroll 8
          for (int ks = 0; ks < (K >> 5); ++ks) { const bf16x8 b = *(const bf16x8*)(bp + 32 * ks);
#pragma unroll
              for (int mt = 0; mt < 4; ++mt) acc1[mt] = MFMA16(*(const bf16x8*)(ap + (size_t)mt * 16 * K + 32 * ks), b, acc1[mt]); } }
#pragma unroll
        for (int mt = 0; mt < 4; ++mt)
#pragma unroll
            for (int r = 0; r < 4; ++r) epi(64 * rg + 16 * mt + 4 * q + r, 16 * s + m, acc0[mt][r], acc1[mt][r]);
    }
}
__device__ __forceinline__ float bf2f1(bf16 v) { return __uint_as_float(((unsigned)v) << 16); }
struct SkIn {
    bf16 *QB, *KVB, *SZA, *SZS, *GM; float *U32, *GN, *out;
    __device__ __forceinline__ void operator()(int r, int c, float v) const {
        const size_t row = (size_t)MP + r;
        if (c < 512) QB[row * 512 + c] = (bf16)f2bf(v * QSCALE);
        else if (c < 1280) { const int kc = c - 512; KVB[row * 768 + kc] = (bf16)f2bf(v);
            if (kc < 512) out[O_KVS + (size_t)r * 512 + kc] = v; else out[O_WINS + ((size_t)(r >> 3) * 512 + 504 + (r & 7)) * 256 + (kc - 512)] = v; }
        else if (c < 1792) SZA[row * 512 + (c - 1280)] = (bf16)f2bf(v * sigmf(v));
        else if (c < 2304) U32[row * 512 + (c - 1792)] = v;
        else if (c < 2816) SZS[row * 512 + (c - 2304)] = (bf16)f2bf(v * sigmf(v));
        else if (c < 4864) GM[row * 2048 + (c - 2816)] = (bf16)f2bf(sigmf(v));
        else if (c < 4888) GN[row * 32 + (c - 4864)] = sigmf(v);
    }
};
struct SkGlu {
    bf16* YB; const bf16* Y1B; const bf16* SZS; const float* bias;
    __device__ __forceinline__ void operator()(int r, int c, float v) const { const size_t i = ((size_t)MP + r) * 512 + c; YB[i] = (bf16)f2bf(bf2f1(Y1B[i]) * sigmf(v + bias[c]) * bf2f1(SZS[i])); }
};
struct SkLift2 {
    bf16* MG; const bf16* GM;
    __device__ __forceinline__ void operator()(int r, int c, float vs, float va) const { const size_t row = (size_t)MP + r;
        MG[row * 1024 + c] = (bf16)f2bf(bf2f1(GM[row * 2048 + c]) * va + bf2f1(GM[row * 2048 + 1024 + c]) * vs); }
};
struct SkOut {
    bf16* YPB; const float* xs;
    __device__ __forceinline__ void operator()(int r, int c, float v) const { YPB[((size_t)MP + r) * 1024 + c] = (bf16)f2bf(xs[(size_t)r * 1024 + c] + v); }
};
__device__ __forceinline__ void p9_final(const Ctx& C) {
    const bf16* YPB = (const bf16*)(C.ws + WS_YPB);
    for (int m0 = C.gw; m0 < MT; m0 += 4 * C.NGW) {
        v4u p[4][2];
#pragma unroll
        for (int u = 0; u < 4; ++u) { const int m = m0 + u * C.NGW < MT ? m0 + u * C.NGW : m0;
#pragma unroll
            for (int j = 0; j < 2; ++j) p[u][j] = *(const v4u*)(YPB + (size_t)m * D + 512 * j + 8 * C.lane); }
#pragma unroll
        for (int u = 0; u < 4; ++u) { const int m = m0 + u * C.NGW; if (m >= MT) break;
            f32x4 v[4]; float s = 0.f;
#pragma unroll
            for (int j = 0; j < 2; ++j) { const v4u pp = p[u][j];
                v[2 * j] = (f32x4){__uint_as_float(pp.x << 16), __uint_as_float(pp.x & 0xffff0000u), __uint_as_float(pp.y << 16), __uint_as_float(pp.y & 0xffff0000u)};
                v[2 * j + 1] = (f32x4){__uint_as_float(pp.z << 16), __uint_as_float(pp.z & 0xffff0000u), __uint_as_float(pp.w << 16), __uint_as_float(pp.w & 0xffff0000u)}; }
#pragma unroll
            for (int j = 0; j < 4; ++j) s += (v[j].x * v[j].x + v[j].y * v[j].y) + (v[j].z * v[j].z + v[j].w * v[j].w);
            const float r = rsqrtf(wave_sum(s) * (1.f / D) + RMS_EPS);
#pragma unroll
            for (int j = 0; j < 4; ++j) { const int col = 512 * (j >> 1) + 8 * C.lane + 4 * (j & 1);
                *(f32x4*)(C.out + (size_t)m * D + col) = v[j] * r * *(const f32x4*)(C.final_g + col); } }
    }
    for (int it = C.gw; it < BS * 504; it += C.NGW) { const int b = it / 504, i = it % 504;
        ((f32x4*)(C.out + O_WINS + ((size_t)b * 512 + i) * 256))[C.lane] = ((const f32x4*)(C.cache_win + ((size_t)b * 512 + i + 8) * 256))[C.lane]; }
}

constexpr int N_PHASES = 8;
struct Args { const void* in[27]; float* out; unsigned char* ws; int ph_lo, ph_hi; };
__device__ __forceinline__ int lane_id() { return (int)__builtin_amdgcn_mbcnt_hi(~0u, __builtin_amdgcn_mbcnt_lo(~0u, 0u)); }
__device__ __forceinline__ void make_ctx(Ctx& C, const Args& a, unsigned char* lds_raw, const int wv) {
    C.lds = (LAS unsigned char*)lds_raw; C.wave = wv; C.lane = lane_id(); C.tid = wv * 64 + C.lane;
    C.G = gridDim.x; C.gw = blockIdx.x * NWAVES + C.wave; C.NGW = C.G * NWAVES;
    C.xp = (const float*)a.in[0]; C.xs = (const float*)a.in[1]; C.cache_kv = (const float*)a.in[2]; C.cache_win = (const float*)a.in[3]; C.st_re = (const float*)a.in[4]; C.st_im = (const float*)a.in[5];
    C.page_table = (const int*)a.in[6]; C.norm_g = (const float*)a.in[7]; C.w_in = (const float*)a.in[8]; C.cmp_pe = (const float*)a.in[9]; C.cmp_w1 = (const float*)a.in[10]; C.cmp_b1 = (const float*)a.in[11];
    C.cmp_w2 = (const float*)a.in[12]; C.lam_re = (const float*)a.in[13]; C.lam_im = (const float*)a.in[14]; C.log_dt = (const float*)a.in[15]; C.b_re = (const float*)a.in[16]; C.b_im = (const float*)a.in[17];
    C.c_re = (const float*)a.in[18]; C.c_im = (const float*)a.in[19]; C.ssm_d = (const float*)a.in[20]; C.w_glu = (const float*)a.in[21]; C.b_glu = (const float*)a.in[22]; C.w_la = (const float*)a.in[23];
    C.w_ls = (const float*)a.in[24]; C.w_out = (const float*)a.in[25]; C.final_g = (const float*)a.in[26];
    C.out = a.out; C.ws = a.ws; unsigned char* ws = a.ws;
    C.WTIN = (bf16*)(ws + WS_WTIN); C.WTGLU = (bf16*)(ws + WS_WTGLU); C.WTLA = (bf16*)(ws + WS_WTLA); C.WTLS = (bf16*)(ws + WS_WTLS); C.WTOUT = (bf16*)(ws + WS_WTOUT); C.WTC1 = (bf16*)(ws + WS_WTC1);
    C.XN = (bf16*)(ws + WS_XN); C.OA = (bf16*)(ws + WS_OA); C.Y1B = (bf16*)(ws + WS_Y1B); C.YB = (bf16*)(ws + WS_YB); C.MG = (bf16*)(ws + WS_MG); C.XC = (bf16*)(ws + WS_XC);
    C.KST = (float*)(ws + WS_CONST); C.SEND = (float*)(ws + WS_SEND); C.KC = (float*)(ws + WS_KC); C.VC = (float*)(ws + WS_VC); C.Y1 = (float*)(ws + WS_Y1); C.MB = (float*)(ws + WS_MB);
    C.PP = (float*)(ws + WS_PP); C.U32 = (float*)(ws + WS_U32); C.GN = (float*)(ws + WS_GN);
    C.KVB = (bf16*)(ws + WS_KVB); C.SZA = (bf16*)(ws + WS_SZA); C.SZS = (bf16*)(ws + WS_SZS); C.GM = (bf16*)(ws + WS_GM);
    C.QB = (bf16*)(ws + WS_QB); C.VST = (bf16*)(ws + WS_VST); C.VWT = (bf16*)(ws + WS_VWT); C.KCB = (bf16*)(ws + WS_KCB); C.VCT = (bf16*)(ws + WS_VCT); C.KCBS = (bf16*)(ws + WS_KCBS); C.VCBS = (bf16*)(ws + WS_VCBS);
}
__global__ void __launch_bounds__(NWAVES * 64, 2) mk_fwd(Args a) {
    extern __shared__ __attribute__((aligned(16))) unsigned char lds_raw[];
    unsigned char* ws = a.ws;
    volatile LAS unsigned* MISC = (volatile LAS unsigned*)((LAS unsigned char*)lds_raw + MISC_OFF);
    const int wv = __builtin_amdgcn_readfirstlane((int)threadIdx.x >> 6);
    if (wv == 0) MISC[lane_id()] = 0u;
    __syncthreads();
    const int lo = a.ph_lo, hi = a.ph_hi;
    const bool multi = (hi - lo) > 1;
    XcdBarrier bar; bar.bar = (unsigned*)(ws + WS_CTL) + CW_BAR; bar.x = 0; bar.st = nullptr;
    if (multi) bar = xcd_barrier_post((unsigned*)(ws + WS_CTL) + CW_BAR, MISC + 8, wv * 64 + lane_id());
#define IN(k) (lo <= (k) && (k) < hi)
#define MK Ctx C; make_ctx(C, a, lds_raw, wv)
#define SEAM(k) do { if (IN(k) && IN((k) + 1)) xcd_barrier(bar, wv * 64 + lane_id()); } while (0)
    if (IN(0)) { MK; p0_prep(C);
#if defined(REPEAT_WHAT) && REPEAT_WHAT == 0
        __syncthreads(); p0_prep(C);
#endif
    } SEAM(0);
    if (IN(1)) { MK; pg8::Gemm g{C.XN, C.WTIN, MP, NINP, D}; pg8::StaticOrder S; S.init(MP, NINP, C.G, (int)blockIdx.x);
        pg8::EpiIn E{C.QB, C.KVB, C.SZA, C.SZS, C.GM, C.XC, C.U32, C.GN, C.out, QSCALE, MP, O_KVP, O_KVS, O_WINP, O_WINS, (size_t)XC_S_ROWS};
        pg8::gemm_phase<pg8::EpiIn, pg8::StaticOrder, true, true>(C.lds, g, S, E, C.tid);
        SkIn K{C.QB, C.KVB, C.SZA, C.SZS, C.GM, C.U32, C.GN, C.out}; skinny_gemm(C, C.XN + (size_t)MP * D, C.WTIN, NINP, D, K);
#if defined(REPEAT_WHAT) && REPEAT_WHAT == 11
        skinny_gemm(C, C.XN + (size_t)MP * D, C.WTIN, NINP, D, K);
#endif
    } SEAM(1);
    if (IN(2)) { MK; p2_cmp1(C); __syncthreads(); p2_ssm_pass1(C); __syncthreads(); p3_ssm_pass2(C, true);
#if defined(REPEAT_WHAT) && REPEAT_WHAT == 21
        __syncthreads(); p2_cmp1(C);
#endif
#if defined(REPEAT_WHAT) && REPEAT_WHAT == 22
        __syncthreads();
#endif
#if defined(REPEAT_WHAT) && REPEAT_WHAT == 23
        __syncthreads(); p2_ssm_pass1(C);
#endif
    } SEAM(2);
    if (IN(3)) { MK; p3_ssm_pass2(C, false); __syncthreads(); p4_cmp2(C);
#if defined(REPEAT_WHAT) && REPEAT_WHAT == 31
        for (int rr = 0; rr < 4; ++rr) { __syncthreads(); p3_ssm_pass2(C, false); }
#endif
#if defined(REPEAT_WHAT) && REPEAT_WHAT == 32
        __syncthreads(); p4_cmp2(C);
#endif
    } SEAM(3);
    if (IN(4)) { MK; { pg8::Gemm g{C.Y1B, C.WTGLU, MP, 512, 512}; pg8::StaticOrder S; S.init(MP, 512, C.G, (int)blockIdx.x); pg8::EpiGlu E{C.YB, C.Y1B, C.SZS, C.b_glu};
        pg8::gemm_phase<pg8::EpiGlu, pg8::StaticOrder, true, true>(C.lds, g, S, E, C.tid);
        SkGlu K{C.YB, C.Y1B, C.SZS, C.b_glu}; skinny_gemm(C, C.Y1B + (size_t)MP * 512, C.WTGLU, 512, 512, K); }
        __syncthreads(); p5_attn<0>(C);
#if defined(REPEAT_WHAT) && REPEAT_WHAT == 41
        __syncthreads(); p5_attn<0>(C, 128);
#endif
#if defined(REPEAT_WHAT) && REPEAT_WHAT == 42
        __syncthreads(); p5_attn<0>(C, 128, false, true);
#endif
#if defined(REPEAT_WHAT) && REPEAT_WHAT >= 400
        __syncthreads(); p5_attn<REPEAT_WHAT - 400>(C, 128, false, true);
#endif
#if defined(REPEAT_WHAT) && REPEAT_WHAT == 43
        __syncthreads(); p5_attn<0>(C, 128, true, false);
#endif
    } SEAM(4);
    if (IN(5)) { MK; pg8::Gemm g{C.YB, C.WTLS, MP, 1024, 512, C.OA, C.WTLA}; pg8::PairOrder S; S.init(MP, 1024, C.G, (int)blockIdx.x); pg8::EpiLift2 E{C.MG, C.GM};
        pg8::gemm_phase<pg8::EpiLift2, pg8::PairOrder, true, true>(C.lds, g, S, E, C.tid);
        SkLift2 K{C.MG, C.GM}; skinny_gemm2(C, C.YB + (size_t)MP * 512, C.WTLS, C.OA + (size_t)MP * 512, C.WTLA, 1024, 512, K);
#if defined(REPEAT_WHAT) && REPEAT_WHAT == 5
        __syncthreads(); pg8::gemm_phase<pg8::EpiLift2, pg8::PairOrder, true, true>(C.lds, g, S, E, C.tid);
#endif
    } SEAM(5);
    if (IN(6)) { MK; pg8::Gemm g{C.MG, C.WTOUT, MP, 1024, 1024}; pg8::StaticOrder S; S.init(MP, 1024, C.G, (int)blockIdx.x); pg8::EpiOut E{(bf16*)(C.ws + WS_YPB), C.xp, C.xs, MP};
        pg8::gemm_phase<pg8::EpiOut, pg8::StaticOrder, true, true>(C.lds, g, S, E, C.tid);
        SkOut K{(bf16*)(C.ws + WS_YPB), C.xs}; skinny_gemm(C, C.MG + (size_t)MP * 1024, C.WTOUT, 1024, 1024, K); } SEAM(6);
    if (IN(7)) { MK; p9_final(C);
#if defined(REPEAT_WHAT) && REPEAT_WHAT == 71
        __syncthreads(); { pg8::Gemm g{C.XN, C.WTIN, MP, NINP, D}; pg8::StaticOrder S; S.init(MP, NINP, C.G, (int)blockIdx.x);
        pg8::EpiIn E{C.QB, C.KVB, C.SZA, C.SZS, C.GM, C.XC, C.U32, C.GN, C.out, QSCALE, MP, O_KVP, O_KVS, O_WINP, O_WINS, (size_t)XC_S_ROWS};
        pg8::gemm_phase<pg8::EpiIn, pg8::StaticOrder, true, true>(C.lds, g, S, E, C.tid); }
#endif
#if defined(REPEAT_WHAT) && REPEAT_WHAT == 72
        __syncthreads(); { pg8::Gemm g{C.YB, C.WTLS, MP, 1024, 512, C.OA, C.WTLA}; pg8::PairOrder S; S.init(MP, 1024, C.G, (int)blockIdx.x); pg8::EpiLift2 E{C.MG, C.GM};
        pg8::gemm_phase<pg8::EpiLift2, pg8::PairOrder, true, true>(C.lds, g, S, E, C.tid); }
#endif
    }
#undef IN
#undef SEAM
}

#ifndef MK_ONE_LAUNCH
#define MK_ONE_LAUNCH 1
#endif
extern "C" void kernel_launch(void* const* d_in, const int* in_sizes, int n_in, void* d_out, int out_size, void* d_ws, size_t ws_size, hipStream_t stream) {
    static int grid = 0;
    if (grid == 0) {
        if (n_in != 27 || (size_t)out_size != O_END || ws_size < WS_END) { fprintf(stderr, "kernel_launch: unexpected shapes: n_in %d out %d ws %zu\n", n_in, out_size, ws_size); grid = -1; return; }
        int dev = 0, cus = 0, per_cu = 0;
        if (hipGetDevice(&dev) != hipSuccess || hipDeviceGetAttribute(&cus, hipDeviceAttributeMultiprocessorCount, dev) != hipSuccess) { grid = -1; return; }
        if (hipFuncSetAttribute((const void*)mk_fwd, hipFuncAttributeMaxDynamicSharedMemorySize, LDS_BYTES) != hipSuccess) { fprintf(stderr, "kernel_launch: hipFuncSetAttribute failed\n"); grid = -1; return; }
        if (hipOccupancyMaxActiveBlocksPerMultiprocessor(&per_cu, (const void*)mk_fwd, NWAVES * 64, LDS_BYTES) != hipSuccess || per_cu < 1) fprintf(stderr, "kernel_launch: occupancy query reports %d\n", per_cu);
        (void)hipGetLastError();
        grid = cus;
    }
    if (grid < 0) return;
    (void)hipMemsetAsync((char*)d_ws + WS_CTL, 0, CTL_ZERO_BYTES, stream);
    Args a{};
    for (int i = 0; i < 27; ++i) a.in[i] = d_in[i];
    a.out = (float*)d_out; a.ws = (unsigned char*)d_ws;
#if MK_ONE_LAUNCH
    a.ph_lo = 0; a.ph_hi = N_PHASES;
    hipLaunchKernelGGL(mk_fwd, dim3(grid), dim3(NWAVES * 64), LDS_BYTES, stream, a);
#else
    for (int p = 0; p < N_PHASES; ++p) { a.ph_lo = p; a.ph_hi = p + 1; hipLaunchKernelGGL(mk_fwd, dim3(grid), dim3(NWAVES * 64), LDS_BYTES, stream, a); }
#endif
}
```

```cpp
#include <hip/hip_runtime.h>
#include <cstdio>
#include <cstdint>
namespace pg8 {
#define PG8_LAS __attribute__((address_space(3)))
typedef unsigned short bf16_t;
typedef short bf16x8 __attribute__((ext_vector_type(8)));
typedef float f32x4 __attribute__((ext_vector_type(4)));
typedef unsigned u32x4 __attribute__((ext_vector_type(4)));
constexpr int BM = 256, BK = 64, HALF = 128, HTB = HALF * BK * 2  , STAGE_BYTES = 8 * HTB, NXCD = 8, WGM = 8;

__host__ __device__ __forceinline__ int lds_byte(int r, int c) { const int st = (r >> 4) * 2 + (c >> 5), rr = r & 15, cc = c & 31, ob = rr * 64 + cc * 2; return st * 1024 + (ob ^ (((ob >> 9) & 1) << 5)); }
__host__ __device__ __forceinline__ void stage_rc(int b, int& R, int& C) { const int st = b / 1024, sb = b % 1024, swz = sb ^ (((sb >> 9) & 1) << 5); R = (st >> 1) * 16 + swz / 64; C = (st & 1) * 32 + (swz % 64) / 2; }
__host__ __device__ __forceinline__ int perm32(int rho) { const int n = rho >> 4, i = rho & 15; return 8 * (i >> 2) + 4 * n + (i & 3); }

struct Unit { int pm, pn, part; };
struct Gemm { const bf16_t* A; const bf16_t* Bt; int M, N, K; const bf16_t* A2; const bf16_t* Bt2; };

struct StaticOrder {
    int nM, nN, nwg, G, c;
    __host__ __device__ void init(int M, int N, int G_, int c_) { nM = M / BM; nN = N / BM; nwg = nM * nN; G = G_; c = c_; }
    __host__ __device__ bool next(int i, Unit& u) const {
        const long L = (long)i * G + c; if (L >= nwg) return false;
        int wgid = (int)L; { const int q = nwg / NXCD, r = nwg % NXCD, xcd = wgid % NXCD, off = wgid / NXCD; wgid = (xcd < r ? xcd * (q + 1) : r * (q + 1) + (xcd - r) * q) + off; }
        const int nig = WGM * nN, gid = wgid / nig, fm = gid * WGM, gsz = (nM - fm) < WGM ? (nM - fm) : WGM;
        u.pm = fm + ((wgid % nig) % gsz); u.pn = (wgid % nig) / gsz; u.part = 0; return true;
    }
    __device__ __forceinline__ void a_ready(const Unit&) const {}
    __device__ __forceinline__ void done(const Unit&) const {}
};
struct PairOrder : StaticOrder {
    __host__ __device__ bool next(int i, Unit& u) const { if (!StaticOrder::next(i >> 1, u)) return false; u.part = i & 1; return true; }
};

__device__ __forceinline__ unsigned cvt_pk_bf16(float lo, float hi) { unsigned r; asm volatile("v_cvt_pk_bf16_f32 %0, %1, %2" : "=v"(r) : "v"(lo), "v"(hi)); return r; }
typedef float f32x2 __attribute__((ext_vector_type(2)));
__device__ __forceinline__ f32x2 gelu_pk(f32x2 v) {
    const f32x2 av = __builtin_elementwise_abs(v), d = av * 0.2316418882f + 1.0f;
    f32x2 t; t.x = __builtin_amdgcn_rcpf(d.x); t.y = __builtin_amdgcn_rcpf(d.y);
    f32x2 q = t * 0.5307027145f + (-0.7265760135f); q = q * t + 0.7107068705f; q = q * t + (-0.142248368f); q = q * t + 0.127414796f; q = q * t;
    const f32x2 s = (v * v) * (-0.72134752044f);
    f32x2 e; e.x = __builtin_amdgcn_exp2f(s.x); e.y = __builtin_amdgcn_exp2f(s.y);
    const f32x2 m = v * (q * e), r = v - m;
    f32x2 o; o.x = v.x < 0.f ? m.x : r.x; o.y = v.y < 0.f ? m.y : r.y; return o;
}

__device__ __forceinline__ float sigm(float x) { return 1.0f / (1.0f + __expf(-x)); }
__device__ __forceinline__ f32x4 sigm4(f32x4 v) { return (f32x4){sigm(v[0]), sigm(v[1]), sigm(v[2]), sigm(v[3])}; }

struct EpiF32 {
    static constexpr bool PERM = false, AFTER_DRAIN = false, TWO_PART = false;
    float* C; int ldc;
    __device__ __forceinline__ void operator()(const f32x4 (&acc)[2][2][4][2], const Unit& u, int wr, int wc, int fr, int fq) const {
        const int row0 = u.pm * BM + wr * 64 + fr, col0 = u.pn * BM + wc * 32 + 4 * fq;
#pragma unroll
        for (int ai = 0; ai < 2; ++ai)
#pragma unroll
            for (int m = 0; m < 4; ++m) { float* rowp = C + (size_t)(row0 + ai * HALF + m * 16) * ldc + col0;
#pragma unroll
                for (int bj = 0; bj < 2; ++bj)
#pragma unroll
                    for (int n = 0; n < 2; ++n) *(f32x4*)(rowp + bj * HALF + n * 16) = acc[ai][bj][m][n]; }
    }
};
__device__ __forceinline__ f32x4 bfx4(unsigned lo, unsigned hi) { return (f32x4){__uint_as_float(lo << 16), __uint_as_float(lo & 0xffff0000u), __uint_as_float(hi << 16), __uint_as_float(hi & 0xffff0000u)}; }
__device__ __forceinline__ u32x4 pack8f(f32x4 v0, f32x4 v1) { u32x4 w; w.x = cvt_pk_bf16(v0[0], v0[1]); w.y = cvt_pk_bf16(v0[2], v0[3]); w.z = cvt_pk_bf16(v1[0], v1[1]); w.w = cvt_pk_bf16(v1[2], v1[3]); return w; }
struct EpiIn {
    static constexpr bool PERM = true, AFTER_DRAIN = false, TWO_PART = false;
    bf16_t *QB, *KVB, *SZA, *SZS, *GM, *XC; float *U32, *GN, *out; float qscale; int mp;
    size_t o_kvp, o_kvs, o_winp, o_wins, xc_prow0;
    __device__ __forceinline__ void operator()(const f32x4 (&acc)[2][2][4][2], const Unit& u, int wr, int wc, int fr, int fq) const {
        const int row0 = u.pm * BM + wr * 64 + fr, pn = u.pn; const bool prm = u.pm * BM < mp;
#pragma unroll
        for (int ai = 0; ai < 2; ++ai)
#pragma unroll
            for (int m = 0; m < 4; ++m) { const size_t row = (size_t)(row0 + ai * HALF + m * 16);
#pragma unroll
                for (int bj = 0; bj < 2; ++bj) { const int c = pn * BM + bj * HALF + wc * 32 + 8 * fq; const f32x4 v0 = acc[ai][bj][m][0], v1 = acc[ai][bj][m][1];
                    if (pn < 2) { *(u32x4*)(QB + row * 512 + c) = pack8f(v0 * qscale, v1 * qscale); }
                    else if (pn < 5) { const int kc = c - 512, slot = kc >> 7;
                        *(u32x4*)(KVB + row * 768 + kc) = pack8f(v0, v1);
                        if (slot < 4) { float* d = out + (prm ? o_kvp + row * 512 : o_kvs + (row - mp) * 512) + kc; *(f32x4*)d = v0; *(f32x4*)(d + 4) = v1;
 }
                        else { const int wk = kc - 512;
                            if (prm) { const int t = (int)(row & 8191); if (t >= 7680) { float* d = out + o_winp + ((row >> 13) * 512 + (t - 7680)) * 256 + wk; *(f32x4*)d = v0; *(f32x4*)(d + 4) = v1; } }
                            else { const size_t q = row - mp; float* d = out + o_wins + ((q >> 3) * 512 + 504 + (q & 7)) * 256 + wk; *(f32x4*)d = v0; *(f32x4*)(d + 4) = v1; } } }
                    else if (pn < 7) { *(u32x4*)(SZA + row * 512 + (c - 1280)) = pack8f(v0 * sigm4(v0), v1 * sigm4(v1)); }
                    else if (pn < 9) { float* d = U32 + row * 512 + (c - 1792); *(f32x4*)d = v0; *(f32x4*)(d + 4) = v1; }
                    else if (pn < 11) { *(u32x4*)(SZS + row * 512 + (c - 2304)) = pack8f(v0 * sigm4(v0), v1 * sigm4(v1)); }
                    else if (pn < 19) { *(u32x4*)(GM + row * 2048 + (c - 2816)) = pack8f(sigm4(v0), sigm4(v1)); }
                    else if (c < 4888) { float* d = GN + row * 32 + (c - 4864); *(f32x4*)d = sigm4(v0); *(f32x4*)(d + 4) = sigm4(v1); } } }
    }
};
struct EpiGlu {
    static constexpr bool PERM = true, AFTER_DRAIN = false, TWO_PART = false;
    bf16_t* O; const bf16_t* Y1B; const bf16_t* SZS; const float* bias;
    __device__ __forceinline__ void operator()(const f32x4 (&acc)[2][2][4][2], const Unit& u, int wr, int wc, int fr, int fq) const {
        const int row0 = u.pm * BM + wr * 64 + fr, col0 = u.pn * BM + wc * 32 + 8 * fq;
#pragma unroll
        for (int ai = 0; ai < 2; ++ai)
#pragma unroll
            for (int m = 0; m < 4; ++m) { const size_t row = (size_t)(row0 + ai * HALF + m * 16);
#pragma unroll
                for (int bj = 0; bj < 2; ++bj) { const int c = col0 + bj * HALF;
                    const f32x4 b0 = *(const f32x4*)(bias + c), b1 = *(const f32x4*)(bias + c + 4);
                    const u32x4 yy = *(const u32x4*)(Y1B + row * 512 + c); const f32x4 y0 = bfx4(yy.x, yy.y), y1 = bfx4(yy.z, yy.w);
                    const u32x4 zz = *(const u32x4*)(SZS + row * 512 + c);
                    *(u32x4*)(O + row * 512 + c) = pack8f(y0 * sigm4(acc[ai][bj][m][0] + b0) * bfx4(zz.x, zz.y), y1 * sigm4(acc[ai][bj][m][1] + b1) * bfx4(zz.z, zz.w)); } }
    }
};
struct EpiLift2 {
    static constexpr bool PERM = true, AFTER_DRAIN = false, TWO_PART = true;
    bf16_t* O; const bf16_t* GM;
    __device__ __forceinline__ void mid(f32x4 (&acc)[2][2][4][2], const Unit& u, int wr, int wc, int fr, int fq) const {
        const int row0 = u.pm * BM + wr * 64 + fr, col0 = u.pn * BM + wc * 32 + 8 * fq;
#pragma unroll
        for (int ai = 0; ai < 2; ++ai)
#pragma unroll
            for (int m = 0; m < 4; ++m) { const size_t row = (size_t)(row0 + ai * HALF + m * 16);
#pragma unroll
                for (int bj = 0; bj < 2; ++bj) { const int c = col0 + bj * HALF; const u32x4 ga = *(const u32x4*)(GM + row * 2048 + c), gb = *(const u32x4*)(GM + row * 2048 + 1024 + c);
                    const f32x4 a0 = bfx4(ga.x, ga.y), a1 = bfx4(ga.z, ga.w), b0 = bfx4(gb.x, gb.y), b1 = bfx4(gb.z, gb.w);
#pragma unroll
                    for (int j = 0; j < 4; ++j) { acc[ai][bj][m][0][j] *= b0[j] * __builtin_amdgcn_rcpf(fmaxf(a0[j], 1e-30f)); acc[ai][bj][m][1][j] *= b1[j] * __builtin_amdgcn_rcpf(fmaxf(a1[j], 1e-30f)); } } }
    }
    __device__ __forceinline__ void operator()(const f32x4 (&acc)[2][2][4][2], const Unit& u, int wr, int wc, int fr, int fq) const {
        const int row0 = u.pm * BM + wr * 64 + fr, col0 = u.pn * BM + wc * 32 + 8 * fq;
#pragma unroll
        for (int ai = 0; ai < 2; ++ai)
#pragma unroll
            for (int m = 0; m < 4; ++m) { const size_t row = (size_t)(row0 + ai * HALF + m * 16);
#pragma unroll
                for (int bj = 0; bj < 2; ++bj) { const int c = col0 + bj * HALF; const u32x4 ga = *(const u32x4*)(GM + row * 2048 + c);
                    *(u32x4*)(O + row * 1024 + c) = pack8f(bfx4(ga.x, ga.y) * acc[ai][bj][m][0], bfx4(ga.z, ga.w) * acc[ai][bj][m][1]); } }
    }
};
struct EpiOut {
    static constexpr bool PERM = true, AFTER_DRAIN = false, TWO_PART = false;
    bf16_t* O; const float* xp; const float* xs; int mp;
    __device__ __forceinline__ void operator()(const f32x4 (&acc)[2][2][4][2], const Unit& u, int wr, int wc, int fr, int fq) const {
        const int row0 = u.pm * BM + wr * 64 + fr, col0 = u.pn * BM + wc * 32 + 8 * fq;
        const float* xb = (u.pm * BM < mp) ? xp : (xs - (size_t)mp * 1024);
#pragma unroll
        for (int ai = 0; ai < 2; ++ai)
#pragma unroll
            for (int m = 0; m < 4; ++m) { const size_t row = (size_t)(row0 + ai * HALF + m * 16);
#pragma unroll
                for (int bj = 0; bj < 2; ++bj) { const int c = col0 + bj * HALF;
                    const f32x4 x0 = *(const f32x4*)(xb + row * 1024 + c), x1 = *(const f32x4*)(xb + row * 1024 + c + 4);
                    *(u32x4*)(O + row * 1024 + c) = pack8f(x0 + acc[ai][bj][m][0], x1 + acc[ai][bj][m][1]); } }
    }
};

template <class Epi, class Sched, bool ALIGN_EPI = false, bool SP2 = false>
__device__ __forceinline__ void gemm_phase(PG8_LAS unsigned char* lds, const Gemm g, const Sched& S, const Epi& E, const int tid_in) {
    const int tid = tid_in, wid = __builtin_amdgcn_readfirstlane(tid >> 6), lane = tid & 63, wr = wid >> 2, wc = wid & 3, fr = lane & 15, fq = lane >> 4;
    const int K = g.K, nt = K / BK;
    unsigned voffA[2], voffB[2];
#pragma unroll
    for (int i = 0; i < 2; ++i) { int R, C; stage_rc(tid * 16 + i * 8192, R, C); const int Rb = Epi::PERM ? ((R & ~31) + perm32(R & 31)) : R;
        voffA[i] = (unsigned)(R * K + C) * 2u; voffB[i] = (unsigned)(Rb * K + C) * 2u; }
    const size_t kstep = (size_t)(BK * 2);
    const size_t hstep = (size_t)HALF * K * 2;
    const size_t tstep = 2 * hstep;
    const unsigned ldsw = (unsigned)wid * 1024u;
    const int aoff = lds_byte(wr * 64 + fr, fq * 8), boff = lds_byte(wc * 32 + fr, fq * 8);
#define PG8_SA(b, h) (((b) * 2 + (h)) * HTB)
#define PG8_SB(b, h) ((4 + (b) * 2 + (h)) * HTB)
#define PG8_STAGE(bufoff, gbase, voff) do { _Pragma("unroll") for (int _i = 0; _i < 2; ++_i) \
        __builtin_amdgcn_global_load_lds((const unsigned*)((const char*)(gbase) + (voff)[_i]), (PG8_LAS unsigned*)(lds + (bufoff) + ldsw + _i * 8192), 16, 0, 0); } while (0)
#define PG8_LDA(dst, b, h) do { _Pragma("unroll") for (int m = 0; m < 4; ++m) _Pragma("unroll") for (int k = 0; k < 2; ++k) dst[m][k] = *(const PG8_LAS bf16x8*)(lds + PG8_SA(b, h) + aoff + m * 2048 + k * 1024); } while (0)
#define PG8_LDB(dst, b, h) do { _Pragma("unroll") for (int n = 0; n < 2; ++n) _Pragma("unroll") for (int k = 0; k < 2; ++k) dst[n][k] = *(const PG8_LAS bf16x8*)(lds + PG8_SB(b, h) + boff + n * 2048 + k * 1024); } while (0)
#define PG8_MMA(ai, bj, At, Bt) do { __builtin_amdgcn_s_setprio(1); _Pragma("unroll") for (int m = 0; m < 4; ++m) _Pragma("unroll") for (int n = 0; n < 2; ++n) _Pragma("unroll") for (int k = 0; k < 2; ++k) \
        acc[ai][bj][m][n] = __builtin_amdgcn_mfma_f32_16x16x32_bf16(Bt[n][k], At[m][k], acc[ai][bj][m][n], 0, 0, 0); __builtin_amdgcn_s_setprio(0); } while (0)
#define PG8_WAIT_V(n) asm volatile("s_waitcnt vmcnt(" #n ")" ::: "memory")
#define PG8_WAIT_L(n) asm volatile("s_waitcnt lgkmcnt(" #n ")" ::: "memory")
#define PG8_BAR __builtin_amdgcn_s_barrier()
#define PG8_SCHED __builtin_amdgcn_sched_barrier(0)
    Unit cur, nxt; int ui = 0;
    if (!S.next(0, cur)) return;
    f32x4 acc[2][2][4][2];
#pragma unroll
    for (int a = 0; a < 2; ++a)
#pragma unroll
        for (int b = 0; b < 2; ++b)
#pragma unroll
            for (int m = 0; m < 4; ++m)
#pragma unroll
                for (int n = 0; n < 2; ++n) acc[a][b][m][n] = (f32x4){0.f, 0.f, 0.f, 0.f};
    bf16x8 At[4][2], B0[2][2], B1[2][2];
    const char* cA = (const char*)((Epi::TWO_PART && cur.part) ? g.A2 : g.A) + (size_t)cur.pm * tstep; const char* cB = (const char*)((Epi::TWO_PART && cur.part) ? g.Bt2 : g.Bt) + (size_t)cur.pn * tstep;
    S.a_ready(cur);
    if constexpr (SP2) {
        PG8_STAGE(PG8_SB(0, 0), cB, voffB); PG8_STAGE(PG8_SB(0, 1), cB + hstep, voffB); PG8_STAGE(PG8_SA(0, 0), cA, voffA); PG8_STAGE(PG8_SA(0, 1), cA + hstep, voffA);
        if (wr == 1) PG8_BAR;
        PG8_WAIT_V(2); PG8_BAR;
        PG8_STAGE(PG8_SB(1, 0), cB + kstep, voffB); PG8_STAGE(PG8_SA(1, 0), cA + kstep, voffA); PG8_STAGE(PG8_SB(1, 1), cB + hstep + kstep, voffB);
        PG8_WAIT_V(6); PG8_BAR;
    } else {
        PG8_STAGE(PG8_SB(0, 0), cB, voffB); PG8_STAGE(PG8_SA(0, 0), cA, voffA); PG8_STAGE(PG8_SB(0, 1), cB + hstep, voffB); PG8_STAGE(PG8_SA(0, 1), cA + hstep, voffA);
        if (wr == 1) PG8_BAR;
        PG8_WAIT_V(4); PG8_BAR;
        PG8_STAGE(PG8_SB(1, 0), cB + kstep, voffB); PG8_STAGE(PG8_SA(1, 0), cA + kstep, voffA); PG8_STAGE(PG8_SB(1, 1), cB + hstep + kstep, voffB);
        PG8_WAIT_V(6); PG8_BAR;
    }
    for (;;) {
        const bool has_next = S.next(ui + 1, nxt);
        const char* nA = has_next ? (const char*)((Epi::TWO_PART && nxt.part) ? g.A2 : g.A) + (size_t)nxt.pm * tstep : cA; const char* nB = has_next ? (const char*)((Epi::TWO_PART && nxt.part) ? g.Bt2 : g.Bt) + (size_t)nxt.pn * tstep : cB;
        for (int t = 0; t < nt; t += 2) {
            const bool last = (t == nt - 2);
            const char* a1 = cA + (size_t)(t + 1) * kstep;
            const char* a2 = last ? nA : cA + (size_t)(t + 2) * kstep; const char* b2 = last ? nB : cB + (size_t)(t + 2) * kstep;
            const char* a3 = a2 + kstep; const char* b3 = b2 + kstep;
            if (last && has_next) S.a_ready(nxt);
            if constexpr (SP2) {
            PG8_LDB(B0, 0, 0); PG8_LDB(B1, 0, 1); PG8_SCHED; PG8_LDA(At, 0, 0); PG8_STAGE(PG8_SA(1, 1), a1 + hstep, voffA);
            PG8_WAIT_V(8); PG8_WAIT_L(0); PG8_BAR; PG8_MMA(0, 0, At, B0); PG8_MMA(0, 1, At, B1); PG8_BAR; PG8_SCHED;
            PG8_LDA(At, 0, 1); PG8_STAGE(PG8_SB(0, 0), b2, voffB); PG8_STAGE(PG8_SB(0, 1), b2 + hstep, voffB); PG8_STAGE(PG8_SA(0, 0), a2, voffA);
            PG8_WAIT_V(8); PG8_WAIT_L(0); PG8_BAR; PG8_MMA(1, 0, At, B0); PG8_MMA(1, 1, At, B1); PG8_BAR; PG8_SCHED;
            PG8_LDB(B0, 1, 0); PG8_LDB(B1, 1, 1); PG8_SCHED; PG8_LDA(At, 1, 0); PG8_STAGE(PG8_SA(0, 1), a2 + hstep, voffA);
            PG8_WAIT_V(8); PG8_WAIT_L(0); PG8_BAR; PG8_MMA(0, 0, At, B0); PG8_MMA(0, 1, At, B1); PG8_BAR; PG8_SCHED;
            PG8_LDA(At, 1, 1); PG8_STAGE(PG8_SB(1, 0), b3, voffB); PG8_STAGE(PG8_SB(1, 1), b3 + hstep, voffB); PG8_STAGE(PG8_SA(1, 0), a3, voffA);
            PG8_WAIT_V(8); PG8_WAIT_L(0); PG8_BAR; PG8_MMA(1, 0, At, B0); PG8_MMA(1, 1, At, B1); PG8_BAR; PG8_SCHED;
            } else {
            PG8_LDB(B0, 0, 0); PG8_SCHED; PG8_LDA(At, 0, 0); PG8_STAGE(PG8_SA(1, 1), a1 + hstep, voffA);
            PG8_WAIT_L(8); PG8_BAR; PG8_WAIT_L(0); PG8_MMA(0, 0, At, B0); PG8_BAR; PG8_SCHED;
            PG8_LDB(B1, 0, 1); PG8_STAGE(PG8_SB(0, 0), b2, voffB);
            PG8_BAR; PG8_WAIT_L(0); PG8_MMA(0, 1, At, B1); PG8_BAR;
            PG8_LDA(At, 0, 1); PG8_STAGE(PG8_SA(0, 0), a2, voffA);
            PG8_BAR; PG8_WAIT_L(0); PG8_MMA(1, 0, At, B0); PG8_BAR; PG8_SCHED;
            PG8_STAGE(PG8_SB(0, 1), b2 + hstep, voffB);
            PG8_WAIT_V(6); PG8_BAR; PG8_MMA(1, 1, At, B1); PG8_BAR;
            PG8_LDB(B0, 1, 0); PG8_SCHED; PG8_LDA(At, 1, 0); PG8_STAGE(PG8_SA(0, 1), a2 + hstep, voffA);
            PG8_WAIT_L(8); PG8_BAR; PG8_WAIT_L(0); PG8_MMA(0, 0, At, B0); PG8_BAR; PG8_SCHED;
            PG8_LDB(B1, 1, 1); PG8_STAGE(PG8_SB(1, 0), b3, voffB);
            PG8_BAR; PG8_WAIT_L(0); PG8_MMA(0, 1, At, B1); PG8_BAR;
            PG8_LDA(At, 1, 1); PG8_STAGE(PG8_SA(1, 0), a3, voffA);
            PG8_BAR; PG8_WAIT_L(0); PG8_MMA(1, 0, At, B0); PG8_BAR; PG8_SCHED;
            PG8_STAGE(PG8_SB(1, 1), b3 + hstep, voffB);
            PG8_WAIT_V(6); PG8_BAR; PG8_MMA(1, 1, At, B1); PG8_BAR;
            }
        }
        if constexpr (ALIGN_EPI) { if (wr == 0) PG8_BAR; }
        bool keep_acc = false;
        if constexpr (Epi::TWO_PART) { if (cur.part == 0) { E.mid(acc, cur, wr, wc, fr, fq); keep_acc = true; } else { E(acc, cur, wr, wc, fr, fq); } }
        else if constexpr (!Epi::AFTER_DRAIN) { E(acc, cur, wr, wc, fr, fq); S.done(cur); }
        if (!has_next) break;
        if (!keep_acc)
#pragma unroll
        for (int a = 0; a < 2; ++a)
#pragma unroll
            for (int b = 0; b < 2; ++b)
#pragma unroll
                for (int m = 0; m < 4; ++m)
#pragma unroll
                    for (int n = 0; n < 2; ++n) acc[a][b][m][n] = (f32x4){0.f, 0.f, 0.f, 0.f};
        cur = nxt; cA = nA; cB = nB; ++ui;
        if constexpr (ALIGN_EPI) { if (wr == 1) PG8_BAR; }
    }
    PG8_WAIT_V(0);
    if constexpr (!ALIGN_EPI) { if (wr == 0) PG8_BAR; }
    PG8_BAR;
    if constexpr (Epi::AFTER_DRAIN) { E.fused(acc, cur, wr, wc, fr, fq, lds, wid, lane); S.done(cur); }
#undef PG8_SA
#undef PG8_SB
#undef PG8_STAGE
#undef PG8_LDA
#undef PG8_LDB
#undef PG8_MMA
#undef PG8_WAIT_V
#undef PG8_WAIT_L
#undef PG8_BAR
#undef PG8_SCHED
}
}
#define LAS __attribute__((address_space(3)))
#define XB_TMO      128
#define XB_XCNT(j)  (256  + 64 * (j))
#define XB_XSUB(j)  (1280 + 64 * (j))
#define XB_XGEN(j)  (2304 + 64 * (j))
#define XB_TOP      3328
#define XB_TOPGEN   3392
#define XCD_BAR_WORDS 3456
#define XB_SPIN_CAP (1u << 18)

__device__ __forceinline__ unsigned xb_ld(unsigned* p)              { return __hip_atomic_load(p, __ATOMIC_RELAXED, __HIP_MEMORY_SCOPE_AGENT); }
__device__ __forceinline__ unsigned xb_add(unsigned* p, unsigned v) { return __hip_atomic_fetch_add(p, v, __ATOMIC_RELAXED, __HIP_MEMORY_SCOPE_AGENT); }
__device__ __forceinline__ unsigned xb_xcc_id() { return (unsigned)__builtin_amdgcn_s_getreg((3 << 11) | 20) & 0xFu; }
#define XB_SPIN(cond, bar) do { unsigned _sp = 0; while (cond) { __builtin_amdgcn_s_sleep(1); \
    if ((++_sp & 255u) == 0u) { if (xb_ld(&(bar)[XB_TMO])) break; if (_sp > XB_SPIN_CAP) { atomicAdd(&(bar)[XB_TMO], 1u); break; } } } } while (0)

struct XcdBarrier {
    unsigned* bar; unsigned x;
    volatile LAS unsigned* st;
};

__device__ __forceinline__ XcdBarrier xcd_barrier_post(unsigned* bar, volatile LAS unsigned* st, const int tid) {
    XcdBarrier b; b.bar = bar; b.x = xb_xcc_id(); b.st = st;
    if (tid == 0) (void)xb_add(&bar[XB_XCNT(b.x)], 1u);
    return b;
}
__device__ __forceinline__ void xcd_barrier_complete(unsigned* bar, unsigned x, unsigned& nloc, unsigned& nx) {
    const unsigned G = gridDim.x * gridDim.y * gridDim.z;
    unsigned sum, cnt, mine, sp = 0u;
    for (;;) {
        sum = 0u; cnt = 0u; mine = 0u;
#pragma unroll
        for (unsigned j = 0; j < 16; ++j) { const unsigned c = xb_ld(&bar[XB_XCNT(j)]); sum += c; cnt += (c > 0u) ? 1u : 0u; mine = (j == x) ? c : mine; }
        if (sum == G) break;
        __builtin_amdgcn_s_sleep(1);
        if ((++sp & 255u) == 0u) { if (xb_ld(&bar[XB_TMO])) break; if (sp > XB_SPIN_CAP) { atomicAdd(&bar[XB_TMO], 1u); break; } }
    }
    nloc = mine > 0u ? mine : 1u; nx = cnt > 0u ? cnt : 1u;
}

__device__ __forceinline__ void xcd_barrier(const XcdBarrier& b, const int tid) {
    asm volatile("s_waitcnt vmcnt(0)" ::: "memory");
    __syncthreads();
    if (tid == 0) {
        unsigned* bar = b.bar;
        __builtin_amdgcn_s_waitcnt(0);
        unsigned nloc = b.st[0], nx = b.st[1];
        if (nloc == 0u) { xcd_barrier_complete(bar, b.x, nloc, nx); b.st[0] = nloc; b.st[1] = nx; }
        const unsigned old = xb_add(&bar[XB_XSUB(b.x)], 1u);
        const unsigned gen = old / nloc;
        if (old + 1u == (gen + 1u) * nloc) {
            __builtin_amdgcn_fence(__ATOMIC_RELEASE, "agent");
            asm volatile("s_waitcnt vmcnt(0)" ::: "memory");
            const unsigned og = xb_add(&bar[XB_TOP], 1u);
            const unsigned tg = og / nx;
            if (og + 1u == (tg + 1u) * nx) xb_add(&bar[XB_TOPGEN], 1u);
            else XB_SPIN(xb_ld(&bar[XB_TOPGEN]) == tg, bar);
            __builtin_amdgcn_fence(__ATOMIC_ACQUIRE, "agent");
            xb_add(&bar[XB_XGEN(b.x)], 1u);
            asm volatile("s_waitcnt vmcnt(0)" ::: "memory");
        } else {
            XB_SPIN(xb_ld(&bar[XB_XGEN(b.x)]) == gen, bar);
            __builtin_amdgcn_fence(__ATOMIC_ACQUIRE, "agent");
            asm volatile("s_waitcnt vmcnt(0)" ::: "memory");
        }
    }
    __syncthreads();
}


constexpr int D = 1024, BP = 4, LP = 8192, BS = 32, LS = 8, PAST = 16384, PAGE = 128, NPAGE = 128;
constexpr int MP = BP * LP, MS = BS * LS, MT = MP + MS;
constexpr int HD = 64, DATT = 512, DSSM = 512, NG = 32, NST = 64;
constexpr int NIN = 4888, NINP = 5120;
constexpr int C_Q = 0, C_KV = 512, C_ZA = 1280, C_U = 1792, C_ZS = 2304, C_GM = 2816, C_GN = 4864;
constexpr int NCS = 1024, NCP = 512;
constexpr int XC_S_ROWS = BS * 2 * 2 * NCS, XC_P_ROWS = BP * 2 * 2 * NCP, XC_ROWS = XC_S_ROWS + XC_P_ROWS;
constexpr int CH = 128, NCHK = LP / CH;
constexpr float RMS_EPS = 1e-6f;
constexpr size_t O_YP = 0, O_YS = 33554432, O_KVP = 33816576, O_WINP = 50593792, O_SRP = 51118080, O_SIP = 51126272, O_KVS = 51134464, O_WINS = 51265536, O_SRS = 55459840, O_SIS = 55525376, O_END = 55590912;
constexpr size_t MiB = 1u << 20;
constexpr size_t WS_CTL = 0, CTL_ZERO_BYTES = 1 * MiB;
constexpr size_t WS_WTIN = 1 * MiB, WS_WTGLU = 11 * MiB, WS_WTLA = 12 * MiB, WS_WTLS = 13 * MiB, WS_WTOUT = 14 * MiB, WS_WTC1 = 16 * MiB, WS_CONST = 17 * MiB, WS_SEND = 20 * MiB  ;
constexpr size_t WS_KC = 20 * MiB, WS_VC = 38 * MiB, WS_XN = 64 * MiB, WS_OA = 130 * MiB, WS_Y1B = 164 * MiB, WS_YB = 198 * MiB, WS_MG = 232 * MiB, WS_Y1 = 298 * MiB, WS_MB = 364 * MiB;
constexpr size_t WS_PP = 494 * MiB, WS_XC = 632 * MiB, WS_KVB = 904 * MiB, WS_SZA = 956 * MiB, WS_U32 = 992 * MiB, WS_SZS = 1060 * MiB, WS_GM = 1096 * MiB, WS_GN = 1228 * MiB;
constexpr size_t WS_QB = 1552 * MiB, WS_KSB = 1586 * MiB, WS_KWB = 1596 * MiB, WS_VST = 1606 * MiB, WS_VWT = 1614 * MiB, WS_KCB = 1622 * MiB, WS_VCT = 1623 * MiB, WS_KCBS = 1624 * MiB, WS_VCBS = 1632 * MiB, WS_OT = 1640 * MiB  , WS_END = 1672 * MiB;
constexpr int K_CB = 0  , K_CBP = 80000  , K_ARE = 256, K_AIM = K_ARE + 2048, K_ALRE = K_AIM + 2048, K_ALIM = K_ALRE + 2048, K_BBRE = K_ALIM + 2048, K_BBIM = K_BBRE + 32768;
constexpr size_t WS_SSMCF = WS_CONST + 512 * 1024;
constexpr size_t WS_SSMW = 632 * MiB;
constexpr size_t WS_TEND = WS_CONST + 1 * MiB;
constexpr size_t WS_YPB = 364 * MiB;
constexpr int CW_BAR = 4096;
constexpr int LDS_BYTES = 163840, MISC_OFF = LDS_BYTES - 256;
constexpr int NWAVES = 8;


typedef unsigned short bf16;
typedef unsigned v4u __attribute__((ext_vector_type(4)));
typedef unsigned v2u __attribute__((ext_vector_type(2)));
typedef float f32x4 __attribute__((ext_vector_type(4)));
#define LDS_FENCE() asm volatile("s_waitcnt lgkmcnt(0)" ::: "memory")
__device__ __forceinline__ unsigned f2bf(float f) { unsigned u = __builtin_bit_cast(unsigned, f); return (u + 0x7fffu + ((u >> 16) & 1u)) >> 16; }
__device__ __forceinline__ unsigned pk2(float lo, float hi) { return f2bf(lo) | (f2bf(hi) << 16); }
__device__ __forceinline__ float wave_sum(float v) {
#pragma unroll
    for (int o = 1; o < 64; o <<= 1) v += __shfl_xor(v, o);
    return v; }
__device__ __forceinline__ float wave_max(float v) {
#pragma unroll
    for (int o = 1; o < 64; o <<= 1) v = fmaxf(v, __shfl_xor(v, o));
    return v; }
__device__ __forceinline__ float sigmf(float x) { return 1.0f / (1.0f + __expf(-x)); }
__device__ __forceinline__ float gelu_t(float x) { const float u = 1.5957691216f * (x + 0.044715f * x * x * x); return x / (1.0f + __expf(-u)); }

struct Ctx {
    LAS unsigned char* lds; int tid, lane, wave, G, gw, NGW;
    const float *xp, *xs, *cache_kv, *cache_win, *st_re, *st_im; const int* page_table;
    const float *norm_g, *w_in, *cmp_pe, *cmp_w1, *cmp_b1, *cmp_w2, *lam_re, *lam_im, *log_dt, *b_re, *b_im, *c_re, *c_im, *ssm_d, *w_glu, *b_glu, *w_la, *w_ls, *w_out, *final_g;
    float* out; unsigned char* ws;
    bf16 *WTIN, *WTGLU, *WTLA, *WTLS, *WTOUT, *WTC1, *XN, *OA, *Y1B, *YB, *MG, *XC, *QB, *KSB, *KWB, *VST, *VWT, *KCB, *VCT, *KCBS, *VCBS, *KVB, *SZA, *SZS, *GM;
    float *KST, *SEND, *KC, *VC, *Y1, *MB, *PP, *U32, *GN;
};

__device__ __forceinline__ void transpose_item(const float* W, int ldw, int nvalid, int nblk, int K, bf16* WT, int row_off, LAS float* scr, int item, int lane) {
    const int kb = item / nblk, nb = item % nblk, k0 = 64 * kb, n0 = 32 * nb;
    const int n = n0 + (lane & 31);
#pragma unroll 8
    for (int i = 0; i < 32; ++i) { const int kk = 2 * i + (lane >> 5); scr[kk * 33 + (lane & 31)] = (n < nvalid) ? W[(size_t)(k0 + kk) * ldw + n] : 0.f; }
    LDS_FENCE();
    const int c = lane & 7;
#pragma unroll
    for (int j = 0; j < 4; ++j) { const int nn = (lane >> 3) + 8 * j; const LAS float* s = scr + (8 * c) * 33 + nn;
        v4u o; o.x = pk2(s[0 * 33], s[1 * 33]); o.y = pk2(s[2 * 33], s[3 * 33]); o.z = pk2(s[4 * 33], s[5 * 33]); o.w = pk2(s[6 * 33], s[7 * 33]);
        *(v4u*)(WT + (size_t)(row_off + n0 + nn) * K + k0 + 8 * c) = o; }
    LDS_FENCE();
}
__device__ __forceinline__ void rms_row_to_bf16(const float* xrow, const float* g, bf16* orow, int lane) {
    const f32x4* xr = (const f32x4*)xrow + lane; const f32x4* gr = (const f32x4*)g + lane;
    f32x4 v[4]; float s = 0.f;
#pragma unroll
    for (int j = 0; j < 4; ++j) { v[j] = xr[64 * j]; s += (v[j].x * v[j].x + v[j].y * v[j].y) + (v[j].z * v[j].z + v[j].w * v[j].w); }
    const float r = rsqrtf(wave_sum(s) * (1.f / D) + RMS_EPS);
    v2u* o8 = (v2u*)orow + lane;
#pragma unroll
    for (int j = 0; j < 4; ++j) { const f32x4 gg = gr[64 * j]; v2u o; o.x = pk2(v[j].x * r * gg.x, v[j].y * r * gg.y); o.y = pk2(v[j].z * r * gg.z, v[j].w * r * gg.w); o8[64 * j] = o; }
}
__device__ __forceinline__ void xc_chunk(const float* src0, size_t rstride, bf16* XC, size_t rowbase  , size_t hstride, size_t sstride, int lane) {
    const int col = 4 * lane, slot = col >> 7, h = (col >> 6) & 1, d = col & 63;
    bf16* dst = XC + (rowbase + (size_t)h * hstride + (size_t)slot * sstride) * 1024 + d;
#pragma unroll 4
    for (int j = 0; j < 16; ++j) { const f32x4 v = *(const f32x4*)(src0 + (size_t)j * rstride + col); v2u o; o.x = pk2(v.x, v.y); o.y = pk2(v.z, v.w); *(v2u*)(dst + j * 64) = o; }
}
__device__ __forceinline__ void p0_prep(const Ctx& C) {
    LAS float* scr = (LAS float*)(C.lds + C.wave * 16384);
    constexpr int I_IN = 16 * 160, I_GLU = 8 * 16, I_LA = 8 * 32, I_LS = 8 * 32, I_OUT = 16 * 32, I_C1 = 16 * 2;
    constexpr int NIT = I_IN + I_GLU + I_LA + I_LS + I_OUT + 4 * I_C1;
    for (int it = C.gw; it < NIT; it += C.NGW) {
        int r = it;
        if (r < I_IN) { const int nb = r % 160, n0 = 32 * nb;
            const int src0 = n0 < 1280 ? n0 : (n0 < 4864 ? n0 + 24 : 1280), nv = n0 < 4864 ? 32 : (n0 == 4864 ? 24 : 0);
            transpose_item(C.w_in + src0 - n0, NIN, n0 + nv, 160, 1024, C.WTIN, 0, scr, r, C.lane); continue; } r -= I_IN;
        if (r < I_GLU) { transpose_item(C.w_glu, 512, 512, 16, 512, C.WTGLU, 0, scr, r, C.lane); continue; } r -= I_GLU;
        if (r < I_LA) { transpose_item(C.w_la, 1024, 1024, 32, 512, C.WTLA, 0, scr, r, C.lane); continue; } r -= I_LA;
        if (r < I_LS) { transpose_item(C.w_ls, 1024, 1024, 32, 512, C.WTLS, 0, scr, r, C.lane); continue; } r -= I_LS;
        if (r < I_OUT) { transpose_item(C.w_out, 1024, 1024, 32, 1024, C.WTOUT, 0, scr, r, C.lane); continue; } r -= I_OUT;
        { const int q = r / I_C1, s = q >> 1, rr = q & 1;
          transpose_item(C.cmp_w1 + (size_t)(s * 32 + rr * 16) * 4096, 64, 64, 2, 1024, C.WTC1, s * 128 + rr * 64, scr, r % I_C1, C.lane); }
    }
    for (int m0 = C.gw; m0 < MT; m0 += 2 * C.NGW) {
        const int m1 = m0 + C.NGW < MT ? m0 + C.NGW : m0;
        const float* x0 = m0 < MP ? C.xp + (size_t)m0 * D : C.xs + (size_t)(m0 - MP) * D; const float* x1 = m1 < MP ? C.xp + (size_t)m1 * D : C.xs + (size_t)(m1 - MP) * D;
        f32x4 va[4], vb[4]; float sa = 0.f, sb = 0.f;
#pragma unroll
        for (int j = 0; j < 4; ++j) { va[j] = ((const f32x4*)x0)[C.lane + 64 * j]; vb[j] = ((const f32x4*)x1)[C.lane + 64 * j]; }
#pragma unroll
        for (int j = 0; j < 4; ++j) { sa += (va[j].x * va[j].x + va[j].y * va[j].y) + (va[j].z * va[j].z + va[j].w * va[j].w); sb += (vb[j].x * vb[j].x + vb[j].y * vb[j].y) + (vb[j].z * vb[j].z + vb[j].w * vb[j].w); }
        const float ra = rsqrtf(wave_sum(sa) * (1.f / D) + RMS_EPS), rb = rsqrtf(wave_sum(sb) * (1.f / D) + RMS_EPS);
#pragma unroll
        for (int j = 0; j < 4; ++j) { const f32x4 gg = ((const f32x4*)C.norm_g)[C.lane + 64 * j];
            v2u o; o.x = pk2(va[j].x * ra * gg.x, va[j].y * ra * gg.y); o.y = pk2(va[j].z * ra * gg.z, va[j].w * ra * gg.w); ((v2u*)(C.XN + (size_t)m0 * D))[C.lane + 64 * j] = o;
            if (m1 != m0) { v2u o1; o1.x = pk2(vb[j].x * rb * gg.x, vb[j].y * rb * gg.y); o1.y = pk2(vb[j].z * rb * gg.z, vb[j].w * rb * gg.w); ((v2u*)(C.XN + (size_t)m1 * D))[C.lane + 64 * j] = o1; } }
    }
    for (int j = C.gw * 64 + C.lane; j < NG * NST * 16; j += C.NGW * 64) {
        const int i = j >> 4, c = j & 15, g = i >> 6;
        const double dt = exp((double)C.log_dt[g]), lr = (double)C.lam_re[i], li = (double)C.lam_im[i];
        const double mag = exp(lr * dt), ar = mag * cos(li * dt), ai = mag * sin(li * dt);
        const double den = lr * lr + li * li, fr = ((ar - 1.0) * lr + ai * li) / den, fi = (ai * lr - (ar - 1.0) * li) / den;
        if (c == 0) { const double magL = exp(lr * dt * CH), aLr = magL * cos(li * dt * CH), aLi = magL * sin(li * dt * CH);
            C.KST[K_ARE + i] = (float)ar; C.KST[K_AIM + i] = (float)ai; C.KST[K_ALRE + i] = (float)aLr; C.KST[K_ALIM + i] = (float)aLi; }
        const double br = (double)C.b_re[i * 16 + c], bi = (double)C.b_im[i * 16 + c];
        C.KST[K_BBRE + i * 16 + c] = (float)(fr * br - fi * bi); C.KST[K_BBIM + i * 16 + c] = (float)(fr * bi + fi * br);
        { bf16* CF = (bf16*)(C.ws + WS_SSMCF); const int pp = i & 63; const size_t o = ((size_t)g * 16 + c) * 128 + 2 * pp;
          CF[o] = (bf16)f2bf(C.c_re[((size_t)g * 16 + c) * 64 + pp]); CF[o + 1] = (bf16)f2bf(-C.c_im[((size_t)g * 16 + c) * 64 + pp]); }
    }
    for (int j = ((C.gw + C.NGW - 512) % C.NGW) * 64 + C.lane; j < NG * NST * (CH / 8); j += C.NGW * 64) {
        const int tb = j & (CH / 8 - 1), i = j >> 4, g = i >> 6, pp = i & 63;
        const double dt = exp((double)C.log_dt[g]), lr = (double)C.lam_re[i], li = (double)C.lam_im[i];
        const double mag = exp(lr * dt), ar = mag * cos(li * dt), ai = mag * sin(li * dt);
        const double den = lr * lr + li * li, fr = ((ar - 1.0) * lr + ai * li) / den, fi = (ai * lr - (ar - 1.0) * li) / den;
        const double dd = (double)(CH - 8 - 8 * tb), magd = exp(lr * dt * dd), pr = magd * cos(li * dt * dd), pi = magd * sin(li * dt * dd);
        double gr = pr * fr - pi * fi, gi = pr * fi + pi * fr;
        bf16* W0 = (bf16*)(C.ws + WS_SSMW); const size_t olo = (size_t)NG * 128 * 2048;
#pragma unroll 1
        for (int tt = 7; tt >= 0; --tt) {
            unsigned hr[8], hi_[8], lr_[8], li_[8];
#pragma unroll
            for (int c2 = 0; c2 < 8; ++c2) { unsigned vh[2][2], vl[2][2];
#pragma unroll
                for (int e = 0; e < 2; ++e) { const int c = 2 * c2 + e; const double br = (double)C.b_re[i * 16 + c], bi = (double)C.b_im[i * 16 + c];
                    const float wr = (float)(gr * br - gi * bi), wi = (float)(gr * bi + gi * br);
                    const unsigned h0 = f2bf(wr), h1 = f2bf(wi);
                    vh[0][e] = h0; vh[1][e] = h1; vl[0][e] = f2bf(wr - __uint_as_float(h0 << 16)); vl[1][e] = f2bf(wi - __uint_as_float(h1 << 16)); }
                hr[c2] = vh[0][0] | (vh[0][1] << 16); hi_[c2] = vh[1][0] | (vh[1][1] << 16); lr_[c2] = vl[0][0] | (vl[0][1] << 16); li_[c2] = vl[1][0] | (vl[1][1] << 16); }
            const size_t ore = ((size_t)g * 128 + pp) * 2048 + (8 * tb + tt) * 16, oim = ore + (size_t)64 * 2048;
            *(v4u*)(W0 + ore) = (v4u){hr[0], hr[1], hr[2], hr[3]}; *(v4u*)(W0 + ore + 8) = (v4u){hr[4], hr[5], hr[6], hr[7]};
            *(v4u*)(W0 + oim) = (v4u){hi_[0], hi_[1], hi_[2], hi_[3]}; *(v4u*)(W0 + oim + 8) = (v4u){hi_[4], hi_[5], hi_[6], hi_[7]};
            *(v4u*)(W0 + olo + ore) = (v4u){lr_[0], lr_[1], lr_[2], lr_[3]}; *(v4u*)(W0 + olo + ore + 8) = (v4u){lr_[4], lr_[5], lr_[6], lr_[7]};
            *(v4u*)(W0 + olo + oim) = (v4u){li_[0], li_[1], li_[2], li_[3]}; *(v4u*)(W0 + olo + oim + 8) = (v4u){li_[4], li_[5], li_[6], li_[7]};
            const double ngr = gr * ar - gi * ai, ngi = gr * ai + gi * ar; gr = ngr; gi = ngi;
        }
    }
    for (int it = C.gw - 64; it >= 0 && it < 64; it += C.NGW) { const int s = it >> 5, part = it & 31;
        float acc = (part == 0) ? C.cmp_b1[s * 64 + C.lane] : 0.f;
#pragma unroll 16
        for (int k = part * 64; k < part * 64 + 64; ++k) acc += C.cmp_pe[s * 2048 + k] * C.cmp_w1[(size_t)s * 131072 + (size_t)k * 64 + C.lane];
        C.KST[K_CBP + (s * 32 + part) * 64 + C.lane] = acc;
    }
}
constexpr int C1_PITCH = 2080, C1_BUF = 16 * C1_PITCH;
constexpr int C1_ITEMS_S = BS * NPAGE, C1_ITEMS_P = BP * (LP / 128), C1_ITEMS = C1_ITEMS_S + C1_ITEMS_P;
typedef short c1_bf16x8 __attribute__((ext_vector_type(8)));
__device__ __forceinline__ void c1_issue(const Ctx& C, f32x4 (&st)[8], int item, int slot, int r0, int i5) {
    if (item < C1_ITEMS_S) { const int b = item >> 7, pg = item & 127, page = C.page_table[b * NPAGE + pg];
        const float* src = C.cache_kv + ((size_t)page * PAGE + r0) * 512 + slot * 128 + 4 * i5;
#pragma unroll
        for (int it = 0; it < 8; ++it) st[it] = *(const f32x4*)(src + (size_t)it * 16 * 512); }
    else { const int q = item - C1_ITEMS_S, b = q >> 6, pg = q & 63; const bf16* src = C.KVB + ((size_t)b * LP + (size_t)pg * 128 + r0) * 768 + slot * 128 + 4 * i5;
#pragma unroll
        for (int it = 0; it < 8; ++it) { const v2u v = *(const v2u*)(src + (size_t)it * 16 * 768); st[it] = (f32x4){__uint_as_float(v.x << 16), __uint_as_float(v.x & 0xffff0000u), __uint_as_float(v.y << 16), __uint_as_float(v.y & 0xffff0000u)}; } }
}
__device__ __forceinline__ void p2_cmp1(const Ctx& C) {
    const int tid = C.tid, lane = C.lane, w = C.wave;
    const int half = C.G / 2, slot = ((int)blockIdx.x >= half) ? 1 : 0, wg = (int)blockIdx.x - slot * half, nwg = slot ? C.G - half : half;
    c1_bf16x8 Bf[32];
    { const bf16* bp = C.WTC1 + (size_t)(slot * 128 + 16 * w + (lane & 15)) * 1024 + 8 * (lane >> 4);
#pragma unroll
      for (int ks = 0; ks < 32; ++ks) Bf[ks] = *(const c1_bf16x8*)(bp + 32 * ks); }
    const int r0 = tid >> 5, i5 = tid & 31, hh = i5 >> 4, d4 = (i5 & 15) * 4;
    f32x4 st[8];
    int item = wg, buf = 0;
    if (item < C1_ITEMS) c1_issue(C, st, item, slot, r0, i5);
    for (; item < C1_ITEMS; item += nwg, buf ^= 1) {
        LAS unsigned char* X = C.lds + buf * C1_BUF;
#pragma unroll
        for (int it = 0; it < 8; ++it) { const int r = r0 + 16 * it; v2u o; o.x = pk2(st[it].x, st[it].y); o.y = pk2(st[it].z, st[it].w);
            *(LAS v2u*)(X + ((r >> 4) * 2 + hh) * C1_PITCH + ((r & 15) * 64 + d4) * 2) = o; }
        LDS_FENCE(); __syncthreads();
        if (item + nwg < C1_ITEMS) c1_issue(C, st, item + nwg, slot, r0, i5);
        f32x4 acc = (f32x4){0.f, 0.f, 0.f, 0.f};
        const LAS unsigned char* ap = X + (lane & 15) * C1_PITCH + (lane >> 4) * 16;
#pragma unroll
        for (int ks = 0; ks < 32; ++ks) acc = __builtin_amdgcn_mfma_f32_16x16x32_bf16(*(const LAS c1_bf16x8*)(ap + 64 * ks), Bf[ks], acc, 0, 0, 0);
        const bool smp = item < C1_ITEMS_S; const int q = smp ? item : item - C1_ITEMS_S;
        const size_t seq0 = (size_t)(smp ? (q >> 7) : (q >> 6)) * 4 + slot; const int ch0 = (smp ? (q & 127) : (q & 63)) * 8, NC = smp ? NCS : NCP;
        bf16* pp = (bf16*)C.PP + (smp ? (size_t)0 : (size_t)XC_S_ROWS * 128);
#pragma unroll
        for (int r = 0; r < 4; ++r) { const int m = 4 * (lane >> 4) + r, chunk = ch0 + (m >> 1), h = m & 1;
            pp[((seq0 + 2 * h) * NC + chunk) * 128 + 16 * w + (lane & 15)] = (bf16)f2bf(acc[r]); }
    }
    __syncthreads();
}
__device__ __forceinline__ void ssm_load_u(const Ctx& C, LAS float* U, size_t row0, int g, int nt, int lane) {
    const int t = lane >> 1, hf = lane & 1;
    if (t < nt) { const float* p = C.U32 + (row0 + t) * 512 + g * 16 + hf * 8; const f32x4 a = *(const f32x4*)p, b = *(const f32x4*)(p + 4);
        *(LAS f32x4*)(U + t * 16 + hf * 8) = a; *(LAS f32x4*)(U + t * 16 + hf * 8 + 4) = b; }
    LDS_FENCE();
}
__device__ __forceinline__ void ssm_issue_u(const Ctx& C, size_t row0, int g, int nt, int lane, f32x4& ua, f32x4& ub) {
    const int t = lane >> 1, hf = lane & 1;
    if (t < nt) { const float* p = C.U32 + (row0 + t) * 512 + g * 16 + hf * 8; ua = *(const f32x4*)p; ub = *(const f32x4*)(p + 4); }
}
typedef float f32x2 __attribute__((ext_vector_type(2)));
#define SFMAC(acc, a, b) asm("v_fmac_f32 %0, %1, %2" : "+v"(acc) : "v"(a), "v"(b))
#define SMUL(d, a, b) asm("v_mul_f32 %0, %1, %2" : "=v"(d) : "v"(a), "v"(b))
__device__ __forceinline__ unsigned ssm_cvt_pk(float lo, float hi) { unsigned r; asm("v_cvt_pk_bf16_f32 %0, %1, %2" : "=v"(r) : "v"(lo), "v"(hi)); return r; }
struct SsmCoef { float are, aim, naim; float bre[16], bim[16]; };
__device__ __forceinline__ void ssm_coef(const Ctx& C, SsmCoef& K, int g, int lane) {
    const int i = g * 64 + lane; K.are = C.KST[K_ARE + i]; K.aim = C.KST[K_AIM + i]; K.naim = -K.aim;
#pragma unroll
    for (int c = 0; c < 16; ++c) { K.bre[c] = C.KST[K_BBRE + i * 16 + c]; K.bim[c] = C.KST[K_BBIM + i * 16 + c]; }
}
__device__ __forceinline__ void ssm_step2(const SsmCoef& K, const LAS float* u, float& hr, float& hi, unsigned& pk0, unsigned& pk1) {
    f32x4 ua[4], ub[4];
#pragma unroll
    for (int c4 = 0; c4 < 4; ++c4) { ua[c4] = *(const LAS f32x4*)(u + 4 * c4); ub[c4] = *(const LAS f32x4*)(u + 16 + 4 * c4); }
    float ra, ia, rb, ib;
    SMUL(ra, K.bre[0], ua[0][0]); SMUL(ia, K.bim[0], ua[0][0]); SMUL(rb, K.bre[0], ub[0][0]); SMUL(ib, K.bim[0], ub[0][0]);
#pragma unroll
    for (int c = 1; c < 16; ++c) { SFMAC(ra, K.bre[c], ua[c >> 2][c & 3]); SFMAC(ia, K.bim[c], ua[c >> 2][c & 3]); SFMAC(rb, K.bre[c], ub[c >> 2][c & 3]); SFMAC(ib, K.bim[c], ub[c >> 2][c & 3]); }
    SFMAC(ra, K.are, hr); SFMAC(ia, K.are, hi); SFMAC(ra, K.naim, hi); SFMAC(ia, K.aim, hr); hr = ra; hi = ia; pk0 = ssm_cvt_pk(hr, hi);
    SFMAC(rb, K.are, hr); SFMAC(ib, K.are, hi); SFMAC(rb, K.naim, hi); SFMAC(ib, K.aim, hr); hr = rb; hi = ib; pk1 = ssm_cvt_pk(hr, hi);
}
typedef short p1_bf16x8 __attribute__((ext_vector_type(8)));
constexpr int P1_PITCH = 132;
__device__ __forceinline__ void p1_split(const f32x4 x0, const f32x4 x1, p1_bf16x8& hi, p1_bf16x8& lo) {
    v4u h, l; float r[8] = {x0.x, x0.y, x0.z, x0.w, x1.x, x1.y, x1.z, x1.w}; unsigned hw[4], lw[4];
#pragma unroll
    for (int e = 0; e < 4; ++e) { const unsigned w = pk2(r[2 * e], r[2 * e + 1]); hw[e] = w;
        lw[e] = pk2(r[2 * e] - __uint_as_float(w << 16), r[2 * e + 1] - __uint_as_float(w & 0xffff0000u)); }
    h = (v4u){hw[0], hw[1], hw[2], hw[3]}; l = (v4u){lw[0], lw[1], lw[2], lw[3]};
    hi = __builtin_bit_cast(p1_bf16x8, h); lo = __builtin_bit_cast(p1_bf16x8, l);
}
__device__ __forceinline__ void p2_ssm_pass1(const Ctx& C) {
    const int lane = C.lane, w = C.wave, m = lane & 15, q = lane >> 4;
    LAS float* red = (LAS float*)C.lds;
    for (int it = blockIdx.x; it < NG * 8; it += C.G) {
        const int g = 4 * (it & 7) + (it >> 6), sub = (it >> 3) & 7;
        f32x4 acc[2][8];
#pragma unroll
        for (int mt = 0; mt < 2; ++mt)
#pragma unroll
            for (int nt = 0; nt < 8; ++nt) acc[mt][nt] = (f32x4){0.f, 0.f, 0.f, 0.f};
        const bf16* Wh = (const bf16*)(C.ws + WS_SSMW) + ((size_t)g * 128 + m) * 2048 + 256 * w + 8 * q;
        const bf16* Wl = Wh + (size_t)NG * 128 * 2048;
        const float* up[2];
#pragma unroll
        for (int mt = 0; mt < 2; ++mt) { const int cr = 32 * sub + 16 * mt + m, b = cr >> 6, k = cr & 63;
            up[mt] = C.U32 + ((size_t)b * LP + (size_t)k * CH + 16 * w + (q >> 1)) * 512 + g * 16 + 8 * (q & 1); }
        f32x4 xa[2][2];
#pragma unroll
        for (int mt = 0; mt < 2; ++mt) { xa[mt][0] = *(const f32x4*)(up[mt]); xa[mt][1] = *(const f32x4*)(up[mt] + 4); }
#pragma unroll 2
        for (int ks = 0; ks < 8; ++ks) {
            p1_bf16x8 ah[2], al[2];
#pragma unroll
            for (int mt = 0; mt < 2; ++mt) p1_split(xa[mt][0], xa[mt][1], ah[mt], al[mt]);
            if (ks < 7) {
#pragma unroll
                for (int mt = 0; mt < 2; ++mt) { const float* p = up[mt] + (size_t)(2 * ks + 2) * 512; xa[mt][0] = *(const f32x4*)p; xa[mt][1] = *(const f32x4*)(p + 4); } }
#pragma unroll
            for (int nt = 0; nt < 8; ++nt) {
                const p1_bf16x8 bh = *(const p1_bf16x8*)(Wh + (size_t)nt * 16 * 2048 + 32 * ks), bl = *(const p1_bf16x8*)(Wl + (size_t)nt * 16 * 2048 + 32 * ks);
#pragma unroll
                for (int mt = 0; mt < 2; ++mt) {
                    acc[mt][nt] = __builtin_amdgcn_mfma_f32_16x16x32_bf16(ah[mt], bh, acc[mt][nt], 0, 0, 0);
                    acc[mt][nt] = __builtin_amdgcn_mfma_f32_16x16x32_bf16(al[mt], bh, acc[mt][nt], 0, 0, 0);
                    acc[mt][nt] = __builtin_amdgcn_mfma_f32_16x16x32_bf16(ah[mt], bl, acc[mt][nt], 0, 0, 0); }
            }
        }
#pragma unroll
        for (int mt = 0; mt < 2; ++mt)
#pragma unroll
            for (int nt = 0; nt < 8; ++nt)
#pragma unroll
                for (int r = 0; r < 4; ++r) red[(w * 32 + 16 * mt + 4 * q + r) * P1_PITCH + 16 * nt + m] = acc[mt][nt][r];
        LDS_FENCE(); __syncthreads();
#pragma unroll
        for (int i = 0; i < 8; ++i) { const int o = C.tid + 512 * i, row = o >> 7, col = o & 127; float s = 0.f;
#pragma unroll
            for (int ww = 0; ww < 8; ++ww) s += red[(ww * 32 + row) * P1_PITCH + col];
            red[8 * 32 * P1_PITCH + row * 128 + col] = s; }
        LDS_FENCE(); __syncthreads();
        if (w == 0) { const LAS float* S2 = red + 8 * 32 * P1_PITCH; const int b = sub >> 1, k0 = 32 * (sub & 1);
            const float aLr = C.KST[K_ALRE + g * 64 + lane], aLi = C.KST[K_ALIM + g * 64 + lane]; float cr = 0.f, ci = 0.f;
#pragma unroll 8
            for (int row = 0; row < 32; ++row) { float* S = C.SEND + ((size_t)(b * NG + g) * NCHK + k0 + row) * 128; S[lane] = cr; S[64 + lane] = ci;
                const float sr = S2[row * 128 + lane], si = S2[row * 128 + 64 + lane];
                const float nr = aLr * cr - aLi * ci + sr, ni = aLr * ci + aLi * cr + si; cr = nr; ci = ni; }
            float* T = (float*)(C.ws + WS_TEND) + ((size_t)(b * NG + g) * 2 + (sub & 1)) * 128; T[lane] = cr; T[64 + lane] = ci; }
        __syncthreads();
    }
}
typedef short ssm_bf16x8 __attribute__((ext_vector_type(8)));
struct SsmRd { ssm_bf16x8 cf[4]; f32x4 dsk; };
__device__ __forceinline__ void ssm_rd(const Ctx& C, SsmRd& R, int g, int lane) {
    const bf16* CF = (const bf16*)(C.ws + WS_SSMCF) + ((size_t)g * 16 + (lane & 15)) * 128 + 8 * (lane >> 4);
#pragma unroll
    for (int ks = 0; ks < 4; ++ks) R.cf[ks] = *(const ssm_bf16x8*)(CF + 32 * ks);
    R.dsk = *(const f32x4*)(C.ssm_d + g * 16 + 4 * (lane >> 4));
}
template <int NT>
__device__ __forceinline__ void ssm_tile(const Ctx& C, const SsmCoef& K, const SsmRd& R, LAS float* U, LAS unsigned* HB, size_t row0, int g, float& hr, float& hi, f32x4& ua, f32x4& ub, const bool more) {
    constexpr int nt = NT;
    { const int t = C.lane >> 1, hf = C.lane & 1;
      if (t < nt) { *(LAS f32x4*)(U + t * 16 + hf * 8) = ua; *(LAS f32x4*)(U + t * 16 + hf * 8 + 4) = ub; }
      LDS_FENCE();
      if (more) ssm_issue_u(C, row0 + NT, g, nt, C.lane, ua, ub); }
#pragma unroll 2
    for (int t = 0; t < NT; t += 2) { unsigned p0, p1; ssm_step2(K, U + t * 16, hr, hi, p0, p1); HB[t * 68 + C.lane] = p0; HB[(t + 1) * 68 + C.lane] = p1; }
    LDS_FENCE();
    const int m = C.lane & 15, q = C.lane >> 4;
#pragma unroll
    for (int n2 = 0; n2 < 2; ++n2) {
        f32x4 y = (f32x4){0.f, 0.f, 0.f, 0.f};
#pragma unroll
        for (int ks = 0; ks < 4; ++ks) y = __builtin_amdgcn_mfma_f32_16x16x32_bf16(R.cf[ks], *(const LAS ssm_bf16x8*)((const LAS unsigned char*)HB + (16 * n2 + m) * 272 + 64 * ks + 16 * q), y, 0, 0, 0);
        const int t = 16 * n2 + m;
        if (t < nt) { const f32x4 uv = *(const LAS f32x4*)(U + t * 16 + 4 * q); const size_t o = (row0 + t) * 512 + g * 16 + 4 * q;
            f32x4 v; v.x = gelu_t(y.x + R.dsk.x * uv.x); v.y = gelu_t(y.y + R.dsk.y * uv.y); v.z = gelu_t(y.z + R.dsk.z * uv.z); v.w = gelu_t(y.w + R.dsk.w * uv.w);
            v2u pk; pk.x = pk2(v.x, v.y); pk.y = pk2(v.z, v.w); *(v2u*)(C.Y1B + o) = pk; }
    }
    LDS_FENCE();
}
__device__ __forceinline__ void p3_ssm_pass2(const Ctx& C, const bool sample_part) {
    LAS float* U = (LAS float*)(C.lds + 8192 + C.wave * 18560);
    LAS unsigned* HB = (LAS unsigned*)(U + 512);
    constexpr int BIG = NCHK / 2, NBIP = NG * BIG, NBI = NBIP + 128;
    for (int bi = (sample_part ? NBIP : 0) + blockIdx.x; bi < (sample_part ? NBI : NBIP); bi += C.G) {
        const bool smp = bi >= NBIP; const int g = smp ? (bi - NBIP) >> 2 : 2 * (bi >> 6) + (C.wave >> 2);
        SsmRd R; ssm_rd(C, R, g, C.lane);
        SsmCoef K; ssm_coef(C, K, g, C.lane);
        if (!smp) {
            const int pr = (bi & 63) * 4 + (C.wave & 3), b = pr / NCHK, k = pr % NCHK;
            float hr = 0.f, hi = 0.f; f32x4 ua = (f32x4){0.f, 0.f, 0.f, 0.f}, ub = ua; ssm_issue_u(C, (size_t)b * LP + (size_t)k * CH, g, 32, C.lane, ua, ub);
            const float aLr = C.KST[K_ALRE + g * 64 + C.lane], aLi = C.KST[K_ALIM + g * 64 + C.lane];
            { const float* S = C.SEND + ((size_t)(b * NG + g) * NCHK + k) * 128; hr = S[C.lane]; hi = S[64 + C.lane]; }
            if (k >= 32) { const float* T = (const float*)(C.ws + WS_TEND) + ((size_t)(b * NG + g) * 2) * 128; const float tr = T[C.lane], ti = T[64 + C.lane];
                float pr = 1.f, pi = 0.f, br = aLr, bi = aLi;
                for (int e = k - 32; e > 0; e >>= 1) { if (e & 1) { const float nr = pr * br - pi * bi, ni = pr * bi + pi * br; pr = nr; pi = ni; }
                    const float nr = br * br - bi * bi, ni = 2.f * br * bi; br = nr; bi = ni; }
                hr += pr * tr - pi * ti; hi += pr * ti + pi * tr; }
#pragma unroll 1
            for (int tl = 0; tl < CH / 32; ++tl) ssm_tile<32>(C, K, R, U, HB, (size_t)b * LP + (size_t)k * CH + tl * 32, g, hr, hi, ua, ub, tl < CH / 32 - 1);
            if (k == NCHK - 1) { C.out[O_SRP + (size_t)(b * NG + g) * 64 + C.lane] = hr; C.out[O_SIP + (size_t)(b * NG + g) * 64 + C.lane] = hi; }
        } else {
            const int b = ((bi - NBIP) & 3) * 8 + C.wave;
            float hr = C.st_re[(size_t)(b * NG + g) * 64 + C.lane], hi = C.st_im[(size_t)(b * NG + g) * 64 + C.lane];
            f32x4 ua = (f32x4){0.f, 0.f, 0.f, 0.f}, ub = ua; ssm_issue_u(C, (size_t)MP + (size_t)b * LS, g, LS, C.lane, ua, ub);
            ssm_tile<LS>(C, K, R, U, HB, (size_t)MP + (size_t)b * LS, g, hr, hi, ua, ub, false);
            C.out[O_SRS + (size_t)(b * NG + g) * 64 + C.lane] = hr; C.out[O_SIS + (size_t)(b * NG + g) * 64 + C.lane] = hi;
        }
    }
    __syncthreads();
}
__device__ __forceinline__ f32x4 unpk4(const v2u p) { return (f32x4){__uint_as_float(p.x << 16), __uint_as_float(p.x & 0xffff0000u), __uint_as_float(p.y << 16), __uint_as_float(p.y & 0xffff0000u)}; }
__device__ __forceinline__ void p4_cmp2(const Ctx& C) {
    LAS float* gs = (LAS float*)(C.lds + C.wave * 256);
    const int lane = C.lane, m = lane & 15, q = lane >> 4;
    constexpr int SEQ_S = BS * 2 * 2, SEQ_P = BP * 2 * 2;
    constexpr int IT_S = SEQ_S * 32, IT_P = SEQ_P * 16;
    int cur_slot = -1; p1_bf16x8 Bf[2][4];
    for (int it = C.gw; it < IT_S + IT_P; it += C.NGW) {
        const bool smp = it < IT_S; const int qq = smp ? it : it - IT_S;
        const int seq = smp ? qq >> 5 : qq >> 4, n0 = (smp ? qq & 31 : qq & 15) * 32, NC = smp ? NCS : NCP, nmax = NC - 1;
        const int slot = seq & 1, h = (seq >> 1) & 1, b = seq >> 2;
        const size_t xrow0 = (smp ? 0 : (size_t)XC_S_ROWS) + (size_t)seq * NC;
        if (slot != cur_slot) { cur_slot = slot;
        { float cb = 0.f;
#pragma unroll 8
          for (int part = 0; part < 32; ++part) cb += C.KST[K_CBP + (slot * 32 + part) * 64 + lane];
          gs[lane] = cb; LDS_FENCE(); }
#pragma unroll
        for (int ks = 0; ks < 2; ++ks)
#pragma unroll
            for (int nt = 0; nt < 4; ++nt) { const float* wp = C.cmp_w2 + (size_t)slot * 4096 + (32 * ks + 8 * q) * 64 + 16 * nt + m;
                v4u pw; pw.x = ssm_cvt_pk(wp[0], wp[64]); pw.y = ssm_cvt_pk(wp[128], wp[192]); pw.z = ssm_cvt_pk(wp[256], wp[320]); pw.w = ssm_cvt_pk(wp[384], wp[448]);
                Bf[ks][nt] = __builtin_bit_cast(p1_bf16x8, pw); } }
        f32x4 acc[2][4];
#pragma unroll
        for (int mt = 0; mt < 2; ++mt)
#pragma unroll
            for (int nt = 0; nt < 4; ++nt) acc[mt][nt] = (f32x4){0.f, 0.f, 0.f, 0.f};
#pragma unroll
        for (int ks = 0; ks < 2; ++ks) { const int e0 = 32 * ks + 8 * q;
            const f32x4 c0 = *(const LAS f32x4*)(gs + e0), c1 = *(const LAS f32x4*)(gs + e0 + 4);
#pragma unroll
            for (int mt = 0; mt < 2; ++mt) { int n = n0 + 16 * mt + m; n = n < nmax ? n : nmax - 1;
                const v4u va = *(const v4u*)((const bf16*)C.PP + (xrow0 + n) * 128 + e0), vb = *(const v4u*)((const bf16*)C.PP + (xrow0 + n + 1) * 128 + 64 + e0);
                const f32x4 h0 = c0 + unpk4((v2u){va.x, va.y}) + unpk4((v2u){vb.x, vb.y}), h1 = c1 + unpk4((v2u){va.z, va.w}) + unpk4((v2u){vb.z, vb.w});
                v4u pk; pk.x = ssm_cvt_pk(gelu_t(h0.x), gelu_t(h0.y)); pk.y = ssm_cvt_pk(gelu_t(h0.z), gelu_t(h0.w)); pk.z = ssm_cvt_pk(gelu_t(h1.x), gelu_t(h1.y)); pk.w = ssm_cvt_pk(gelu_t(h1.z), gelu_t(h1.w));
                const p1_bf16x8 A = __builtin_bit_cast(p1_bf16x8, pk);
#pragma unroll
                for (int nt = 0; nt < 4; ++nt) acc[mt][nt] = __builtin_amdgcn_mfma_f32_16x16x32_bf16(A, Bf[ks][nt], acc[mt][nt], 0, 0, 0); } }
#pragma unroll
        for (int mt = 0; mt < 2; ++mt)
#pragma unroll
            for (int nt = 0; nt < 4; ++nt) { const int nb = n0 + 16 * mt + 4 * q, d = 16 * nt + m;
                if (smp) { bf16* o = (slot ? C.VCBS : C.KCBS) + ((size_t)(b * 2 + h) * NCS + nb) * 64 + d;
#pragma unroll
                    for (int r = 0; r < 4; ++r) if (nb + r < nmax) o[r * 64] = (bf16)f2bf(acc[mt][nt][r]); }
                else { bf16* o = (slot ? C.VCT : C.KCB) + ((size_t)(b * 2 + h) * NCP + nb) * 64 + d;
#pragma unroll
                    for (int r = 0; r < 4; ++r) if (nb + r < nmax) o[r * 64] = (bf16)f2bf(acc[mt][nt][r]); } }
        LDS_FENCE();
    }
}


constexpr float QSCALE = 0.125f * 1.4426950408889634f;
typedef short bf16x8 __attribute__((ext_vector_type(8)));
typedef short s16x4 __attribute__((ext_vector_type(4)));
#define MFMA16(a, b, c) __builtin_amdgcn_mfma_f32_16x16x32_bf16((a), (b), (c), 0, 0, 0)
constexpr int TP = 144, TILEB = 64 * TP;
constexpr int RSLOT = 16384  , NRING = 4;
constexpr int NRING2 = 8, RG2 = NRING2 / 2;
constexpr int A_BUF = 0, A_IMP = NRING * RSLOT  , A_SELM = NRING2 * RSLOT  , A_WUNI = A_SELM + 1024, A_LIST = A_WUNI + 128, A_MISC = A_LIST + 512, A_TUN = A_MISC + 64, A_END = A_TUN + 256;
static_assert(A_END <= MISC_OFF, "prompt attention LDS map");
constexpr int CW_QCTR = 8192;

struct StageRegs { v4u k, v; };
__device__ __forceinline__ void stage_load(StageRegs& R, const bf16* ksrc, size_t kpitch, const bf16* vsrc, size_t vpitch, int tid) {
    const int r = tid >> 3, ch = tid & 7; R.k = *(const v4u*)(ksrc + (size_t)r * kpitch + ch * 8); R.v = *(const v4u*)(vsrc + (size_t)r * vpitch + ch * 8); }
__device__ __forceinline__ void stage_write(const StageRegs& R, LAS unsigned char* buf, int tid) {
    const int r = tid >> 3, ch = tid & 7; *(LAS v4u*)(buf + r * TP + ch * 16) = R.k; *(LAS v4u*)(buf + TILEB + r * TP + ch * 16) = R.v; }
__device__ __forceinline__ void qk_tile(const LAS unsigned char* Kt, const bf16x8 q0, const bf16x8 q1, int c, int q, f32x4 (&s)[4]) {
    const LAS unsigned char* kp = Kt + c * TP + q * 16;
#pragma unroll
    for (int t = 0; t < 4; ++t) { const bf16x8 k0 = *(const LAS bf16x8*)(kp + t * 16 * TP), k1 = *(const LAS bf16x8*)(kp + t * 16 * TP + 64);
        s[t] = MFMA16(k0, q0, ((f32x4){0.f, 0.f, 0.f, 0.f})); s[t] = MFMA16(k1, q1, s[t]); }
}
__device__ __forceinline__ bf16x8 pack8(const f32x4 a, const f32x4 b) {
    v4u w; w.x = pg8::cvt_pk_bf16(a.x, a.y); w.y = pg8::cvt_pk_bf16(a.z, a.w); w.z = pg8::cvt_pk_bf16(b.x, b.y); w.w = pg8::cvt_pk_bf16(b.z, b.w); return __builtin_bit_cast(bf16x8, w); }
__device__ __forceinline__ void pv_tile(const LAS unsigned char* Vt, const f32x4 (&p)[4], int c, int q, f32x4 (&acc)[4]) {
    const bf16x8 P0 = pack8(p[0], p[1]), P1 = pack8(p[2], p[3]);
    const LAS unsigned char* vp = Vt + c * TP + q * 8;
#pragma unroll
    for (int dt = 0; dt < 4; ++dt) { const LAS unsigned char* vr = vp + dt * 16 * TP;
        const s16x4 a0 = *(const LAS s16x4*)(vr), a1 = *(const LAS s16x4*)(vr + 32), b0 = *(const LAS s16x4*)(vr + 64), b1 = *(const LAS s16x4*)(vr + 96);
        const bf16x8 va = (bf16x8){a0[0], a0[1], a0[2], a0[3], a1[0], a1[1], a1[2], a1[3]}, vb = (bf16x8){b0[0], b0[1], b0[2], b0[3], b1[0], b1[1], b1[2], b1[3]};
        acc[dt] = MFMA16(va, P0, acc[dt]); acc[dt] = MFMA16(vb, P1, acc[dt]); }
}
__device__ __forceinline__ void mask_tile(f32x4 (&s)[4], int q, int lo, int hi) {
    const float NINF = -__builtin_inff();
#pragma unroll
    for (int t = 0; t < 4; ++t)
#pragma unroll
        for (int r = 0; r < 4; ++r) { const int key = 16 * t + 4 * q + r; s[t][r] = (key >= lo && key <= hi) ? s[t][r] : NINF; }
}
__device__ __forceinline__ float xor16_max(float v) { const auto r = __builtin_amdgcn_permlane16_swap(__float_as_uint(v), __float_as_uint(v), false, false); return fmaxf(__uint_as_float(r[0]), __uint_as_float(r[1])); }
__device__ __forceinline__ float xor32_max(float v) { const auto r = __builtin_amdgcn_permlane32_swap(__float_as_uint(v), __float_as_uint(v), false, false); return fmaxf(__uint_as_float(r[0]), __uint_as_float(r[1])); }
__device__ __forceinline__ float xor16_sum(float v) { const auto r = __builtin_amdgcn_permlane16_swap(__float_as_uint(v), __float_as_uint(v), false, false); return __uint_as_float(r[0]) + __uint_as_float(r[1]); }
__device__ __forceinline__ float xor32_sum(float v) { const auto r = __builtin_amdgcn_permlane32_swap(__float_as_uint(v), __float_as_uint(v), false, false); return __uint_as_float(r[0]) + __uint_as_float(r[1]); }
__device__ __forceinline__ float colmax(const f32x4 (&s)[4]) {
    float mx = fmaxf(fmaxf(s[0].x, s[0].y), fmaxf(s[0].z, s[0].w));
#pragma unroll
    for (int t = 1; t < 4; ++t) mx = fmaxf(mx, fmaxf(fmaxf(s[t].x, s[t].y), fmaxf(s[t].z, s[t].w)));
    return xor32_max(xor16_max(mx));
}
__device__ __forceinline__ float ex2(float x) { return __builtin_amdgcn_exp2f(x); }
__device__ __forceinline__ void online_step(f32x4 (&s)[4], const bool mine, float& m, float& l, f32x4 (&acc)[4]) {
    const float NINF = -__builtin_inff(), PINF = __builtin_inff();
    float mx = colmax(s); mx = mine ? mx : NINF;
    const float mn = fmaxf(m, mx), ms = (mn > NINF) ? mn : 0.f, msub = mine ? ms : PINF;
    float sum = 0.f;
#pragma unroll
    for (int t = 0; t < 4; ++t) { s[t].x = ex2(s[t].x - msub); s[t].y = ex2(s[t].y - msub); s[t].z = ex2(s[t].z - msub); s[t].w = ex2(s[t].w - msub); sum += (s[t].x + s[t].y) + (s[t].z + s[t].w); }
    if (__any(mn != m)) { const float al = ex2(m - ms); l = l * al + sum;
#pragma unroll
        for (int dt = 0; dt < 4; ++dt) acc[dt] = acc[dt] * al; }
    else l += sum;
    m = mn;
}
__device__ __forceinline__ float dpp_xor1(float v) { return __builtin_bit_cast(float, __builtin_amdgcn_update_dpp(0, __builtin_bit_cast(int, v), 0xB1, 0xF, 0xF, true)); }
__device__ __forceinline__ float dpp_xor2(float v) { return __builtin_bit_cast(float, __builtin_amdgcn_update_dpp(0, __builtin_bit_cast(int, v), 0x4E, 0xF, 0xF, true)); }
__device__ __forceinline__ unsigned getw(const v4u v, int wi) { return wi == 0 ? v.x : (wi == 1 ? v.y : (wi == 2 ? v.z : v.w)); }

__device__ __forceinline__ v4u topk_token(const LAS float* imp, int cur, int lane) {
    const bool c0 = lane >= 1 && lane < cur, c1 = (lane + 64) < cur;
    const unsigned u0 = c0 ? __float_as_uint(imp[lane]) : 0u, u1 = c1 ? __float_as_uint(imp[64 + lane]) : 0u;
    bool s0, s1;
    const int K = cur >= 1 ? 14 : 15, ncand = cur >= 1 ? cur - 1 : 0;
    if (ncand <= K) { s0 = c0; s1 = c1; }
    else {
        unsigned prefix = 0u; int rem = K;
        for (int bit = 30; bit >= 11; --bit) {
            const unsigned cand = prefix | (1u << bit);
            const bool m0 = c0 && ((u0 >> bit) == (cand >> bit)), m1 = c1 && ((u1 >> bit) == (cand >> bit));
            const int cnt = __popcll(__ballot(m0)) + __popcll(__ballot(m1));
            if (cnt >= rem) prefix = cand; else rem -= cnt;
        }
        const unsigned ph = prefix >> 11;
        const bool e0 = c0 && (u0 >> 11) == ph, e1 = c1 && (u1 >> 11) == ph;
        const unsigned long long be0 = __ballot(e0), be1 = __ballot(e1), lt = (1ull << lane) - 1ull;
        const int r0 = __popcll(be0 & lt), r1 = __popcll(be0) + __popcll(be1 & lt);
        s0 = c0 && ((u0 >> 11) > ph || (e0 && r0 < rem)); s1 = c1 && ((u1 >> 11) > ph || (e1 && r1 < rem));
    }
    s0 = s0 || lane == 0 || lane == cur; s1 = s1 || (lane + 64) == cur;
    const unsigned long long b0 = __ballot(s0), b1 = __ballot(s1);
    return (v4u){(unsigned)b0, (unsigned)(b0 >> 32), (unsigned)b1, (unsigned)(b1 >> 32)};
}


__device__ __forceinline__ void ring_issue(LAS unsigned char* slot, const bf16* ksrc, size_t kpitch, const bf16* vsrc, size_t vpitch, int w, int lane) {
    const int row = 8 * w + (lane >> 3), cl = (lane & 7) ^ ((row >> 1) & 7);
    __builtin_amdgcn_global_load_lds((const unsigned*)(ksrc + (size_t)row * kpitch + cl * 8), (LAS unsigned*)(slot + w * 1024), 16, 0, 0);
    __builtin_amdgcn_global_load_lds((const unsigned*)(vsrc + (size_t)row * vpitch + cl * 8), (LAS unsigned*)(slot + 8192 + w * 1024), 16, 0, 0);
}
#define RING_PAIR_SYNC() do { asm volatile("s_waitcnt vmcnt(0)" ::: "memory"); __builtin_amdgcn_s_barrier(); asm volatile("" ::: "memory"); } while (0)
__device__ __forceinline__ void qk_tile_sw(const LAS unsigned char* Kt, const bf16x8 q0, const bf16x8 q1, int c, int q, f32x4 (&s)[4]) {
    const int sw = (c >> 1) & 7; const LAS unsigned char* kp = Kt + c * 128;
    const int o0 = (q ^ sw) * 16, o1 = ((4 + q) ^ sw) * 16;
#pragma unroll
    for (int t = 0; t < 4; ++t) { const bf16x8 k0 = *(const LAS bf16x8*)(kp + t * 2048 + o0), k1 = *(const LAS bf16x8*)(kp + t * 2048 + o1);
        s[t] = MFMA16(k0, q0, ((f32x4){0.f, 0.f, 0.f, 0.f})); s[t] = MFMA16(k1, q1, s[t]); }
}
typedef short v4i16_t __attribute__((ext_vector_type(4)));
__device__ __forceinline__ s16x4 vtr(const LAS unsigned char* p) { return __builtin_bit_cast(s16x4, __builtin_amdgcn_ds_read_tr16_b64_v4i16((LAS v4i16_t*)p)); }
__device__ __forceinline__ void pv_tile_sw(const LAS unsigned char* Vt, const f32x4 (&p)[4], int c, int q, f32x4 (&acc)[4]) {
    const bf16x8 P0 = pack8(p[0], p[1]), P1 = pack8(p[2], p[3]);
    const int sw = (2 * q + (c >> 3)) & 7, ch = (c & 3) >> 1;
    const LAS unsigned char* vb = Vt + (4 * q + (c >> 2)) * 128 + (c & 1) * 8;
#pragma unroll
    for (int dt = 0; dt < 4; ++dt) { const LAS unsigned char* vr = vb + (((2 * dt + ch) ^ sw) << 4);
        const s16x4 a0 = vtr(vr), a1 = vtr(vr + 16 * 128), b0 = vtr(vr + 32 * 128), b1 = vtr(vr + 48 * 128);
        const bf16x8 va = (bf16x8){a0[0], a0[1], a0[2], a0[3], a1[0], a1[1], a1[2], a1[3]}, vb8 = (bf16x8){b0[0], b0[1], b0[2], b0[3], b1[0], b1[1], b1[2], b1[3]};
        acc[dt] = MFMA16(va, P0, acc[dt]); acc[dt] = MFMA16(vb8, P1, acc[dt]); }
}

struct KFr { bf16x8 k0[4], k1[4]; };
__device__ __forceinline__ void attn_ld_k(const LAS unsigned char* Kt, int c, int q, KFr& F) {
    const int sw = (c >> 1) & 7; const LAS unsigned char* kp = Kt + c * 128;
    const int o0 = (q ^ sw) * 16, o1 = ((4 + q) ^ sw) * 16;
#pragma unroll
    for (int t = 0; t < 4; ++t) F.k0[t] = *(const LAS bf16x8*)(kp + t * 2048 + o0);
#pragma unroll
    for (int t = 0; t < 4; ++t) F.k1[t] = *(const LAS bf16x8*)(kp + t * 2048 + o1);
}
__device__ __forceinline__ void attn_qk(const KFr& F, const bf16x8 q0, const bf16x8 q1, const f32x4 cinit, f32x4 (&s)[4]) {
#pragma unroll
    for (int t = 0; t < 4; ++t) s[t] = MFMA16(F.k0[t], q0, cinit);
#pragma unroll
    for (int t = 0; t < 4; ++t) s[t] = MFMA16(F.k1[t], q1, s[t]);
}
struct VFr { v2u r[4][4]; };
__device__ __forceinline__ void attn_v_issue(const LAS unsigned char* Vt, int c, int q, VFr& V) {
    const int sw = (2 * q + (c >> 3)) & 7, ch = (c & 3) >> 1;
    const unsigned vb = (unsigned)(size_t)Vt + (unsigned)((4 * q + (c >> 2)) * 128 + (c & 1) * 8);
#pragma unroll
    for (int dt = 0; dt < 4; ++dt) { const unsigned a = vb + (unsigned)(((2 * dt + ch) ^ sw) << 4);
        asm volatile("ds_read_b64_tr_b16 %0, %4\n\tds_read_b64_tr_b16 %1, %4 offset:2048\n\tds_read_b64_tr_b16 %2, %4 offset:4096\n\tds_read_b64_tr_b16 %3, %4 offset:6144"
                     : "=&v"(V.r[dt][0]), "=&v"(V.r[dt][1]), "=&v"(V.r[dt][2]), "=&v"(V.r[dt][3]) : "v"(a)); }
}
__device__ __forceinline__ void attn_v_wait(VFr& V) {
    asm volatile("s_waitcnt lgkmcnt(0)" : "+v"(V.r[0][0]), "+v"(V.r[0][1]), "+v"(V.r[0][2]), "+v"(V.r[0][3]), "+v"(V.r[1][0]), "+v"(V.r[1][1]), "+v"(V.r[1][2]), "+v"(V.r[1][3]),
                                          "+v"(V.r[2][0]), "+v"(V.r[2][1]), "+v"(V.r[2][2]), "+v"(V.r[2][3]), "+v"(V.r[3][0]), "+v"(V.r[3][1]), "+v"(V.r[3][2]), "+v"(V.r[3][3]));
}
__device__ __forceinline__ bf16x8 pack8n(const f32x4 a, const f32x4 b) {
    v4u w; w.x = ssm_cvt_pk(a.x, a.y); w.y = ssm_cvt_pk(a.z, a.w); w.z = ssm_cvt_pk(b.x, b.y); w.w = ssm_cvt_pk(b.z, b.w); return __builtin_bit_cast(bf16x8, w); }
__device__ __forceinline__ void attn_pv(const VFr& V, const bf16x8 P0, const bf16x8 P1, f32x4 (&acc)[4]) {
#pragma unroll
    for (int dt = 0; dt < 4; ++dt) { const v4u va = (v4u){V.r[dt][0].x, V.r[dt][0].y, V.r[dt][1].x, V.r[dt][1].y}; acc[dt] = MFMA16(__builtin_bit_cast(bf16x8, va), P0, acc[dt]); }
#pragma unroll
    for (int dt = 0; dt < 4; ++dt) { const v4u vb = (v4u){V.r[dt][2].x, V.r[dt][2].y, V.r[dt][3].x, V.r[dt][3].y}; acc[dt] = MFMA16(__builtin_bit_cast(bf16x8, vb), P1, acc[dt]); }
}
#define A_VADD(d, a, b) asm("v_add_f32 %0, %1, %2" : "=v"(d) : "v"(a), "v"(b))
#define A_VMAX(d, a, b) asm("v_max_f32 %0, %1, %2" : "=v"(d) : "v"(a), "v"(b))
#define A_VMAX3(d, a, b, c) asm("v_max3_f32 %0, %1, %2, %3" : "=v"(d) : "v"(a), "v"(b), "v"(c))
__device__ __forceinline__ float colmax2(const f32x4 (&s)[4]) {
    float r, r2; A_VMAX3(r, s[0].x, s[0].y, s[0].z); A_VMAX3(r2, s[2].x, s[2].y, s[2].z); A_VMAX3(r, r, s[0].w, s[1].x); A_VMAX3(r2, r2, s[2].w, s[3].x);
    A_VMAX3(r, r, s[1].y, s[1].z); A_VMAX3(r2, r2, s[3].y, s[3].z); A_VMAX3(r, r, s[1].w, s[3].w); A_VMAX(r, r, r2);
    { const auto x = __builtin_amdgcn_permlane16_swap(__float_as_uint(r), __float_as_uint(r), false, false); A_VMAX(r, __uint_as_float(x[0]), __uint_as_float(x[1])); }
    { const auto x = __builtin_amdgcn_permlane32_swap(__float_as_uint(r), __float_as_uint(r), false, false); A_VMAX(r, __uint_as_float(x[0]), __uint_as_float(x[1])); }
    return r;
}
__device__ __forceinline__ void online_step2(f32x4 (&s)[4], const bool mine, float& m, float& l, f32x4& Cn, f32x4 (&acc)[4], bf16x8& P0, bf16x8& P1) {
    const float NINF = -__builtin_inff();
    float mx = colmax2(s); mx = mine ? mx : NINF;
    const float mref = -Cn.x, mn = fmaxf(m, mref + mx);
    if (__any(mn != m)) {
        const float mnew = (mn > NINF) ? mn : 0.f, d = mnew - mref, al = ex2(m - mnew);
#pragma unroll
        for (int t = 0; t < 4; ++t) { s[t].x -= d; s[t].y -= d; s[t].z -= d; s[t].w -= d; }
        l *= al;
#pragma unroll
        for (int dt = 0; dt < 4; ++dt) acc[dt] = acc[dt] * al;
        m = mn; Cn = (f32x4){-mnew, -mnew, -mnew, -mnew};
    }
#pragma unroll
    for (int t = 0; t < 4; ++t) { s[t].x = ex2(s[t].x); s[t].y = ex2(s[t].y); s[t].z = ex2(s[t].z); s[t].w = ex2(s[t].w); }
    float a0, a1, a2, a3, a4, a5, a6, a7;
    A_VADD(a0, s[0].x, s[0].y); A_VADD(a1, s[0].z, s[0].w); A_VADD(a2, s[1].x, s[1].y); A_VADD(a3, s[1].z, s[1].w); A_VADD(a4, s[2].x, s[2].y); A_VADD(a5, s[2].z, s[2].w); A_VADD(a6, s[3].x, s[3].y); A_VADD(a7, s[3].z, s[3].w);
    A_VADD(a0, a0, a1); A_VADD(a2, a2, a3); A_VADD(a4, a4, a5); A_VADD(a6, a6, a7); A_VADD(a0, a0, a2); A_VADD(a4, a4, a6); A_VADD(a0, a0, a4);
    l += mine ? a0 : 0.f;
    const unsigned mm = mine ? 0xffffffffu : 0u;
    v4u w0, w1; w0.x = ssm_cvt_pk(s[0].x, s[0].y) & mm; w0.y = ssm_cvt_pk(s[0].z, s[0].w) & mm; w0.z = ssm_cvt_pk(s[1].x, s[1].y) & mm; w0.w = ssm_cvt_pk(s[1].z, s[1].w) & mm;
    w1.x = ssm_cvt_pk(s[2].x, s[2].y) & mm; w1.y = ssm_cvt_pk(s[2].z, s[2].w) & mm; w1.z = ssm_cvt_pk(s[3].x, s[3].y) & mm; w1.w = ssm_cvt_pk(s[3].z, s[3].w) & mm;
    P0 = __builtin_bit_cast(bf16x8, w0); P1 = __builtin_bit_cast(bf16x8, w1);
}
template <bool A0, bool A1, bool MSK>
__device__ __forceinline__ void attn_step(const LAS unsigned char* buf, const bf16x8 (&Q0)[2], const bf16x8 (&Q1)[2], const int c, const int q, const bool mine0, const bool mine1,
                                          const int lo0, const int hi0, const int lo1, const int hi1, float (&m)[2], float (&l)[2], f32x4 (&Cn)[2], f32x4 (&acc)[2][4]) {
    f32x4 s0[4], s1[4];
    { KFr F; attn_ld_k(buf, c, q, F);
      if (A0) attn_qk(F, Q0[0], Q1[0], Cn[0], s0);
      if (A1) attn_qk(F, Q0[1], Q1[1], Cn[1], s1); }
    bf16x8 P00, P01, P10, P11;
    if (A0) { if (MSK) mask_tile(s0, q, lo0, hi0); online_step2(s0, mine0, m[0], l[0], Cn[0], acc[0], P00, P01); }
    if (A1) { if (MSK) mask_tile(s1, q, lo1, hi1); online_step2(s1, mine1, m[1], l[1], Cn[1], acc[1], P10, P11); }
    VFr V; attn_v_issue(buf + 8192, c, q, V); attn_v_wait(V);
    if (A0) attn_pv(V, P00, P01, acc[0]);
    if (A1) attn_pv(V, P10, P11, acc[1]);
}
template <int MODE> __device__ __forceinline__ void attn_prompt_unit(const Ctx& C, int b, int h, int T) {
    const float NINF = -__builtin_inff();
    int tid_ = C.tid; asm volatile("" : "+v"(tid_));
    const int tid = tid_, lane = tid & 63, w = __builtin_amdgcn_readfirstlane(tid >> 6), c = lane & 15, q = lane >> 4, ti = c >> 2, g = c & 3;
    LAS unsigned char* L = C.lds;
    LAS float* impS = (LAS float*)(L + A_IMP); LAS unsigned* selm = (LAS unsigned*)(L + A_SELM); LAS unsigned* wuni = (LAS unsigned*)(L + A_WUNI); LAS int* list = (LAS int*)(L + A_LIST); LAS int* misc = (LAS int*)(L + A_MISC);
    const int q0 = 64 * T, seq = b * 2 + h;
    bf16x8 Q0[2], Q1[2]; int toff[2];
    f32x4* OT = (f32x4*)(C.ws + WS_OT) + (size_t)blockIdx.x * 4096 + tid;
#pragma unroll
    for (int a = 0; a < 2; ++a) { toff[a] = 8 * w + 4 * a + ti; const bf16* qp = C.QB + ((size_t)b * LP + q0 + toff[a]) * 512 + h * 256 + g * 64 + 8 * q;
        Q0[a] = *(const bf16x8*)qp; Q1[a] = *(const bf16x8*)(qp + 32);
    }
    for (int i = tid; i < 2048; i += 512) ((LAS f32x4*)impS)[i] = (f32x4){0.f, 0.f, 0.f, 0.f};
    const int nvmax = 4 * T + 3, ntc = (MODE & 4) ? 0 : (nvmax + 63) >> 6;
    const bf16* kcb = C.KCB + (size_t)seq * NCP * 64; const bf16* vcb = C.VCT + (size_t)seq * NCP * 64;
    int nvis[2], nvmin[2]; float mC[2], lC[2];
#pragma unroll
    for (int a = 0; a < 2; ++a) { const int qpos = q0 + toff[a]; nvis[a] = qpos >= 31 ? ((qpos - 31) >> 4) + 1 : 0; mC[a] = NINF; lC[a] = 0.f;
        const int qmin = q0 + 8 * w + 4 * a; nvmin[a] = qmin >= 31 ? ((qmin - 31) >> 4) + 1 : 0; }
    for (int s = 0; s < 2 && s < ntc; ++s) ring_issue(L + s * RSLOT, kcb + (size_t)s * 4096, 64, vcb + (size_t)s * 4096, 64, w, lane);
    for (int s = 0; s < ntc; ++s) {
        if (!(s & 1)) { RING_PAIR_SYNC();
            for (int s2 = s + 2; s2 < s + 4 && s2 < ntc; ++s2) ring_issue(L + (s2 & 3) * RSLOT, kcb + (size_t)s2 * 4096, 64, vcb + (size_t)s2 * 4096, 64, w, lane); }
        const LAS unsigned char* buf = L + (s & 3) * RSLOT;
#pragma unroll
        for (int a = 0; a < 2; ++a) { __builtin_amdgcn_sched_barrier(0); f32x4 sc[4]; qk_tile_sw(buf, Q0[a], Q1[a], c, q, sc); if (64 * (s + 1) > nvmin[a]) mask_tile(sc, q, 0, nvis[a] - 64 * s - 1);
            const float mn = fmaxf(mC[a], colmax(sc)), ms = (mn > NINF) ? mn : 0.f; float sum = 0.f;
#pragma unroll
            for (int t = 0; t < 4; ++t) sum += (ex2(sc[t].x - ms) + ex2(sc[t].y - ms)) + (ex2(sc[t].z - ms) + ex2(sc[t].w - ms));
            lC[a] = lC[a] * ex2(mC[a] - ms) + sum; mC[a] = mn; }
    }
    __builtin_amdgcn_s_barrier();
    float invC[2], msC[2];
#pragma unroll
    for (int a = 0; a < 2; ++a) { float l = lC[a]; l += __shfl_xor(l, 16); l += __shfl_xor(l, 32); invC[a] = 1.0f / fmaxf(l, 1e-30f); msC[a] = (mC[a] > NINF) ? mC[a] : 0.f; }
    f32x4 acc[2][4]; float carry[2];
#pragma unroll
    for (int a = 0; a < 2; ++a) { carry[a] = 0.f;
#pragma unroll
        for (int dt = 0; dt < 4; ++dt) acc[a][dt] = (f32x4){0.f, 0.f, 0.f, 0.f}; }
    for (int s = 0; s < 2 && s < ntc; ++s) ring_issue(L + s * RSLOT, kcb + (size_t)s * 4096, 64, vcb + (size_t)s * 4096, 64, w, lane);
    for (int s = 0; s < ntc; ++s) {
        if (!(s & 1)) { RING_PAIR_SYNC();
            for (int s2 = s + 2; s2 < s + 4 && s2 < ntc; ++s2) ring_issue(L + (s2 & 3) * RSLOT, kcb + (size_t)s2 * 4096, 64, vcb + (size_t)s2 * 4096, 64, w, lane); }
        const LAS unsigned char* buf = L + (s & 3) * RSLOT;
#pragma unroll
        for (int a = 0; a < 2; ++a) { __builtin_amdgcn_sched_barrier(0); f32x4 sc[4]; qk_tile_sw(buf, Q0[a], Q1[a], c, q, sc); if (64 * (s + 1) > nvmin[a]) mask_tile(sc, q, 0, nvis[a] - 64 * s - 1);
            float x[4], A[4];
#pragma unroll
            for (int t = 0; t < 4; ++t) { sc[t].x = ex2(sc[t].x - msC[a]) * invC[a]; sc[t].y = ex2(sc[t].y - msC[a]) * invC[a]; sc[t].z = ex2(sc[t].z - msC[a]) * invC[a]; sc[t].w = ex2(sc[t].w - msC[a]) * invC[a];
                f32x4 ps = sc[t]; ps.x += dpp_xor1(ps.x); ps.y += dpp_xor1(ps.y); ps.z += dpp_xor1(ps.z); ps.w += dpp_xor1(ps.w);
                ps.x += dpp_xor2(ps.x); ps.y += dpp_xor2(ps.y); ps.z += dpp_xor2(ps.z); ps.w += dpp_xor2(ps.w);
                A[t] = (ps.x + ps.y) + (ps.z + 0.5f * ps.w); x[t] = __shfl(0.5f * ps.w, (lane + 48) & 63); }
            if (g == 0) { LAS float* ip = impS + ((2 * w + a) * 4 + ti) * 128 + 16 * s + q;
                ip[0] = A[0] + (q ? x[0] : carry[a]); ip[4] = A[1] + (q ? x[1] : x[0]); ip[8] = A[2] + (q ? x[2] : x[1]); ip[12] = A[3] + (q ? x[3] : x[2]); }
            carry[a] = x[3];
            pv_tile_sw(buf + 8192, sc, c, q, acc[a]); }
    }
    __builtin_amdgcn_s_barrier();
    {
        LDS_FENCE();
#pragma unroll
        for (int a = 0; a < 2; ++a) { const float gc = C.GN[((size_t)b * LP + q0 + toff[a]) * 32 + (h * 4 + g) * 3 + 0];
#pragma unroll
            for (int dt = 0; dt < 4; ++dt) OT[(a * 4 + dt) * 512] = acc[a][dt] * gc; }
    }
    v4u wu = (v4u){0u, 0u, 0u, 0u};
    for (int tt = 0; tt < ((MODE & 2) ? 0 : 8); ++tt) { const v4u mk = topk_token(impS + ((2 * w + (tt >> 2)) * 4 + (tt & 3)) * 128, T, lane);
        if (lane == 0) *(LAS v4u*)(selm + (8 * w + tt) * 4) = mk;
        wu.x |= mk.x; wu.y |= mk.y; wu.z |= mk.z; wu.w |= mk.w; }
    if (lane == 0) *(LAS v4u*)(wuni + 4 * w) = wu;
    __syncthreads();
    LAS unsigned* tun = (LAS unsigned*)(L + A_TUN);
    if (lane < 8) { const int a = lane >> 2, wi = lane & 3; unsigned o = 0u;
#pragma unroll
        for (int i = 0; i < 4; ++i) o |= selm[(8 * w + 4 * a + i) * 4 + wi];
        tun[(2 * w + a) * 4 + wi] = o; }
    if (w == 0) {
        v4u U = (v4u){0u, 0u, 0u, 0u};
#pragma unroll
        for (int i = 0; i < 8; ++i) { const v4u o = *(const LAS v4u*)(wuni + 4 * i); U.x |= o.x; U.y |= o.y; U.z |= o.z; U.w |= o.w; }
        const unsigned long long lt = (1ull << lane) - 1ull;
        const bool b0 = ((lane < 32 ? U.x : U.y) >> (lane & 31)) & 1u, b1 = ((lane < 32 ? U.z : U.w) >> (lane & 31)) & 1u;
        const unsigned long long m0 = __ballot(b0), m1 = __ballot(b1); const int n0 = __popcll(m0);
        if (b0) list[__popcll(m0 & lt)] = lane; if (b1) list[n0 + __popcll(m1 & lt)] = 64 + lane;
        if (lane == 0) { misc[0] = n0 + __popcll(m1); misc[4] = (int)U.x; misc[5] = (int)U.y; misc[6] = (int)U.z; misc[7] = (int)U.w; }
    }
    __syncthreads();
    const int nsel = (MODE & 3) ? 0 : misc[0];
#define RFL(x) ((unsigned)__builtin_amdgcn_readfirstlane((int)(x)))
    const unsigned long long Ulo = RFL(misc[4]) | ((unsigned long long)RFL(misc[5]) << 32), Uhi = RFL(misc[6]) | ((unsigned long long)RFL(misc[7]) << 32);
    const unsigned long long tm0lo = RFL(tun[(2 * w) * 4 + 0]) | ((unsigned long long)RFL(tun[(2 * w) * 4 + 1]) << 32), tm0hi = RFL(tun[(2 * w) * 4 + 2]) | ((unsigned long long)RFL(tun[(2 * w) * 4 + 3]) << 32);
    const unsigned long long tm1lo = RFL(tun[(2 * w + 1) * 4 + 0]) | ((unsigned long long)RFL(tun[(2 * w + 1) * 4 + 1]) << 32), tm1hi = RFL(tun[(2 * w + 1) * 4 + 2]) | ((unsigned long long)RFL(tun[(2 * w + 1) * 4 + 3]) << 32);
#undef RFL
#define NEXTJ(lo, hi, j) do { if (lo) { j = __builtin_ctzll(lo); lo &= lo - 1ull; } else { j = 64 + __builtin_ctzll(hi); hi &= hi - 1ull; } } while (0)
    unsigned long long curLo = Ulo, curHi = Uhi, preLo = Ulo, preHi = Uhi;
    const bf16* ksb = C.KVB + ((size_t)b * LP) * 768 + 2 * 128 + h * 64; const bf16* vsb = C.KVB + ((size_t)b * LP) * 768 + 3 * 128 + h * 64;
    float mS[2], lS[2]; f32x4 Cn[2];
#pragma unroll
    for (int a = 0; a < 2; ++a) { mS[a] = NINF; lS[a] = 0.f; Cn[a] = (f32x4){0.f, 0.f, 0.f, 0.f};
#pragma unroll
        for (int dt = 0; dt < 4; ++dt) acc[a][dt] = (f32x4){0.f, 0.f, 0.f, 0.f}; }
#pragma unroll
    for (int s = 0; s < RG2; ++s) if (s < nsel) { int jn; NEXTJ(preLo, preHi, jn); ring_issue(L + s * RSLOT, ksb + (size_t)jn * 64 * 768, 768, vsb + (size_t)jn * 64 * 768, 768, w, lane); }
    for (int s = 0; s < nsel; ++s) {
        if (!(s & (RG2 - 1))) { RING_PAIR_SYNC();
#pragma unroll
            for (int u = 0; u < RG2; ++u) { const int s2 = s + RG2 + u; if (s2 < nsel) { int jn; NEXTJ(preLo, preHi, jn); ring_issue(L + (s2 & (NRING2 - 1)) * RSLOT, ksb + (size_t)jn * 64 * 768, 768, vsb + (size_t)jn * 64 * 768, 768, w, lane); } } }
        int j; NEXTJ(curLo, curHi, j);
        const LAS unsigned char* buf = L + (s & (NRING2 - 1)) * RSLOT;
        const int wi = j >> 5, bt = j & 31;
        const bool p0 = (MODE & 512) ? true : (MODE & 1024) ? false : (bool)(((j < 64 ? tm0lo : tm0hi) >> (j & 63)) & 1ull), p1 = (MODE & 512) ? true : (MODE & 1024) ? false : (bool)(((j < 64 ? tm1lo : tm1hi) >> (j & 63)) & 1ull);
        if (!(p0 || p1)) continue;
        const bool mine0 = (selm[(8 * w + ti) * 4 + wi] >> bt) & 1u, mine1 = (selm[(8 * w + 4 + ti) * 4 + wi] >> bt) & 1u;
        __builtin_amdgcn_sched_barrier(0);
        if (j == T && !(MODE & 1024)) attn_step<true, true, true>(buf, Q0, Q1, c, q, mine0, mine1, 0, toff[0], 0, toff[1], mS, lS, Cn, acc);
        else if (p0 && p1) attn_step<true, true, false>(buf, Q0, Q1, c, q, mine0, mine1, 0, 63, 0, 63, mS, lS, Cn, acc);
        else if (p0) attn_step<true, false, false>(buf, Q0, Q1, c, q, mine0, mine1, 0, 63, 0, 63, mS, lS, Cn, acc);
        else if (p1) attn_step<false, true, false>(buf, Q0, Q1, c, q, mine0, mine1, 0, 63, 0, 63, mS, lS, Cn, acc);
        __builtin_amdgcn_sched_barrier(0);
    }
    __builtin_amdgcn_s_barrier();
#pragma unroll
    for (int a = 0; a < 2; ++a) { float l = lS[a]; l += __shfl_xor(l, 16); l += __shfl_xor(l, 32);
        const float gs = C.GN[((size_t)b * LP + q0 + toff[a]) * 32 + (h * 4 + g) * 3 + 1] / fmaxf(l, 1e-30f);
#pragma unroll
        for (int dt = 0; dt < 4; ++dt) OT[(a * 4 + dt) * 512] = OT[(a * 4 + dt) * 512] + acc[a][dt] * gs; }
    const bf16* kwb = C.KVB + ((size_t)b * LP) * 768 + 4 * 128 + h * 64; const bf16* vwb = C.KVB + ((size_t)b * LP) * 768 + 5 * 128 + h * 64;
#pragma unroll
    for (int a = 0; a < 2; ++a) { mS[a] = NINF; lS[a] = 0.f; Cn[a] = (f32x4){0.f, 0.f, 0.f, 0.f};
#pragma unroll
        for (int dt = 0; dt < 4; ++dt) acc[a][dt] = (f32x4){0.f, 0.f, 0.f, 0.f}; }
    const int jw0 = T >= 8 ? T - 8 : 0, nw = (MODE & 8) ? 0 : T - jw0 + 1;
#pragma unroll
    for (int s = 0; s < RG2; ++s) if (s < nw) ring_issue(L + s * RSLOT, kwb + (size_t)(jw0 + s) * 64 * 768, 768, vwb + (size_t)(jw0 + s) * 64 * 768, 768, w, lane);
    for (int s = 0; s < nw; ++s) {
        if (!(s & (RG2 - 1))) { RING_PAIR_SYNC();
#pragma unroll
            for (int u = 0; u < RG2; ++u) { const int s2 = s + RG2 + u; if (s2 < nw) ring_issue(L + (s2 & (NRING2 - 1)) * RSLOT, kwb + (size_t)(jw0 + s2) * 64 * 768, 768, vwb + (size_t)(jw0 + s2) * 64 * 768, 768, w, lane); } }
        const int j = jw0 + s;
        const LAS unsigned char* buf = L + (s & (NRING2 - 1)) * RSLOT;
        __builtin_amdgcn_sched_barrier(0);
        if (j == T - 8 || j == T) attn_step<true, true, true>(buf, Q0, Q1, c, q, true, true, (j == T - 8) ? toff[0] + 1 : 0, (j == T) ? toff[0] : 63, (j == T - 8) ? toff[1] + 1 : 0, (j == T) ? toff[1] : 63, mS, lS, Cn, acc);
        else attn_step<true, true, false>(buf, Q0, Q1, c, q, true, true, 0, 63, 0, 63, mS, lS, Cn, acc);
        __builtin_amdgcn_sched_barrier(0);
    }
    __builtin_amdgcn_s_barrier();
#pragma unroll
    for (int a = 0; a < 2; ++a) { float l = lS[a]; l += __shfl_xor(l, 16); l += __shfl_xor(l, 32);
        const size_t row = (size_t)b * LP + q0 + toff[a];
        const float gw = C.GN[row * 32 + (h * 4 + g) * 3 + 2] / fmaxf(l, 1e-30f);
#pragma unroll
        for (int dt = 0; dt < 4; ++dt) { const f32x4 o = OT[(a * 4 + dt) * 512] + acc[a][dt] * gw; const int col = h * 256 + g * 64 + 16 * dt + 4 * q;
            const f32x4 z = unpk4(*(const v2u*)(C.SZA + row * 512 + col));
            v2u ov; ov.x = pk2(o.x * z.x, o.y * z.y); ov.y = pk2(o.z * z.z, o.w * z.w);
            if (!(MODE & 32)) *(v2u*)(C.OA + row * 512 + col) = ov; else if (ov.x == 0x12345678u) *(v2u*)(C.OA + row * 512 + col) = ov; } }
}

constexpr int S_TILE = 2 * TILEB, S_IMPA = 4 * S_TILE, S_IMPB = S_IMPA + 8448, S_SELM = S_IMPB + 8448, S_LIST = S_SELM + 512, S_MISC = S_LIST + 1088, S_TUN = S_MISC + 64, S_MRG = S_TUN + 128, S_END = S_MRG + 8 * 64 * 18 * 4;
static_assert(S_END <= MISC_OFF, "sample attention LDS map");
__device__ __forceinline__ void pv_tile_tr(const LAS unsigned char* Vt, const f32x4 (&p)[4], int lane, f32x4 (&acc)[4]) {
    const bf16x8 P0 = pack8(p[0], p[1]), P1 = pack8(p[2], p[3]);
    const int i = lane & 15, q = lane >> 4;
    const LAS unsigned char* vb = Vt + (4 * q + (i >> 2)) * TP + (i & 3) * 8;
#pragma unroll
    for (int dt = 0; dt < 4; ++dt) {
        const s16x4 a0 = vtr(vb + dt * 32), a1 = vtr(vb + dt * 32 + 16 * TP), b0 = vtr(vb + dt * 32 + 32 * TP), b1 = vtr(vb + dt * 32 + 48 * TP);
        const bf16x8 va = (bf16x8){a0[0], a0[1], a0[2], a0[3], a1[0], a1[1], a1[2], a1[3]}, vb8 = (bf16x8){b0[0], b0[1], b0[2], b0[3], b1[0], b1[1], b1[2], b1[3]};
        acc[dt] = MFMA16(va, P0, acc[dt]); acc[dt] = MFMA16(vb8, P1, acc[dt]); }
}
struct TileSrc { const float* k; const float* v; int stride; int nrows; };
__device__ __forceinline__ void stage4_f32(LAS unsigned char* L, const TileSrc (&ts)[4], int tid) {
    const int r0 = tid >> 4, d4 = (tid & 15) * 4;
    f32x4 kv[4][2], vv[4][2];
#pragma unroll
    for (int t = 0; t < 4; ++t)
#pragma unroll
        for (int hh = 0; hh < 2; ++hh) { const int r = r0 + 32 * hh; const bool ok = r < ts[t].nrows;
            kv[t][hh] = ok ? *(const f32x4*)(ts[t].k + (size_t)r * ts[t].stride + d4) : (f32x4){0.f, 0.f, 0.f, 0.f};
            vv[t][hh] = ok ? *(const f32x4*)(ts[t].v + (size_t)r * ts[t].stride + d4) : (f32x4){0.f, 0.f, 0.f, 0.f}; }
#pragma unroll
    for (int t = 0; t < 4; ++t)
#pragma unroll
        for (int hh = 0; hh < 2; ++hh) { const int r = r0 + 32 * hh; v2u a, b2; a.x = pk2(kv[t][hh].x, kv[t][hh].y); a.y = pk2(kv[t][hh].z, kv[t][hh].w); b2.x = pk2(vv[t][hh].x, vv[t][hh].y); b2.y = pk2(vv[t][hh].z, vv[t][hh].w);
            *(LAS v2u*)(L + t * S_TILE + r * TP + d4 * 2) = a; *(LAS v2u*)(L + t * S_TILE + TILEB + r * TP + d4 * 2) = b2; }
}
__device__ __forceinline__ void stage4_bf16(LAS unsigned char* L, const bf16* kb, const bf16* vb, int tid) {
    const int r = tid >> 3, ch = tid & 7;
    v4u kk[4], vv[4];
#pragma unroll
    for (int t = 0; t < 4; ++t) { kk[t] = *(const v4u*)(kb + (size_t)(64 * t + r) * 64 + ch * 8); vv[t] = *(const v4u*)(vb + (size_t)(64 * t + r) * 64 + ch * 8); }
#pragma unroll
    for (int t = 0; t < 4; ++t) { *(LAS v4u*)(L + t * S_TILE + r * TP + ch * 16) = kk[t]; *(LAS v4u*)(L + t * S_TILE + TILEB + r * TP + ch * 16) = vv[t]; }
}
__device__ __forceinline__ void merge4(LAS float* mrg, int w, int lane, float& m, float& l, f32x4 (&acc)[4]) {
    const float NINF = -__builtin_inff();
    LAS float* me = mrg + (w * 64 + lane) * 18;
    me[0] = m; me[1] = l;
#pragma unroll
    for (int dt = 0; dt < 4; ++dt) { me[2 + 4 * dt] = acc[dt].x; me[3 + 4 * dt] = acc[dt].y; me[4 + 4 * dt] = acc[dt].z; me[5 + 4 * dt] = acc[dt].w; }
    LDS_FENCE(); __syncthreads();
    const int w0 = w & 4;
    float M = NINF;
#pragma unroll
    for (int k = 0; k < 4; ++k) M = fmaxf(M, mrg[((w0 + k) * 64 + lane) * 18]);
    const float Ms = (M > NINF) ? M : 0.f; float Lx = 0.f; f32x4 A[4];
#pragma unroll
    for (int dt = 0; dt < 4; ++dt) A[dt] = (f32x4){0.f, 0.f, 0.f, 0.f};
#pragma unroll
    for (int k = 0; k < 4; ++k) { const LAS float* o = mrg + ((w0 + k) * 64 + lane) * 18; const float f = ex2(o[0] - Ms); Lx += o[1] * f;
#pragma unroll
        for (int dt = 0; dt < 4; ++dt) { A[dt].x += o[2 + 4 * dt] * f; A[dt].y += o[3 + 4 * dt] * f; A[dt].z += o[4 + 4 * dt] * f; A[dt].w += o[5 + 4 * dt] * f; } }
    m = M; l = Lx;
#pragma unroll
    for (int dt = 0; dt < 4; ++dt) acc[dt] = A[dt];
    asm volatile("" : "+v"(m), "+v"(l), "+v"(acc[0]), "+v"(acc[1]), "+v"(acc[2]), "+v"(acc[3]));
    __syncthreads();
}
__device__ __forceinline__ void topk_token_s(const LAS float* ia, const LAS float* ib, int lane, LAS unsigned* dst) {
    bool cv[5], sv[5]; unsigned u[5];
#pragma unroll
    for (int k = 0; k < 5; ++k) { const int j = lane + 64 * k; cv[k] = j >= 1 && j < 256; u[k] = cv[k] ? __float_as_uint(ia[j] + ib[j]) : 0u; }
    unsigned prefix = 0u; int rem = 14;
    for (int bit = 30; bit >= 0; --bit) {
        const unsigned cand = prefix | (1u << bit); int cnt = 0;
#pragma unroll
        for (int k = 0; k < 5; ++k) cnt += __popcll(__ballot(cv[k] && ((u[k] >> bit) == (cand >> bit))));
        if (cnt >= rem) prefix = cand; else rem -= cnt;
    }
    const unsigned long long lt = (1ull << lane) - 1ull; int before = 0;
#pragma unroll
    for (int k = 0; k < 5; ++k) { const bool e = cv[k] && u[k] == prefix; const unsigned long long be = __ballot(e); const int rk = before + __popcll(be & lt); before += __popcll(be);
        sv[k] = cv[k] && (u[k] > prefix || (e && rk < rem)); }
    sv[0] = sv[0] || lane == 0; sv[4] = sv[4] || lane == 0;
#pragma unroll
    for (int k = 0; k < 5; ++k) { const unsigned long long bb = __ballot(sv[k]); if (lane == 0) { dst[2 * k] = (unsigned)bb; dst[2 * k + 1] = (unsigned)(bb >> 32); } }
}
__device__ __forceinline__ void attn_sample_unit(const Ctx& C, int b, int h) {
    const float NINF = -__builtin_inff();
    int tid_ = C.tid; asm volatile("" : "+v"(tid_));
    const int tid = tid_, lane = tid & 63, w = __builtin_amdgcn_readfirstlane(tid >> 6), c = lane & 15, q = lane >> 4, ti = c >> 2, g = c & 3, a = w >> 2, ks = w & 3;
    LAS unsigned char* L = C.lds;
    LAS float* impA = (LAS float*)(L + S_IMPA); LAS float* impB = (LAS float*)(L + S_IMPB); LAS unsigned* selm = (LAS unsigned*)(L + S_SELM); LAS int* list = (LAS int*)(L + S_LIST);
    LAS int* misc = (LAS int*)(L + S_MISC); LAS unsigned* tun = (LAS unsigned*)(L + S_TUN); LAS float* mrg = (LAS float*)(L + S_MRG);
    const int seq = b * 2 + h, tok = 4 * a + ti;
    const size_t row = (size_t)MP + (size_t)b * LS + tok;
    const bf16* qp = C.QB + row * 512 + h * 256 + g * 64 + 8 * q;
    const bf16x8 Q0 = *(const bf16x8*)qp, Q1 = *(const bf16x8*)(qp + 32);
    for (int i = tid; i < 2 * 8448 / 4; i += 512) impA[i] = 0.f;
    const unsigned char* Lt = nullptr; (void)Lt;
    const LAS unsigned char* myK = L + ks * S_TILE; const LAS unsigned char* myV = myK + TILEB;
    f32x4 acc[4], outv[4]; float m = NINF, l = 0.f;
#pragma unroll
    for (int dt = 0; dt < 4; ++dt) { acc[dt] = (f32x4){0.f, 0.f, 0.f, 0.f}; outv[dt] = (f32x4){0.f, 0.f, 0.f, 0.f}; }
    const bf16* kcb = C.KCBS + (size_t)seq * NCS * 64; const bf16* vcb = C.VCBS + (size_t)seq * NCS * 64;
    for (int s = 0; s < 4; ++s) {
        stage4_bf16(L, kcb + (size_t)s * 256 * 64, vcb + (size_t)s * 256 * 64, tid); LDS_FENCE(); __syncthreads();
        { f32x4 sc[4]; qk_tile(myK, Q0, Q1, c, q, sc); mask_tile(sc, q, 0, 1022 - 64 * (4 * s + ks));
          const float mn = fmaxf(m, colmax(sc)), ms = (mn > NINF) ? mn : 0.f; float sum = 0.f;
#pragma unroll
          for (int t = 0; t < 4; ++t) sum += (ex2(sc[t].x - ms) + ex2(sc[t].y - ms)) + (ex2(sc[t].z - ms) + ex2(sc[t].w - ms));
          l = l * ex2(m - ms) + sum; m = mn; }
        __syncthreads();
    }
    merge4(mrg, w, lane, m, l, acc);
    float lt_ = l; lt_ += __shfl_xor(lt_, 16); lt_ += __shfl_xor(lt_, 32);
    const float invC = 1.0f / fmaxf(lt_, 1e-30f), msC = (m > NINF) ? m : 0.f;
    for (int s = 0; s < 4; ++s) {
        stage4_bf16(L, kcb + (size_t)s * 256 * 64, vcb + (size_t)s * 256 * 64, tid); LDS_FENCE(); __syncthreads();
        { f32x4 sc[4]; qk_tile(myK, Q0, Q1, c, q, sc); const int tl = 4 * s + ks; mask_tile(sc, q, 0, 1022 - 64 * tl);
#pragma unroll
          for (int t = 0; t < 4; ++t) { sc[t].x = ex2(sc[t].x - msC) * invC; sc[t].y = ex2(sc[t].y - msC) * invC; sc[t].z = ex2(sc[t].z - msC) * invC; sc[t].w = ex2(sc[t].w - msC) * invC;
              f32x4 ps = sc[t]; ps.x += dpp_xor1(ps.x); ps.y += dpp_xor1(ps.y); ps.z += dpp_xor1(ps.z); ps.w += dpp_xor1(ps.w);
              ps.x += dpp_xor2(ps.x); ps.y += dpp_xor2(ps.y); ps.z += dpp_xor2(ps.z); ps.w += dpp_xor2(ps.w);
              if (g == 0) { const int j = 16 * tl + 4 * t + q; impA[tok * 264 + j] = (ps.x + ps.y) + (ps.z + 0.5f * ps.w); impB[tok * 264 + j + 1] = 0.5f * ps.w; } }
          pv_tile_tr(myV, sc, lane, acc); }
        __syncthreads();
    }
    m = 0.f; l = 0.f;
    merge4(mrg, w, lane, m, l, acc);
    { const float gc = C.GN[row * 32 + (h * 4 + g) * 3 + 0];
#pragma unroll
      for (int dt = 0; dt < 4; ++dt) outv[dt] = acc[dt] * gc; }
    topk_token_s(impA + w * 264, impB + w * 264, lane, selm + w * 12);
    LDS_FENCE(); __syncthreads();
    if (lane < 20 && w == 0) { const int aa = lane / 10, wi = lane % 10; unsigned o = 0u;
#pragma unroll
        for (int i = 0; i < 4; ++i) o |= selm[(4 * aa + i) * 12 + wi];
        tun[aa * 12 + wi] = o; }
    if (w == 1) {
        const unsigned long long lt = (1ull << lane) - 1ull; int base = 0;
#pragma unroll
        for (int k = 0; k < 5; ++k) { unsigned o = 0u; const int wi = 2 * k + (lane >> 5);
#pragma unroll
            for (int i = 0; i < 8; ++i) o |= selm[i * 12 + wi];
            const bool bt = (o >> (lane & 31)) & 1u; const unsigned long long mm = __ballot(bt);
            if (bt) list[base + __popcll(mm & lt)] = 64 * k + lane;
            base += __popcll(mm); }
        if (lane == 0) misc[0] = base;
    }
    LDS_FENCE(); __syncthreads();
    const int nsel = misc[0];
    m = NINF; l = 0.f;
#pragma unroll
    for (int dt = 0; dt < 4; ++dt) acc[dt] = (f32x4){0.f, 0.f, 0.f, 0.f};
    for (int s0 = 0; s0 < nsel; s0 += 4) {
        TileSrc ts[4];
#pragma unroll
        for (int t = 0; t < 4; ++t) { const int j = (s0 + t < nsel) ? list[s0 + t] : -1;
            if (j < 0) { ts[t].k = C.out; ts[t].v = C.out; ts[t].stride = 0; ts[t].nrows = 0; }
            else if (j < 256) { const int page = C.page_table[b * NPAGE + (j >> 1)]; const float* base = C.cache_kv + ((size_t)page * PAGE + (size_t)(j & 1) * 64) * 512 + 2 * 128 + h * 64;
                ts[t].k = base; ts[t].v = base + 128; ts[t].stride = 512; ts[t].nrows = 64; }
            else { const float* base = C.out + O_KVS + ((size_t)b * LS) * 512 + 2 * 128 + h * 64; ts[t].k = base; ts[t].v = base + 128; ts[t].stride = 512; ts[t].nrows = LS; } }
        stage4_f32(L, ts, tid); LDS_FENCE(); __syncthreads();
        if (s0 + ks < nsel) { const int j = list[s0 + ks], wi = j >> 5, bt = j & 31;
            if ((__builtin_amdgcn_readfirstlane(tun[a * 12 + wi]) >> bt) & 1u) {
                f32x4 sc[4]; qk_tile(myK, Q0, Q1, c, q, sc);
                const bool mine = (selm[tok * 12 + wi] >> bt) & 1u;
                mask_tile(sc, q, 0, mine ? (j == 256 ? tok : 63) : -1);
                online_step(sc, true, m, l, acc);
                pv_tile_tr(myV, sc, lane, acc); } }
        __syncthreads();
    }
    merge4(mrg, w, lane, m, l, acc);
    { float lx = l; lx += __shfl_xor(lx, 16); lx += __shfl_xor(lx, 32);
      const float gs = C.GN[row * 32 + (h * 4 + g) * 3 + 1] / fmaxf(lx, 1e-30f);
#pragma unroll
      for (int dt = 0; dt < 4; ++dt) outv[dt] += acc[dt] * gs; }
    m = NINF; l = 0.f;
#pragma unroll
    for (int dt = 0; dt < 4; ++dt) acc[dt] = (f32x4){0.f, 0.f, 0.f, 0.f};
    for (int s0 = 0; s0 < 9; s0 += 4) {
        TileSrc ts[4];
#pragma unroll
        for (int t = 0; t < 4; ++t) { const int i = s0 + t;
            if (i < 8) { const float* base = C.cache_win + (((size_t)b * 512 + (size_t)i * 64) * 2) * 128 + h * 64; ts[t].k = base; ts[t].v = base + 128; ts[t].stride = 256; ts[t].nrows = 64; }
            else if (i == 8) { const float* base = C.out + O_WINS + ((size_t)b * 512 + 504) * 256 + h * 64; ts[t].k = base; ts[t].v = base + 128; ts[t].stride = 256; ts[t].nrows = LS; }
            else { ts[t].k = C.out; ts[t].v = C.out; ts[t].stride = 0; ts[t].nrows = 0; } }
        stage4_f32(L, ts, tid); LDS_FENCE(); __syncthreads();
        { const int i = s0 + ks;
          if (i < 9) { f32x4 sc[4]; qk_tile(myK, Q0, Q1, c, q, sc);
              mask_tile(sc, q, (i == 0) ? tok + 1 : 0, (i == 8) ? tok : 63);
              online_step(sc, true, m, l, acc);
              pv_tile_tr(myV, sc, lane, acc); } }
        __syncthreads();
    }
    merge4(mrg, w, lane, m, l, acc);
    if (ks == 0) { float lx = l; lx += __shfl_xor(lx, 16); lx += __shfl_xor(lx, 32);
        const float gw = C.GN[row * 32 + (h * 4 + g) * 3 + 2] / fmaxf(lx, 1e-30f);
#pragma unroll
        for (int dt = 0; dt < 4; ++dt) { const f32x4 o = outv[dt] + acc[dt] * gw; const int col = h * 256 + g * 64 + 16 * dt + 4 * q;
            const f32x4 z = unpk4(*(const v2u*)(C.SZA + row * 512 + col));
            v2u ov; ov.x = pk2(o.x * z.x, o.y * z.y); ov.y = pk2(o.z * z.z, o.w * z.w);
            *(v2u*)(C.OA + row * 512 + col) = ov; } }
}
template <int MODE> __device__ __forceinline__ void p5_attn(const Ctx& C, const int qoff = 0, const bool do_s = true, const bool do_p = true) {
    LAS int* misc = (LAS int*)(C.lds + MISC_OFF + 128);
    unsigned* qctr = (unsigned*)(C.ws + WS_CTL) + CW_QCTR + qoff;
    for (;;) {
        if (C.tid == 0) misc[1] = (int)atomicAdd(qctr, 1u);
        __syncthreads();
        const int u = misc[1];
        __syncthreads();
        if (u >= BS * 2) break;
        if (!(MODE & 16) && do_s) attn_sample_unit(C, u >> 1, u & 1);
    }
    int nextv = 0;
    if (C.tid == 0) nextv = (int)atomicAdd(qctr + 64, 1u);
    for (;;) {
        if (C.tid == 0) misc[1] = nextv;
        __syncthreads();
        const int v = misc[1];
        __syncthreads();
        if (v >= BP * 2 * 128) break;
        if (C.tid == 0) nextv = (int)atomicAdd(qctr + 64, 1u);
        const int T = 127 - (v >> 3), sq = v & 7; if (do_p) attn_prompt_unit<MODE>(C, sq >> 1, sq & 1, T);
    }
}


template <class F>
__device__ __forceinline__ void skinny_gemm(const Ctx& C, const bf16* A, const bf16* Bt, int N, int K, const F& epi) {
    const int lane = C.lane, m = lane & 15, q = lane >> 4, nitems = (N >> 4) * 4;
    for (int it = C.gw; it < nitems; it += C.NGW) {
        const int s = it >> 2, rg = it & 3;
        const bf16* ap = A + (size_t)(64 * rg + m) * K + 8 * q; const bf16* bp = Bt + (size_t)(16 * s + m) * K + 8 * q;
        f32x4 acc[4];
#pragma unroll
        for (int mt = 0; mt < 4; ++mt) acc[mt] = (f32x4){0.f, 0.f, 0.f, 0.f};
#pragma unroll 8
        for (int ks = 0; ks < (K >> 5); ++ks) { const bf16x8 b = *(const bf16x8*)(bp + 32 * ks);
#pragma unroll
            for (int mt = 0; mt < 4; ++mt) acc[mt] = MFMA16(*(const bf16x8*)(ap + (size_t)mt * 16 * K + 32 * ks), b, acc[mt]); }
#pragma unroll
        for (int mt = 0; mt < 4; ++mt)
#pragma unroll
            for (int r = 0; r < 4; ++r) epi(64 * rg + 16 * mt + 4 * q + r, 16 * s + m, acc[mt][r]);
    }
}
template <class F>
__device__ __forceinline__ void skinny_gemm2(const Ctx& C, const bf16* A0, const bf16* Bt0, const bf16* A1, const bf16* Bt1, int N, int K, const F& epi) {
    const int lane = C.lane, m = lane & 15, q = lane >> 4, nitems = (N >> 4) * 4;
    for (int it = C.gw; it < nitems; it += C.NGW) {
        const int s = it >> 2, rg = it & 3;
        f32x4 acc0[4], acc1[4];
#pragma unroll
        for (int mt = 0; mt < 4; ++mt) { acc0[mt] = (f32x4){0.f, 0.f, 0.f, 0.f}; acc1[mt] = (f32x4){0.f, 0.f, 0.f, 0.f}; }
        { const bf16* ap = A0 + (size_t)(64 * rg + m) * K + 8 * q; const bf16* bp = Bt0 + (size_t)(16 * s + m) * K + 8 * q;
#pragma unroll 8
          for (int ks = 0; ks < (K >> 5); ++ks) { const bf16x8 b = *(const bf16x8*)(bp + 32 * ks);
#pragma unroll
              for (int mt = 0; mt < 4; ++mt) acc0[mt] = MFMA16(*(const bf16x8*)(ap + (size_t)mt * 16 * K + 32 * ks), b, acc0[mt]); } }
        { const bf16* ap = A1 + (size_t)(64 * rg + m) * K + 8 * q; const bf16* bp = Bt1 + (size_t)(16 * s + m) * K + 8 * q;
#pragma unroll 8
          for (int ks = 0; ks < (K >> 5); ++ks) { const bf16x8 b = *(const bf16x8*)(bp + 32 * ks);
#pragma unroll
              for (int mt = 0; mt < 4; ++mt) acc1[mt] = MFMA16(*(const bf16x8*)(ap + (size_t)mt * 16 * K + 32 * ks), b, acc1[mt]); } }
#pragma unroll
        for (int mt = 0; mt < 4; ++mt)
#pragma unroll
            for (int r = 0; r < 4; ++r) epi(64 * rg + 16 * mt + 4 * q + r, 16 * s + m, acc0[mt][r], acc1[mt][r]);
    }
}
__device__ __forceinline__ float bf2f1(bf16 v) { return __uint_as_float(((unsigned)v) << 16); }
struct SkIn {
    bf16 *QB, *KVB, *SZA, *SZS, *GM; float *U32, *GN, *out;
    __device__ __forceinline__ void operator()(int r, int c, float v) const {
        const size_t row = (size_t)MP + r;
        if (c < 512) QB[row * 512 + c] = (bf16)f2bf(v * QSCALE);
        else if (c < 1280) { const int kc = c - 512; KVB[row * 768 + kc] = (bf16)f2bf(v);
            if (kc < 512) out[O_KVS + (size_t)r * 512 + kc] = v; else out[O_WINS + ((size_t)(r >> 3) * 512 + 504 + (r & 7)) * 256 + (kc - 512)] = v; }
        else if (c < 1792) SZA[row * 512 + (c - 1280)] = (bf16)f2bf(v * sigmf(v));
        else if (c < 2304) U32[row * 512 + (c - 1792)] = v;
        else if (c < 2816) SZS[row * 512 + (c - 2304)] = (bf16)f2bf(v * sigmf(v));
        else if (c < 4864) GM[row * 2048 + (c - 2816)] = (bf16)f2bf(sigmf(v));
        else if (c < 4888) GN[row * 32 + (c - 4864)] = sigmf(v);
    }
};
struct SkGlu {
    bf16* YB; const bf16* Y1B; const bf16* SZS; const float* bias;
    __device__ __forceinline__ void operator()(int r, int c, float v) const { const size_t i = ((size_t)MP + r) * 512 + c; YB[i] = (bf16)f2bf(bf2f1(Y1B[i]) * sigmf(v + bias[c]) * bf2f1(SZS[i])); }
};
struct SkLift2 {
    bf16* MG; const bf16* GM;
    __device__ __forceinline__ void operator()(int r, int c, float vs, float va) const { const size_t row = (size_t)MP + r;
        MG[row * 1024 + c] = (bf16)f2bf(bf2f1(GM[row * 2048 + c]) * va + bf2f1(GM[row * 2048 + 1024 + c]) * vs); }
};
struct SkOut {
    bf16* YPB; const float* xs;
    __device__ __forceinline__ void operator()(int r, int c, float v) const { YPB[((size_t)MP + r) * 1024 + c] = (bf16)f2bf(xs[(size_t)r * 1024 + c] + v); }
};
__device__ __forceinline__ void p9_final(const Ctx& C) {
    const bf16* YPB = (const bf16*)(C.ws + WS_YPB);
    for (int m0 = C.gw; m0 < MT; m0 += 4 * C.NGW) {
        v4u p[4][2];
#pragma unroll
        for (int u = 0; u < 4; ++u) { const int m = m0 + u * C.NGW < MT ? m0 + u * C.NGW : m0;
#pragma unroll
            for (int j = 0; j < 2; ++j) p[u][j] = *(const v4u*)(YPB + (size_t)m * D + 512 * j + 8 * C.lane); }
#pragma unroll
        for (int u = 0; u < 4; ++u) { const int m = m0 + u * C.NGW; if (m >= MT) break;
            f32x4 v[4]; float s = 0.f;
#pragma unroll
            for (int j = 0; j < 2; ++j) { const v4u pp = p[u][j];
                v[2 * j] = (f32x4){__uint_as_float(pp.x << 16), __uint_as_float(pp.x & 0xffff0000u), __uint_as_float(pp.y << 16), __uint_as_float(pp.y & 0xffff0000u)};
                v[2 * j + 1] = (f32x4){__uint_as_float(pp.z << 16), __uint_as_float(pp.z & 0xffff0000u), __uint_as_float(pp.w << 16), __uint_as_float(pp.w & 0xffff0000u)}; }
#pragma unroll
            for (int j = 0; j < 4; ++j) s += (v[j].x * v[j].x + v[j].y * v[j].y) + (v[j].z * v[j].z + v[j].w * v[j].w);
            const float r = rsqrtf(wave_sum(s) * (1.f / D) + RMS_EPS);
#pragma unroll
            for (int j = 0; j < 4; ++j) { const int col = 512 * (j >> 1) + 8 * C.lane + 4 * (j & 1);
                *(f32x4*)(C.out + (size_t)m * D + col) = v[j] * r * *(const f32x4*)(C.final_g + col); } }
    }
    for (int it = C.gw; it < BS * 504; it += C.NGW) { const int b = it / 504, i = it % 504;
        ((f32x4*)(C.out + O_WINS + ((size_t)b * 512 + i) * 256))[C.lane] = ((const f32x4*)(C.cache_win + ((size_t)b * 512 + i + 8) * 256))[C.lane]; }
}

constexpr int N_PHASES = 8;
struct Args { const void* in[27]; float* out; unsigned char* ws; int ph_lo, ph_hi; };
__device__ __forceinline__ int lane_id() { return (int)__builtin_amdgcn_mbcnt_hi(~0u, __builtin_amdgcn_mbcnt_lo(~0u, 0u)); }
__device__ __forceinline__ void make_ctx(Ctx& C, const Args& a, unsigned char* lds_raw, const int wv) {
    C.lds = (LAS unsigned char*)lds_raw; C.wave = wv; C.lane = lane_id(); C.tid = wv * 64 + C.lane;
    C.G = gridDim.x; C.gw = blockIdx.x * NWAVES + C.wave; C.NGW = C.G * NWAVES;
    C.xp = (const float*)a.in[0]; C.xs = (const float*)a.in[1]; C.cache_kv = (const float*)a.in[2]; C.cache_win = (const float*)a.in[3]; C.st_re = (const float*)a.in[4]; C.st_im = (const float*)a.in[5];
    C.page_table = (const int*)a.in[6]; C.norm_g = (const float*)a.in[7]; C.w_in = (const float*)a.in[8]; C.cmp_pe = (const float*)a.in[9]; C.cmp_w1 = (const float*)a.in[10]; C.cmp_b1 = (const float*)a.in[11];
    C.cmp_w2 = (const float*)a.in[12]; C.lam_re = (const float*)a.in[13]; C.lam_im = (const float*)a.in[14]; C.log_dt = (const float*)a.in[15]; C.b_re = (const float*)a.in[16]; C.b_im = (const float*)a.in[17];
    C.c_re = (const float*)a.in[18]; C.c_im = (const float*)a.in[19]; C.ssm_d = (const float*)a.in[20]; C.w_glu = (const float*)a.in[21]; C.b_glu = (const float*)a.in[22]; C.w_la = (const float*)a.in[23];
    C.w_ls = (const float*)a.in[24]; C.w_out = (const float*)a.in[25]; C.final_g = (const float*)a.in[26];
    C.out = a.out; C.ws = a.ws; unsigned char* ws = a.ws;
    C.WTIN = (bf16*)(ws + WS_WTIN); C.WTGLU = (bf16*)(ws + WS_WTGLU); C.WTLA = (bf16*)(ws + WS_WTLA); C.WTLS = (bf16*)(ws + WS_WTLS); C.WTOUT = (bf16*)(ws + WS_WTOUT); C.WTC1 = (bf16*)(ws + WS_WTC1);
    C.XN = (bf16*)(ws + WS_XN); C.OA = (bf16*)(ws + WS_OA); C.Y1B = (bf16*)(ws + WS_Y1B); C.YB = (bf16*)(ws + WS_YB); C.MG = (bf16*)(ws + WS_MG); C.XC = (bf16*)(ws + WS_XC);
    C.KST = (float*)(ws + WS_CONST); C.SEND = (float*)(ws + WS_SEND); C.KC = (float*)(ws + WS_KC); C.VC = (float*)(ws + WS_VC); C.Y1 = (float*)(ws + WS_Y1); C.MB = (float*)(ws + WS_MB);
    C.PP = (float*)(ws + WS_PP); C.U32 = (float*)(ws + WS_U32); C.GN = (float*)(ws + WS_GN);
    C.KVB = (bf16*)(ws + WS_KVB); C.SZA = (bf16*)(ws + WS_SZA); C.SZS = (bf16*)(ws + WS_SZS); C.GM = (bf16*)(ws + WS_GM);
    C.QB = (bf16*)(ws + WS_QB); C.VST = (bf16*)(ws + WS_VST); C.VWT = (bf16*)(ws + WS_VWT); C.KCB = (bf16*)(ws + WS_KCB); C.VCT = (bf16*)(ws + WS_VCT); C.KCBS = (bf16*)(ws + WS_KCBS); C.VCBS = (bf16*)(ws + WS_VCBS);
}
__global__ void __launch_bounds__(NWAVES * 64, 2) mk_fwd(Args a) {
    extern __shared__ __attribute__((aligned(16))) unsigned char lds_raw[];
    unsigned char* ws = a.ws;
    volatile LAS unsigned* MISC = (volatile LAS unsigned*)((LAS unsigned char*)lds_raw + MISC_OFF);
    const int wv = __builtin_amdgcn_readfirstlane((int)threadIdx.x >> 6);
    if (wv == 0) MISC[lane_id()] = 0u;
    __syncthreads();
    const int lo = a.ph_lo, hi = a.ph_hi;
    const bool multi = (hi - lo) > 1;
    XcdBarrier bar; bar.bar = (unsigned*)(ws + WS_CTL) + CW_BAR; bar.x = 0; bar.st = nullptr;
    if (multi) bar = xcd_barrier_post((unsigned*)(ws + WS_CTL) + CW_BAR, MISC + 8, wv * 64 + lane_id());
#define IN(k) (lo <= (k) && (k) < hi)
#define MK Ctx C; make_ctx(C, a, lds_raw, wv)
#define SEAM(k) do { if (IN(k) && IN((k) + 1)) xcd_barrier(bar, wv * 64 + lane_id()); } while (0)
    if (IN(0)) { MK; p0_prep(C);
#if defined(REPEAT_WHAT) && REPEAT_WHAT == 0
        __syncthreads(); p0_prep(C);
#endif
    } SEAM(0);
    if (IN(1)) { MK; pg8::Gemm g{C.XN, C.WTIN, MP, NINP, D}; pg8::StaticOrder S; S.init(MP, NINP, C.G, (int)blockIdx.x);
        pg8::EpiIn E{C.QB, C.KVB, C.SZA, C.SZS, C.GM, C.XC, C.U32, C.GN, C.out, QSCALE, MP, O_KVP, O_KVS, O_WINP, O_WINS, (size_t)XC_S_ROWS};
        pg8::gemm_phase<pg8::EpiIn, pg8::StaticOrder, true, true>(C.lds, g, S, E, C.tid);
        SkIn K{C.QB, C.KVB, C.SZA, C.SZS, C.GM, C.U32, C.GN, C.out}; skinny_gemm(C, C.XN + (size_t)MP * D, C.WTIN, NINP, D, K);
#if defined(REPEAT_WHAT) && REPEAT_WHAT == 11
        skinny_gemm(C, C.XN + (size_t)MP * D, C.WTIN, NINP, D, K);
#endif
    } SEAM(1);
    if (IN(2)) { MK; p2_cmp1(C); __syncthreads(); p2_ssm_pass1(C); __syncthreads(); p3_ssm_pass2(C, true);
#if defined(REPEAT_WHAT) && REPEAT_WHAT == 21
        __syncthreads(); p2_cmp1(C);
#endif
#if defined(REPEAT_WHAT) && REPEAT_WHAT == 22
        __syncthreads();
#endif
#if defined(REPEAT_WHAT) && REPEAT_WHAT == 23
        __syncthreads(); p2_ssm_pass1(C);
#endif
    } SEAM(2);
    if (IN(3)) { MK; p3_ssm_pass2(C, false); __syncthreads(); p4_cmp2(C);
#if defined(REPEAT_WHAT) && REPEAT_WHAT == 31
        for (int rr = 0; rr < 4; ++rr) { __syncthreads(); p3_ssm_pass2(C, false); }
#endif
#if defined(REPEAT_WHAT) && REPEAT_WHAT == 32
        __syncthreads(); p4_cmp2(C);
#endif
    } SEAM(3);
    if (IN(4)) { MK; { pg8::Gemm g{C.Y1B, C.WTGLU, MP, 512, 512}; pg8::StaticOrder S; S.init(MP, 512, C.G, (int)blockIdx.x); pg8::EpiGlu E{C.YB, C.Y1B, C.SZS, C.b_glu};
        pg8::gemm_phase<pg8::EpiGlu, pg8::StaticOrder, true, true>(C.lds, g, S, E, C.tid);
        SkGlu K{C.YB, C.Y1B, C.SZS, C.b_glu}; skinny_gemm(C, C.Y1B + (size_t)MP * 512, C.WTGLU, 512, 512, K); }
        __syncthreads(); p5_attn<0>(C);
#if defined(REPEAT_WHAT) && REPEAT_WHAT == 41
        __syncthreads(); p5_attn<0>(C, 128);
#endif
#if defined(REPEAT_WHAT) && REPEAT_WHAT == 42
        __syncthreads(); p5_attn<0>(C, 128, false, true);
#endif
#if defined(REPEAT_WHAT) && REPEAT_WHAT >= 400
        __syncthreads(); p5_attn<REPEAT_WHAT - 400>(C, 128, false, true);
#endif
#if defined(REPEAT_WHAT) && REPEAT_WHAT == 43
        __syncthreads(); p5_attn<0>(C, 128, true, false);
#endif
    } SEAM(4);
    if (IN(5)) { MK; pg8::Gemm g{C.YB, C.WTLS, MP, 1024, 512, C.OA, C.WTLA}; pg8::PairOrder S; S.init(MP, 1024, C.G, (int)blockIdx.x); pg8::EpiLift2 E{C.MG, C.GM};
        pg8::gemm_phase<pg8::EpiLift2, pg8::PairOrder, true, true>(C.lds, g, S, E, C.tid);
        SkLift2 K{C.MG, C.GM}; skinny_gemm2(C, C.YB + (size_t)MP * 512, C.WTLS, C.OA + (size_t)MP * 512, C.WTLA, 1024, 512, K);
#if defined(REPEAT_WHAT) && REPEAT_WHAT == 5
        __syncthreads(); pg8::gemm_phase<pg8::EpiLift2, pg8::PairOrder, true, true>(C.lds, g, S, E, C.tid);
#endif
    } SEAM(5);
    if (IN(6)) { MK; pg8::Gemm g{C.MG, C.WTOUT, MP, 1024, 1024}; pg8::StaticOrder S; S.init(MP, 1024, C.G, (int)blockIdx.x); pg8::EpiOut E{(bf16*)(C.ws + WS_YPB), C.xp, C.xs, MP};
        pg8::gemm_phase<pg8::EpiOut, pg8::StaticOrder, true, true>(C.lds, g, S, E, C.tid);
        SkOut K{(bf16*)(C.ws + WS_YPB), C.xs}; skinny_gemm(C, C.MG + (size_t)MP * 1024, C.WTOUT, 1024, 1024, K); } SEAM(6);
    if (IN(7)) { MK; p9_final(C);
#if defined(REPEAT_WHAT) && REPEAT_WHAT == 71
        __syncthreads(); { pg8::Gemm g{C.XN, C.WTIN, MP, NINP, D}; pg8::StaticOrder S; S.init(MP, NINP, C.G, (int)blockIdx.x);
        pg8::EpiIn E{C.QB, C.KVB, C.SZA, C.SZS, C.GM, C.XC, C.U32, C.GN, C.out, QSCALE, MP, O_KVP, O_KVS, O_WINP, O_WINS, (size_t)XC_S_ROWS};
        pg8::gemm_phase<pg8::EpiIn, pg8::StaticOrder, true, true>(C.lds, g, S, E, C.tid); }
#endif
#if defined(REPEAT_WHAT) && REPEAT_WHAT == 72
        __syncthreads(); { pg8::Gemm g{C.YB, C.WTLS, MP, 1024, 512, C.OA, C.WTLA}; pg8::PairOrder S; S.init(MP, 1024, C.G, (int)blockIdx.x); pg8::EpiLift2 E{C.MG, C.GM};
        pg8::gemm_phase<pg8::EpiLift2, pg8::PairOrder, true, true>(C.lds, g, S, E, C.tid); }
#endif
    }
#undef IN
#undef SEAM
}

#ifndef MK_ONE_LAUNCH
#define MK_ONE_LAUNCH 1
#endif
extern "C" void kernel_launch(void* const* d_in, const int* in_sizes, int n_in, void* d_out, int out_size, void* d_ws, size_t ws_size, hipStream_t stream) {
    static int grid = 0;
    if (grid == 0) {
        if (n_in != 27 || (size_t)out_size != O_END || ws_size < WS_END) { fprintf(stderr, "kernel_launch: unexpected shapes: n_in %d out %d ws %zu\n", n_in, out_size, ws_size); grid = -1; return; }
        int dev = 0, cus = 0, per_cu = 0;
        if (hipGetDevice(&dev) != hipSuccess || hipDeviceGetAttribute(&cus, hipDeviceAttributeMultiprocessorCount, dev) != hipSuccess) { grid = -1; return; }
        if (hipFuncSetAttribute((const void*)mk_fwd, hipFuncAttributeMaxDynamicSharedMemorySize, LDS_BYTES) != hipSuccess) { fprintf(stderr, "kernel_launch: hipFuncSetAttribute failed\n"); grid = -1; return; }
        if (hipOccupancyMaxActiveBlocksPerMultiprocessor(&per_cu, (const void*)mk_fwd, NWAVES * 64, LDS_BYTES) != hipSuccess || per_cu < 1) fprintf(stderr, "kernel_launch: occupancy query reports %d\n", per_cu);
        (void)hipGetLastError();
        grid = cus;
    }
    if (grid < 0) return;
    (void)hipMemsetAsync((char*)d_ws + WS_CTL, 0, CTL_ZERO_BYTES, stream);
    Args a{};
    for (int i = 0; i < 27; ++i) a.in[i] = d_in[i];
    a.out = (float*)d_out; a.ws = (unsigned char*)d_ws;
#if MK_ONE_LAUNCH
    a.ph_lo = 0; a.ph_hi = N_PHASES;
    hipLaunchKernelGGL(mk_fwd, dim3(grid), dim3(NWAVES * 64), LDS_BYTES, stream, a);
#else
    for (int p = 0; p < N_PHASES; ++p) { a.ph_lo = p; a.ph_hi = p + 1; hipLaunchKernelGGL(mk_fwd, dim3(grid), dim3(NWAVES * 64), LDS_BYTES, stream, a); }
#endif
}
```
